# Optimizing an MI355X kernel written in HIP

```python
import math
import jax
import jax.numpy as jnp
from jax import lax
import numpy as np

D_MODEL = 2048
BATCH = 1
SEQ = 16384
DEPTH = 2

GRID_W = 64
CTX_LEN = 256
N_EVEN = (DEPTH + 1) // 2
N_ODD = DEPTH // 2

HY_WIDTH = D_MODEL // 2
HY_ORDER = 2
HY_EMB = 33
HY_BANDS = (HY_EMB - 1) // 2
HY_FILTER_HIDDEN = 64
HY_DECAY_TARGET = 1e-2
HY_FAST_PCT = 0.3
HY_SLOW_PCT = 1.5
HY_SHORT = 3
NA_HEADS = 8
NA_HEAD_DIM = (D_MODEL // 2) // NA_HEADS
NA_WIN_ROWS = 8
NA_WIN_COLS = 16
ML_HEADS = 8
ML_V_DIM = D_MODEL // ML_HEADS
ML_QK_DIM = ML_V_DIM // 2
ML_CHUNK = 64
ML_SHORT = 3
ML_M0 = -1e30
ROPE_BASE = 10000.0
PEER_HEADS = 8
PEER_NKEYS = 128
PEER_EXPERTS = PEER_NKEYS * PEER_NKEYS
PEER_TOPK = 16
PEER_QDIM = 256
PEER_BLOCK = 128

LN_EPS = 1e-6
DEEPNORM_ALPHA = (2 * DEPTH) ** 0.25
DEEPNORM_BETA = (8 * DEPTH) ** -0.25

kernel_name = 'hybrid_hyena_natten_mlstm_peer_dit'


def layer_norm(x, w, b):
    xf = x.astype(jnp.float32)
    mu = jnp.mean(xf, axis=-1, keepdims=True)
    var = jnp.mean(jnp.square(xf - mu), axis=-1, keepdims=True)
    return ((xf - mu) * lax.rsqrt(var + LN_EPS) * w + b).astype(x.dtype)


def short_conv(z, w, b):
    n_taps, seq_len = w.shape[0], z.shape[1]
    pad = n_taps // 2
    zp = jnp.pad(z, ((0, 0), (pad, pad), (0, 0)))
    out = b
    for j in range(n_taps):
        out = out + zp[:, j:j + seq_len] * w[j]
    return out


def hyena_filters(seq_len, w1, b1, w2, b2, w3, b3, w4):
    t = jnp.linspace(0.0, 1.0, seq_len, dtype=jnp.float32)[:, None]
    omega = 2.0 * math.pi * jnp.arange(seq_len, dtype=jnp.float32) / seq_len
    freqs = jnp.linspace(1e-4, HY_BANDS - 1, HY_BANDS, dtype=jnp.float32)
    ang = omega[:, None] * freqs[None, :]
    feats = jnp.concatenate([t, jnp.cos(ang), -jnp.sin(ang)], axis=-1).astype(w1.dtype)
    h = jnp.sin(feats @ w1 + b1)
    h = jnp.sin(h @ w2 + b2)
    h = jnp.sin(h @ w3 + b3)
    h = (h @ w4).astype(jnp.float32).reshape(seq_len, 2, HY_ORDER, HY_WIDTH)
    max_decay = math.log(HY_DECAY_TARGET) / HY_FAST_PCT
    min_decay = math.log(HY_DECAY_TARGET) / HY_SLOW_PCT
    deltas = jnp.abs(jnp.linspace(min_decay, max_decay, HY_WIDTH, dtype=jnp.float32))
    window = jnp.exp(-t * deltas[None, :])
    return h * window[:, None, None, :]


def bidir_long_conv(z, h_fwd, h_bwd, skip):
    seq_len, ch = z.shape[1], z.shape[2]
    taps = jnp.concatenate([h_fwd, jnp.zeros((1, ch), jnp.float32), h_bwd[:0:-1]], axis=0)
    zf = z.astype(jnp.float32)
    spec = jnp.fft.rfft(zf, n=2 * seq_len, axis=1) * jnp.fft.rfft(taps, axis=0)[None]
    y = jnp.fft.irfft(spec, n=2 * seq_len, axis=1)[:, :seq_len]
    return (y + zf * skip.astype(jnp.float32)).astype(z.dtype)


def hyena_mix(proj, conv_w, conv_b, filt, skip):
    zc = short_conv(proj, conv_w, conv_b)
    z = zc[..., :HY_WIDTH]
    for o in range(HY_ORDER):
        gate = zc[..., (o + 1) * HY_WIDTH:(o + 2) * HY_WIDTH]
        z = gate * bidir_long_conv(z, filt[:, 0, o], filt[:, 1, o], skip[o])
    return z


def rope_2d(x):
    seq_len, d = x.shape[1], x.shape[-1]
    quarter = d // 4
    pos = jnp.arange(seq_len)
    inv = ROPE_BASE ** (-jnp.arange(quarter, dtype=jnp.float32) / quarter)

    def rot(y, p):
        ang = p.astype(jnp.float32)[:, None] * inv[None]
        cos, sin = jnp.cos(ang)[None, :, None], jnp.sin(ang)[None, :, None]
        y1, y2 = y[..., :quarter], y[..., quarter:]
        return jnp.concatenate([y1 * cos - y2 * sin, y1 * sin + y2 * cos], axis=-1)

    xf = x.astype(jnp.float32)
    out = jnp.concatenate([rot(xf[..., :2 * quarter], pos // GRID_W), rot(xf[..., 2 * quarter:], pos % GRID_W)], axis=-1)
    return out.astype(x.dtype)


def neighbourhood_attention(q, k, v, k_ctx, v_ctx, rpb):
    bsz, seq_len, heads, hd = q.shape
    rows = seq_len // GRID_W
    kr, kc = min(NA_WIN_ROWS, rows), NA_WIN_COLS
    scale = hd ** -0.5
    qg = q.reshape(bsz, rows, GRID_W, heads, hd)
    kg = k.reshape(bsz, rows, GRID_W, heads, hd)
    vg = v.reshape(bsz, rows, GRID_W, heads, hd)
    cols = np.arange(GRID_W)
    col_idx = np.clip(cols - kc // 2, 0, GRID_W - kc)[:, None] + np.arange(kc)[None]
    col_off = col_idx - cols[:, None] + NA_WIN_COLS - 1
    rpb_cols = rpb[:, :, col_off]

    def row_block(r):
        r0 = jnp.clip(r - kr // 2, 0, rows - kr)
        q_r = lax.dynamic_index_in_dim(qg, r, axis=1, keepdims=False)
        k_nb = lax.dynamic_slice_in_dim(kg, r0, kr, axis=1)[:, :, col_idx]
        v_nb = lax.dynamic_slice_in_dim(vg, r0, kr, axis=1)[:, :, col_idx]
        row_off = r0 + jnp.arange(kr) - r + NA_WIN_ROWS - 1
        bias = jnp.take(rpb_cols, row_off, axis=1).transpose(0, 2, 1, 3)
        s_lat = jnp.einsum('bqhd,brqkhd->bhqrk', q_r, k_nb) * scale + bias[None]
        s_ctx = jnp.einsum('bqhd,bchd->bhqc', q_r, k_ctx) * scale
        s = jnp.concatenate([s_lat.reshape(bsz, heads, GRID_W, kr * kc), s_ctx], axis=-1)
        p = jax.nn.softmax(s.astype(jnp.float32), axis=-1).astype(v.dtype)
        p_lat = p[..., :kr * kc].reshape(bsz, heads, GRID_W, kr, kc)
        return (jnp.einsum('bhqrk,brqkhd->bqhd', p_lat, v_nb)
                + jnp.einsum('bhqc,bchd->bqhd', p[..., kr * kc:], v_ctx))

    out = lax.map(row_block, jnp.arange(rows))
    return jnp.moveaxis(out, 0, 1).reshape(bsz, seq_len, heads * hd)


def context_attention(q, k, v):
    bsz, n, heads, hd = q.shape
    s = jnp.einsum('bqhd,bkhd->bhqk', q, k) * hd ** -0.5
    p = jax.nn.softmax(s.astype(jnp.float32), axis=-1).astype(v.dtype)
    return jnp.einsum('bhqk,bkhd->bqhd', p, v).reshape(bsz, n, heads * hd)


def hyena_na_mixer(u_lat, u_ctx, w_in, conv_w, conv_b, fw1, fb1, fw2, fb2, fw3, fb3, fw4, skip, rpb, w_out, with_ctx):
    bsz, seq_len, _ = u_lat.shape
    n_ctx = u_ctx.shape[1]
    split = 3 * HY_WIDTH
    na_w = NA_HEADS * NA_HEAD_DIM
    p_lat = u_lat @ w_in
    hy_lat = hyena_mix(p_lat[..., :split], conv_w, conv_b,
                       hyena_filters(seq_len, fw1, fb1, fw2, fb2, fw3, fb3, fw4), skip)
    qkv = p_lat[..., split:].reshape(bsz, seq_len, 3, NA_HEADS, NA_HEAD_DIM)
    if with_ctx:
        p_ctx = u_ctx @ w_in
        qkv_c = p_ctx[..., split:].reshape(bsz, n_ctx, 3, NA_HEADS, NA_HEAD_DIM)
        k_c, v_c = qkv_c[:, :, 1], qkv_c[:, :, 2]
    else:
        kv_c = (u_ctx @ w_in[:, split + na_w:]).reshape(bsz, n_ctx, 2, NA_HEADS, NA_HEAD_DIM)
        k_c, v_c = kv_c[:, :, 0], kv_c[:, :, 1]
    na_lat = neighbourhood_attention(qkv[:, :, 0], qkv[:, :, 1], qkv[:, :, 2], k_c, v_c, rpb)
    y_lat = jnp.concatenate([hy_lat, na_lat], axis=-1) @ w_out
    if not with_ctx:
        return y_lat, None
    hy_ctx = hyena_mix(p_ctx[..., :split], conv_w, conv_b,
                       hyena_filters(n_ctx, fw1, fb1, fw2, fb2, fw3, fb3, fw4), skip)
    na_ctx = context_attention(qkv_c[:, :, 0], k_c, v_c)
    y_ctx = jnp.concatenate([hy_ctx, na_ctx], axis=-1) @ w_out
    return y_lat, y_ctx


def mlstm_chunkwise(k, v, log_i, log_f, state, q=None):
    bsz, seq_len, heads, _ = k.shape
    n_chunks = seq_len // ML_CHUNK

    def chunks(a):
        a = a.astype(jnp.float32)
        return jnp.moveaxis(a.reshape(bsz, n_chunks, ML_CHUNK, *a.shape[2:]), 1, 0)

    xs = (chunks(k), chunks(v), chunks(log_i), chunks(log_f))
    if q is not None:
        xs = xs + (chunks(q),)
    lower = jnp.tril(jnp.ones((ML_CHUNK, ML_CHUNK), dtype=bool))

    def step(carry, xc):
        c_mat, n_vec, m = carry
        kc, vc, ic, fc = xc[:4]
        b = jnp.cumsum(fc, axis=1)
        b_end = b[:, -1]
        w_log = b_end[:, None] - b + ic
        m_new = jnp.maximum(b_end + m, jnp.max(w_log, axis=1))
        carry_decay = jnp.exp(b_end + m - m_new)
        w = jnp.exp(w_log - m_new[:, None])
        c_new = carry_decay[..., None, None] * c_mat + jnp.einsum('bshv,bshd->bhvd', vc * w[..., None], kc)
        n_new = carry_decay[..., None] * n_vec + jnp.einsum('bsh,bshd->bhd', w, kc)
        if q is None:
            return (c_new, n_new, m_new), None
        qc = xc[4]
        log_d = jnp.where(lower[None, :, :, None], b[:, :, None] - b[:, None] + ic[:, None], -jnp.inf)
        m_in = b + m[:, None]
        m_t = jnp.maximum(m_in, jnp.max(log_d, axis=2))
        scores = jnp.einsum('bthd,bshd->btsh', qc, kc) * jnp.exp(log_d - m_t[:, :, None])
        g_in = jnp.exp(m_in - m_t)
        num = (jnp.einsum('btsh,bshv->bthv', scores, vc)
               + jnp.einsum('bthd,bhvd->bthv', qc, c_mat) * g_in[..., None])
        den = jnp.sum(scores, axis=2) + jnp.einsum('bthd,bhd->bth', qc, n_vec) * g_in
        h = num / jnp.maximum(jnp.abs(den), jnp.exp(-m_t))[..., None]
        return (c_new, n_new, m_new), h

    state, hs = lax.scan(step, state, xs)
    if q is None:
        return state, None
    return state, jnp.moveaxis(hs, 0, 1).reshape(bsz, seq_len, heads, v.shape[-1])


def _flip(a):
    return None if a is None else jnp.flip(a, axis=1)


def mlstm_mixer(u_lat, u_ctx, w_in, b_gates, conv_w, conv_b, norm_w, w_out, with_ctx):
    bsz = u_lat.shape[0]
    heads, dk, dv = ML_HEADS, ML_QK_DIM, ML_V_DIM
    qk_w, v_w = heads * dk, heads * dv
    g0 = 2 * qk_w + 2 * v_w
    k_scale = dk ** -0.5

    def gate_terms(g):
        g = (g + b_gates).astype(jnp.float32).reshape(g.shape[0], g.shape[1], 4, heads)
        return (g[..., 0, :], jax.nn.log_sigmoid(g[..., 1, :]), g[..., 2, :], jax.nn.log_sigmoid(g[..., 3, :]))

    def split_heads(a, d):
        return a.reshape(a.shape[0], a.shape[1], heads, d)

    p = u_lat @ w_in
    qk = jax.nn.silu(short_conv(p[..., :2 * qk_w], conv_w, conv_b))
    q_l = rope_2d(split_heads(qk[..., :qk_w], dk))
    k_l = rope_2d(split_heads(qk[..., qk_w:], dk)) * k_scale
    v_l = split_heads(p[..., 2 * qk_w:2 * qk_w + v_w], dv)
    o_l = p[..., 2 * qk_w + v_w:g0]
    g_l = gate_terms(p[..., g0:])
    if with_ctx:
        pc = u_ctx @ w_in
        qkc = jax.nn.silu(short_conv(pc[..., :2 * qk_w], conv_w, conv_b))
        q_c = split_heads(qkc[..., :qk_w], dk)
        k_c = split_heads(qkc[..., qk_w:], dk) * k_scale
        v_c = split_heads(pc[..., 2 * qk_w:2 * qk_w + v_w], dv)
        o_c = pc[..., 2 * qk_w + v_w:g0]
        g_c = gate_terms(pc[..., g0:])
    else:
        pc = u_ctx @ w_in[:, qk_w:2 * qk_w + v_w]
        k_c = split_heads(jax.nn.silu(short_conv(pc[..., :qk_w], conv_w[:, qk_w:], conv_b[qk_w:])), dk) * k_scale
        v_c = split_heads(pc[..., qk_w:], dv)
        g_c = gate_terms(u_ctx @ w_in[:, g0:])
        q_c, o_c = None, None

    init = (jnp.zeros((bsz, heads, dv, dk), jnp.float32), jnp.zeros((bsz, heads, dk), jnp.float32),
            jnp.full((bsz, heads), ML_M0, jnp.float32))
    st_f, hc_f = mlstm_chunkwise(k_c, v_c, g_c[0], g_c[1], init, q_c)
    st_b, hc_b = mlstm_chunkwise(_flip(k_c), _flip(v_c), _flip(g_c[2]), _flip(g_c[3]), init, _flip(q_c))
    _, hl_f = mlstm_chunkwise(k_l, v_l, g_l[0], g_l[1], st_f, q_l)
    _, hl_b = mlstm_chunkwise(_flip(k_l), _flip(v_l), _flip(g_l[2]), _flip(g_l[3]), st_b, _flip(q_l))

    def merge(h_f, h_b, o):
        h = h_f + jnp.flip(h_b, axis=1)
        mu = jnp.mean(h, axis=-1, keepdims=True)
        var = jnp.mean(jnp.square(h - mu), axis=-1, keepdims=True)
        hn = ((h - mu) * lax.rsqrt(var + LN_EPS)).reshape(h.shape[0], h.shape[1], v_w) * norm_w
        return (hn.astype(o.dtype) * jax.nn.sigmoid(o)) @ w_out

    y_lat = merge(hl_f, hl_b, o_l)
    y_ctx = merge(hc_f, hc_b, o_c) if with_ctx else None
    return y_lat, y_ctx


def peer_ffn(x, wq, k1, k2, u, v):
    n_tok, d = x.shape
    half = PEER_QDIM // 2
    q = (x @ wq).astype(jnp.float32).reshape(n_tok, PEER_HEADS, PEER_QDIM)
    s1 = jnp.einsum('thd,nd->thn', q[..., :half], k1.astype(jnp.float32))
    s2 = jnp.einsum('thd,nd->thn', q[..., half:], k2.astype(jnp.float32))
    v1, i1 = lax.top_k(s1, PEER_TOPK)
    v2, i2 = lax.top_k(s2, PEER_TOPK)
    cand = (v1[..., :, None] + v2[..., None, :]).reshape(n_tok, PEER_HEADS, PEER_TOPK * PEER_TOPK)
    cand_idx = (i1[..., :, None] * PEER_NKEYS + i2[..., None, :]).reshape(n_tok, PEER_HEADS, PEER_TOPK * PEER_TOPK)
    top_s, top_pos = lax.top_k(cand, PEER_TOPK)
    experts = jnp.take_along_axis(cand_idx, top_pos, axis=-1).reshape(n_tok, PEER_HEADS * PEER_TOPK)
    gates = jax.nn.softmax(top_s, axis=-1).reshape(n_tok, PEER_HEADS * PEER_TOPK).astype(x.dtype)
    n_blk = n_tok // PEER_BLOCK

    def block(args):
        xb, eb, gb = args
        act = jnp.einsum('td,tkd->tk', xb, u[eb])
        return jnp.einsum('tk,tkd->td', gb * jax.nn.gelu(act, approximate=False), v[eb])

    y = lax.map(block, (x.reshape(n_blk, PEER_BLOCK, d),
                        experts.reshape(n_blk, PEER_BLOCK, -1),
                        gates.reshape(n_blk, PEER_BLOCK, -1)))
    return y.reshape(n_tok, d)


def setup_inputs(seed: int = 0) -> dict:
    key = jax.random.key(seed)
    ks = iter(jax.random.split(key, 40))

    def nrm(shape, scale):
        return scale * jax.random.normal(next(ks), shape, jnp.float32)

    d = D_MODEL
    na_w = NA_HEADS * NA_HEAD_DIM
    qk_w, v_w = ML_HEADS * ML_QK_DIM, ML_HEADS * ML_V_DIM
    hid = HY_FILTER_HIDDEN
    fb = jnp.linspace(3.0, 6.0, ML_HEADS, dtype=jnp.float32)
    zb = jnp.zeros_like(fb)
    gate_base = jnp.concatenate([zb, fb, zb, fb])
    return {
        'x': nrm((BATCH, SEQ, d), 1.0),
        'c': nrm((BATCH, d), 1.0),
        'ctx': nrm((BATCH, CTX_LEN, d), 1.0),
        'c_ctx': nrm((d,), 1.0),
        'ada_w': nrm((DEPTH, d, 6 * d), d ** -0.5),
        'ada_b': nrm((DEPTH, 6 * d), 0.02),
        'ln_w': 1.0 + nrm((DEPTH, 2, d), 0.02),
        'ln_b': nrm((DEPTH, 2, d), 0.02),
        'ab_w_in': nrm((N_EVEN, d, 3 * HY_WIDTH + 3 * na_w), d ** -0.5),
        'hy_conv_w': nrm((N_EVEN, HY_SHORT, 3 * HY_WIDTH), HY_SHORT ** -0.5),
        'hy_conv_b': nrm((N_EVEN, 3 * HY_WIDTH), 0.02),
        'hy_fw1': nrm((N_EVEN, HY_EMB, hid), HY_EMB ** -0.5),
        'hy_fb1': nrm((N_EVEN, hid), 0.1),
        'hy_fw2': nrm((N_EVEN, hid, hid), hid ** -0.5),
        'hy_fb2': nrm((N_EVEN, hid), 0.1),
        'hy_fw3': nrm((N_EVEN, hid, hid), hid ** -0.5),
        'hy_fb3': nrm((N_EVEN, hid), 0.1),
        'hy_fw4': nrm((N_EVEN, hid, 2 * HY_ORDER * HY_WIDTH), 0.02 * hid ** -0.5),
        'hy_skip': nrm((N_EVEN, HY_ORDER, HY_WIDTH), 0.5),
        'na_rpb': nrm((N_EVEN, NA_HEADS, 2 * NA_WIN_ROWS - 1, 2 * NA_WIN_COLS - 1), 0.02),
        'ab_w_out': nrm((N_EVEN, HY_WIDTH + na_w, d), DEEPNORM_BETA * (HY_WIDTH + na_w) ** -0.5),
        'ml_w_in': jnp.concatenate([nrm((N_ODD, d, 2 * qk_w + 2 * v_w), d ** -0.5),
                                    nrm((N_ODD, d, 4 * ML_HEADS), 0.1 * d ** -0.5)], axis=-1),
        'ml_b_gates': gate_base[None] + nrm((N_ODD, 4 * ML_HEADS), 0.1),
        'ml_conv_w': nrm((N_ODD, ML_SHORT, 2 * qk_w), ML_SHORT ** -0.5),
        'ml_conv_b': nrm((N_ODD, 2 * qk_w), 0.02),
        'ml_norm_w': 1.0 + nrm((N_ODD, v_w), 0.02),
        'ml_w_out': nrm((N_ODD, v_w, d), DEEPNORM_BETA * v_w ** -0.5),
        'peer_wq': nrm((DEPTH, d, PEER_HEADS * PEER_QDIM), d ** -0.5),
        'peer_k1': nrm((DEPTH, PEER_NKEYS, PEER_QDIM // 2), (PEER_QDIM // 2) ** -0.5),
        'peer_k2': nrm((DEPTH, PEER_NKEYS, PEER_QDIM // 2), (PEER_QDIM // 2) ** -0.5),
        'peer_u': nrm((DEPTH, PEER_EXPERTS, d), d ** -0.5),
        'peer_v': nrm((DEPTH, PEER_EXPERTS, d), DEEPNORM_BETA),
    }


def reference(x, c, ctx, c_ctx, ada_w, ada_b, ln_w, ln_b, ab_w_in, hy_conv_w, hy_conv_b,
              hy_fw1, hy_fb1, hy_fw2, hy_fb2, hy_fw3, hy_fb3, hy_fw4, hy_skip, na_rpb, ab_w_out,
              ml_w_in, ml_b_gates, ml_conv_w, ml_conv_b, ml_norm_w, ml_w_out,
              peer_wq, peer_k1, peer_k2, peer_u, peer_v):
    bsz, seq_len, d = x.shape
    n_ctx = ctx.shape[1]
    h_lat, h_ctx = x, ctx
    for layer in range(DEPTH):
        last = layer == DEPTH - 1
        j = layer // 2
        mod_lat = jnp.split(jax.nn.silu(c) @ ada_w[layer] + ada_b[layer], 6, axis=-1)
        mod_ctx = jnp.split(jax.nn.silu(c_ctx) @ ada_w[layer] + ada_b[layer], 6, axis=-1)
        sh_l, sc_l, g_l, shf_l, scf_l, gf_l = [m[:, None] for m in mod_lat]
        sh_c, sc_c, g_c, shf_c, scf_c, gf_c = mod_ctx
        u_lat = h_lat * (1 + sc_l) + sh_l
        u_ctx = h_ctx * (1 + sc_c) + sh_c
        if layer % 2 == 0:
            y_lat, y_ctx = hyena_na_mixer(u_lat, u_ctx, ab_w_in[j], hy_conv_w[j], hy_conv_b[j],
                                          hy_fw1[j], hy_fb1[j], hy_fw2[j], hy_fb2[j], hy_fw3[j], hy_fb3[j],
                                          hy_fw4[j], hy_skip[j], na_rpb[j], ab_w_out[j], not last)
        else:
            y_lat, y_ctx = mlstm_mixer(u_lat, u_ctx, ml_w_in[j], ml_b_gates[j], ml_conv_w[j], ml_conv_b[j],
                                       ml_norm_w[j], ml_w_out[j], not last)
        h_lat = layer_norm(DEEPNORM_ALPHA * h_lat + g_l * y_lat, ln_w[layer, 0], ln_b[layer, 0])
        v_lat = h_lat * (1 + scf_l) + shf_l
        if last:
            f_lat = peer_ffn(v_lat.reshape(-1, d), peer_wq[layer], peer_k1[layer], peer_k2[layer],
                             peer_u[layer], peer_v[layer]).reshape(bsz, seq_len, d)
        else:
            h_ctx = layer_norm(DEEPNORM_ALPHA * h_ctx + g_c * y_ctx, ln_w[layer, 0], ln_b[layer, 0])
            v_ctx = h_ctx * (1 + scf_c) + shf_c
            f_all = peer_ffn(jnp.concatenate([v_ctx, v_lat], axis=1).reshape(-1, d), peer_wq[layer],
                             peer_k1[layer], peer_k2[layer], peer_u[layer], peer_v[layer])
            f_all = f_all.reshape(bsz, n_ctx + seq_len, d)
            f_lat = f_all[:, n_ctx:]
            h_ctx = layer_norm(DEEPNORM_ALPHA * h_ctx + gf_c * f_all[:, :n_ctx], ln_w[layer, 1], ln_b[layer, 1])
        h_lat = layer_norm(DEEPNORM_ALPHA * h_lat + gf_l * f_lat, ln_w[layer, 1], ln_b[layer, 1])
    return h_lat
```

```cpp
#include <hip/hip_runtime.h>
#include <cstdio>
#include <cstdint>

#define LAS __attribute__((address_space(3)))
typedef unsigned short bf16_t;
typedef short bf16x8 __attribute__((ext_vector_type(8)));
typedef short bf16x4 __attribute__((ext_vector_type(4)));
typedef float f32x2 __attribute__((ext_vector_type(2)));
typedef float f32x4 __attribute__((ext_vector_type(4)));
typedef float f32x16 __attribute__((ext_vector_type(16)));
typedef unsigned u32x2 __attribute__((ext_vector_type(2)));
typedef unsigned u32x4 __attribute__((ext_vector_type(4)));
typedef __bf16 bf2_t __attribute__((ext_vector_type(2)));

constexpr int DM = 2048;
constexpr int TL = 16384;
constexpr int TCX = 256;
constexpr int MT = TL + TCX;
constexpr int NTHREADS = 512;
constexpr int LDS_BYTES = 151552;
constexpr float LN_EPS = 1e-6f;
constexpr float DN_ALPHA = 1.41421356237309515f;

constexpr size_t al256(size_t x) { return (x + 255) & ~(size_t)255; }
constexpr size_t OFF_BAR   = 0;
constexpr size_t OFF_MOD   = 16384;
constexpr size_t OFF_ROPE  = OFF_MOD + al256((size_t)2 * 2 * 12288 * 4);
constexpr size_t OFF_A3    = OFF_ROPE + al256((size_t)256 * 32 * 8);
constexpr size_t OFF_GATE  = OFF_A3 + al256((size_t)MT * 64 * 2);
constexpr size_t OFF_GX    = OFF_GATE + al256((size_t)MT * 32 * 4);
constexpr size_t GX_STRIDE = (size_t)2 * 8 * MT;
constexpr size_t OFF_NST   = OFF_GX + al256((3 * GX_STRIDE + 2 * 8 * 260 + 64) * 4);
constexpr size_t OFF_W0T   = OFF_NST + al256((size_t)17 * 16 * 128 * 4);
constexpr size_t OFF_WO0T  = OFF_W0T + (size_t)6144 * 2048 * 2;
constexpr size_t OFF_W1T   = OFF_WO0T + (size_t)2048 * 2048 * 2;
constexpr size_t OFF_WO1T  = OFF_W1T + (size_t)6400 * 2048 * 2;
constexpr size_t OFF_WQK   = OFF_WO1T + (size_t)2048 * 2048 * 2;
constexpr size_t OFF_PEER  = OFF_WQK + (size_t)2 * 2048 * 2048 * 2;
constexpr size_t PEER_TBL  = (size_t)16384 * 2048;
constexpr float PEER_USCALE = 64.0f, PEER_VSCALE = 4.0f;
constexpr size_t OFF_BIG1  = OFF_PEER + 4 * PEER_TBL * 2;
constexpr size_t BIG_BYTES = al256((size_t)140000000);
constexpr size_t OFF_BIG2  = OFF_BIG1 + BIG_BYTES;
constexpr size_t OFF_H     = OFF_BIG2 + BIG_BYTES;
constexpr size_t OFF_A     = OFF_H + (size_t)MT * DM * 4;
constexpr size_t OFF_QK    = OFF_A + (size_t)MT * DM * 2;
constexpr size_t OFF_HYT   = OFF_QK + (size_t)MT * DM * 2;
constexpr size_t OFF_EXP   = OFF_HYT + al256((size_t)40000000);
constexpr size_t OFF_X     = OFF_EXP + (size_t)MT * 128 * 8;
constexpr size_t WS_END    = OFF_X + (size_t)MT * DM * 2;
static_assert(WS_END <= (size_t)1073741824, "workspace map exceeds 1 GiB");

__device__ __forceinline__ int opq(int v) { asm volatile("" : "+s"(v)); return v; }
__device__ __forceinline__ int otid() { int t = threadIdx.x; asm volatile("" : "+v"(t)); return t; }
__device__ __forceinline__ bf16_t f2bf(float f) { unsigned u = __float_as_uint(f); u += 0x7FFFu + ((u >> 16) & 1u); return (bf16_t)(u >> 16); }
__device__ __forceinline__ float bf2f(bf16_t b) { return __uint_as_float(((unsigned)b) << 16); }
__device__ __forceinline__ unsigned pk_bf16(float lo, float hi) { unsigned r; asm volatile("v_cvt_pk_bf16_f32 %0, %1, %2" : "=v"(r) : "v"(lo), "v"(hi)); return r; }
__device__ __forceinline__ float bflo(unsigned u) { return __uint_as_float(u << 16); }
__device__ __forceinline__ float bfhi(unsigned u) { return __uint_as_float(u & 0xFFFF0000u); }
__device__ __forceinline__ float wave_sum(float v) {
#pragma unroll
    for (int o = 32; o > 0; o >>= 1) v += __shfl_xor(v, o);
    return v;
}
__device__ __forceinline__ float wave_max(float v) {
#pragma unroll
    for (int o = 32; o > 0; o >>= 1) v = fmaxf(v, __shfl_xor(v, o));
    return v;
}
__device__ __forceinline__ float silu_f(float x) { return x / (1.f + __expf(-x)); }
__device__ __forceinline__ float sigmoid_f(float x) { return 1.f / (1.f + __expf(-x)); }

#define XB_TMO      128
#define XB_XCNT(j)  (256  + 64 * (j))
#define XB_XSUB(j)  (1280 + 64 * (j))
#define XB_XGEN(j)  (2304 + 64 * (j))
#define XB_TOP      3328
#define XB_TOPGEN   3392
#define XCD_BAR_WORDS 3456
#define XB_SPIN_CAP (1u << 30)
__device__ __forceinline__ unsigned xb_ld(unsigned* p)              { return __hip_atomic_load(p, __ATOMIC_RELAXED, __HIP_MEMORY_SCOPE_AGENT); }
__device__ __forceinline__ unsigned xb_add(unsigned* p, unsigned v) { return __hip_atomic_fetch_add(p, v, __ATOMIC_RELAXED, __HIP_MEMORY_SCOPE_AGENT); }
__device__ __forceinline__ unsigned xb_xcc_id() { return (unsigned)__builtin_amdgcn_s_getreg((3 << 11) | 20) & 0xFu; }
#define XB_SPIN(cond, bar) do { unsigned _sp = 0; while (cond) { __builtin_amdgcn_s_sleep(1); \
    if ((++_sp & 255u) == 0u) { if (xb_ld(&(bar)[XB_TMO])) break; if (_sp > XB_SPIN_CAP) { atomicAdd(&(bar)[XB_TMO], 1u); break; } } } } while (0)
struct XcdBarrier { unsigned* bar; unsigned x; volatile LAS unsigned* st; };
__device__ __forceinline__ XcdBarrier xcd_barrier_post(unsigned* bar, volatile LAS unsigned* st) {
    XcdBarrier b; b.bar = bar; b.x = xb_xcc_id(); b.st = st;
    if (threadIdx.x == 0) (void)xb_add(&bar[XB_XCNT(b.x)], 1u);
    return b;
}
__device__ __forceinline__ void xcd_barrier_complete(unsigned* bar, unsigned x, unsigned& nloc, unsigned& nx) {
    const unsigned G = gridDim.x * gridDim.y * gridDim.z;
    unsigned sum, cnt, mine, sp = 0u;
    for (;;) {
        sum = 0u; cnt = 0u; mine = 0u;
#pragma unroll
        for (unsigned j = 0; j < 16; ++j) { const unsigned c = xb_ld(&bar[XB_XCNT(j)]); sum += c; cnt += (c > 0u) ? 1u : 0u; mine = (j == x) ? c : mine; }
        if (sum == G) break;
        __builtin_amdgcn_s_sleep(1);
        if ((++sp & 255u) == 0u) { if (xb_ld(&bar[XB_TMO])) break; if (sp > XB_SPIN_CAP) { atomicAdd(&bar[XB_TMO], 1u); break; } }
    }
    nloc = mine > 0u ? mine : 1u; nx = cnt > 0u ? cnt : 1u;
}
__device__ __forceinline__ void xcd_barrier(const XcdBarrier& b) {
    asm volatile("s_waitcnt vmcnt(0)" ::: "memory");
    __syncthreads();
    if (threadIdx.x == 0) {
        unsigned* bar = b.bar;
        __builtin_amdgcn_s_waitcnt(0);
        unsigned nloc = b.st[0], nx = b.st[1];
        if (nloc == 0u) { xcd_barrier_complete(bar, b.x, nloc, nx); b.st[0] = nloc; b.st[1] = nx; }
        const unsigned old = xb_add(&bar[XB_XSUB(b.x)], 1u);
        const unsigned gen = old / nloc;
        if (old + 1u == (gen + 1u) * nloc) {
            __builtin_amdgcn_fence(__ATOMIC_RELEASE, "agent");
            asm volatile("s_waitcnt vmcnt(0)" ::: "memory");
            const unsigned og = xb_add(&bar[XB_TOP], 1u);
            const unsigned tg = og / nx;
            if (og + 1u == (tg + 1u) * nx) xb_add(&bar[XB_TOPGEN], 1u);
            else XB_SPIN(xb_ld(&bar[XB_TOPGEN]) == tg, bar);
            __builtin_amdgcn_fence(__ATOMIC_ACQUIRE, "agent");
            xb_add(&bar[XB_XGEN(b.x)], 1u);
            asm volatile("s_waitcnt vmcnt(0)" ::: "memory");
        } else {
            XB_SPIN(xb_ld(&bar[XB_XGEN(b.x)]) == gen, bar);
            __builtin_amdgcn_fence(__ATOMIC_ACQUIRE, "agent");
            asm volatile("s_waitcnt vmcnt(0)" ::: "memory");
        }
    }
    __syncthreads();
}

namespace pg8 {
constexpr int BM = 256, BK = 64, HALF = 128, HTB = HALF * BK * 2, STAGE_BYTES = 8 * HTB, NXCD = 8, WGM = 8;
__host__ __device__ __forceinline__ int lds_byte(int r, int c) { const int st = (r >> 4) * 2 + (c >> 5), rr = r & 15, cc = c & 31, ob = rr * 64 + cc * 2; return st * 1024 + (ob ^ (((ob >> 9) & 1) << 5)); }
__host__ __device__ __forceinline__ void stage_rc(int b, int& R, int& C) { const int st = b / 1024, sb = b % 1024, swz = sb ^ (((sb >> 9) & 1) << 5); R = (st >> 1) * 16 + swz / 64; C = (st & 1) * 32 + (swz % 64) / 2; }
__host__ __device__ __forceinline__ int perm32(int rho) { const int n = rho >> 4, i = rho & 15; return 8 * (i >> 2) + 4 * n + (i & 3); }
struct Unit { int pm, pn; };
struct Gemm { const bf16_t* A; const bf16_t* Bt; int M, N, K; };
struct StaticOrder {
    int nM, nN, nwg, G, c;
    __host__ __device__ void init(int M, int N, int G_, int c_) { nM = M / BM; nN = N / BM; nwg = nM * nN; G = G_; c = c_; }
    __host__ __device__ bool next(int i, Unit& u) const {
        const long L = (long)i * G + c; if (L >= nwg) return false;
        int wgid = (int)L; { const int q = nwg / NXCD, r = nwg % NXCD, xcd = wgid % NXCD, off = wgid / NXCD; wgid = (xcd < r ? xcd * (q + 1) : r * (q + 1) + (xcd - r) * q) + off; }
        const int nig = WGM * nN, gid = wgid / nig, fm = gid * WGM, gsz = (nM - fm) < WGM ? (nM - fm) : WGM;
        u.pm = fm + ((wgid % nig) % gsz); u.pn = (wgid % nig) / gsz; return true;
    }
    __device__ __forceinline__ void a_ready(const Unit&) const {}
    __device__ __forceinline__ void done(const Unit&) const {}
};
struct EpiF32 {
    static constexpr bool PERM = false;
    float* C; int ldc;
    __device__ __forceinline__ void operator()(const f32x4 (&acc)[2][2][4][2], const Unit& u, int wr, int wc, int fr, int fq) const {
        const int row0 = u.pm * BM + wr * 64 + fr, col0 = u.pn * BM + wc * 32 + 4 * fq;
#pragma unroll
        for (int ai = 0; ai < 2; ++ai)
#pragma unroll
            for (int m = 0; m < 4; ++m) { float* rowp = C + (size_t)(row0 + ai * HALF + m * 16) * ldc + col0;
#pragma unroll
                for (int bj = 0; bj < 2; ++bj)
#pragma unroll
                    for (int n = 0; n < 2; ++n) *(f32x4*)(rowp + bj * HALF + n * 16) = acc[ai][bj][m][n]; }
    }
};
struct EpiBf16 {
    static constexpr bool PERM = true;
    bf16_t* O; int ldc;
    __device__ __forceinline__ void operator()(const f32x4 (&acc)[2][2][4][2], const Unit& u, int wr, int wc, int fr, int fq) const {
        const int row0 = u.pm * BM + wr * 64 + fr, col0 = u.pn * BM + wc * 32 + 8 * fq;
#pragma unroll
        for (int ai = 0; ai < 2; ++ai)
#pragma unroll
            for (int m = 0; m < 4; ++m) { bf16_t* rowp = O + (size_t)(row0 + ai * HALF + m * 16) * ldc + col0;
#pragma unroll
                for (int bj = 0; bj < 2; ++bj) { const f32x4 v0 = acc[ai][bj][m][0], v1 = acc[ai][bj][m][1];
                    u32x4 w; w.x = pk_bf16(v0[0], v0[1]); w.y = pk_bf16(v0[2], v0[3]); w.z = pk_bf16(v1[0], v1[1]); w.w = pk_bf16(v1[2], v1[3]);
                    *(u32x4*)(rowp + bj * HALF) = w; } }
    }
};
struct EpiL1 {
    static constexpr bool PERM = true;
    bf16_t* QKp; bf16_t* Ob; float* G;
    __device__ __forceinline__ void operator()(const f32x4 (&acc)[2][2][4][2], const Unit& u, int wr, int wc, int fr, int fq) const {
        const int row0 = u.pm * BM + wr * 64 + fr;
        if (u.pn < 16) {
            bf16_t* base = (u.pn < 8) ? QKp : Ob; const int col0 = (u.pn & 7) * BM + wc * 32 + 8 * fq;
#pragma unroll
            for (int ai = 0; ai < 2; ++ai)
#pragma unroll
                for (int m = 0; m < 4; ++m) { bf16_t* rowp = base + (size_t)(row0 + ai * HALF + m * 16) * 2048 + col0;
#pragma unroll
                    for (int bj = 0; bj < 2; ++bj) { const f32x4 v0 = acc[ai][bj][m][0], v1 = acc[ai][bj][m][1];
                        u32x4 w; w.x = pk_bf16(v0[0], v0[1]); w.y = pk_bf16(v0[2], v0[3]); w.z = pk_bf16(v1[0], v1[1]); w.w = pk_bf16(v1[2], v1[3]);
                        *(u32x4*)(rowp + bj * HALF) = w; } }
        } else if (wc == 0) {
#pragma unroll
            for (int ai = 0; ai < 2; ++ai)
#pragma unroll
                for (int m = 0; m < 4; ++m) { float* rowp = G + (size_t)(row0 + ai * HALF + m * 16) * 32 + 8 * fq;
                    *(f32x4*)(rowp) = acc[ai][0][m][0]; *(f32x4*)(rowp + 4) = acc[ai][0][m][1]; }
        }
    }
};

template <class Epi, class Sched>
__device__ __forceinline__ void gemm_phase(LAS unsigned char* lds, const Gemm g, const Sched& S, const Epi& E) {
    const int tid = otid(), wid = __builtin_amdgcn_readfirstlane(tid >> 6), lane = tid & 63, wr = wid >> 2, wc = wid & 3, fr = lane & 15, fq = lane >> 4;
    const int K = g.K, nt = K / BK;
    unsigned voffA[2], voffB[2];
#pragma unroll
    for (int i = 0; i < 2; ++i) { int R, C; stage_rc(tid * 16 + i * 8192, R, C); const int Rb = Epi::PERM ? ((R & ~31) + perm32(R & 31)) : R;
        voffA[i] = (unsigned)(R * K + C) * 2u; voffB[i] = (unsigned)(Rb * K + C) * 2u; }
    const size_t kstep = (size_t)(BK * 2);
    const size_t hstep = (size_t)HALF * K * 2;
    const size_t tstep = 2 * hstep;
    const unsigned ldsw = (unsigned)wid * 1024u;
    const int aoff = lds_byte(wr * 64 + fr, fq * 8), boff = lds_byte(wc * 32 + fr, fq * 8);
#define PG8_SA(b, h) (((b) * 2 + (h)) * HTB)
#define PG8_SB(b, h) ((4 + (b) * 2 + (h)) * HTB)
#define PG8_STAGE(bufoff, gbase, voff) do { _Pragma("unroll") for (int _i = 0; _i < 2; ++_i) \
        __builtin_amdgcn_global_load_lds((const unsigned*)((const char*)(gbase) + (voff)[_i]), (LAS unsigned*)(lds + (bufoff) + ldsw + _i * 8192), 16, 0, 0); } while (0)
#define PG8_LDA(dst, b, h) do { _Pragma("unroll") for (int m = 0; m < 4; ++m) _Pragma("unroll") for (int k = 0; k < 2; ++k) dst[m][k] = *(const LAS bf16x8*)(lds + PG8_SA(b, h) + aoff + m * 2048 + k * 1024); } while (0)
#define PG8_LDB(dst, b, h) do { _Pragma("unroll") for (int n = 0; n < 2; ++n) _Pragma("unroll") for (int k = 0; k < 2; ++k) dst[n][k] = *(const LAS bf16x8*)(lds + PG8_SB(b, h) + boff + n * 2048 + k * 1024); } while (0)
#define PG8_MMA(ai, bj, At, Bt) do { __builtin_amdgcn_s_setprio(1); _Pragma("unroll") for (int m = 0; m < 4; ++m) _Pragma("unroll") for (int n = 0; n < 2; ++n) _Pragma("unroll") for (int k = 0; k < 2; ++k) \
        acc[ai][bj][m][n] = __builtin_amdgcn_mfma_f32_16x16x32_bf16(Bt[n][k], At[m][k], acc[ai][bj][m][n], 0, 0, 0); __builtin_amdgcn_s_setprio(0); } while (0)
#define PG8_WAIT_V(n) asm volatile("s_waitcnt vmcnt(" #n ")" ::: "memory")
#define PG8_WAIT_L(n) asm volatile("s_waitcnt lgkmcnt(" #n ")" ::: "memory")
#define PG8_BAR __builtin_amdgcn_s_barrier()
#define PG8_SCHED __builtin_amdgcn_sched_barrier(0)
    Unit cur, nxt; int ui = 0;
    if (!S.next(0, cur)) return;
    f32x4 acc[2][2][4][2];
#pragma unroll
    for (int a = 0; a < 2; ++a)
#pragma unroll
        for (int b = 0; b < 2; ++b)
#pragma unroll
            for (int m = 0; m < 4; ++m)
#pragma unroll
                for (int n = 0; n < 2; ++n) acc[a][b][m][n] = (f32x4){0.f, 0.f, 0.f, 0.f};
    bf16x8 At[4][2], B0[2][2], B1[2][2];
    const char* cA = (const char*)g.A + (size_t)cur.pm * tstep; const char* cB = (const char*)g.Bt + (size_t)cur.pn * tstep;
    S.a_ready(cur);
    PG8_STAGE(PG8_SB(0, 0), cB, voffB); PG8_STAGE(PG8_SA(0, 0), cA, voffA); PG8_STAGE(PG8_SB(0, 1), cB + hstep, voffB); PG8_STAGE(PG8_SA(0, 1), cA + hstep, voffA);
    if (wr == 1) PG8_BAR;
    PG8_WAIT_V(4); PG8_BAR;
    PG8_STAGE(PG8_SB(1, 0), cB + kstep, voffB); PG8_STAGE(PG8_SA(1, 0), cA + kstep, voffA); PG8_STAGE(PG8_SB(1, 1), cB + hstep + kstep, voffB);
    PG8_WAIT_V(6); PG8_BAR;
    for (;;) {
        const bool has_next = S.next(ui + 1, nxt);
        const char* nA = has_next ? (const char*)g.A + (size_t)nxt.pm * tstep : cA; const char* nB = has_next ? (const char*)g.Bt + (size_t)nxt.pn * tstep : cB;
        for (int t = 0; t < nt; t += 2) {
            const bool last = (t == nt - 2);
            const char* a1 = cA + (size_t)(t + 1) * kstep;
            const char* a2 = last ? nA : cA + (size_t)(t + 2) * kstep; const char* b2 = last ? nB : cB + (size_t)(t + 2) * kstep;
            const char* a3 = a2 + kstep; const char* b3 = b2 + kstep;
            if (last && has_next) S.a_ready(nxt);
            PG8_LDB(B0, 0, 0); PG8_SCHED; PG8_LDA(At, 0, 0); PG8_STAGE(PG8_SA(1, 1), a1 + hstep, voffA);
            PG8_WAIT_L(8); PG8_BAR; PG8_WAIT_L(0); PG8_MMA(0, 0, At, B0); PG8_BAR; PG8_SCHED;
            PG8_LDB(B1, 0, 1); PG8_STAGE(PG8_SB(0, 0), b2, voffB);
            PG8_BAR; PG8_WAIT_L(0); PG8_MMA(0, 1, At, B1); PG8_BAR;
            PG8_LDA(At, 0, 1); PG8_STAGE(PG8_SA(0, 0), a2, voffA);
            PG8_BAR; PG8_WAIT_L(0); PG8_MMA(1, 0, At, B0); PG8_BAR; PG8_SCHED;
            PG8_STAGE(PG8_SB(0, 1), b2 + hstep, voffB);
            PG8_WAIT_V(6); PG8_BAR; PG8_MMA(1, 1, At, B1); PG8_BAR;
            PG8_LDB(B0, 1, 0); PG8_SCHED; PG8_LDA(At, 1, 0); PG8_STAGE(PG8_SA(0, 1), a2 + hstep, voffA);
            PG8_WAIT_L(8); PG8_BAR; PG8_WAIT_L(0); PG8_MMA(0, 0, At, B0); PG8_BAR; PG8_SCHED;
            PG8_LDB(B1, 1, 1); PG8_STAGE(PG8_SB(1, 0), b3, voffB);
            PG8_BAR; PG8_WAIT_L(0); PG8_MMA(0, 1, At, B1); PG8_BAR;
            PG8_LDA(At, 1, 1); PG8_STAGE(PG8_SA(1, 0), a3, voffA);
            PG8_BAR; PG8_WAIT_L(0); PG8_MMA(1, 0, At, B0); PG8_BAR; PG8_SCHED;
            PG8_STAGE(PG8_SB(1, 1), b3 + hstep, voffB);
            PG8_WAIT_V(6); PG8_BAR; PG8_MMA(1, 1, At, B1); PG8_BAR;
        }
        E(acc, cur, wr, wc, fr, fq); S.done(cur);
        if (!has_next) break;
#pragma unroll
        for (int a = 0; a < 2; ++a)
#pragma unroll
            for (int b = 0; b < 2; ++b)
#pragma unroll
                for (int m = 0; m < 4; ++m)
#pragma unroll
                    for (int n = 0; n < 2; ++n) acc[a][b][m][n] = (f32x4){0.f, 0.f, 0.f, 0.f};
        cur = nxt; cA = nA; cB = nB; ++ui;
    }
    PG8_WAIT_V(0);
    if (wr == 0) PG8_BAR;
    PG8_BAR;
#undef PG8_SA
#undef PG8_SB
#undef PG8_STAGE
#undef PG8_LDA
#undef PG8_LDB
#undef PG8_MMA
#undef PG8_WAIT_V
#undef PG8_WAIT_L
#undef PG8_BAR
#undef PG8_SCHED
}
struct GUnit { const char* A; const char* B; int pm, pn, nkt, tag; };
template <class Epi, class Sched>
__device__ __forceinline__ void gemm_stream(LAS unsigned char* lds, const int K, const Sched& S, const Epi& E) {
    const int tid = otid(), wid = __builtin_amdgcn_readfirstlane(tid >> 6), lane = tid & 63, wr = wid >> 2, wc = wid & 3, fr = lane & 15, fq = lane >> 4;
    unsigned voffA[2], voffB[2];
#pragma unroll
    for (int i = 0; i < 2; ++i) { int R, C; stage_rc(tid * 16 + i * 8192, R, C); const int Rb = Epi::PERM ? ((R & ~31) + perm32(R & 31)) : R;
        voffA[i] = (unsigned)(R * K + C) * 2u; voffB[i] = (unsigned)(Rb * K + C) * 2u; }
    const size_t kstep = (size_t)(BK * 2);
    const size_t hstep = (size_t)HALF * K * 2;
    const unsigned ldsw = (unsigned)wid * 1024u;
    const int aoff = lds_byte(wr * 64 + fr, fq * 8), boff = lds_byte(wc * 32 + fr, fq * 8);
#define PG8_SA(b, h) (((b) * 2 + (h)) * HTB)
#define PG8_SB(b, h) ((4 + (b) * 2 + (h)) * HTB)
#define PG8_STAGE(bufoff, gbase, voff) do { _Pragma("unroll") for (int _i = 0; _i < 2; ++_i) \
        __builtin_amdgcn_global_load_lds((const unsigned*)((const char*)(gbase) + (voff)[_i]), (LAS unsigned*)(lds + (bufoff) + ldsw + _i * 8192), 16, 0, 0); } while (0)
#define PG8_LDA(dst, b, h) do { _Pragma("unroll") for (int m = 0; m < 4; ++m) _Pragma("unroll") for (int k = 0; k < 2; ++k) dst[m][k] = *(const LAS bf16x8*)(lds + PG8_SA(b, h) + aoff + m * 2048 + k * 1024); } while (0)
#define PG8_LDB(dst, b, h) do { _Pragma("unroll") for (int n = 0; n < 2; ++n) _Pragma("unroll") for (int k = 0; k < 2; ++k) dst[n][k] = *(const LAS bf16x8*)(lds + PG8_SB(b, h) + boff + n * 2048 + k * 1024); } while (0)
#define PG8_MMA(ai, bj, At, Bt) do { __builtin_amdgcn_s_setprio(1); _Pragma("unroll") for (int m = 0; m < 4; ++m) _Pragma("unroll") for (int n = 0; n < 2; ++n) _Pragma("unroll") for (int k = 0; k < 2; ++k) \
        acc[ai][bj][m][n] = __builtin_amdgcn_mfma_f32_16x16x32_bf16(Bt[n][k], At[m][k], acc[ai][bj][m][n], 0, 0, 0); __builtin_amdgcn_s_setprio(0); } while (0)
#define PG8_WAIT_V(n) asm volatile("s_waitcnt vmcnt(" #n ")" ::: "memory")
#define PG8_WAIT_L(n) asm volatile("s_waitcnt lgkmcnt(" #n ")" ::: "memory")
#define PG8_BAR __builtin_amdgcn_s_barrier()
#define PG8_SCHED __builtin_amdgcn_sched_barrier(0)
    GUnit cur, nxt; int ui = 0;
    if (!S.next(0, cur)) return;
    f32x4 acc[2][2][4][2];
#pragma unroll
    for (int a = 0; a < 2; ++a)
#pragma unroll
        for (int b = 0; b < 2; ++b)
#pragma unroll
            for (int m = 0; m < 4; ++m)
#pragma unroll
                for (int n = 0; n < 2; ++n) acc[a][b][m][n] = (f32x4){0.f, 0.f, 0.f, 0.f};
    bf16x8 At[4][2], B0[2][2], B1[2][2];
    const char* cA = cur.A; const char* cB = cur.B;
    PG8_STAGE(PG8_SB(0, 0), cB, voffB); PG8_STAGE(PG8_SA(0, 0), cA, voffA); PG8_STAGE(PG8_SB(0, 1), cB + hstep, voffB); PG8_STAGE(PG8_SA(0, 1), cA + hstep, voffA);
    if (wr == 1) PG8_BAR;
    PG8_WAIT_V(4); PG8_BAR;
    PG8_STAGE(PG8_SB(1, 0), cB + kstep, voffB); PG8_STAGE(PG8_SA(1, 0), cA + kstep, voffA); PG8_STAGE(PG8_SB(1, 1), cB + hstep + kstep, voffB);
    PG8_WAIT_V(6); PG8_BAR;
    for (;;) {
        const bool has_next = S.next(ui + 1, nxt);
        const char* nA = has_next ? nxt.A : cA; const char* nB = has_next ? nxt.B : cB;
        const int nt = cur.nkt;
        for (int t = 0; t < nt; t += 2) {
            const bool last = (t == nt - 2);
            const char* a1 = cA + (size_t)(t + 1) * kstep;
            const char* a2 = last ? nA : cA + (size_t)(t + 2) * kstep; const char* b2 = last ? nB : cB + (size_t)(t + 2) * kstep;
            const char* a3 = a2 + kstep; const char* b3 = b2 + kstep;
            PG8_LDB(B0, 0, 0); PG8_SCHED; PG8_LDA(At, 0, 0); PG8_STAGE(PG8_SA(1, 1), a1 + hstep, voffA);
            PG8_WAIT_L(8); PG8_BAR; PG8_WAIT_L(0); PG8_MMA(0, 0, At, B0); PG8_BAR; PG8_SCHED;
            PG8_LDB(B1, 0, 1); PG8_STAGE(PG8_SB(0, 0), b2, voffB);
            PG8_BAR; PG8_WAIT_L(0); PG8_MMA(0, 1, At, B1); PG8_BAR;
            PG8_LDA(At, 0, 1); PG8_STAGE(PG8_SA(0, 0), a2, voffA);
            PG8_BAR; PG8_WAIT_L(0); PG8_MMA(1, 0, At, B0); PG8_BAR; PG8_SCHED;
            PG8_STAGE(PG8_SB(0, 1), b2 + hstep, voffB);
            PG8_WAIT_V(6); PG8_BAR; PG8_MMA(1, 1, At, B1); PG8_BAR;
            PG8_LDB(B0, 1, 0); PG8_SCHED; PG8_LDA(At, 1, 0); PG8_STAGE(PG8_SA(0, 1), a2 + hstep, voffA);
            PG8_WAIT_L(8); PG8_BAR; PG8_WAIT_L(0); PG8_MMA(0, 0, At, B0); PG8_BAR; PG8_SCHED;
            PG8_LDB(B1, 1, 1); PG8_STAGE(PG8_SB(1, 0), b3, voffB);
            PG8_BAR; PG8_WAIT_L(0); PG8_MMA(0, 1, At, B1); PG8_BAR;
            PG8_LDA(At, 1, 1); PG8_STAGE(PG8_SA(1, 0), a3, voffA);
            PG8_BAR; PG8_WAIT_L(0); PG8_MMA(1, 0, At, B0); PG8_BAR; PG8_SCHED;
            PG8_STAGE(PG8_SB(1, 1), b3 + hstep, voffB);
            PG8_WAIT_V(6); PG8_BAR; PG8_MMA(1, 1, At, B1); PG8_BAR;
        }
        E(acc, cur, wr, wc, fr, fq);
        if (!has_next) break;
#pragma unroll
        for (int a = 0; a < 2; ++a)
#pragma unroll
            for (int b = 0; b < 2; ++b)
#pragma unroll
                for (int m = 0; m < 4; ++m)
#pragma unroll
                    for (int n = 0; n < 2; ++n) acc[a][b][m][n] = (f32x4){0.f, 0.f, 0.f, 0.f};
        cur = nxt; cA = nA; cB = nB; ++ui;
    }
    PG8_WAIT_V(0);
    if (wr == 0) PG8_BAR;
    PG8_BAR;
#undef PG8_SA
#undef PG8_SB
#undef PG8_STAGE
#undef PG8_LDA
#undef PG8_LDB
#undef PG8_MMA
#undef PG8_WAIT_V
#undef PG8_WAIT_L
#undef PG8_BAR
#undef PG8_SCHED
}
}

namespace pg8 {
__device__ __forceinline__ void tile_map(int L, int nM, int nN, int& pm, int& pn) {
    const int nwg = nM * nN; int wgid = L; { const int q = nwg / NXCD, r = nwg % NXCD, xcd = wgid % NXCD, off = wgid / NXCD; wgid = (xcd < r ? xcd * (q + 1) : r * (q + 1) + (xcd - r) * q) + off; }
    const int nig = WGM * nN, gid = wgid / nig, fm = gid * WGM, gsz = (nM - fm) < WGM ? (nM - fm) : WGM;
    pm = fm + ((wgid % nig) % gsz); pn = (wgid % nig) / gsz;
}
constexpr size_t TROW = (size_t)256 * 2048 * 2;
template <bool PERM_>
__device__ __forceinline__ void store_f32_tile(const f32x4 (&acc)[2][2][4][2], float* C, int ldc, int wr, int wc, int fr, int fq) {
    const int row0 = wr * 64 + fr, col0 = wc * 32 + (PERM_ ? 8 : 4) * fq;
#pragma unroll
    for (int ai = 0; ai < 2; ++ai)
#pragma unroll
        for (int m = 0; m < 4; ++m) { float* rowp = C + (size_t)(row0 + ai * HALF + m * 16) * ldc + col0;
#pragma unroll
            for (int bj = 0; bj < 2; ++bj)
#pragma unroll
                for (int n = 0; n < 2; ++n) *(f32x4*)(rowp + bj * HALF + n * (PERM_ ? 4 : 16)) = acc[ai][bj][m][n]; }
}
template <class Epi1> struct Sched2 {
    const char* A0; const char* B0; int nM0, nN0; const char* A1; const char* B1; int nM1, nN1; int G, c;
    __device__ __forceinline__ bool next(int i, GUnit& u) const {
        int L = i * G + c; const int n0 = nM0 * nN0;
        if (L < n0) { tile_map(L, nM0, nN0, u.pm, u.pn); u.A = A0 + (size_t)u.pm * TROW; u.B = B0 + (size_t)u.pn * TROW; u.nkt = 32; u.tag = 0; return true; }
        L -= n0; if (L >= nM1 * nN1) return false;
        tile_map(L, nM1, nN1, u.pm, u.pn); u.A = A1 + (size_t)u.pm * TROW; u.B = B1 + (size_t)u.pn * TROW; u.nkt = 32; u.tag = 1; return true;
    }
};
template <class Epi1> struct EpiS2 {
    static constexpr bool PERM = true;
    EpiBf16 e0; Epi1 e1;
    __device__ __forceinline__ void operator()(const f32x4 (&acc)[2][2][4][2], const GUnit& g, int wr, int wc, int fr, int fq) const {
        const Unit u{g.pm, g.pn}; if (g.tag == 0) e0(acc, u, wr, wc, fr, fq); else e1(acc, u, wr, wc, fr, fq); }
};
struct SchedTail {
    const char* A; const char* B; int nM, nN; bool ctx_is_row;
    int G, c;
    __device__ __forceinline__ bool next(int i, GUnit& u) const {
        int L = i * G + c; const int n0 = nM * nN;
        if (L < n0) { tile_map(L, nM, nN, u.pm, u.pn); u.A = A + (size_t)u.pm * TROW; u.B = B + (size_t)u.pn * TROW; u.nkt = 32; u.tag = 0; return true; }
        L -= n0; const int nt_ = ctx_is_row ? nN : nM; if (L >= nt_ * 8) return false;
        const int t = L >> 3, sl = L & 7;
        u.pm = ctx_is_row ? nM : t; u.pn = ctx_is_row ? t : nN;
        u.A = A + (size_t)u.pm * TROW + (size_t)sl * 512; u.B = B + (size_t)u.pn * TROW + (size_t)sl * 512; u.nkt = 4; u.tag = 1 + sl + 8 * t; return true;
    }
};
template <bool PERM_, class Epi0> struct EpiTail {
    static constexpr bool PERM = PERM_;
    Epi0 e0; float* slab;
    __device__ __forceinline__ void operator()(const f32x4 (&acc)[2][2][4][2], const GUnit& g, int wr, int wc, int fr, int fq) const {
        if (g.tag == 0) { const Unit u{g.pm, g.pn}; e0(acc, u, wr, wc, fr, fq); }
        else { const int sl = (g.tag - 1) & 7, t = (g.tag - 1) >> 3; store_f32_tile<PERM_>(acc, slab + ((size_t)(sl * 8 + t) << 16), 256, wr, wc, fr, fq); }
    }
};
}
template <class Epi>
__device__ __forceinline__ void run_gemm(LAS unsigned char* lds, const bf16_t* A, const bf16_t* Bt, int M, int N, int K, const Epi& E) {
    pg8::Gemm g{A, Bt, M, N, K};
    pg8::StaticOrder S; S.init(M, N, (int)gridDim.x, (int)blockIdx.x);
    pg8::gemm_phase(lds, g, S, E);
    __syncthreads();
}
struct Params {
    const float* in[32];
    float* out;
    unsigned char* ws;
};
__device__ __forceinline__ unsigned char* get_ws() { const __attribute__((address_space(4))) char* ka = (const __attribute__((address_space(4))) char*)__builtin_amdgcn_kernarg_segment_ptr();
    unsigned long long w = *(const __attribute__((address_space(4))) unsigned long long*)(ka + __builtin_offsetof(Params, ws)); asm volatile("" : "+s"(w));
    return (unsigned char*)(__attribute__((address_space(1))) unsigned char*)w; }
__device__ __forceinline__ Params fresh(const Params& p) { Params q = p; q.ws = get_ws(); return q; }
enum { I_X = 0, I_C, I_CTX, I_CCTX, I_ADAW, I_ADAB, I_LNW, I_LNB, I_ABWIN, I_HYCW, I_HYCB, I_FW1, I_FB1, I_FW2, I_FB2, I_FW3, I_FB3, I_FW4, I_HYSKIP, I_RPB, I_ABWOUT,
       I_MLWIN, I_MLBG, I_MLCW, I_MLCB, I_MLNW, I_MLWOUT, I_PWQ, I_PK1, I_PK2, I_PU, I_PV };

__device__ __forceinline__ void task_transpose(LAS float* tile, const float* __restrict__ src, int ld, int ncols, bf16_t* __restrict__ dst, int K, int k0, int n_src0, int n_dst0) {
    const int tid = otid();
    const int nn = tid & 63, kb = tid >> 6;
    const bool ok = n_src0 + nn < ncols;
    const float* sp = src + (size_t)(k0 + kb) * ld + n_src0 + nn;
#pragma unroll
    for (int h = 0; h < 2; ++h) { float v[16];
#pragma unroll
        for (int it = 0; it < 16; ++it) v[it] = ok ? sp[(size_t)((h * 16 + it) * 8) * ld] : 0.f;
#pragma unroll
        for (int it = 0; it < 16; ++it) tile[nn * 257 + (h * 16 + it) * 8 + kb] = v[it]; }
    __syncthreads();
#pragma unroll
    for (int it = 0; it < 16; ++it) { const int i = tid + it * 512, n2 = i >> 7, kp = i & 127;
        const float a = tile[n2 * 257 + 2 * kp], b = tile[n2 * 257 + 2 * kp + 1];
        *(unsigned*)(dst + (size_t)(n_dst0 + n2) * K + k0 + 2 * kp) = pk_bf16(a, b); }
    __syncthreads();
}
__device__ __forceinline__ void task_convert(const float* __restrict__ src, unsigned char* __restrict__ dst, float scale) {
    const int tid = otid();
#pragma unroll 2
    for (int it = 0; it < 8; ++it) { const size_t i = ((size_t)it * 512 + tid) * 16;
        u32x4 w;
#pragma unroll
        for (int q = 0; q < 4; ++q) { const f32x4 a = *(const f32x4*)(src + i + 4 * q) * scale;
            int v = 0; v = __builtin_amdgcn_cvt_pk_fp8_f32(a[0], a[1], v, false); v = __builtin_amdgcn_cvt_pk_fp8_f32(a[2], a[3], v, true);
            if (q == 0) w.x = (unsigned)v; else if (q == 1) w.y = (unsigned)v; else if (q == 2) w.z = (unsigned)v; else w.w = (unsigned)v; }
        *(u32x4*)(dst + i) = w; }
}
__device__ __forceinline__ void task_wqk(LAS float* lds, const float* __restrict__ wq, const float* __restrict__ keys, bf16_t* __restrict__ dstT, int hh, int jt) {
    LAS float* km = lds;
    LAS float* wt = lds + 128 * 129;
    const int tid = otid();
    for (int i = tid; i < 128 * 128; i += 512) { const int n = i >> 7, d = i & 127; km[n * 129 + d] = keys[i]; }
    for (int i = tid; i < 64 * 128; i += 512) { const int j = i >> 7, d = i & 127; wt[j * 129 + d] = wq[(size_t)(jt * 64 + j) * 2048 + hh * 128 + d]; }
    __syncthreads();
    const int ns = tid & 31, js = tid >> 5;
    float acc[4][4];
#pragma unroll
    for (int a = 0; a < 4; ++a)
#pragma unroll
        for (int b = 0; b < 4; ++b) acc[a][b] = 0.f;
    for (int d = 0; d < 128; ++d) {
        float kv[4], wv[4];
#pragma unroll
        for (int a = 0; a < 4; ++a) kv[a] = km[(ns + 32 * a) * 129 + d];
#pragma unroll
        for (int b = 0; b < 4; ++b) wv[b] = wt[(js + 16 * b) * 129 + d];
#pragma unroll
        for (int a = 0; a < 4; ++a)
#pragma unroll
            for (int b = 0; b < 4; ++b) acc[a][b] = fmaf(kv[a], wv[b], acc[a][b]);
    }
    __syncthreads();
    LAS float* ot = wt;
#pragma unroll
    for (int a = 0; a < 4; ++a)
#pragma unroll
        for (int b = 0; b < 4; ++b) ot[(ns + 32 * a) * 65 + js + 16 * b] = acc[a][b];
    __syncthreads();
#pragma unroll
    for (int it = 0; it < 8; ++it) { const int i = tid + it * 512, n = i >> 5, jp = i & 31;
        *(unsigned*)(dstT + (size_t)(hh * 128 + n) * 2048 + jt * 64 + 2 * jp) = pk_bf16(ot[n * 65 + 2 * jp], ot[n * 65 + 2 * jp + 1]); }
    __syncthreads();
}
__device__ __forceinline__ void task_ada(LAS float* lds, const float* __restrict__ c, const float* __restrict__ cc, const float* __restrict__ W, const float* __restrict__ bias,
                                         float* __restrict__ out_lat, float* __restrict__ out_ctx, int n0) {
    LAS float* sl = lds; LAS float* sc = lds + 2048; LAS float* red = lds + 4096;
    const int tid = otid(), w = tid >> 6, lane = tid & 63;
    for (int i = tid; i < 2048; i += 512) { sl[i] = silu_f(c[i]); sc[i] = silu_f(cc[i]); }
    __syncthreads();
    float al = 0.f, ac = 0.f;
    const float* wp = W + (size_t)(w * 256) * 12288 + n0 + lane;
#pragma unroll 8
    for (int k = 0; k < 256; ++k) { const float wv = wp[(size_t)k * 12288]; al = fmaf(sl[w * 256 + k], wv, al); ac = fmaf(sc[w * 256 + k], wv, ac); }
    red[(w * 64 + lane) * 2] = al; red[(w * 64 + lane) * 2 + 1] = ac;
    __syncthreads();
    if (tid < 64) { float a = 0.f, b = 0.f;
#pragma unroll
        for (int ww = 0; ww < 8; ++ww) { a += red[(ww * 64 + tid) * 2]; b += red[(ww * 64 + tid) * 2 + 1]; }
        out_lat[n0 + tid] = a + bias[n0 + tid]; out_ctx[n0 + tid] = b + bias[n0 + tid]; }
    __syncthreads();
}
__device__ __forceinline__ void task_a3(const Params& p, LAS float* lds, bf16_t* __restrict__ a3, int task) {
    const int tid = otid(), w = tid >> 6, lane = tid & 63;
    LAS float* W2s = lds; LAS float* W3s = lds + 4096; LAS float* hb = lds + 8192 + w * 128;
    for (int i = tid; i < 4096; i += 512) { W2s[i] = p.in[I_FW2][i]; W3s[i] = p.in[I_FW3][i]; }
    __syncthreads();
    const float* W1 = p.in[I_FW1];
    float w1[33];
#pragma unroll
    for (int f = 0; f < 33; ++f) w1[f] = W1[f * 64 + lane];
    const float b1 = p.in[I_FB1][lane], b2 = p.in[I_FB2][lane], b3 = p.in[I_FB3][lane];
    const float freq = 1e-4f + (float)(lane & 15) * ((15.0f - 1e-4f) / 15.0f);
#pragma unroll 1
    for (int i = 0; i < (w == 0 ? 9 : 8); ++i) {
        const int pos = task * 65 + (i < 8 ? w * 8 + i : 64);
        const int n = pos < TL ? pos : pos - TL; const int L = pos < TL ? TL : TCX;
        const float tl = (float)n / (float)(L - 1);
        const float omega = 6.283185307179586f * (float)n / (float)L;
        float sn, cs; sincosf(omega * freq, &sn, &cs);
        float h = fmaf(tl, w1[0], b1);
#pragma unroll
        for (int b = 0; b < 16; ++b) { h = fmaf(__shfl(cs, b), w1[1 + b], h); h = fmaf(-__shfl(sn, b), w1[17 + b], h); }
        hb[lane] = sinf(h);
        __builtin_amdgcn_wave_barrier();
        float g = b2;
#pragma unroll 8
        for (int j = 0; j < 64; ++j) g = fmaf(hb[j], W2s[j * 64 + lane], g);
        hb[64 + lane] = sinf(g);
        __builtin_amdgcn_wave_barrier();
        float q = b3;
#pragma unroll 8
        for (int j = 0; j < 64; ++j) q = fmaf(hb[64 + j], W3s[j * 64 + lane], q);
        a3[(size_t)pos * 64 + lane] = f2bf(sinf(q));
        __builtin_amdgcn_wave_barrier();
    }
    __syncthreads();
}

constexpr int P0_NT_TR0 = 8 * 96, P0_NT_TRO = 8 * 32, P0_NT_TR1 = 8 * 100;
constexpr int P0_T0 = 0;
constexpr int P0_T1 = P0_T0 + P0_NT_TR0;
constexpr int P0_T2 = P0_T1 + P0_NT_TRO;
constexpr int P0_T3 = P0_T2 + P0_NT_TR1;
constexpr int P0_T4 = P0_T3 + P0_NT_TRO;
constexpr int P0_T5 = P0_T4 + 4 * 512;
constexpr int P0_T6 = P0_T5 + 1024;
constexpr int P0_T7 = P0_T6 + 384;
constexpr int P0_T8 = P0_T7 + 256;
constexpr int P0_NT = P0_T8 + 1;
constexpr int P0_T5B = P0_T5 + 512;
constexpr int P0_T6B = P0_T6 + 192;

__device__ __forceinline__ void phase0(const Params& p, LAS unsigned char* lds, int t_begin = 0, int t_end = P0_NT, int skip_blocks = 0) {
    LAS float* ldsf = (LAS float*)lds;
    unsigned char* ws = p.ws;
    if ((int)blockIdx.x < skip_blocks) return;
    for (int task = t_begin + (int)blockIdx.x - skip_blocks; task < t_end; task += (int)gridDim.x - skip_blocks) {
        if (task < P0_T1) {
            const int t = task - P0_T0, kt = t & 7, nt = t >> 3; const int nd = nt * 64;
            const int nsrc = nd < 3072 ? nd : (nd < 4096 ? 5120 + (nd - 3072) : 3072 + (nd - 4096));
            task_transpose(ldsf, p.in[I_ABWIN], 6144, 6144, (bf16_t*)(ws + OFF_W0T), 2048, kt * 256, nsrc, nd);
        } else if (task < P0_T2) {
            const int t = task - P0_T1, kt = t & 7, nt = t >> 3;
            task_transpose(ldsf, p.in[I_ABWOUT], 2048, 2048, (bf16_t*)(ws + OFF_WO0T), 2048, kt * 256, nt * 64, nt * 64);
        } else if (task < P0_T3) {
            const int t = task - P0_T2, kt = t & 7, nt = t >> 3; const int nd = nt * 64;
            const int nsrc = nd < 2048 ? 2048 + nd : (nd < 4096 ? nd - 2048 : nd);
            task_transpose(ldsf, p.in[I_MLWIN], 6176, 6176, (bf16_t*)(ws + OFF_W1T), 2048, kt * 256, nsrc, nd);
        } else if (task < P0_T4) {
            const int t = task - P0_T3, kt = t & 7, nt = t >> 3;
            task_transpose(ldsf, p.in[I_MLWOUT], 2048, 2048, (bf16_t*)(ws + OFF_WO1T), 2048, kt * 256, nt * 64, nt * 64);
        } else if (task < P0_T5) {
            const int t = task - P0_T4, ti = t >> 9, ch = t & 511; const int layer = ti >> 1, which = ti & 1;
            task_convert((which ? p.in[I_PV] : p.in[I_PU]) + (size_t)layer * PEER_TBL + (size_t)ch * 65536, ws + OFF_PEER + (size_t)ti * PEER_TBL + (size_t)ch * 65536, which ? PEER_VSCALE : PEER_USCALE);
        } else if (task < P0_T6) {
            const int t = task - P0_T5, layer = t >> 9, hh = (t >> 5) & 15, jt = t & 31;
            task_wqk(ldsf, p.in[I_PWQ] + (size_t)layer * 2048 * 2048, ((hh & 1) ? p.in[I_PK2] : p.in[I_PK1]) + (size_t)layer * 16384, (bf16_t*)(ws + OFF_WQK) + (size_t)layer * 2048 * 2048, hh, jt);
        } else if (task < P0_T7) {
            const int t = task - P0_T6, layer = t / 192, ch = t % 192;
            float* mod = (float*)(ws + OFF_MOD) + (size_t)layer * 2 * 12288;
            task_ada(ldsf, p.in[I_C], p.in[I_CCTX], p.in[I_ADAW] + (size_t)layer * 2048 * 12288, p.in[I_ADAB] + (size_t)layer * 12288, mod, mod + 12288, ch * 64);
        } else if (task < P0_T8) {
            task_a3(p, ldsf, (bf16_t*)(ws + OFF_A3), task - P0_T7);
        } else {
            f32x2* rt = (f32x2*)(ws + OFF_ROPE);
            for (int i = otid(); i < 256 * 32; i += 512) { const int pos = i >> 5, q = i & 31;
                const float inv = expf(-(float)q * (9.210340371976184f / 32.0f)); float sn, cs; sincosf((float)pos * inv, &sn, &cs); rt[i] = (f32x2){cs, sn}; }
        }
    }
}

__device__ __forceinline__ void modulate_rows(const float* __restrict__ xlat, const float* __restrict__ xctx, const float* __restrict__ mod  , bf16_t* __restrict__ U) {
    const int tid = otid(), w = tid >> 6, lane = tid & 63;
    const int stride = gridDim.x * 8;
    for (int r0 = blockIdx.x * 8 + w; r0 < MT; r0 += 2 * stride) {
        f32x4 xa[2][4], xb[2][4];
#pragma unroll
        for (int k = 0; k < 2; ++k) { const int r = r0 + k * stride; if (r < MT) { const float* src = r < TL ? xlat + (size_t)r * DM : xctx + (size_t)(r - TL) * DM;
#pragma unroll
            for (int pc = 0; pc < 4; ++pc) { const int e = pc * 512 + lane * 8; xa[k][pc] = *(const f32x4*)(src + e); xb[k][pc] = *(const f32x4*)(src + e + 4); } } }
#pragma unroll
        for (int k = 0; k < 2; ++k) { const int r = r0 + k * stride; if (r < MT) { const float* md = mod + (r < TL ? 0 : 12288);
#pragma unroll
            for (int pc = 0; pc < 4; ++pc) { const int e = pc * 512 + lane * 8;
                const f32x4 s0 = *(const f32x4*)(md + 2048 + e), s1 = *(const f32x4*)(md + 2048 + e + 4), h0 = *(const f32x4*)(md + e), h1 = *(const f32x4*)(md + e + 4);
                const f32x4 x = xa[k][pc] * (s0 + 1.f) + h0, y = xb[k][pc] * (s1 + 1.f) + h1;
                u32x4 o; o.x = pk_bf16(x[0], x[1]); o.y = pk_bf16(x[2], x[3]); o.z = pk_bf16(y[0], y[1]); o.w = pk_bf16(y[2], y[3]);
                *(u32x4*)(U + (size_t)r * DM + e) = o; } } }
    }
}
__device__ __forceinline__ void hyena_taps(const Params& p) {
    const int tid = otid(), w = tid >> 6, lane = tid & 63, fr = lane & 15, fq = lane >> 4;
    const bf16_t* a3 = (const bf16_t*)(p.ws + OFF_A3);
    const float* w4 = p.in[I_FW4];
    bf16_t* HmT = (bf16_t*)(p.ws + OFF_BIG1);
    bf16_t* HmC = HmT + (size_t)4096 * TL;
    const int NWT = 256 * 16 + 256;
    for (int wt = blockIdx.x * 8 + w; wt < NWT; wt += gridDim.x * 8) {
        const bool isctx = wt >= 4096;
        const int ct = isctx ? wt - 4096 : (wt >> 4), tch = isctx ? 0 : (wt & 15);
        const int col = ct * 16 + fr;
        bf16x8 bw[2];
#pragma unroll
        for (int ks = 0; ks < 2; ++ks)
#pragma unroll
            for (int j = 0; j < 8; ++j) bw[ks][j] = (short)f2bf(w4[(size_t)(ks * 32 + fq * 8 + j) * 4096 + col]);
        const int ch = col & 1023;
        const float mind = -3.0701134573253945f, maxd = -15.350567286626973f;
        const float delta = fabsf(mind + (maxd - mind) * ((float)ch / 1023.0f));
        const int nblk = isctx ? 4 : 16;
        const int t00 = isctx ? 0 : tch * 1024;
        const float invL1 = isctx ? (1.0f / 255.0f) : (1.0f / 16383.0f);
        for (int blk = 0; blk < nblk; ++blk) {
            const int t0 = t00 + blk * 64;
            f32x4 acc[4];
#pragma unroll
            for (int tau = 0; tau < 4; ++tau) {
                acc[tau] = (f32x4){0.f, 0.f, 0.f, 0.f};
                const int trow = t0 + 16 * (fr >> 2) + 4 * tau + (fr & 3);
                const bf16_t* ap = a3 + (size_t)((isctx ? TL : 0) + trow) * 64 + fq * 8;
                const bf16x8 a0 = *(const bf16x8*)(ap), a1 = *(const bf16x8*)(ap + 32);
                acc[tau] = __builtin_amdgcn_mfma_f32_16x16x32_bf16(a0, bw[0], acc[tau], 0, 0, 0);
                acc[tau] = __builtin_amdgcn_mfma_f32_16x16x32_bf16(a1, bw[1], acc[tau], 0, 0, 0);
            }
            unsigned o[8];
#pragma unroll
            for (int tau = 0; tau < 4; ++tau) {
                float v[4];
#pragma unroll
                for (int rg = 0; rg < 4; ++rg) { const int t = t0 + 16 * fq + 4 * tau + rg; v[rg] = acc[tau][rg] * __expf(-(float)t * invL1 * delta); }
                o[tau * 2] = pk_bf16(v[0], v[1]); o[tau * 2 + 1] = pk_bf16(v[2], v[3]);
            }
            bf16_t* dst = isctx ? HmC + (size_t)col * TCX + t0 + 16 * fq : HmT + (size_t)col * TL + t0 + 16 * fq;
            *(u32x4*)(dst) = (u32x4){o[0], o[1], o[2], o[3]};
            *(u32x4*)(dst + 8) = (u32x4){o[4], o[5], o[6], o[7]};
        }
    }
}
constexpr int HY_TW = 143360;
__device__ __forceinline__ f32x2 cmul(f32x2 a, f32x2 b) { return (f32x2){a.x * b.x - a.y * b.y, a.x * b.y + a.y * b.x}; }
__device__ __forceinline__ int fpad(int p) { return p + (p >> 4) + ((p >> 9) << 4); }
__device__ __forceinline__ int kpos(int k) { return fpad((k & 31) * 512 + ((k >> 5) & 31) * 16 + (k >> 10)); }
__host__ __device__ constexpr int brev_c(int q, int bits) { int r = 0; for (int i = 0; i < bits; ++i) r |= ((q >> i) & 1) << (bits - 1 - i); return r; }

template <int R, int LOGR, bool INV>
__device__ __forceinline__ void fft_regs(f32x2 (&v)[R]) {
    constexpr float C32[16] = {1.0f, 0.98078528040323043f, 0.92387953251128674f, 0.83146961230254524f, 0.70710678118654757f, 0.55557023301960229f, 0.38268343236508984f, 0.19509032201612833f,
                               0.0f, -0.19509032201612819f, -0.38268343236508973f, -0.55557023301960196f, -0.70710678118654746f, -0.83146961230254535f, -0.92387953251128674f, -0.98078528040323043f};
    constexpr float S32[16] = {0.0f, 0.19509032201612825f, 0.38268343236508978f, 0.55557023301960218f, 0.70710678118654746f, 0.83146961230254524f, 0.92387953251128674f, 0.98078528040323043f,
                               1.0f, 0.98078528040323043f, 0.92387953251128674f, 0.83146961230254546f, 0.70710678118654757f, 0.55557023301960218f, 0.38268343236508989f, 0.19509032201612861f};
#pragma unroll
    for (int s = 0; s < LOGR; ++s) {
        const int half = (R / 2) >> s;
#pragma unroll
        for (int start = 0; start < R; start += 2 * half) {
#pragma unroll
            for (int i = 0; i < half; ++i) {
                const f32x2 a = v[start + i], b = v[start + i + half];
                v[start + i] = a + b;
                const f32x2 d = a - b;
                const int e = i * (16 / half);
                if (e == 0) v[start + i + half] = d;
                else if (e == 8) v[start + i + half] = INV ? (f32x2){-d.y, d.x} : (f32x2){d.y, -d.x};
                else { const float c = C32[e], sn = INV ? S32[e] : -S32[e]; v[start + i + half] = (f32x2){d.x * c - d.y * sn, d.x * sn + d.y * c}; }
            }
        }
    }
}
template <int R, int LOGR, bool INV, bool TW>
__device__ __forceinline__ void fft_bfly(LAS f32x2* Z, int a0, int astride, f32x2 bw) {
    f32x2 v[R];
#pragma unroll
    for (int r = 0; r < R; ++r) v[r] = Z[a0 + r * astride];
    if (TW) {
        const f32x2 base = (f32x2){bw.x, INV ? -bw.y : bw.y};
        f32x2 tw = base;
        if (INV) {
#pragma unroll
            for (int q = 1; q < R; ++q) { v[q] = cmul(v[q], tw); tw = cmul(tw, base); }
            fft_regs<R, LOGR, INV>(v);
        } else {
            fft_regs<R, LOGR, INV>(v);
#pragma unroll
            for (int q = 1; q < R; ++q) { v[brev_c(q, LOGR)] = cmul(v[brev_c(q, LOGR)], tw); tw = cmul(tw, base); }
        }
    } else fft_regs<R, LOGR, INV>(v);
#pragma unroll
    for (int q = 0; q < R; ++q) Z[a0 + q * astride] = v[brev_c(q, LOGR)];
}
__device__ __forceinline__ void fft16k_fwd(LAS f32x2* Z) {
    const int tid = otid();
    const LAS f32x2* T1 = (const LAS f32x2*)((LAS unsigned char*)Z + HY_TW);
    fft_bfly<32, 5, false, true>(Z, tid + (tid >> 4), 560, T1[tid]);
    __syncthreads();
    { const int b = tid >> 4, j = tid & 15; fft_bfly<32, 5, false, true>(Z, 560 * b + j, 17, T1[32 * j]); }
    __syncthreads();
#pragma unroll
    for (int h = 0; h < 2; ++h) { const int bb = tid + 512 * h; fft_bfly<16, 4, false, false>(Z, 17 * bb + 16 * (bb >> 5), 1, (f32x2){1.f, 0.f}); }
    __syncthreads();
}
__device__ __forceinline__ void fft16k_inv(LAS f32x2* Z) {
    const int tid = otid();
#pragma unroll
    for (int h = 0; h < 2; ++h) { const int bb = tid + 512 * h; fft_bfly<16, 4, true, false>(Z, 17 * bb + 16 * (bb >> 5), 1, (f32x2){1.f, 0.f}); }
    __syncthreads();
    const LAS f32x2* T1 = (const LAS f32x2*)((LAS unsigned char*)Z + HY_TW);
    { const int b = tid >> 4, j = tid & 15; fft_bfly<32, 5, true, true>(Z, 560 * b + j, 17, T1[32 * j]); }
    __syncthreads();
    fft_bfly<32, 5, true, true>(Z, tid + (tid >> 4), 560, T1[tid]);
    __syncthreads();
}
__device__ __forceinline__ int pair_k(int tid, int jj) { return ((tid >> 8) * 16 + jj) + 32 * ((tid >> 3) & 31) + 1024 * (tid & 7); }

__device__ __forceinline__ void hy_stash(LAS f32x2* Z, f32x4 (&st)[16], f32x4& stx) {
    const int tid = otid();
#pragma unroll
    for (int jj = 0; jj < 16; ++jj) { const int k = pair_k(tid, jj), kp = (16384 - k) & 16383;
        const f32x2 A = Z[kpos(k)], Bc = Z[kpos(kp)]; const f32x2 B = (f32x2){Bc.x, -Bc.y};
        const f32x2 S = A + B, Dd = A - B;
        st[jj] = (f32x4){0.5f * S.x, 0.5f * S.y, 0.5f * Dd.y, -0.5f * Dd.x}; }
    { const f32x2 A = Z[kpos(8192)]; stx = (f32x4){A.x, 0.f, A.y, 0.f}; }
}
__device__ __forceinline__ void hy_pointwise_one(LAS f32x2* Z, int k, const f32x4 hh, bool do_write) {
    const int kp = (16384 - k) & 16383; const int pa = kpos(k), pb = kpos(kp);
    const f32x2 A = Z[pa], Bc = Z[pb]; const f32x2 B = (f32x2){Bc.x, -Bc.y};
    const f32x2 S = A + B, Dd = A - B;
    const f32x2 Xe = (f32x2){0.5f * S.x, 0.5f * S.y}, Xo = (f32x2){0.5f * Dd.y, -0.5f * Dd.x};
    const f32x2 He = (f32x2){hh.x, hh.y}, Ho = (f32x2){hh.z, hh.w};
    const LAS f32x2* T1 = (const LAS f32x2*)((LAS unsigned char*)Z + HY_TW);
    const f32x2 w2 = cmul(T1[k & 511], T1[512 + (k >> 9)]);
    const f32x2 P = cmul(Xe, He) + cmul(w2, cmul(Xo, Ho));
    const f32x2 Q = cmul(Xe, Ho) + cmul(Xo, He);
    if (do_write) { Z[pa] = (f32x2){P.x - Q.y, P.y + Q.x}; Z[pb] = (f32x2){P.x + Q.y, Q.x - P.y}; }
}
__device__ __forceinline__ void hy_pointwise(LAS f32x2* Z, const f32x4 (&st)[16], const f32x4& stx) {
    const int tid = otid();
#pragma unroll
    for (int jj = 0; jj < 16; ++jj) hy_pointwise_one(Z, pair_k(tid, jj), st[jj], true);
    hy_pointwise_one(Z, 8192, stx, tid == 0);
    __syncthreads();
}
__device__ __forceinline__ void ld32bf(const bf16_t* __restrict__ p, float (&o)[32]) {
#pragma unroll
    for (int q = 0; q < 4; ++q) { const u32x4 w = *(const u32x4*)(p + q * 8);
        o[q * 8 + 0] = bflo(w.x); o[q * 8 + 1] = bfhi(w.x); o[q * 8 + 2] = bflo(w.y); o[q * 8 + 3] = bfhi(w.y);
        o[q * 8 + 4] = bflo(w.z); o[q * 8 + 5] = bfhi(w.z); o[q * 8 + 6] = bflo(w.w); o[q * 8 + 7] = bfhi(w.w); }
}
__device__ __forceinline__ void conv32(const bf16_t* __restrict__ row, int t0, int len, float w0, float w1, float w2, float cb, float (&o)[32]) {
    float x[32]; ld32bf(row + t0, x);
    const float xm = t0 > 0 ? bf2f(row[t0 - 1]) : 0.f, xp = (t0 + 32 < len) ? bf2f(row[t0 + 32]) : 0.f;
#pragma unroll
    for (int i = 0; i < 32; ++i) { const float a = i > 0 ? x[i - 1] : xm, c = i < 31 ? x[i + 1] : xp; o[i] = cb + w0 * a + w1 * x[i] + w2 * c; }
}
__device__ __forceinline__ void hy_load_taps(LAS f32x2* Z, const bf16_t* __restrict__ hf, const bf16_t* __restrict__ hb) {
    const int tid = otid();
    { float x[32]; ld32bf(hf + 32 * tid, x);
#pragma unroll
      for (int i = 0; i < 16; ++i) Z[fpad(16 * tid + i)] = (f32x2){x[2 * i], x[2 * i + 1]}; }
    { const int e0 = 16384 - 32 * tid; float x[32]; ld32bf(hb + e0 - 32, x);
      const float ex = (e0 < 16384) ? bf2f(hb[e0]) : 0.f;
#pragma unroll
      for (int i = 0; i < 16; ++i) Z[fpad(8192 + 16 * tid + i)] = (f32x2){i == 0 ? ex : x[32 - 2 * i], x[31 - 2 * i]}; }
    __syncthreads();
}
__device__ __forceinline__ void hy_load_data(LAS f32x2* Z, const float (&zc)[32]) {
    const int tid = otid();
#pragma unroll
    for (int i = 0; i < 16; ++i) { Z[fpad(16 * tid + i)] = (f32x2){zc[2 * i], zc[2 * i + 1]}; Z[fpad(8192 + 16 * tid + i)] = (f32x2){0.f, 0.f}; }
    __syncthreads();
}
__device__ __forceinline__ void hy_get_z(const Params& p, int o, int c, int t0, float (&zc)[32]) {
    if (o == 0) { const bf16_t* PRE = (const bf16_t*)(p.ws + OFF_BIG2); const float* cw = p.in[I_HYCW];
        conv32(PRE + (size_t)c * MT, t0, TL, cw[c], cw[3072 + c], cw[6144 + c], p.in[I_HYCB][c], zc);
    } else { const float* ZS = (const float*)(p.ws + OFF_X) + (size_t)c * TL + t0;
#pragma unroll
        for (int q = 0; q < 8; ++q) { const f32x4 v = *(const f32x4*)(ZS + 4 * q); zc[4 * q] = v[0]; zc[4 * q + 1] = v[1]; zc[4 * q + 2] = v[2]; zc[4 * q + 3] = v[3]; } }
}
__device__ __forceinline__ void hyena_channel(const Params& p, LAS f32x2* Z, int c) {
    const int tid = otid();
    const bf16_t* PRE = (const bf16_t*)(p.ws + OFF_BIG2);
    const bf16_t* HmT = (const bf16_t*)(p.ws + OFF_BIG1);
    bf16_t* hyT = (bf16_t*)(p.ws + OFF_HYT);
    float* ZS = (float*)(p.ws + OFF_X);
    const float* cw = p.in[I_HYCW]; const float* cbias = p.in[I_HYCB]; const float* skip = p.in[I_HYSKIP];
    const int t0 = 32 * tid;
#pragma unroll 1
    for (int o = 0; o < 2; ++o) {
        f32x4 st[16], stx;
        hy_load_taps(Z, HmT + (size_t)(o * 1024 + c) * TL, HmT + (size_t)(2048 + o * 1024 + c) * TL);
        fft16k_fwd(Z);
        hy_stash(Z, st, stx);
        __syncthreads();
        { float zc[32]; hy_get_z(p, o, c, t0, zc); hy_load_data(Z, zc); }
        fft16k_fwd(Z);
        hy_pointwise(Z, st, stx);
        fft16k_inv(Z);
        {
            const int gr = (o + 1) * 1024 + c;
            float zc[32]; hy_get_z(p, o, c, t0, zc);
            float g[32]; conv32(PRE + (size_t)gr * MT, t0, TL, cw[gr], cw[3072 + gr], cw[6144 + gr], cbias[gr], g);
            const float sk = skip[o * 1024 + c];
#pragma unroll
            for (int i = 0; i < 16; ++i) { const f32x2 y = Z[fpad(16 * tid + i)];
                zc[2 * i] = g[2 * i] * (y.x * (1.0f / 16384.0f) + sk * zc[2 * i]); zc[2 * i + 1] = g[2 * i + 1] * (y.y * (1.0f / 16384.0f) + sk * zc[2 * i + 1]); }
            if (o == 0) {
#pragma unroll
                for (int q = 0; q < 8; ++q) *(f32x4*)(ZS + (size_t)c * TL + t0 + 4 * q) = (f32x4){zc[4 * q], zc[4 * q + 1], zc[4 * q + 2], zc[4 * q + 3]};
            } else {
                bf16_t* dst = hyT + (size_t)c * MT + t0;
#pragma unroll
                for (int q = 0; q < 4; ++q) { u32x4 w; w.x = pk_bf16(zc[q * 8], zc[q * 8 + 1]); w.y = pk_bf16(zc[q * 8 + 2], zc[q * 8 + 3]); w.z = pk_bf16(zc[q * 8 + 4], zc[q * 8 + 5]); w.w = pk_bf16(zc[q * 8 + 6], zc[q * 8 + 7]);
                    *(u32x4*)(dst + q * 8) = w; }
            }
        }
        __syncthreads();
    }
}
__device__ __forceinline__ void hyena_ctx_channel(const Params& p, LAS float* wl, int c) {
    const int lane = otid() & 63;
    const bf16_t* PRE = (const bf16_t*)(p.ws + OFF_BIG2);
    const bf16_t* HmC = (const bf16_t*)(p.ws + OFF_BIG1) + (size_t)4096 * TL;
    bf16_t* hyT = (bf16_t*)(p.ws + OFF_HYT);
    const float* cw = p.in[I_HYCW]; const float* cbias = p.in[I_HYCB]; const float* skip = p.in[I_HYSKIP];
    LAS float* zs = wl; LAS float* tp = wl + 256;
    float z[4];
    {
        const bf16_t* row = PRE + (size_t)c * MT + TL;
        float x[6];
#pragma unroll
        for (int i = 0; i < 6; ++i) { const int t = 4 * lane - 1 + i; x[i] = (t >= 0 && t < TCX) ? bf2f(row[t]) : 0.f; }
#pragma unroll
        for (int i = 0; i < 4; ++i) z[i] = cbias[c] + cw[c] * x[i] + cw[3072 + c] * x[i + 1] + cw[6144 + c] * x[i + 2];
    }
#pragma unroll 1
    for (int o = 0; o < 2; ++o) {
        const bf16_t* hf = HmC + (size_t)(o * 1024 + c) * TCX; const bf16_t* hb = HmC + (size_t)(2048 + o * 1024 + c) * TCX;
#pragma unroll
        for (int i = 0; i < 4; ++i) { const int d = 4 * lane + i; zs[d] = z[i]; tp[255 + d] = bf2f(hf[d]); if (d > 0) tp[255 - d] = bf2f(hb[d]); }
        __builtin_amdgcn_s_waitcnt(0);
        __builtin_amdgcn_wave_barrier();
        float y[4] = {0.f, 0.f, 0.f, 0.f};
        for (int s = 0; s < 256; ++s) { const float zv = zs[s];
#pragma unroll
            for (int i = 0; i < 4; ++i) y[i] = fmaf(tp[255 + 4 * lane + i - s], zv, y[i]); }
        const int gr = (o + 1) * 1024 + c;
        const bf16_t* row = PRE + (size_t)gr * MT + TL;
        float x[6];
#pragma unroll
        for (int i = 0; i < 6; ++i) { const int t = 4 * lane - 1 + i; x[i] = (t >= 0 && t < TCX) ? bf2f(row[t]) : 0.f; }
        const float sk = skip[o * 1024 + c];
#pragma unroll
        for (int i = 0; i < 4; ++i) { const float g = cbias[gr] + cw[gr] * x[i] + cw[3072 + gr] * x[i + 1] + cw[6144 + gr] * x[i + 2]; z[i] = g * (y[i] + sk * z[i]); }
        __builtin_amdgcn_wave_barrier();
    }
    *(u32x2*)(hyT + (size_t)c * MT + TL + 4 * lane) = (u32x2){pk_bf16(z[0], z[1]), pk_bf16(z[2], z[3])};
}

constexpr int NA_KS = 0;
constexpr int NA_VS = 34816;
__device__ __forceinline__ void na_block_task(const Params& p, LAS unsigned char* lds, int task) {
    const int tid = otid(), wv = __builtin_amdgcn_readfirstlane(tid >> 6), lane = tid & 63, fr = lane & 15, fq = lane >> 4;
    const bf16_t* QK = (const bf16_t*)(p.ws + OFF_QK);
    const bf16_t* VT = (const bf16_t*)(p.ws + OFF_BIG2) + (size_t)3072 * MT;
    bf16_t* A2 = (bf16_t*)(p.ws + OFF_A);
    const float* rpb = p.in[I_RPB];
    const float scale = 0.08838834764831845f;
    const int hl = wv >> 2;
    int hp, qrow, nlat, r = 0, g = 0, r0 = 0, cb = 0;
    if (task < 1024) { hp = task & 3; r = task >> 2; g = wv & 3; qrow = r * 64 + 16 * g + fr; nlat = 8;
        r0 = r - 4; r0 = r0 < 0 ? 0 : (r0 > 248 ? 248 : r0); cb = 16 * g - 8; cb = cb < 0 ? 0 : (cb > 32 ? 32 : cb);
    } else { const int t = task - 1024; hp = t & 3; qrow = TL + 16 * (4 * (t >> 2) + (wv & 3)) + fr; nlat = 0; }
    const int h = 2 * hp + hl;
    const unsigned so_k = (unsigned)((tid >> 3) * 2048 + (tid & 7) * 8);
    const unsigned so_v = (unsigned)((tid >> 1) * MT + (tid & 1) * 32);
    u32x4 sk[4], sv[4];
#define NA_LOAD(tk0_) do { const bf16_t* kb_ = QK + (size_t)(tk0_) * 2048 + 1024 + hp * 256; const bf16_t* vb_ = VT + (size_t)(hp * 256) * MT + (tk0_); \
        _Pragma("unroll") for (int j = 0; j < 4; ++j) { sk[j] = *(const u32x4*)(kb_ + so_k + 64u * j); sv[j] = *(const u32x4*)(vb_ + so_v + 8u * j); } } while (0)
#define NA_STORE() do { _Pragma("unroll") for (int j = 0; j < 4; ++j) { \
        *(LAS u32x4*)(lds + NA_KS + (j >> 1) * 17408 + (tid >> 3) * 272 + ((tid & 7) * 8 + 64 * (j & 1)) * 2) = sk[j]; \
        *(LAS u32x4*)(lds + NA_VS + (tid >> 1) * 144 + ((tid & 1) * 32 + 8 * j) * 2) = sv[j]; } } while (0)
    bf16x8 qf[4];
#pragma unroll
    for (int ks = 0; ks < 4; ++ks) qf[ks] = *(const bf16x8*)(QK + (size_t)qrow * 2048 + h * 128 + ks * 32 + fq * 8);
    f32x4 oacc[8];
#pragma unroll
    for (int dt = 0; dt < 8; ++dt) oacc[dt] = (f32x4){0.f, 0.f, 0.f, 0.f};
    float mrun = -1e30f, lrun = 0.f;
    const int c = 16 * g + fr;
    int cs = c - 8; cs = cs < 0 ? 0 : (cs > 48 ? 48 : cs);
    const int nsteps = nlat + 4;
    __syncthreads();
    { const int tk0 = nlat ? r0 * 64 : TL; NA_LOAD(tk0); NA_STORE(); }
    __syncthreads();
    LAS unsigned char* Kh = lds + NA_KS + hl * 17408;
    LAS unsigned char* Vh = lds + NA_VS + hl * 128 * 144;
#pragma unroll 1
    for (int step = 0; step < nsteps; ++step) {
        const bool lat = step < nlat;
        if (step + 1 < nsteps) { const int tk1 = (step + 1 < nlat) ? (r0 + step + 1) * 64 : TL + 64 * (step + 1 - nlat); NA_LOAD(tk1); }
        const int kr = r0 + step;
        const int nsub = lat ? 1 : 2;
#pragma unroll 1
        for (int sub = 0; sub < nsub; ++sub) {
            const int kb = lat ? cb : 32 * sub;
            f32x4 s[2];
#pragma unroll
            for (int tl = 0; tl < 2; ++tl) {
                s[tl] = (f32x4){0.f, 0.f, 0.f, 0.f};
#pragma unroll
                for (int ks = 0; ks < 4; ++ks) { const bf16x8 kf = *(const LAS bf16x8*)(Kh + (kb + 16 * tl + fr) * 272 + 64 * ks + 16 * fq);
                    s[tl] = __builtin_amdgcn_mfma_f32_16x16x32_bf16(kf, qf[ks], s[tl], 0, 0, 0); }
            }
            float svv[8]; float mx = -1e30f;
#pragma unroll
            for (int tl = 0; tl < 2; ++tl)
#pragma unroll
                for (int rg = 0; rg < 4; ++rg) {
                    float v = s[tl][rg] * scale;
                    if (lat) { const int kc = kb + 16 * tl + 4 * fq + rg; const bool ok = (kc >= cs) && (kc < cs + 16);
                        const int ro = kr - r + 7, co = kc - c + 15;
                        const float bias = ok ? rpb[(h * 15 + ro) * 31 + co] : 0.f;
                        v = ok ? v + bias : -1e30f; }
                    svv[tl * 4 + rg] = v; mx = fmaxf(mx, v);
                }
            mx = fmaxf(mx, __shfl_xor(mx, 16)); mx = fmaxf(mx, __shfl_xor(mx, 32));
            const float mnew = fmaxf(mrun, mx);
            const float alpha = __expf(mrun - mnew);
            float ps = 0.f; float pv[8];
#pragma unroll
            for (int i = 0; i < 8; ++i) { pv[i] = (svv[i] > -1e29f) ? __expf(svv[i] - mnew) : 0.f; ps += pv[i]; }
            ps += __shfl_xor(ps, 16); ps += __shfl_xor(ps, 32);
            lrun = lrun * alpha + ps; mrun = mnew;
            bf16x8 pf;
            { const u32x4 w = (u32x4){pk_bf16(pv[0], pv[1]), pk_bf16(pv[2], pv[3]), pk_bf16(pv[4], pv[5]), pk_bf16(pv[6], pv[7])}; pf = __builtin_bit_cast(bf16x8, w); }
#pragma unroll
            for (int dt = 0; dt < 8; ++dt) {
                oacc[dt] *= alpha;
                LAS unsigned char* vp = Vh + (dt * 16 + fr) * 144 + (kb + 4 * fq) * 2;
                const u32x2 va = *(const LAS u32x2*)(vp), vb = *(const LAS u32x2*)(vp + 32);
                const u32x4 vw = (u32x4){va.x, va.y, vb.x, vb.y};
                oacc[dt] = __builtin_amdgcn_mfma_f32_16x16x32_bf16(__builtin_bit_cast(bf16x8, vw), pf, oacc[dt], 0, 0, 0);
            }
        }
        __syncthreads();
        if (step + 1 < nsteps) NA_STORE();
        __syncthreads();
    }
#undef NA_LOAD
#undef NA_STORE
    const float inv = 1.0f / lrun;
#pragma unroll
    for (int dt = 0; dt < 8; ++dt) {
        const f32x4 o = oacc[dt] * inv;
        *(u32x2*)(A2 + (size_t)qrow * 2048 + 1024 + h * 128 + dt * 16 + 4 * fq) = (u32x2){pk_bf16(o[0], o[1]), pk_bf16(o[2], o[3])};
    }
}

__device__ __forceinline__ void phase3(const Params& p, LAS unsigned char* lds, int which = 7) {
    const int tid = otid(), w = tid >> 6;
    {
        LAS f32x2* T1 = (LAS f32x2*)(lds + HY_TW); float sn, cs;
        sincospif((float)tid * (1.0f / 8192.0f), &sn, &cs); T1[tid] = (f32x2){cs, -sn};
        if (tid < 17) { sincospif((float)tid * (1.0f / 16.0f), &sn, &cs); T1[512 + tid] = (f32x2){cs, -sn}; }
        __syncthreads();
    }
    if (which & 1) for (int c = blockIdx.x; c < 1024; c += gridDim.x) hyena_channel(p, (LAS f32x2*)lds, c);
    __syncthreads();
    if (which & 2) for (int c = blockIdx.x * 8 + w; c < 1024; c += gridDim.x * 8) hyena_ctx_channel(p, (LAS float*)lds + w * 768, c);
    __syncthreads();
    if (which & 4) for (int t = blockIdx.x; t < 1024 + 16; t += gridDim.x) na_block_task(p, lds, t);
}

__device__ __forceinline__ void phase4(const Params& p, LAS unsigned char* lds) {
    LAS unsigned short* tile = (LAS unsigned short*)lds;
    const bf16_t* hyT = (const bf16_t*)(p.ws + OFF_HYT);
    bf16_t* A2 = (bf16_t*)(p.ws + OFF_A);
    const int tid = otid();
    for (int task = blockIdx.x; task < 16 * 260; task += gridDim.x) {
        const int ct = task & 15, rt = task >> 4;
#pragma unroll
        for (int it = 0; it < 4; ++it) { const int i = tid + it * 512, cc = i >> 5, rp = i & 31;
            const unsigned v = *(const unsigned*)(hyT + (size_t)(ct * 64 + cc) * MT + rt * 64 + 2 * rp);
            tile[cc * 66 + 2 * rp] = (unsigned short)(v & 0xFFFFu); tile[cc * 66 + 2 * rp + 1] = (unsigned short)(v >> 16); }
        __syncthreads();
#pragma unroll
        for (int it = 0; it < 4; ++it) { const int i = tid + it * 512, rr = i >> 5, cp = i & 31;
            const unsigned lo = tile[(2 * cp) * 66 + rr], hi = tile[(2 * cp + 1) * 66 + rr];
            *(unsigned*)(A2 + (size_t)(rt * 64 + rr) * 2048 + ct * 64 + 2 * cp) = (lo | (hi << 16)); }
        __syncthreads();
    }
}
__device__ __forceinline__ void ld8(const float* __restrict__ p, float (&o)[8]) { const f32x4 a = *(const f32x4*)p, b = *(const f32x4*)(p + 4);
    o[0] = a[0]; o[1] = a[1]; o[2] = a[2]; o[3] = a[3]; o[4] = b[0]; o[5] = b[1]; o[6] = b[2]; o[7] = b[3]; }
__device__ __forceinline__ void st8(float* __restrict__ p, const float (&o)[8]) { *(f32x4*)p = (f32x4){o[0], o[1], o[2], o[3]}; *(f32x4*)(p + 4) = (f32x4){o[4], o[5], o[6], o[7]}; }
__device__ __forceinline__ void st8bf(bf16_t* __restrict__ p, const float (&o)[8]) { *(u32x4*)p = (u32x4){pk_bf16(o[0], o[1]), pk_bf16(o[2], o[3]), pk_bf16(o[4], o[5]), pk_bf16(o[6], o[7])}; }

__device__ __forceinline__ void ld8bf(const bf16_t* __restrict__ p, float (&o)[8]) { const u32x4 w = *(const u32x4*)p; o[0] = bflo(w.x); o[1] = bfhi(w.x); o[2] = bflo(w.y); o[3] = bfhi(w.y); o[4] = bflo(w.z); o[5] = bfhi(w.z); o[6] = bflo(w.w); o[7] = bfhi(w.w); }
__device__ __forceinline__ void ln_row(float (&v)[4][8], const float* __restrict__ lw, const float* __restrict__ lb, int lane) {
    float s = 0.f;
#pragma unroll
    for (int pc = 0; pc < 4; ++pc)
#pragma unroll
        for (int j = 0; j < 8; ++j) s += v[pc][j];
    const float mu = wave_sum(s) * (1.0f / 2048.0f);
    float q = 0.f;
#pragma unroll
    for (int pc = 0; pc < 4; ++pc)
#pragma unroll
        for (int j = 0; j < 8; ++j) { const float d = v[pc][j] - mu; q += d * d; }
    const float rs = rsqrtf(wave_sum(q) * (1.0f / 2048.0f) + LN_EPS);
#pragma unroll
    for (int pc = 0; pc < 4; ++pc) { float w[8], b[8]; ld8(lw + pc * 512 + lane * 8, w); ld8(lb + pc * 512 + lane * 8, b);
#pragma unroll
        for (int j = 0; j < 8; ++j) v[pc][j] = (v[pc][j] - mu) * rs * w[j] + b[j]; }
}

template <bool SLAB>
__device__ __forceinline__ void ln1_load(const Params& p, int layer, int r, int lane, const float* __restrict__ slab, float (&v)[4][8]) {
    const bf16_t* y = (const bf16_t*)(p.ws + OFF_BIG2); const bf16_t* H = (const bf16_t*)(p.ws + OFF_H);
    const float* hp = r < TL ? p.in[I_X] + (size_t)r * DM : p.in[I_CTX] + (size_t)(r - TL) * DM;
    const float* md = (const float*)(p.ws + OFF_MOD) + (size_t)layer * 2 * 12288 + (r < TL ? 0 : 12288);
#pragma unroll
    for (int pc = 0; pc < 4; ++pc) { const int e = pc * 512 + lane * 8; float hv[8], yv[8], gv[8];
        if (layer == 0) ld8(hp + e, hv); else ld8bf(H + (size_t)r * DM + e, hv);
        if (SLAB) {
#pragma unroll
            for (int j = 0; j < 8; ++j) yv[j] = 0.f;
#pragma unroll 1
            for (int sl = 0; sl < 8; ++sl) { float t8[8]; ld8(slab + ((size_t)(sl * 8 + (e >> 8)) << 16) + (size_t)(r - TL) * 256 + (e & 255), t8);
#pragma unroll
                for (int j = 0; j < 8; ++j) yv[j] += t8[j]; }
        } else ld8bf(y + (size_t)r * DM + e, yv);
        ld8(md + 2 * 2048 + e, gv);
#pragma unroll
        for (int j = 0; j < 8; ++j) v[pc][j] = DN_ALPHA * hv[j] + gv[j] * yv[j]; }
}
__device__ __forceinline__ void ln1_finish(const Params& p, int layer, int r, int lane, float (&v)[4][8]) {
    bf16_t* H = (bf16_t*)(p.ws + OFF_H); bf16_t* A = (bf16_t*)(p.ws + OFF_A);
    const float* lw = p.in[I_LNW] + (size_t)(layer * 2 + 0) * DM; const float* lb = p.in[I_LNB] + (size_t)(layer * 2 + 0) * DM;
    const float* md = (const float*)(p.ws + OFF_MOD) + (size_t)layer * 2 * 12288 + (r < TL ? 0 : 12288);
    ln_row(v, lw, lb, lane);
#pragma unroll
    for (int pc = 0; pc < 4; ++pc) { const int e = pc * 512 + lane * 8; st8bf(H + (size_t)r * DM + e, v[pc]);
        float sc[8], sh[8], o[8]; ld8(md + 4 * 2048 + e, sc); ld8(md + 3 * 2048 + e, sh);
#pragma unroll
        for (int j = 0; j < 8; ++j) o[j] = v[pc][j] * (1.f + sc[j]) + sh[j];
        st8bf(A + (size_t)r * DM + e, o); }
}
__device__ __forceinline__ void phase_ln1(const Params& p, int layer, int nrows, const float* __restrict__ slab) {
    const int tid = otid(), w = tid >> 6, lane = tid & 63;
    const int stride = gridDim.x * 8;
    const int nmain = slab != nullptr ? TL : nrows;
    for (int r = blockIdx.x * 8 + w; r < nmain; r += 2 * stride) {
        const int r2 = r + stride; const bool has2 = r2 < nmain;
        float v[4][8], v2[4][8];
        ln1_load<false>(p, layer, r, lane, slab, v);
        if (has2) ln1_load<false>(p, layer, r2, lane, slab, v2);
        ln1_finish(p, layer, r, lane, v);
        if (has2) ln1_finish(p, layer, r2, lane, v2);
    }
    if (slab != nullptr) {
#pragma unroll 1
        for (int r = TL + blockIdx.x * 8 + w; r < nrows; r += stride) { float v[4][8]; ln1_load<true>(p, layer, r, lane, slab, v); ln1_finish(p, layer, r, lane, v); }
    }
}

__device__ __forceinline__ unsigned fkey(float f) { const unsigned u = __float_as_uint(f); return (u & 0x80000000u) ? ~u : (u | 0x80000000u); }
__device__ __forceinline__ float kval(unsigned k) { const unsigned u = (k & 0x80000000u) ? (k & 0x7FFFFFFFu) : ~k; return __uint_as_float(u); }
__device__ __forceinline__ void kins(unsigned (&L)[16], unsigned x) {
#pragma unroll
    for (int i = 0; i < 16; ++i) { const unsigned hi = L[i] > x ? L[i] : x; x = L[i] > x ? x : L[i]; L[i] = hi; }
}
__device__ __forceinline__ unsigned wave_umax(unsigned v) {
#pragma unroll
    for (int o = 32; o > 0; o >>= 1) { const unsigned t = (unsigned)__shfl_xor((int)v, o); v = v > t ? v : t; }
    return v;
}
__device__ __forceinline__ void topk_ctx_wave(const Params& p, const float* __restrict__ slab) {
    const int tid = otid(), wv = tid >> 6, lane = tid & 63;
    int* EI = (int*)(p.ws + OFF_EXP); float* EG = (float*)(p.ws + OFF_EXP + (size_t)MT * 128 * 4);
    for (int item = blockIdx.x * 8 + wv; item < TCX * 8; item += gridDim.x * 8) {
        const int h = item & 7, rl = item >> 3, r = TL + rl;
        float s1a = 0.f, s1b = 0.f, s2a = 0.f, s2b = 0.f;
#pragma unroll
        for (int sl = 0; sl < 8; ++sl) { const float* sb = slab + ((size_t)(sl * 8 + h) << 16) + rl;
            s1a += sb[(size_t)lane * 256]; s1b += sb[(size_t)(lane + 64) * 256]; s2a += sb[(size_t)(128 + lane) * 256]; s2b += sb[(size_t)(192 + lane) * 256]; }
        unsigned k1a = (fkey(s1a) & ~0x7Fu) | (unsigned)(127 - lane), k1b = (fkey(s1b) & ~0x7Fu) | (unsigned)(63 - lane);
        unsigned k2a = (fkey(s2a) & ~0x7Fu) | (unsigned)(127 - lane), k2b = (fkey(s2b) & ~0x7Fu) | (unsigned)(63 - lane);
        unsigned vec1 = 0u, vec2 = 0u;
#pragma unroll
        for (int i = 0; i < 16; ++i) {
            const unsigned w1 = wave_umax(k1a > k1b ? k1a : k1b); if (k1a == w1) k1a = 0u; if (k1b == w1) k1b = 0u; vec1 = lane == i ? w1 : vec1;
            const unsigned w2 = wave_umax(k2a > k2b ? k2a : k2b); if (k2a == w2) k2a = 0u; if (k2b == w2) k2b = 0u; vec2 = lane == i ? w2 : vec2;
        }
        const float v1 = kval((unsigned)__shfl((int)vec1, lane >> 2) & ~0x7Fu);
        unsigned ck[4];
#pragma unroll
        for (int t = 0; t < 4; ++t) { const int i = lane >> 2, j = 4 * (lane & 3) + t; const float v2 = kval((unsigned)__shfl((int)vec2, j) & ~0x7Fu);
            ck[t] = ((i + 1) * (j + 1) <= 16) ? ((fkey(v1 + v2) & ~0xFFu) | (unsigned)(255 - (i * 16 + j))) : 0u; }
        unsigned vec3 = 0u;
#pragma unroll
        for (int s3 = 0; s3 < 16; ++s3) { unsigned m = ck[0] > ck[1] ? ck[0] : ck[1]; const unsigned m2 = ck[2] > ck[3] ? ck[2] : ck[3]; m = m > m2 ? m : m2;
            const unsigned w3 = wave_umax(m);
#pragma unroll
            for (int t = 0; t < 4; ++t) if (ck[t] == w3) ck[t] = 0u;
            vec3 = lane == s3 ? w3 : vec3; }
        const float top = kval((unsigned)__shfl((int)vec3, 0) & ~0xFFu);
        const float ev = lane < 16 ? __expf(kval(vec3 & ~0xFFu) - top) : 0.f;
        const float sum = wave_sum(ev);
        const unsigned id = 255u - (vec3 & 0xFFu); const int ii = (int)(id >> 4), jj = (int)(id & 15u);
        const unsigned kk1 = (unsigned)__shfl((int)vec1, ii), kk2 = (unsigned)__shfl((int)vec2, jj);
        if (lane < 16) { const int n1 = 127 - (int)(kk1 & 0x7Fu), n2 = 127 - (int)(kk2 & 0x7Fu);
            EI[(size_t)r * 128 + h * 16 + lane] = n1 * 128 + n2; EG[(size_t)r * 128 + h * 16 + lane] = ev / sum; }
    }
}

__device__ __forceinline__ void phase_topk(const Params& p, LAS unsigned char* lds, int nrows, const float* __restrict__ slab) {
    LAS unsigned short* nsel = (LAS unsigned short*)lds;
    const float* ST = (const float*)(p.ws + OFF_BIG1);
    int* EI = (int*)(p.ws + OFF_EXP); float* EG = (float*)(p.ws + OFF_EXP + (size_t)MT * 128 * 4);
    const int tid = otid();
    const int nch = slab != nullptr ? TL / 512 : (nrows + 511) / 512;
    for (int task = blockIdx.x; task < nch * 8; task += gridDim.x) {
        const int h = task & 7, r = (task >> 3) * 512 + tid;
        const bool act = r < nrows; const int rr = act ? r : nrows - 1;
        unsigned L1[16], L2[16], L3[16];
#pragma unroll
        for (int i = 0; i < 16; ++i) { L1[i] = 0u; L2[i] = 0u; L3[i] = 0u; }
        const float* s1 = ST + (size_t)(h * 256) * MT + rr; const float* s2 = s1 + (size_t)128 * MT;
#pragma unroll 1
        for (int n0 = 0; n0 < 128; n0 += 16) {
            float a[16], b[16];
#pragma unroll
            for (int j = 0; j < 16; ++j) { a[j] = s1[(size_t)(n0 + j) * MT]; b[j] = s2[(size_t)(n0 + j) * MT]; }
#pragma unroll
            for (int j = 0; j < 16; ++j) { kins(L1, (fkey(a[j]) & ~0x7Fu) | (unsigned)(127 - n0 - j)); kins(L2, (fkey(b[j]) & ~0x7Fu) | (unsigned)(127 - n0 - j)); }
        }
        float v1[16], v2[16];
#pragma unroll
        for (int i = 0; i < 16; ++i) { v1[i] = kval(L1[i] & ~0x7Fu); v2[i] = kval(L2[i] & ~0x7Fu);
            nsel[i * 512 + tid] = (unsigned short)(127u - (L1[i] & 0x7Fu)); nsel[(16 + i) * 512 + tid] = (unsigned short)(127u - (L2[i] & 0x7Fu)); }
#pragma unroll
        for (int i = 0; i < 16; ++i)
#pragma unroll
            for (int j = 0; j < 16; ++j)
                if ((i + 1) * (j + 1) <= 16) { const unsigned kc = (fkey(v1[i] + v2[j]) & ~0xFFu) | (unsigned)(255 - (i * 16 + j)); kins(L3, kc); }
        const float m = kval(L3[0] & ~0xFFu);
        float e[16], sum = 0.f;
#pragma unroll
        for (int s = 0; s < 16; ++s) { e[s] = __expf(kval(L3[s] & ~0xFFu) - m); sum += e[s]; }
        const float inv = 1.0f / sum;
        if (act) {
#pragma unroll
            for (int s = 0; s < 16; ++s) { const unsigned id = 255u - (L3[s] & 0xFFu); const unsigned i = id >> 4, j = id & 15u;
                const int n1 = nsel[i * 512 + tid], n2 = nsel[(16 + j) * 512 + tid];
                EI[(size_t)r * 128 + h * 16 + s] = n1 * 128 + n2; EG[(size_t)r * 128 + h * 16 + s] = e[s] * inv; }
        }
    }
    if (slab != nullptr) topk_ctx_wave(p, slab);
}

__device__ __forceinline__ float dpp_sum63(float v) {
    v += __builtin_bit_cast(float, __builtin_amdgcn_update_dpp(0, __builtin_bit_cast(int, v), 0x111, 0xf, 0xf, false));
    v += __builtin_bit_cast(float, __builtin_amdgcn_update_dpp(0, __builtin_bit_cast(int, v), 0x112, 0xf, 0xf, false));
    v += __builtin_bit_cast(float, __builtin_amdgcn_update_dpp(0, __builtin_bit_cast(int, v), 0x114, 0xf, 0xf, false));
    v += __builtin_bit_cast(float, __builtin_amdgcn_update_dpp(0, __builtin_bit_cast(int, v), 0x118, 0xf, 0xf, false));
    v += __builtin_bit_cast(float, __builtin_amdgcn_update_dpp(0, __builtin_bit_cast(int, v), 0x142, 0xa, 0xf, false));
    v += __builtin_bit_cast(float, __builtin_amdgcn_update_dpp(0, __builtin_bit_cast(int, v), 0x143, 0xc, 0xf, false));
    return v;
}
__device__ __forceinline__ float readlane_f(float v, int l) { return __builtin_bit_cast(float, __builtin_amdgcn_readlane(__builtin_bit_cast(int, v), l)); }
__device__ __forceinline__ float dot8(const u32x4 a, const u32x4 b, float acc) {
    const unsigned a0 = a.x, a1 = a.y, a2 = a.z, a3 = a.w, b0 = b.x, b1 = b.y, b2 = b.z, b3 = b.w;
    acc = __builtin_amdgcn_fdot2_f32_bf16(__builtin_bit_cast(bf2_t, a0), __builtin_bit_cast(bf2_t, b0), acc, false);
    acc = __builtin_amdgcn_fdot2_f32_bf16(__builtin_bit_cast(bf2_t, a1), __builtin_bit_cast(bf2_t, b1), acc, false);
    acc = __builtin_amdgcn_fdot2_f32_bf16(__builtin_bit_cast(bf2_t, a2), __builtin_bit_cast(bf2_t, b2), acc, false);
    acc = __builtin_amdgcn_fdot2_f32_bf16(__builtin_bit_cast(bf2_t, a3), __builtin_bit_cast(bf2_t, b3), acc, false);
    return acc;
}
__device__ __forceinline__ void axpy8(float (&o)[8], const u32x4 v, float c) {
    o[0] = fmaf(c, bflo(v.x), o[0]); o[1] = fmaf(c, bfhi(v.x), o[1]); o[2] = fmaf(c, bflo(v.y), o[2]); o[3] = fmaf(c, bfhi(v.y), o[3]);
    o[4] = fmaf(c, bflo(v.z), o[4]); o[5] = fmaf(c, bfhi(v.z), o[5]); o[6] = fmaf(c, bflo(v.w), o[6]); o[7] = fmaf(c, bfhi(v.w), o[7]);
}
__device__ __forceinline__ void cvt16(const u32x4 w, float (&o)[16]) {
    const int w0 = (int)w.x, w1 = (int)w.y, w2 = (int)w.z, w3 = (int)w.w;
    f32x2 t;
    t = __builtin_amdgcn_cvt_pk_f32_fp8(w0, false); o[0] = t.x; o[1] = t.y;   t = __builtin_amdgcn_cvt_pk_f32_fp8(w0, true); o[2] = t.x; o[3] = t.y;
    t = __builtin_amdgcn_cvt_pk_f32_fp8(w1, false); o[4] = t.x; o[5] = t.y;   t = __builtin_amdgcn_cvt_pk_f32_fp8(w1, true); o[6] = t.x; o[7] = t.y;
    t = __builtin_amdgcn_cvt_pk_f32_fp8(w2, false); o[8] = t.x; o[9] = t.y;   t = __builtin_amdgcn_cvt_pk_f32_fp8(w2, true); o[10] = t.x; o[11] = t.y;
    t = __builtin_amdgcn_cvt_pk_f32_fp8(w3, false); o[12] = t.x; o[13] = t.y; t = __builtin_amdgcn_cvt_pk_f32_fp8(w3, true); o[14] = t.x; o[15] = t.y;
}
__device__ __forceinline__ void ld16(const float* __restrict__ p, float (&o)[16]) {
#pragma unroll
    for (int q = 0; q < 4; ++q) { const f32x4 a = *(const f32x4*)(p + 4 * q); o[4 * q] = a[0]; o[4 * q + 1] = a[1]; o[4 * q + 2] = a[2]; o[4 * q + 3] = a[3]; }
}
__device__ __forceinline__ void peer_finish(const Params& p, int layer, int r, int lane, float (&f)[2][16]) {
    bf16_t* H = (bf16_t*)(p.ws + OFF_H); bf16_t* A = (bf16_t*)(p.ws + OFF_A);
    const float* lw = p.in[I_LNW] + (size_t)(layer * 2 + 1) * DM; const float* lb = p.in[I_LNB] + (size_t)(layer * 2 + 1) * DM;
    const float* md = (const float*)(p.ws + OFF_MOD) + (size_t)layer * 2 * 12288 + (r < TL ? 0 : 12288);
    float s = 0.f;
#pragma unroll
    for (int pc = 0; pc < 2; ++pc) { const int e = pc * 1024 + lane * 16; float hv[16], gv[16]; { float t0[8], t1[8]; ld8bf(H + (size_t)r * DM + e, t0); ld8bf(H + (size_t)r * DM + e + 8, t1);
#pragma unroll
            for (int j = 0; j < 8; ++j) { hv[j] = t0[j]; hv[8 + j] = t1[j]; } } ld16(md + 5 * 2048 + e, gv);
#pragma unroll
        for (int j = 0; j < 16; ++j) { f[pc][j] = DN_ALPHA * hv[j] + gv[j] * f[pc][j]; s += f[pc][j]; } }
    const float mu = wave_sum(s) * (1.0f / 2048.0f);
    float qv = 0.f;
#pragma unroll
    for (int pc = 0; pc < 2; ++pc)
#pragma unroll
        for (int j = 0; j < 16; ++j) { const float d = f[pc][j] - mu; qv += d * d; }
    const float rs = rsqrtf(wave_sum(qv) * (1.0f / 2048.0f) + LN_EPS);
    const float* md1 = (const float*)(p.ws + OFF_MOD) + (size_t)2 * 12288 + (r < TL ? 0 : 12288);
#pragma unroll
    for (int pc = 0; pc < 2; ++pc) { const int e = pc * 1024 + lane * 16; float wv[16], bv[16]; ld16(lw + e, wv); ld16(lb + e, bv);
        float o[16];
#pragma unroll
        for (int j = 0; j < 16; ++j) o[j] = (f[pc][j] - mu) * rs * wv[j] + bv[j];
        if (layer == 0) {
            *(u32x4*)(H + (size_t)r * DM + e) = (u32x4){pk_bf16(o[0], o[1]), pk_bf16(o[2], o[3]), pk_bf16(o[4], o[5]), pk_bf16(o[6], o[7])};
            *(u32x4*)(H + (size_t)r * DM + e + 8) = (u32x4){pk_bf16(o[8], o[9]), pk_bf16(o[10], o[11]), pk_bf16(o[12], o[13]), pk_bf16(o[14], o[15])};
            float sc[16], sh[16]; ld16(md1 + 2048 + e, sc); ld16(md1 + e, sh);
#pragma unroll
            for (int j = 0; j < 16; ++j) o[j] = o[j] * (1.f + sc[j]) + sh[j];
            bf16_t* ap = A + (size_t)r * DM + e;
            *(u32x4*)ap = (u32x4){pk_bf16(o[0], o[1]), pk_bf16(o[2], o[3]), pk_bf16(o[4], o[5]), pk_bf16(o[6], o[7])};
            *(u32x4*)(ap + 8) = (u32x4){pk_bf16(o[8], o[9]), pk_bf16(o[10], o[11]), pk_bf16(o[12], o[13]), pk_bf16(o[14], o[15])};
        } else {
#pragma unroll
            for (int q = 0; q < 4; ++q) *(f32x4*)(p.out + (size_t)r * DM + e + 4 * q) = (f32x4){o[4 * q], o[4 * q + 1], o[4 * q + 2], o[4 * q + 3]};
        }
    }
}
typedef long i64_t;
constexpr float PEER_XS = 16.0f;
__device__ __forceinline__ i64_t mk64(unsigned lo, unsigned hi) { return (i64_t)(((unsigned long long)hi << 32) | (unsigned long long)lo); }
__device__ __forceinline__ unsigned fp8x4(float a, float b, float c, float d) { int v = 0; v = __builtin_amdgcn_cvt_pk_fp8_f32(a, b, v, false); v = __builtin_amdgcn_cvt_pk_fp8_f32(c, d, v, true); return (unsigned)v; }
__device__ __forceinline__ void peer_load_x8(const bf16_t* __restrict__ A, int r, int lane, u32x4 (&xh)[2], u32x4 (&xl)[2]) {
#pragma unroll
    for (int pc = 0; pc < 2; ++pc) { const bf16_t* ap = A + (size_t)r * DM + pc * 1024 + lane * 16;
        const u32x4 a = *(const u32x4*)ap, b = *(const u32x4*)(ap + 8);
        const unsigned w[8] = {a.x, a.y, a.z, a.w, b.x, b.y, b.z, b.w};
        unsigned h[4], l[4];
#pragma unroll
        for (int q = 0; q < 4; ++q) { const float v0 = bflo(w[2 * q]) * PEER_XS, v1 = bfhi(w[2 * q]) * PEER_XS, v2 = bflo(w[2 * q + 1]) * PEER_XS, v3 = bfhi(w[2 * q + 1]) * PEER_XS;
            h[q] = fp8x4(__builtin_amdgcn_fmed3f(v0, -448.f, 448.f), __builtin_amdgcn_fmed3f(v1, -448.f, 448.f), __builtin_amdgcn_fmed3f(v2, -448.f, 448.f), __builtin_amdgcn_fmed3f(v3, -448.f, 448.f));
            const f32x2 d0 = __builtin_amdgcn_cvt_pk_f32_fp8((int)h[q], false), d1 = __builtin_amdgcn_cvt_pk_f32_fp8((int)h[q], true);
            l[q] = fp8x4(__builtin_amdgcn_fmed3f(v0 - d0.x, -448.f, 448.f), __builtin_amdgcn_fmed3f(v1 - d0.y, -448.f, 448.f), __builtin_amdgcn_fmed3f(v2 - d1.x, -448.f, 448.f), __builtin_amdgcn_fmed3f(v3 - d1.y, -448.f, 448.f)); }
        xh[pc] = (u32x4){h[0], h[1], h[2], h[3]}; xl[pc] = (u32x4){l[0], l[1], l[2], l[3]}; }
}
typedef int i32x8 __attribute__((ext_vector_type(8)));
template <int nb4, int NLO>
__device__ __forceinline__ void peer_acc3(const unsigned char* __restrict__ U, const unsigned char* __restrict__ V, int lane, int myid, float myg, const u32x4 (&xh)[2], const u32x4 (&xl)[2], float (&f)[2][16]) {
    float actv = 0.f;
    const bool dg = (((lane & 15) >> 2) == (lane >> 4));
    const float w0 = (dg && (lane & 3) == 0) ? 1.f : 0.f, w1 = (dg && (lane & 3) == 1) ? 1.f : 0.f, w2 = (dg && (lane & 3) == 2) ? 1.f : 0.f, w3 = (dg && (lane & 3) == 3) ? 1.f : 0.f;
    const i32x8 bh = {(int)xh[0].x, (int)xh[0].y, (int)xh[0].z, (int)xh[0].w, (int)xh[1].x, (int)xh[1].y, (int)xh[1].z, (int)xh[1].w};
    const i32x8 bl = {(int)xl[0].x, (int)xl[0].y, (int)xl[0].z, (int)xl[0].w, (int)xl[1].x, (int)xl[1].y, (int)xl[1].z, (int)xl[1].w};
    int sc = 0x7F7F7F7F; asm volatile("" : "+v"(sc));
#pragma unroll 1
    for (int e4 = 0; e4 < nb4; ++e4) {
        u32x4 raw[4][2];
#pragma unroll
        for (int q = 0; q < 4; ++q) { const int eid = __builtin_amdgcn_readlane(myid, e4 * 4 + q);
            const unsigned char* row = U + (size_t)eid * DM + lane * 16;
            raw[q][0] = *(const u32x4*)row; raw[q][1] = *(const u32x4*)(row + 1024); }
#pragma unroll
        for (int q = 0; q < 4; ++q) { f32x4 acc = (f32x4){0.f, 0.f, 0.f, 0.f};
            const i32x8 a = {(int)raw[q][0].x, (int)raw[q][0].y, (int)raw[q][0].z, (int)raw[q][0].w, (int)raw[q][1].x, (int)raw[q][1].y, (int)raw[q][1].z, (int)raw[q][1].w};
            acc = __builtin_amdgcn_mfma_scale_f32_16x16x128_f8f6f4(a, bh, acc, 0, 0, 0, sc, 0, sc);
            if (NLO) acc = __builtin_amdgcn_mfma_scale_f32_16x16x128_f8f6f4(a, bl, acc, 0, 0, 0, sc, 0, sc);
            const float dv = fmaf(acc[0], w0, fmaf(acc[1], w1, fmaf(acc[2], w2, acc[3] * w3)));
            const float tot = readlane_f(dpp_sum63(dv), 63); actv = (lane == e4 * 4 + q) ? tot : actv; }
    }
    actv *= (1.0f / (PEER_XS * PEER_USCALE));
    const float coef = myg * (0.5f / PEER_VSCALE) * actv * (1.0f + erff(actv * 0.70710678118654752f));
#pragma unroll 1
    for (int e4 = 0; e4 < nb4; ++e4) {
        u32x4 raw[4][2]; float cf[4];
#pragma unroll
        for (int q = 0; q < 4; ++q) { const int eid = __builtin_amdgcn_readlane(myid, e4 * 4 + q); cf[q] = readlane_f(coef, e4 * 4 + q);
            const unsigned char* row = V + (size_t)eid * DM + lane * 16;
            raw[q][0] = *(const u32x4*)row; raw[q][1] = *(const u32x4*)(row + 1024); }
#pragma unroll
        for (int q = 0; q < 4; ++q)
#pragma unroll
            for (int pc = 0; pc < 2; ++pc) { float vv[16]; cvt16(raw[q][pc], vv);
#pragma unroll
                for (int j = 0; j < 16; ++j) f[pc][j] = fmaf(cf[q], vv[j], f[pc][j]); }
    }
}
__device__ __forceinline__ void phase_peer(const Params& p, LAS unsigned char* lds, int layer, int nrows) {
    const int tid = otid(), w = tid >> 6, lane = tid & 63;
    const unsigned char* U = p.ws + OFF_PEER + (size_t)(layer * 2) * PEER_TBL; const unsigned char* V = U + PEER_TBL;
    const int* EI = (const int*)(p.ws + OFF_EXP); const float* EG = (const float*)(p.ws + OFF_EXP + (size_t)MT * 128 * 4);
    const bf16_t* A = (const bf16_t*)(p.ws + OFF_A);
    for (int r = blockIdx.x * 8 + w; r < TL; r += gridDim.x * 8) {
        u32x4 xh[2], xl[2]; peer_load_x8(A, r, lane, xh, xl);
        float f[2][16];
#pragma unroll
        for (int pc = 0; pc < 2; ++pc)
#pragma unroll
            for (int j = 0; j < 16; ++j) f[pc][j] = 0.f;
#pragma unroll
        for (int hf = 0; hf < 2; ++hf) peer_acc3<16, 1>(U, V, lane, EI[(size_t)r * 128 + hf * 64 + lane], EG[(size_t)r * 128 + hf * 64 + lane], xh, xl, f);
        peer_finish(p, layer, r, lane, f);
    }
    if (nrows > TL) {
        LAS float* fb = (LAS float*)lds;
        for (int rc = blockIdx.x; rc < nrows - TL; rc += gridDim.x) {
            const int r = TL + rc;
            u32x4 xh[2], xl[2]; peer_load_x8(A, r, lane, xh, xl);
            float f[2][16];
#pragma unroll
            for (int pc = 0; pc < 2; ++pc)
#pragma unroll
                for (int j = 0; j < 16; ++j) f[pc][j] = 0.f;
            const int li = lane & 15;
            peer_acc3<4, 1>(U, V, lane, EI[(size_t)r * 128 + w * 16 + li], EG[(size_t)r * 128 + w * 16 + li], xh, xl, f);
            __syncthreads();
#pragma unroll
            for (int pc = 0; pc < 2; ++pc)
#pragma unroll
                for (int q = 0; q < 4; ++q) *(LAS f32x4*)(fb + w * 2048 + pc * 1024 + lane * 16 + 4 * q) = (f32x4){f[pc][4 * q], f[pc][4 * q + 1], f[pc][4 * q + 2], f[pc][4 * q + 3]};
            __syncthreads();
            if (w == 0) {
#pragma unroll
                for (int pc = 0; pc < 2; ++pc)
#pragma unroll
                    for (int j = 0; j < 16; ++j) f[pc][j] = 0.f;
#pragma unroll 1
                for (int ww = 0; ww < 8; ++ww)
#pragma unroll
                    for (int pc = 0; pc < 2; ++pc)
#pragma unroll
                        for (int q = 0; q < 4; ++q) { const f32x4 t = *(const LAS f32x4*)(fb + ww * 2048 + pc * 1024 + lane * 16 + 4 * q);
                            f[pc][4 * q] += t[0]; f[pc][4 * q + 1] += t[1]; f[pc][4 * q + 2] += t[2]; f[pc][4 * q + 3] += t[3]; }
                peer_finish(p, layer, r, lane, f);
            }
        }
        __syncthreads();
    }
}

constexpr size_t L1_OFF_OB = OFF_BIG2 + (size_t)2048 * MT * 2;
constexpr size_t L1_OFF_QS = OFF_BIG1;
constexpr size_t L1_OFF_KS = L1_OFF_QS + (size_t)TL * 1024 * 2;
constexpr size_t L1_OFF_KT = L1_OFF_KS + (size_t)MT * 1024 * 2;
static_assert(L1_OFF_KT + (size_t)MT * 1024 * 2 <= OFF_BIG1 + BIG_BYTES, "BIG1 overflow");
static_assert(L1_OFF_OB + (size_t)MT * 2048 * 2 <= OFF_BIG2 + BIG_BYTES, "BIG2 overflow");

__device__ __forceinline__ float logsig_f(float x) { return fminf(x, 0.f) - log1pf(expf(-fabsf(x))); }
__device__ __forceinline__ int chunk_row0(int cidx) { return cidx < 256 ? cidx * 64 : TL + (cidx - 256) * 64; }
__device__ __forceinline__ int chunk_of(int sc, int dir, int i) { return sc == 0 ? (dir ? 259 - i : 256 + i) : (dir ? 255 - (sc - 1) * 16 - i : (sc - 1) * 16 + i); }

__device__ __forceinline__ void unpack8(const u32x4 w, float (&o)[8]) { o[0] = bflo(w.x); o[1] = bfhi(w.x); o[2] = bflo(w.y); o[3] = bfhi(w.y); o[4] = bflo(w.z); o[5] = bfhi(w.z); o[6] = bflo(w.w); o[7] = bfhi(w.w); }
__device__ __forceinline__ void l1_qk_task(const Params& p, LAS unsigned char* lds, int task) {
    const int tid = otid();
    int tile, isk, hq, nh, h0;
    if (task < 32) { tile = 256 + (task >> 3); isk = 1; h0 = task & 7; nh = 1; hq = h0 >> 2; } else { const int t = task - 32; tile = t >> 2; isk = (t >> 1) & 1; hq = t & 1; h0 = hq * 4; nh = 4; }
    const bool lat = tile < 256;
    const int r0 = lat ? tile * 64 : TL + (tile - 256) * 64;
    const int sq0 = lat ? 0 : TL, sq1 = lat ? TL : MT;
    const bf16_t* QKp = (const bf16_t*)(p.ws + OFF_QK);
    bf16_t* QS = (bf16_t*)(p.ws + L1_OFF_QS); bf16_t* KS = (bf16_t*)(p.ws + L1_OFF_KS); bf16_t* KT = (bf16_t*)(p.ws + L1_OFF_KT);
    const float* cw = p.in[I_MLCW]; const float* cb = p.in[I_MLCB];
    const f32x2* rope = (const f32x2*)(p.ws + OFF_ROPE);
    LAS unsigned short* tl_ = (LAS unsigned short*)lds;
    LAS float* wl = (LAS float*)(lds + 4 * 128 * 66 * 2);
    { const int c = tid, col = isk * 1024 + hq * 512 + c;
#pragma unroll
      for (int j = 0; j < 4; ++j) wl[j * 512 + c] = j < 3 ? cw[j * 2048 + col] : cb[col]; }
    __syncthreads();
    const int tl = tid >> 3, pc = tid & 7, half = pc >> 2, cc = pc & 3;
    const int d1 = half * 64 + cc * 8, d2 = d1 + 32;
    const int r = r0 + tl;
    const int pos = half == 0 ? (r >> 6) : (r & 63);
    f32x2 csn[8];
#pragma unroll
    for (int j = 0; j < 8; ++j) csn[j] = lat ? rope[pos * 32 + cc * 8 + j] : (f32x2){1.f, 0.f};
    const u32x4 z4 = (u32x4){0u, 0u, 0u, 0u};
#pragma unroll 1
    for (int hh = h0 - hq * 4; hh < h0 - hq * 4 + nh; ++hh) {
        const int h = hq * 4 + hh;
        const bf16_t* x0 = QKp + (size_t)r * 2048 + isk * 1024 + h * 128;
        const u32x4 a0 = *(const u32x4*)(x0 + d1), b0 = *(const u32x4*)(x0 + d2);
        const u32x4 am = r > sq0 ? *(const u32x4*)(x0 + d1 - 2048) : z4, bm = r > sq0 ? *(const u32x4*)(x0 + d2 - 2048) : z4;
        const u32x4 ap = r + 1 < sq1 ? *(const u32x4*)(x0 + d1 + 2048) : z4, bp = r + 1 < sq1 ? *(const u32x4*)(x0 + d2 + 2048) : z4;
        float A0[8], B0[8], AM[8], BM[8], AP[8], BP[8];
        unpack8(a0, A0); unpack8(b0, B0); unpack8(am, AM); unpack8(bm, BM); unpack8(ap, AP); unpack8(bp, BP);
        float o1[8], o2[8];
        const int w1 = hh * 128 + d1, w2 = hh * 128 + d2;
#pragma unroll
        for (int j = 0; j < 8; ++j) {
            const float y1 = silu_f(wl[1536 + w1 + j] + wl[w1 + j] * AM[j] + wl[512 + w1 + j] * A0[j] + wl[1024 + w1 + j] * AP[j]);
            const float y2 = silu_f(wl[1536 + w2 + j] + wl[w2 + j] * BM[j] + wl[512 + w2 + j] * B0[j] + wl[1024 + w2 + j] * BP[j]);
            float q1 = y1 * csn[j].x - y2 * csn[j].y, q2 = y1 * csn[j].y + y2 * csn[j].x;
            if (isk) { q1 *= 0.08838834764831845f; q2 *= 0.08838834764831845f; }
            o1[j] = q1; o2[j] = q2;
        }
        const u32x4 v1 = (u32x4){pk_bf16(o1[0], o1[1]), pk_bf16(o1[2], o1[3]), pk_bf16(o1[4], o1[5]), pk_bf16(o1[6], o1[7])};
        const u32x4 v2 = (u32x4){pk_bf16(o2[0], o2[1]), pk_bf16(o2[2], o2[3]), pk_bf16(o2[4], o2[5]), pk_bf16(o2[6], o2[7])};
        if (isk) {
            bf16_t* dst = KS + (size_t)r * 1024 + h * 128;
            *(u32x4*)(dst + d1) = v1; *(u32x4*)(dst + d2) = v2;
            LAS unsigned short* th = tl_ + hh * 128 * 66;
            const unsigned u1[4] = {v1.x, v1.y, v1.z, v1.w}, u2[4] = {v2.x, v2.y, v2.z, v2.w};
#pragma unroll
            for (int j = 0; j < 4; ++j) { th[(d1 + 2 * j) * 66 + tl] = (unsigned short)(u1[j] & 0xFFFFu); th[(d1 + 2 * j + 1) * 66 + tl] = (unsigned short)(u1[j] >> 16);
                                          th[(d2 + 2 * j) * 66 + tl] = (unsigned short)(u2[j] & 0xFFFFu); th[(d2 + 2 * j + 1) * 66 + tl] = (unsigned short)(u2[j] >> 16); }
        } else {
            bf16_t* dst = QS + (size_t)r * 1024 + h * 128;
            *(u32x4*)(dst + d1) = v1; *(u32x4*)(dst + d2) = v2;
        }
    }
    if (isk) {
        __syncthreads();
#pragma unroll 4
        for (int it = (h0 - hq * 4) * 8; it < (h0 - hq * 4 + nh) * 8; ++it) { const int i = tid + 512 * it, d = i >> 5, tp = i & 31;
            const unsigned lo = tl_[d * 66 + 2 * tp], hi = tl_[d * 66 + 2 * tp + 1];
            *(unsigned*)(KT + (size_t)(hq * 512 + d) * MT + r0 + 2 * tp) = lo | (hi << 16); }
    }
    __syncthreads();
}
__device__ __forceinline__ void l1_gate_items(const Params& p) {
    const int tid = otid(), wv = tid >> 6, lane = tid & 63;
    const float* G = (const float*)(p.ws + OFF_GATE); const float* bg = p.in[I_MLBG];
    float* GA = (float*)(p.ws + OFF_GX); float* GC = GA + GX_STRIDE; float* GW = GC + GX_STRIDE; float* DEC = GW + GX_STRIDE;
    for (int item = blockIdx.x * 8 + wv; item < 260 * 16; item += gridDim.x * 8) {
        const int cidx = item >> 4, hd = item & 15, h = hd >> 1, dir = hd & 1;
        const int r = chunk_row0(cidx) + lane;
        const int ci = (dir ? 2 : 0) * 8 + h, cf = (dir ? 3 : 1) * 8 + h;
        const float lf = logsig_f(G[(size_t)r * 32 + cf] + bg[cf]), li = G[(size_t)r * 32 + ci] + bg[ci];
        float b = lf;
        if (dir == 0) {
#pragma unroll
            for (int o = 1; o < 64; o <<= 1) { const float t = __shfl_up(b, o); if (lane >= o) b += t; }
        } else {
#pragma unroll
            for (int o = 1; o < 64; o <<= 1) { const float t = __shfl_down(b, o); if (lane + o < 64) b += t; }
        }
        const float bend = __shfl(b, dir ? 0 : 63);
        const size_t gb = (size_t)(dir * 8 + h) * MT;
        GA[gb + r] = expf(b); GC[gb + r] = expf(li - b); GW[gb + r] = expf(bend - b + li);
        if (lane == 0) DEC[(dir * 8 + h) * 260 + cidx] = expf(bend);
    }
}
__device__ __forceinline__ void phase_l1_prep(const Params& p, LAS unsigned char* lds) {
    l1_gate_items(p);
    for (int task = blockIdx.x; task < 32 + 1024; task += gridDim.x) l1_qk_task(p, lds, task);
}

__device__ __forceinline__ void phase_l1_passB(const Params& p) {
    const float* DEC = (const float*)(p.ws + OFF_GX) + 3 * GX_STRIDE;
    float* CST = (float*)(p.ws + OFF_HYT); float* NST = (float*)(p.ws + OFF_NST);
    const int NE = 16 * 32768 + 16 * 128;
    for (int g = blockIdx.x * 512 + otid(); g < NE; g += gridDim.x * 512) {
        const bool isn = g >= 16 * 32768;
        const int hd = isn ? (g - 16 * 32768) >> 7 : g >> 15, idx = isn ? (g - 16 * 32768) & 127 : g & 32767;
        const int h = hd >> 1, dir = hd & 1;
        float cin = 0.f;
        for (int sc = 0; sc < 17; ++sc) {
            float dsc = 1.f; const int nc = sc == 0 ? 4 : 16;
            for (int c = 0; c < nc; ++c) dsc *= DEC[(dir * 8 + h) * 260 + chunk_of(sc, dir, c)];
            float* ptr = isn ? NST + (size_t)(sc * 16 + hd) * 128 + idx : CST + (size_t)(sc * 16 + hd) * 32768 + idx;
            const float loc = sc < 16 ? *ptr : 0.f; *ptr = cin; cin = dsc * cin + loc;
        }
    }
}
constexpr int PC_QS = 0;
constexpr int PC_KS = 16896;
constexpr int PC_KT = 33792;
constexpr int PC_VS = 52224;
constexpr int PC_OS = 89088;
constexpr int PC_WT = 130048;
constexpr int PC_NL = 130816;
__device__ __forceinline__ bf16x8 pack8(const f32x16& v, int o) {
    u32x4 w; w.x = pk_bf16(v[o], v[o + 1]); w.y = pk_bf16(v[o + 2], v[o + 3]); w.z = pk_bf16(v[o + 4], v[o + 5]); w.w = pk_bf16(v[o + 6], v[o + 7]);
    return __builtin_bit_cast(bf16x8, w);
}
struct PcStage { u32x4 q0, q1, k0, k1, t0, t1, v0, v1, v2, v3; float wt; };
__device__ __forceinline__ bf16x8 lds_frag2(LAS unsigned char* base, int byteoff) {
    const u32x2 a = *(const LAS u32x2*)(base + byteoff), b = *(const LAS u32x2*)(base + byteoff + 16);
    const u32x4 w = (u32x4){a.x, a.y, b.x, b.y}; return __builtin_bit_cast(bf16x8, w);
}
__device__ __forceinline__ void phase_l1_passC(const Params& p, LAS unsigned char* lds) {
    const int tid = otid(), wv = __builtin_amdgcn_readfirstlane(tid >> 6), lane = tid & 63, l31 = lane & 31, hh = lane >> 5;
    const bf16_t* QS = (const bf16_t*)(p.ws + L1_OFF_QS); const bf16_t* KS = (const bf16_t*)(p.ws + L1_OFF_KS); const bf16_t* KT = (const bf16_t*)(p.ws + L1_OFF_KT);
    const bf16_t* VT = (const bf16_t*)(p.ws + OFF_BIG2);
    const unsigned so_q = (unsigned)((tid >> 3) * 1024 + (tid & 7) * 8), so_t = (unsigned)((tid >> 2) * MT + (tid & 3) * 8), so_v = (unsigned)((lane >> 1) * MT + (lane & 1) * 32), so_w = (unsigned)((tid >> 6) * (int)GX_STRIDE + (tid & 63));
    const float* GX = (const float*)(p.ws + OFF_GX); const float* DEC = GX + 3 * GX_STRIDE;
    const float* CST = (const float*)(p.ws + OFF_HYT); const float* NST = (const float*)(p.ws + OFF_NST);
    bf16_t* HF = (bf16_t*)(p.ws + OFF_A); bf16_t* HB = (bf16_t*)(p.ws + OFF_X);
    const u32x4 ones_u = (u32x4){0x3F803F80u, 0x3F803F80u, 0x3F803F80u, 0x3F803F80u};
    const bf16x8 ones = __builtin_bit_cast(bf16x8, ones_u);
    LAS float* WT = (LAS float*)(lds + PC_WT);
    LAS unsigned char* VSw = lds + PC_VS + wv * 4608;
    LAS unsigned char* OSw = lds + PC_OS + wv * 5120;
    for (int task = blockIdx.x; task < 16 * 16; task += gridDim.x) {
        const int hd = task & 15, sc = 1 + (task >> 4), h = hd >> 1, dir = hd & 1, w = wv;
        const size_t gb = (size_t)(dir * 8 + h) * MT;
        bf16_t* HO = dir ? HB : HF;
        f32x16 X[4];
        { const float* src = CST + (size_t)((sc * 16 + hd) * 8 + w) * 4096;
#pragma unroll
          for (int i = 0; i < 4; ++i)
#pragma unroll
              for (int q = 0; q < 16; ++q) X[i][q] = src[(i * 16 + q) * 64 + lane]; }
        LAS float* nlc = (LAS float*)(lds + PC_NL); LAS float* nln = nlc + 128;
        if (tid < 128) nlc[tid] = NST[(size_t)(sc * 16 + hd) * 128 + tid];
        PcStage sg;
#define PC_LOAD(cidx_) do { const int rw_ = (cidx_) * 64; \
            const bf16_t* qb_ = QS + (size_t)rw_ * 1024 + h * 128; sg.q0 = *(const u32x4*)(qb_ + so_q); sg.q1 = *(const u32x4*)(qb_ + so_q + 64u); \
            const bf16_t* kb_ = KS + (size_t)rw_ * 1024 + h * 128; sg.k0 = *(const u32x4*)(kb_ + so_q); sg.k1 = *(const u32x4*)(kb_ + so_q + 64u); \
            const bf16_t* tb_ = KT + (size_t)(h * 128) * MT + rw_; sg.t0 = *(const u32x4*)(tb_ + so_t); sg.t1 = *(const u32x4*)(tb_ + so_t + 32u); \
            const bf16_t* vb2_ = VT + (size_t)(h * 256 + 32 * w) * MT + rw_; sg.v0 = *(const u32x4*)(vb2_ + so_v); sg.v1 = *(const u32x4*)(vb2_ + so_v + 8u); sg.v2 = *(const u32x4*)(vb2_ + so_v + 16u); sg.v3 = *(const u32x4*)(vb2_ + so_v + 24u); \
            sg.wt = tid < 192 ? (GX + gb + rw_)[so_w] : 0.f; } while (0)
#define PC_ST64(base_, off_, v_) do { *(LAS u32x2*)((base_) + (off_)) = (u32x2){(v_).x, (v_).y}; *(LAS u32x2*)((base_) + (off_) + 8) = (u32x2){(v_).z, (v_).w}; } while (0)
#define PC_STORE() do { \
            PC_ST64(lds + PC_QS, (tid >> 3) * 264 + (tid & 7) * 16, sg.q0); PC_ST64(lds + PC_QS, (tid >> 3) * 264 + (tid & 7) * 16 + 128, sg.q1); \
            PC_ST64(lds + PC_KS, (tid >> 3) * 264 + (tid & 7) * 16, sg.k0); PC_ST64(lds + PC_KS, (tid >> 3) * 264 + (tid & 7) * 16 + 128, sg.k1); \
            *(LAS u32x4*)(lds + PC_KT + (tid >> 2) * 144 + (tid & 3) * 16) = sg.t0; *(LAS u32x4*)(lds + PC_KT + (tid >> 2) * 144 + (tid & 3) * 16 + 64) = sg.t1; \
            { LAS unsigned char* vb_ = VSw + (lane >> 1) * 144 + (lane & 1) * 64; *(LAS u32x4*)vb_ = sg.v0; *(LAS u32x4*)(vb_ + 16) = sg.v1; *(LAS u32x4*)(vb_ + 32) = sg.v2; *(LAS u32x4*)(vb_ + 48) = sg.v3; } \
            if (tid < 192) WT[tid] = sg.wt; } while (0)
        __syncthreads();
        PC_LOAD(chunk_of(sc, dir, 0)); PC_STORE();
        __syncthreads();
#pragma unroll 1
        for (int c = 0; c < 16; ++c) {
            const int cidx = chunk_of(sc, dir, c), rw0 = cidx * 64;
#pragma unroll 1
            for (int tt = 0; tt < 2; ++tt) {
                const int qoff = PC_QS + (32 * tt + l31) * 264 + 8 * hh;
                f32x16 num, den;
#pragma unroll
                for (int q = 0; q < 16; ++q) { num[q] = 0.f; den[q] = 0.f; }
#pragma unroll
                for (int st = 0; st < 2; ++st) {
                    f32x16 S;
#pragma unroll
                    for (int q = 0; q < 16; ++q) S[q] = 0.f;
#pragma unroll
                    for (int ks = 0; ks < 8; ++ks) { const bf16x8 qf = lds_frag2(lds, qoff + 32 * ks); const bf16x8 kf = lds_frag2(lds, PC_KS + (32 * st + l31) * 264 + 8 * hh + 32 * ks);
                        S = __builtin_amdgcn_mfma_f32_32x32x16_bf16(kf, qf, S, 0, 0, 0); }
                    const int t = 32 * tt + l31;
#pragma unroll
                    for (int g = 0; g < 4; ++g) { const f32x4 c4 = *(const LAS f32x4*)(WT + 64 + 32 * st + 8 * g + 4 * hh);
#pragma unroll
                        for (int q = 0; q < 4; ++q) { const int s_ = 32 * st + 8 * g + 4 * hh + q; const bool ok = dir ? (s_ >= t) : (s_ <= t);
                            S[4 * g + q] = ok ? S[4 * g + q] * c4[q] : 0.f; } }
#pragma unroll
                    for (int kk = 0; kk < 2; ++kk) {
                        const bf16x8 xf = pack8(S, 8 * kk);
                        const bf16x8 vf = lds_frag2(VSw, l31 * 144 + (32 * st + 16 * kk + 4 * hh) * 2);
                        num = __builtin_amdgcn_mfma_f32_32x32x16_bf16(xf, vf, num, 0, 0, 0);
                        den = __builtin_amdgcn_mfma_f32_32x32x16_bf16(xf, ones, den, 0, 0, 0);
                    }
                }
#pragma unroll
                for (int i = 0; i < 4; ++i)
#pragma unroll
                    for (int s2 = 0; s2 < 2; ++s2) {
                        const bf16x8 bx = pack8(X[i], 8 * s2);
                        const bf16x8 qf = lds_frag2(lds, qoff + 32 * (2 * i + s2));
                        num = __builtin_amdgcn_mfma_f32_32x32x16_bf16(qf, bx, num, 0, 0, 0);
                        const f32x4 na = *(const LAS f32x4*)(nlc + 32 * i + 16 * s2 + 4 * hh), nb = *(const LAS f32x4*)(nlc + 32 * i + 16 * s2 + 8 + 4 * hh);
                        u32x4 nw; nw.x = pk_bf16(na[0], na[1]); nw.y = pk_bf16(na[2], na[3]); nw.z = pk_bf16(nb[0], nb[1]); nw.w = pk_bf16(nb[2], nb[3]);
                        den = __builtin_amdgcn_mfma_f32_32x32x16_bf16(qf, __builtin_bit_cast(bf16x8, nw), den, 0, 0, 0);
                    }
#pragma unroll
                for (int g = 0; g < 4; ++g) { const f32x4 a4 = *(const LAS f32x4*)(WT + 32 * tt + 8 * g + 4 * hh);
#pragma unroll
                    for (int q = 0; q < 4; ++q) { const float a = a4[q]; const float hv = a * num[4 * g + q] / fmaxf(fabsf(a * den[4 * g + q]), 1.0f);
                        *(LAS unsigned short*)(OSw + (32 * tt + 8 * g + 4 * hh + q) * 80 + l31 * 2) = f2bf(hv); } }
            }
#pragma unroll
            for (int it = 0; it < 4; ++it) { const int tok = it * 16 + (lane >> 2), sgm = lane & 3;
                const u32x4 ov = *(const LAS u32x4*)(OSw + tok * 80 + sgm * 16);
                *(u32x4*)((HO + (size_t)rw0 * 2048 + h * 256 + 32 * w) + (unsigned)(tok * 2048 + sgm * 8)) = ov; }
            const float dec = DEC[(dir * 8 + h) * 260 + cidx];
#pragma unroll
            for (int i = 0; i < 4; ++i) X[i] *= dec;
#pragma unroll
            for (int ks = 0; ks < 4; ++ks) {
                const u32x4 vr = *(const LAS u32x4*)(VSw + l31 * 144 + 32 * ks + 16 * hh);
                const f32x4 wa = *(const LAS f32x4*)(WT + 128 + 16 * ks + 8 * hh), wb = *(const LAS f32x4*)(WT + 128 + 16 * ks + 8 * hh + 4);
                u32x4 vs; vs.x = pk_bf16(bflo(vr.x) * wa[0], bfhi(vr.x) * wa[1]); vs.y = pk_bf16(bflo(vr.y) * wa[2], bfhi(vr.y) * wa[3]);
                vs.z = pk_bf16(bflo(vr.z) * wb[0], bfhi(vr.z) * wb[1]); vs.w = pk_bf16(bflo(vr.w) * wb[2], bfhi(vr.w) * wb[3]);
                const bf16x8 bfr = __builtin_bit_cast(bf16x8, vs);
#pragma unroll
                for (int i = 0; i < 4; ++i) { const u32x4 ar = *(const LAS u32x4*)(lds + PC_KT + (32 * i + l31) * 144 + 32 * ks + 16 * hh);
                    X[i] = __builtin_amdgcn_mfma_f32_32x32x16_bf16(__builtin_bit_cast(bf16x8, ar), bfr, X[i], 0, 0, 0); }
            }
            if (tid < 128) { float a = 0.f;
#pragma unroll
                for (int q = 0; q < 8; ++q) { const u32x4 kr = *(const LAS u32x4*)(lds + PC_KT + tid * 144 + 16 * q);
                    const f32x4 wa = *(const LAS f32x4*)(WT + 128 + 8 * q), wb = *(const LAS f32x4*)(WT + 128 + 8 * q + 4);
                    a = fmaf(wa[0], bflo(kr.x), a); a = fmaf(wa[1], bfhi(kr.x), a); a = fmaf(wa[2], bflo(kr.y), a); a = fmaf(wa[3], bfhi(kr.y), a);
                    a = fmaf(wb[0], bflo(kr.z), a); a = fmaf(wb[1], bfhi(kr.z), a); a = fmaf(wb[2], bflo(kr.w), a); a = fmaf(wb[3], bfhi(kr.w), a); }
                nln[tid] = dec * nlc[tid] + a; }
            __syncthreads();
            if (c + 1 < 16) { PC_LOAD(chunk_of(sc, dir, c + 1)); PC_STORE(); }
            { LAS float* t_ = nlc; nlc = nln; nln = t_; }
            __syncthreads();
        }
#undef PC_LOAD
#undef PC_ST64
#undef PC_STORE
    }
}
__device__ __forceinline__ void phase_l1_passA2(const Params& p, LAS unsigned char* lds) {
    const int tid = otid(), wv = __builtin_amdgcn_readfirstlane(tid >> 6), lane = tid & 63, l31 = lane & 31, hh = lane >> 5;
    const bf16_t* KT = (const bf16_t*)(p.ws + L1_OFF_KT); const bf16_t* VT = (const bf16_t*)(p.ws + OFF_BIG2);
    const float* GX = (const float*)(p.ws + OFF_GX); const float* DEC = GX + 3 * GX_STRIDE;
    float* CST = (float*)(p.ws + OFF_HYT); float* NST = (float*)(p.ws + OFF_NST);
    const unsigned so_t = (unsigned)((tid >> 2) * MT + (tid & 3) * 8), so_v = (unsigned)((lane >> 1) * MT + (lane & 1) * 32);
    LAS float* WT = (LAS float*)(lds + PC_WT);
    LAS unsigned char* VSw = lds + PC_VS + wv * 4608;
    for (int task = blockIdx.x; task < 16 * 16; task += gridDim.x) {
        const int hd = task & 15, sc = task >> 4, h = hd >> 1, dir = hd & 1, w = wv;
        const size_t gb = (size_t)(dir * 8 + h) * MT;
        f32x16 X[4];
#pragma unroll
        for (int i = 0; i < 4; ++i)
#pragma unroll
            for (int q = 0; q < 16; ++q) X[i][q] = 0.f;
        float nacc = 0.f;
        const int nc = sc == 0 ? 4 : 16;
#pragma unroll 1
        for (int c = 0; c < nc; ++c) {
            const int cidx = chunk_of(sc, dir, c), rw0 = chunk_row0(cidx);
            __syncthreads();
            { const bf16_t* tb_ = KT + (size_t)(h * 128) * MT + rw0; const u32x4 t0 = *(const u32x4*)(tb_ + so_t), t1 = *(const u32x4*)(tb_ + so_t + 32u);
              const bf16_t* vb_ = VT + (size_t)(h * 256 + 32 * w) * MT + rw0; const u32x4 v0 = *(const u32x4*)(vb_ + so_v), v1 = *(const u32x4*)(vb_ + so_v + 8u), v2 = *(const u32x4*)(vb_ + so_v + 16u), v3 = *(const u32x4*)(vb_ + so_v + 24u);
              const float wt = tid < 64 ? (GX + 2 * GX_STRIDE + gb + rw0)[tid] : 0.f;
              *(LAS u32x4*)(lds + PC_KT + (tid >> 2) * 144 + (tid & 3) * 16) = t0; *(LAS u32x4*)(lds + PC_KT + (tid >> 2) * 144 + (tid & 3) * 16 + 64) = t1;
              LAS unsigned char* vb2 = VSw + (lane >> 1) * 144 + (lane & 1) * 64; *(LAS u32x4*)vb2 = v0; *(LAS u32x4*)(vb2 + 16) = v1; *(LAS u32x4*)(vb2 + 32) = v2; *(LAS u32x4*)(vb2 + 48) = v3;
              if (tid < 64) WT[128 + tid] = wt; }
            __syncthreads();
            const float dec = DEC[(dir * 8 + h) * 260 + cidx];
#pragma unroll
            for (int i = 0; i < 4; ++i) X[i] *= dec;
#pragma unroll
            for (int ks = 0; ks < 4; ++ks) {
                const u32x4 vr = *(const LAS u32x4*)(VSw + l31 * 144 + 32 * ks + 16 * hh);
                const f32x4 wa = *(const LAS f32x4*)(WT + 128 + 16 * ks + 8 * hh), wb = *(const LAS f32x4*)(WT + 128 + 16 * ks + 8 * hh + 4);
                u32x4 vs; vs.x = pk_bf16(bflo(vr.x) * wa[0], bfhi(vr.x) * wa[1]); vs.y = pk_bf16(bflo(vr.y) * wa[2], bfhi(vr.y) * wa[3]);
                vs.z = pk_bf16(bflo(vr.z) * wb[0], bfhi(vr.z) * wb[1]); vs.w = pk_bf16(bflo(vr.w) * wb[2], bfhi(vr.w) * wb[3]);
                const bf16x8 bfr = __builtin_bit_cast(bf16x8, vs);
#pragma unroll
                for (int i = 0; i < 4; ++i) { const u32x4 ar = *(const LAS u32x4*)(lds + PC_KT + (32 * i + l31) * 144 + 32 * ks + 16 * hh);
                    X[i] = __builtin_amdgcn_mfma_f32_32x32x16_bf16(__builtin_bit_cast(bf16x8, ar), bfr, X[i], 0, 0, 0); }
            }
            if (tid < 128) { float a = 0.f;
#pragma unroll
                for (int q = 0; q < 8; ++q) { const u32x4 kr = *(const LAS u32x4*)(lds + PC_KT + tid * 144 + 16 * q);
                    const f32x4 wa = *(const LAS f32x4*)(WT + 128 + 8 * q), wb = *(const LAS f32x4*)(WT + 128 + 8 * q + 4);
                    a = fmaf(wa[0], bflo(kr.x), a); a = fmaf(wa[1], bfhi(kr.x), a); a = fmaf(wa[2], bflo(kr.y), a); a = fmaf(wa[3], bfhi(kr.y), a);
                    a = fmaf(wb[0], bflo(kr.z), a); a = fmaf(wb[1], bfhi(kr.z), a); a = fmaf(wb[2], bflo(kr.w), a); a = fmaf(wb[3], bfhi(kr.w), a); }
                nacc = dec * nacc + a; }
        }
        float* dst = CST + (size_t)((sc * 16 + hd) * 8 + w) * 4096;
#pragma unroll
        for (int i = 0; i < 4; ++i)
#pragma unroll
            for (int q = 0; q < 16; ++q) dst[(i * 16 + q) * 64 + lane] = X[i][q];
        if (tid < 128) NST[(size_t)(sc * 16 + hd) * 128 + tid] = nacc;
    }
    __syncthreads();
}
__device__ __forceinline__ void phase_l1_merge(const Params& p) {
    const int tid = otid(), wv = tid >> 6, lane = tid & 63;
    const bf16_t* HF = (const bf16_t*)(p.ws + OFF_A); const bf16_t* HB = (const bf16_t*)(p.ws + OFF_X); const bf16_t* Ob = (const bf16_t*)(p.ws + L1_OFF_OB);
    bf16_t* OUT = (bf16_t*)(p.ws + OFF_QK);
    const float* nw = p.in[I_MLNW];
    for (int t = blockIdx.x * 8 + wv; t < TL; t += gridDim.x * 8) {
#pragma unroll
        for (int pc = 0; pc < 4; ++pc) { const int e = pc * 512 + lane * 8;
            const u32x4 a = *(const u32x4*)(HF + (size_t)t * 2048 + e), b = *(const u32x4*)(HB + (size_t)t * 2048 + e), o = *(const u32x4*)(Ob + (size_t)t * 2048 + e);
            float hv[8] = {bflo(a.x) + bflo(b.x), bfhi(a.x) + bfhi(b.x), bflo(a.y) + bflo(b.y), bfhi(a.y) + bfhi(b.y), bflo(a.z) + bflo(b.z), bfhi(a.z) + bfhi(b.z), bflo(a.w) + bflo(b.w), bfhi(a.w) + bfhi(b.w)};
            const float ov[8] = {bflo(o.x), bfhi(o.x), bflo(o.y), bfhi(o.y), bflo(o.z), bfhi(o.z), bflo(o.w), bfhi(o.w)};
            float s = 0.f;
#pragma unroll
            for (int j = 0; j < 8; ++j) s += hv[j];
#pragma unroll
            for (int of = 16; of > 0; of >>= 1) s += __shfl_xor(s, of);
            const float mu = s * (1.0f / 256.0f);
            float q = 0.f;
#pragma unroll
            for (int j = 0; j < 8; ++j) { const float d = hv[j] - mu; q += d * d; }
#pragma unroll
            for (int of = 16; of > 0; of >>= 1) q += __shfl_xor(q, of);
            const float rs = rsqrtf(q * (1.0f / 256.0f) + LN_EPS);
            float wn[8], r8[8]; ld8(nw + e, wn);
#pragma unroll
            for (int j = 0; j < 8; ++j) { const float hn = bf2f(f2bf((hv[j] - mu) * rs * wn[j])); r8[j] = hn * sigmoid_f(ov[j]); }
            st8bf(OUT + (size_t)t * 2048 + e, r8); }
    }
}
__global__ void __launch_bounds__(NTHREADS, 2) hybrid_fwd_megakernel(Params p) {
    extern __shared__ __attribute__((aligned(16))) unsigned char smem_raw[];
    LAS unsigned char* lds = (LAS unsigned char*)smem_raw;
    volatile LAS unsigned* bst = (volatile LAS unsigned*)(lds + LDS_BYTES - 16);
    if (threadIdx.x < 4) bst[threadIdx.x] = 0u;
    __syncthreads();
    XcdBarrier bar = xcd_barrier_post((unsigned*)(p.ws + OFF_BAR), bst);
#define ws (get_ws())
#define Abuf ((bf16_t*)(ws + OFF_A))
    phase0(fresh(p), lds, P0_T0, P0_T2);
    phase0(fresh(p), lds, P0_T4, P0_T5);
    phase0(fresh(p), lds, P0_T5, P0_T6);
    phase0(fresh(p), lds, P0_T6, P0_T7);
    phase0(fresh(p), lds, P0_T7, P0_NT);
    xcd_barrier(bar);
    modulate_rows(p.in[I_X], p.in[I_CTX], (const float*)(ws + OFF_MOD), Abuf);
    hyena_taps(fresh(p));
    xcd_barrier(bar);
    {
        unsigned char* w_ = ws;
        pg8::Sched2<pg8::EpiBf16> S{(const char*)(w_ + OFF_W0T), (const char*)(w_ + OFF_A), 16, 65, (const char*)(w_ + OFF_A), (const char*)(w_ + OFF_W0T) + (size_t)4096 * 4096, 65, 8, (int)gridDim.x, (int)blockIdx.x};
        pg8::EpiS2<pg8::EpiBf16> E{pg8::EpiBf16{(bf16_t*)(w_ + OFF_BIG2), MT}, pg8::EpiBf16{(bf16_t*)(w_ + OFF_QK), 2048}};
        pg8::gemm_stream(lds, 2048, S, E); __syncthreads();
    }
    xcd_barrier(bar);
    phase3(fresh(p), lds);
    xcd_barrier(bar);
    phase4(fresh(p), lds);
    xcd_barrier(bar);
    {
        unsigned char* w_ = ws;
        pg8::SchedTail S{(const char*)(w_ + OFF_A), (const char*)(w_ + OFF_WO0T), 64, 8, true, (int)gridDim.x, (int)blockIdx.x};
        pg8::EpiTail<true, pg8::EpiBf16> E{pg8::EpiBf16{(bf16_t*)(w_ + OFF_BIG2), 2048}, (float*)(w_ + OFF_X)};
        pg8::gemm_stream(lds, 2048, S, E); __syncthreads();
    }
    phase0(fresh(p), lds, P0_T2, P0_T4, 8);
    xcd_barrier(bar);
    phase_ln1(fresh(p), 0, MT, (const float*)(ws + OFF_X));
    xcd_barrier(bar);
    {
        unsigned char* w_ = ws;
        pg8::SchedTail S{(const char*)(w_ + OFF_WQK), (const char*)(w_ + OFF_A), 8, 64, false, (int)gridDim.x, (int)blockIdx.x};
        pg8::EpiTail<false, pg8::EpiF32> E{pg8::EpiF32{(float*)(w_ + OFF_BIG1), MT}, (float*)(w_ + OFF_X)};
        pg8::gemm_stream(lds, 2048, S, E); __syncthreads();
    }
    xcd_barrier(bar);
    phase_topk(fresh(p), lds, MT, (const float*)(ws + OFF_X));
    xcd_barrier(bar);
    phase_peer(fresh(p), lds, 0, MT);
    xcd_barrier(bar);
    {
        unsigned char* w_ = ws;
        pg8::Sched2<pg8::EpiL1> S{(const char*)(w_ + OFF_W1T), (const char*)(w_ + OFF_A), 8, 65, (const char*)(w_ + OFF_A), (const char*)(w_ + OFF_W1T) + (size_t)2048 * 4096, 65, 17, (int)gridDim.x, (int)blockIdx.x};
        pg8::EpiS2<pg8::EpiL1> E{pg8::EpiBf16{(bf16_t*)(w_ + OFF_BIG2), MT}, pg8::EpiL1{(bf16_t*)(w_ + OFF_QK), (bf16_t*)(w_ + L1_OFF_OB), (float*)(w_ + OFF_GATE)}};
        pg8::gemm_stream(lds, 2048, S, E); __syncthreads();
    }
    xcd_barrier(bar);
    phase_l1_prep(fresh(p), lds);
    xcd_barrier(bar);
    phase_l1_passA2(fresh(p), lds);
    xcd_barrier(bar);
    phase_l1_passB(fresh(p));
    xcd_barrier(bar);
    phase_l1_passC(fresh(p), lds);
    xcd_barrier(bar);
    phase_l1_merge(fresh(p));
    xcd_barrier(bar);
    run_gemm(lds, (const bf16_t*)(ws + OFF_QK), (const bf16_t*)(ws + OFF_WO1T), TL, 2048, 2048, pg8::EpiBf16{(bf16_t*)(ws + OFF_BIG2), 2048});
    xcd_barrier(bar);
    phase_ln1(fresh(p), 1, TL, nullptr);
    xcd_barrier(bar);
    run_gemm(lds, (const bf16_t*)(ws + OFF_WQK) + (size_t)2048 * 2048, Abuf, 2048, TL, 2048, pg8::EpiF32{(float*)(ws + OFF_BIG1), MT});
    xcd_barrier(bar);
    phase_topk(fresh(p), lds, TL, nullptr);
    xcd_barrier(bar);
    phase_peer(fresh(p), lds, 1, TL);
#undef ws
#undef Abuf
}

extern "C" void kernel_launch(void* const* d_in, const int* in_sizes, int n_in, void* d_out, int out_size, void* d_ws, size_t ws_size, hipStream_t stream) {
    static int grid = 0;
    if (grid == 0) {
        int dev = 0, cus = 0;
        if (hipGetDevice(&dev) != hipSuccess || hipDeviceGetAttribute(&cus, hipDeviceAttributeMultiprocessorCount, dev) != hipSuccess) { fprintf(stderr, "kernel_launch: device query failed\n"); grid = -1; return; }
        if (hipFuncSetAttribute((const void*)hybrid_fwd_megakernel, hipFuncAttributeMaxDynamicSharedMemorySize, LDS_BYTES) != hipSuccess) { fprintf(stderr, "kernel_launch: hipFuncSetAttribute failed\n"); grid = -1; return; }
        int per_cu = 0;
        if (hipOccupancyMaxActiveBlocksPerMultiprocessor(&per_cu, (const void*)hybrid_fwd_megakernel, NTHREADS, LDS_BYTES) != hipSuccess || per_cu < 1) { fprintf(stderr, "kernel_launch: occupancy query says %d blocks/CU\n", per_cu); (void)hipGetLastError(); }
        if (n_in != 32 || ws_size < WS_END) { fprintf(stderr, "kernel_launch: unexpected n_in %d / ws_size %zu (need %zu)\n", n_in, ws_size, (size_t)WS_END); grid = -1; return; }
        grid = cus;
    }
    if (grid < 0) return;
    (void)hipMemsetAsync((char*)d_ws + OFF_BAR, 0, 16384, stream);
    Params prm{};
    for (int i = 0; i < 32; ++i) prm.in[i] = (const float*)d_in[i];
    prm.out = (float*)d_out; prm.ws = (unsigned char*)d_ws;
    void* args[] = {&prm};
    hipError_t e = hipLaunchCooperativeKernel((const void*)hybrid_fwd_megakernel, dim3(grid), dim3(NTHREADS), args, LDS_BYTES, stream);
    if (e != hipSuccess) fprintf(stderr, "kernel_launch: cooperative launch failed: %s (grid %d)\n", hipGetErrorString(e), grid);
}
```

```cpp
#include <hip/hip_runtime.h>
#include <cstdio>
#include <cstdint>

#define LAS __attribute__((address_space(3)))
typedef unsigned short bf16_t;
typedef short bf16x8 __attribute__((ext_vector_type(8)));
typedef short bf16x4 __attribute__((ext_vector_type(4)));
typedef float f32x2 __attribute__((ext_vector_type(2)));
typedef float f32x4 __attribute__((ext_vector_type(4)));
typedef float f32x16 __attribute__((ext_vector_type(16)));
typedef unsigned u32x2 __attribute__((ext_vector_type(2)));
typedef unsigned u32x4 __attribute__((ext_vector_type(4)));
typedef __bf16 bf2_t __attribute__((ext_vector_type(2)));

constexpr int DM = 2048;
constexpr int TL = 16384;
constexpr int TCX = 256;
constexpr int MT = TL + TCX;
constexpr int NTHREADS = 512;
constexpr int LDS_BYTES = 151552;
constexpr float LN_EPS = 1e-6f;
constexpr float DN_ALPHA = 1.41421356237309515f;

constexpr size_t al256(size_t x) { return (x + 255) & ~(size_t)255; }
constexpr size_t OFF_BAR   = 0;
constexpr size_t OFF_MOD   = 16384;
constexpr size_t OFF_ROPE  = OFF_MOD + al256((size_t)2 * 2 * 12288 * 4);
constexpr size_t OFF_A3    = OFF_ROPE + al256((size_t)256 * 32 * 8);
constexpr size_t OFF_GATE  = OFF_A3 + al256((size_t)MT * 64 * 2);
constexpr size_t OFF_GX    = OFF_GATE + al256((size_t)MT * 32 * 4);
constexpr size_t GX_STRIDE = (size_t)2 * 8 * MT;
constexpr size_t OFF_NST   = OFF_GX + al256((3 * GX_STRIDE + 2 * 8 * 260 + 64) * 4);
constexpr size_t OFF_W0T   = OFF_NST + al256((size_t)17 * 16 * 128 * 4);
constexpr size_t OFF_WO0T  = OFF_W0T + (size_t)6144 * 2048 * 2;
constexpr size_t OFF_W1T   = OFF_WO0T + (size_t)2048 * 2048 * 2;
constexpr size_t OFF_WO1T  = OFF_W1T + (size_t)6400 * 2048 * 2;
constexpr size_t OFF_WQK   = OFF_WO1T + (size_t)2048 * 2048 * 2;
constexpr size_t OFF_PEER  = OFF_WQK + (size_t)2 * 2048 * 2048 * 2;
constexpr size_t PEER_TBL  = (size_t)16384 * 2048;
constexpr float PEER_USCALE = 64.0f, PEER_VSCALE = 4.0f;
constexpr size_t OFF_BIG1  = OFF_PEER + 4 * PEER_TBL * 2;
constexpr size_t BIG_BYTES = al256((size_t)140000000);
constexpr size_t OFF_BIG2  = OFF_BIG1 + BIG_BYTES;
constexpr size_t OFF_H     = OFF_BIG2 + BIG_BYTES;
constexpr size_t OFF_A     = OFF_H + (size_t)MT * DM * 4;
constexpr size_t OFF_QK    = OFF_A + (size_t)MT * DM * 2;
constexpr size_t OFF_HYT   = OFF_QK + (size_t)MT * DM * 2;
constexpr size_t OFF_EXP   = OFF_HYT + al256((size_t)40000000);
constexpr size_t OFF_X     = OFF_EXP + (size_t)MT * 128 * 8;
constexpr size_t WS_END    = OFF_X + (size_t)MT * DM * 2;
static_assert(WS_END <= (size_t)1073741824, "workspace map exceeds 1 GiB");

__device__ __forceinline__ int opq(int v) { asm volatile("" : "+s"(v)); return v; }
__device__ __forceinline__ int otid() { int t = threadIdx.x; asm volatile("" : "+v"(t)); return t; }
__device__ __forceinline__ bf16_t f2bf(float f) { unsigned u = __float_as_uint(f); u += 0x7FFFu + ((u >> 16) & 1u); return (bf16_t)(u >> 16); }
__device__ __forceinline__ float bf2f(bf16_t b) { return __uint_as_float(((unsigned)b) << 16); }
__device__ __forceinline__ unsigned pk_bf16(float lo, float hi) { unsigned r; asm volatile("v_cvt_pk_bf16_f32 %0, %1, %2" : "=v"(r) : "v"(lo), "v"(hi)); return r; }
typedef int i32x4 __attribute__((ext_vector_type(4)));
typedef int i32x8 __attribute__((ext_vector_type(8)));
__device__ __forceinline__ unsigned fp8x4(float a, float b, float c, float d) { int v = 0; v = __builtin_amdgcn_cvt_pk_fp8_f32(a, b, v, false); v = __builtin_amdgcn_cvt_pk_fp8_f32(c, d, v, true); return (unsigned)v; }
__device__ __forceinline__ float clamp8(float v) { return __builtin_amdgcn_fmed3f(v, -448.f, 448.f); }
constexpr float G8_XS = 16.0f, G8_WS = 64.0f, G8_OS = 1.0f / (16.0f * 64.0f);
#define F8_L0 0
#define F8_L1 1
#define F8_L1O 1
__device__ __forceinline__ float bflo(unsigned u) { return __uint_as_float(u << 16); }
__device__ __forceinline__ float bfhi(unsigned u) { return __uint_as_float(u & 0xFFFF0000u); }
__device__ __forceinline__ float wave_sum(float v) {
#pragma unroll
    for (int o = 32; o > 0; o >>= 1) v += __shfl_xor(v, o);
    return v;
}
__device__ __forceinline__ float wave_max(float v) {
#pragma unroll
    for (int o = 32; o > 0; o >>= 1) v = fmaxf(v, __shfl_xor(v, o));
    return v;
}
__device__ __forceinline__ float silu_f(float x) { return x / (1.f + __expf(-x)); }
__device__ __forceinline__ float sigmoid_f(float x) { return 1.f / (1.f + __expf(-x)); }

#define XB_TMO      128
#define XB_XCNT(j)  (256  + 64 * (j))
#define XB_XSUB(j)  (1280 + 64 * (j))
#define XB_XGEN(j)  (2304 + 64 * (j))
#define XB_TOP      3328
#define XB_TOPGEN   3392
#define XCD_BAR_WORDS 3456
#define XB_SPIN_CAP (1u << 30)
__device__ __forceinline__ unsigned xb_ld(unsigned* p)              { return __hip_atomic_load(p, __ATOMIC_RELAXED, __HIP_MEMORY_SCOPE_AGENT); }
__device__ __forceinline__ unsigned xb_add(unsigned* p, unsigned v) { return __hip_atomic_fetch_add(p, v, __ATOMIC_RELAXED, __HIP_MEMORY_SCOPE_AGENT); }
__device__ __forceinline__ unsigned xb_xcc_id() { return (unsigned)__builtin_amdgcn_s_getreg((3 << 11) | 20) & 0xFu; }
#define XB_SPIN(cond, bar) do { unsigned _sp = 0; while (cond) { __builtin_amdgcn_s_sleep(1); \
    if ((++_sp & 255u) == 0u) { if (xb_ld(&(bar)[XB_TMO])) break; if (_sp > XB_SPIN_CAP) { atomicAdd(&(bar)[XB_TMO], 1u); break; } } } } while (0)
struct XcdBarrier { unsigned* bar; unsigned x; volatile LAS unsigned* st; };
__device__ __forceinline__ XcdBarrier xcd_barrier_post(unsigned* bar, volatile LAS unsigned* st) {
    XcdBarrier b; b.bar = bar; b.x = xb_xcc_id(); b.st = st;
    if (threadIdx.x == 0) (void)xb_add(&bar[XB_XCNT(b.x)], 1u);
    return b;
}
__device__ __forceinline__ void xcd_barrier_complete(unsigned* bar, unsigned x, unsigned& nloc, unsigned& nx) {
    const unsigned G = gridDim.x * gridDim.y * gridDim.z;
    unsigned sum, cnt, mine, sp = 0u;
    for (;;) {
        sum = 0u; cnt = 0u; mine = 0u;
#pragma unroll
        for (unsigned j = 0; j < 16; ++j) { const unsigned c = xb_ld(&bar[XB_XCNT(j)]); sum += c; cnt += (c > 0u) ? 1u : 0u; mine = (j == x) ? c : mine; }
        if (sum == G) break;
        __builtin_amdgcn_s_sleep(1);
        if ((++sp & 255u) == 0u) { if (xb_ld(&bar[XB_TMO])) break; if (sp > XB_SPIN_CAP) { atomicAdd(&bar[XB_TMO], 1u); break; } }
    }
    nloc = mine > 0u ? mine : 1u; nx = cnt > 0u ? cnt : 1u;
}
__device__ __forceinline__ void xcd_barrier(const XcdBarrier& b) {
    asm volatile("s_waitcnt vmcnt(0)" ::: "memory");
    __syncthreads();
    if (threadIdx.x == 0) {
        unsigned* bar = b.bar;
        __builtin_amdgcn_s_waitcnt(0);
        unsigned nloc = b.st[0], nx = b.st[1];
        if (nloc == 0u) { xcd_barrier_complete(bar, b.x, nloc, nx); b.st[0] = nloc; b.st[1] = nx; }
        const unsigned old = xb_add(&bar[XB_XSUB(b.x)], 1u);
        const unsigned gen = old / nloc;
        if (old + 1u == (gen + 1u) * nloc) {
            __builtin_amdgcn_fence(__ATOMIC_RELEASE, "agent");
            asm volatile("s_waitcnt vmcnt(0)" ::: "memory");
            const unsigned og = xb_add(&bar[XB_TOP], 1u);
            const unsigned tg = og / nx;
            if (og + 1u == (tg + 1u) * nx) xb_add(&bar[XB_TOPGEN], 1u);
            else XB_SPIN(xb_ld(&bar[XB_TOPGEN]) == tg, bar);
            __builtin_amdgcn_fence(__ATOMIC_ACQUIRE, "agent");
            xb_add(&bar[XB_XGEN(b.x)], 1u);
            asm volatile("s_waitcnt vmcnt(0)" ::: "memory");
        } else {
            XB_SPIN(xb_ld(&bar[XB_XGEN(b.x)]) == gen, bar);
            __builtin_amdgcn_fence(__ATOMIC_ACQUIRE, "agent");
            asm volatile("s_waitcnt vmcnt(0)" ::: "memory");
        }
    }
    __syncthreads();
}

namespace pg8 {
constexpr int BM = 256, BK = 64, HALF = 128, HTB = HALF * BK * 2, STAGE_BYTES = 8 * HTB, NXCD = 8, WGM = 8;
__host__ __device__ __forceinline__ int lds_byte(int r, int c) { const int st = (r >> 4) * 2 + (c >> 5), rr = r & 15, cc = c & 31, ob = rr * 64 + cc * 2; return st * 1024 + (ob ^ (((ob >> 9) & 1) << 5)); }
__host__ __device__ __forceinline__ void stage_rc(int b, int& R, int& C) { const int st = b / 1024, sb = b % 1024, swz = sb ^ (((sb >> 9) & 1) << 5); R = (st >> 1) * 16 + swz / 64; C = (st & 1) * 32 + (swz % 64) / 2; }
__host__ __device__ __forceinline__ int perm32(int rho) { const int n = rho >> 4, i = rho & 15; return 8 * (i >> 2) + 4 * n + (i & 3); }
struct Unit { int pm, pn; };
struct Gemm { const bf16_t* A; const bf16_t* Bt; int M, N, K; };
struct StaticOrder {
    int nM, nN, nwg, G, c;
    __host__ __device__ void init(int M, int N, int G_, int c_) { nM = M / BM; nN = N / BM; nwg = nM * nN; G = G_; c = c_; }
    __host__ __device__ bool next(int i, Unit& u) const {
        const long L = (long)i * G + c; if (L >= nwg) return false;
        int wgid = (int)L; { const int q = nwg / NXCD, r = nwg % NXCD, xcd = wgid % NXCD, off = wgid / NXCD; wgid = (xcd < r ? xcd * (q + 1) : r * (q + 1) + (xcd - r) * q) + off; }
        const int nig = WGM * nN, gid = wgid / nig, fm = gid * WGM, gsz = (nM - fm) < WGM ? (nM - fm) : WGM;
        u.pm = fm + ((wgid % nig) % gsz); u.pn = (wgid % nig) / gsz; return true;
    }
    __device__ __forceinline__ void a_ready(const Unit&) const {}
    __device__ __forceinline__ void done(const Unit&) const {}
};
struct EpiF32 {
    static constexpr bool PERM = false;
    float* C; int ldc;
    __device__ __forceinline__ void operator()(const f32x4 (&acc)[2][2][4][2], const Unit& u, int wr, int wc, int fr, int fq) const {
        const int row0 = u.pm * BM + wr * 64 + fr, col0 = u.pn * BM + wc * 32 + 4 * fq;
#pragma unroll
        for (int ai = 0; ai < 2; ++ai)
#pragma unroll
            for (int m = 0; m < 4; ++m) { float* rowp = C + (size_t)(row0 + ai * HALF + m * 16) * ldc + col0;
#pragma unroll
                for (int bj = 0; bj < 2; ++bj)
#pragma unroll
                    for (int n = 0; n < 2; ++n) *(f32x4*)(rowp + bj * HALF + n * 16) = acc[ai][bj][m][n]; }
    }
};
struct EpiBf16 {
    static constexpr bool PERM = true;
    bf16_t* O; int ldc;
    __device__ __forceinline__ void operator()(const f32x4 (&acc)[2][2][4][2], const Unit& u, int wr, int wc, int fr, int fq) const {
        const int row0 = u.pm * BM + wr * 64 + fr, col0 = u.pn * BM + wc * 32 + 8 * fq;
#pragma unroll
        for (int ai = 0; ai < 2; ++ai)
#pragma unroll
            for (int m = 0; m < 4; ++m) { bf16_t* rowp = O + (size_t)(row0 + ai * HALF + m * 16) * ldc + col0;
#pragma unroll
                for (int bj = 0; bj < 2; ++bj) { const f32x4 v0 = acc[ai][bj][m][0], v1 = acc[ai][bj][m][1];
                    u32x4 w; w.x = pk_bf16(v0[0], v0[1]); w.y = pk_bf16(v0[2], v0[3]); w.z = pk_bf16(v1[0], v1[1]); w.w = pk_bf16(v1[2], v1[3]);
                    *(u32x4*)(rowp + bj * HALF) = w; } }
    }
};
struct EpiL1 {
    static constexpr bool PERM = true;
    bf16_t* QKp; bf16_t* Ob; float* G;
    __device__ __forceinline__ void operator()(const f32x4 (&acc)[2][2][4][2], const Unit& u, int wr, int wc, int fr, int fq) const {
        const int row0 = u.pm * BM + wr * 64 + fr;
        if (u.pn < 16) {
            bf16_t* base = (u.pn < 8) ? QKp : Ob; const int col0 = (u.pn & 7) * BM + wc * 32 + 8 * fq;
#pragma unroll
            for (int ai = 0; ai < 2; ++ai)
#pragma unroll
                for (int m = 0; m < 4; ++m) { bf16_t* rowp = base + (size_t)(row0 + ai * HALF + m * 16) * 2048 + col0;
#pragma unroll
                    for (int bj = 0; bj < 2; ++bj) { const f32x4 v0 = acc[ai][bj][m][0], v1 = acc[ai][bj][m][1];
                        u32x4 w; w.x = pk_bf16(v0[0], v0[1]); w.y = pk_bf16(v0[2], v0[3]); w.z = pk_bf16(v1[0], v1[1]); w.w = pk_bf16(v1[2], v1[3]);
                        *(u32x4*)(rowp + bj * HALF) = w; } }
        } else if (wc == 0) {
#pragma unroll
            for (int ai = 0; ai < 2; ++ai)
#pragma unroll
                for (int m = 0; m < 4; ++m) { float* rowp = G + (size_t)(row0 + ai * HALF + m * 16) * 32 + 8 * fq;
                    *(f32x4*)(rowp) = acc[ai][0][m][0]; *(f32x4*)(rowp + 4) = acc[ai][0][m][1]; }
        }
    }
};

template <class Epi, class Sched>
__device__ __forceinline__ void gemm_phase(LAS unsigned char* lds, const Gemm g, const Sched& S, const Epi& E) {
    const int tid = otid(), wid = __builtin_amdgcn_readfirstlane(tid >> 6), lane = tid & 63, wr = wid >> 2, wc = wid & 3, fr = lane & 15, fq = lane >> 4;
    const int K = g.K, nt = K / BK;
    unsigned voffA[2], voffB[2];
#pragma unroll
    for (int i = 0; i < 2; ++i) { int R, C; stage_rc(tid * 16 + i * 8192, R, C); const int Rb = Epi::PERM ? ((R & ~31) + perm32(R & 31)) : R;
        voffA[i] = (unsigned)(R * K + C) * 2u; voffB[i] = (unsigned)(Rb * K + C) * 2u; }
    const size_t kstep = (size_t)(BK * 2);
    const size_t hstep = (size_t)HALF * K * 2;
    const size_t tstep = 2 * hstep;
    const unsigned ldsw = (unsigned)wid * 1024u;
    const int aoff = lds_byte(wr * 64 + fr, fq * 8), boff = lds_byte(wc * 32 + fr, fq * 8);
#define PG8_SA(b, h) (((b) * 2 + (h)) * HTB)
#define PG8_SB(b, h) ((4 + (b) * 2 + (h)) * HTB)
#define PG8_STAGE(bufoff, gbase, voff) do { _Pragma("unroll") for (int _i = 0; _i < 2; ++_i) \
        __builtin_amdgcn_global_load_lds((const unsigned*)((const char*)(gbase) + (voff)[_i]), (LAS unsigned*)(lds + (bufoff) + ldsw + _i * 8192), 16, 0, 0); } while (0)
#define PG8_LDA(dst, b, h) do { _Pragma("unroll") for (int m = 0; m < 4; ++m) _Pragma("unroll") for (int k = 0; k < 2; ++k) dst[m][k] = *(const LAS bf16x8*)(lds + PG8_SA(b, h) + aoff + m * 2048 + k * 1024); } while (0)
#define PG8_LDB(dst, b, h) do { _Pragma("unroll") for (int n = 0; n < 2; ++n) _Pragma("unroll") for (int k = 0; k < 2; ++k) dst[n][k] = *(const LAS bf16x8*)(lds + PG8_SB(b, h) + boff + n * 2048 + k * 1024); } while (0)
#define PG8_MMA(ai, bj, At, Bt) do { __builtin_amdgcn_s_setprio(1); _Pragma("unroll") for (int m = 0; m < 4; ++m) _Pragma("unroll") for (int n = 0; n < 2; ++n) _Pragma("unroll") for (int k = 0; k < 2; ++k) \
        acc[ai][bj][m][n] = __builtin_amdgcn_mfma_f32_16x16x32_bf16(Bt[n][k], At[m][k], acc[ai][bj][m][n], 0, 0, 0); __builtin_amdgcn_s_setprio(0); } while (0)
#define PG8_WAIT_V(n) asm volatile("s_waitcnt vmcnt(" #n ")" ::: "memory")
#define PG8_WAIT_L(n) asm volatile("s_waitcnt lgkmcnt(" #n ")" ::: "memory")
#define PG8_BAR __builtin_amdgcn_s_barrier()
#define PG8_SCHED __builtin_amdgcn_sched_barrier(0)
    Unit cur, nxt; int ui = 0;
    if (!S.next(0, cur)) return;
    f32x4 acc[2][2][4][2];
#pragma unroll
    for (int a = 0; a < 2; ++a)
#pragma unroll
        for (int b = 0; b < 2; ++b)
#pragma unroll
            for (int m = 0; m < 4; ++m)
#pragma unroll
                for (int n = 0; n < 2; ++n) acc[a][b][m][n] = (f32x4){0.f, 0.f, 0.f, 0.f};
    bf16x8 At[4][2], B0[2][2], B1[2][2];
    const char* cA = (const char*)g.A + (size_t)cur.pm * tstep; const char* cB = (const char*)g.Bt + (size_t)cur.pn * tstep;
    S.a_ready(cur);
    PG8_STAGE(PG8_SB(0, 0), cB, voffB); PG8_STAGE(PG8_SA(0, 0), cA, voffA); PG8_STAGE(PG8_SB(0, 1), cB + hstep, voffB); PG8_STAGE(PG8_SA(0, 1), cA + hstep, voffA);
    if (wr == 1) PG8_BAR;
    PG8_WAIT_V(4); PG8_BAR;
    PG8_STAGE(PG8_SB(1, 0), cB + kstep, voffB); PG8_STAGE(PG8_SA(1, 0), cA + kstep, voffA); PG8_STAGE(PG8_SB(1, 1), cB + hstep + kstep, voffB);
    PG8_WAIT_V(6); PG8_BAR;
    for (;;) {
        const bool has_next = S.next(ui + 1, nxt);
        const char* nA = has_next ? (const char*)g.A + (size_t)nxt.pm * tstep : cA; const char* nB = has_next ? (const char*)g.Bt + (size_t)nxt.pn * tstep : cB;
        for (int t = 0; t < nt; t += 2) {
            const bool last = (t == nt - 2);
            const char* a1 = cA + (size_t)(t + 1) * kstep;
            const char* a2 = last ? nA : cA + (size_t)(t + 2) * kstep; const char* b2 = last ? nB : cB + (size_t)(t + 2) * kstep;
            const char* a3 = a2 + kstep; const char* b3 = b2 + kstep;
            if (last && has_next) S.a_ready(nxt);
            PG8_LDB(B0, 0, 0); PG8_SCHED; PG8_LDA(At, 0, 0); PG8_STAGE(PG8_SA(1, 1), a1 + hstep, voffA);
            PG8_WAIT_L(8); PG8_BAR; PG8_WAIT_L(0); PG8_MMA(0, 0, At, B0); PG8_BAR; PG8_SCHED;
            PG8_LDB(B1, 0, 1); PG8_STAGE(PG8_SB(0, 0), b2, voffB);
            PG8_BAR; PG8_WAIT_L(0); PG8_MMA(0, 1, At, B1); PG8_BAR;
            PG8_LDA(At, 0, 1); PG8_STAGE(PG8_SA(0, 0), a2, voffA);
            PG8_BAR; PG8_WAIT_L(0); PG8_MMA(1, 0, At, B0); PG8_BAR; PG8_SCHED;
            PG8_STAGE(PG8_SB(0, 1), b2 + hstep, voffB);
            PG8_WAIT_V(6); PG8_BAR; PG8_MMA(1, 1, At, B1); PG8_BAR;
            PG8_LDB(B0, 1, 0); PG8_SCHED; PG8_LDA(At, 1, 0); PG8_STAGE(PG8_SA(0, 1), a2 + hstep, voffA);
            PG8_WAIT_L(8); PG8_BAR; PG8_WAIT_L(0); PG8_MMA(0, 0, At, B0); PG8_BAR; PG8_SCHED;
            PG8_LDB(B1, 1, 1); PG8_STAGE(PG8_SB(1, 0), b3, voffB);
            PG8_BAR; PG8_WAIT_L(0); PG8_MMA(0, 1, At, B1); PG8_BAR;
            PG8_LDA(At, 1, 1); PG8_STAGE(PG8_SA(1, 0), a3, voffA);
            PG8_BAR; PG8_WAIT_L(0); PG8_MMA(1, 0, At, B0); PG8_BAR; PG8_SCHED;
            PG8_STAGE(PG8_SB(1, 1), b3 + hstep, voffB);
            PG8_WAIT_V(6); PG8_BAR; PG8_MMA(1, 1, At, B1); PG8_BAR;
        }
        E(acc, cur, wr, wc, fr, fq); S.done(cur);
        if (!has_next) break;
#pragma unroll
        for (int a = 0; a < 2; ++a)
#pragma unroll
            for (int b = 0; b < 2; ++b)
#pragma unroll
                for (int m = 0; m < 4; ++m)
#pragma unroll
                    for (int n = 0; n < 2; ++n) acc[a][b][m][n] = (f32x4){0.f, 0.f, 0.f, 0.f};
        cur = nxt; cA = nA; cB = nB; ++ui;
    }
    PG8_WAIT_V(0);
    if (wr == 0) PG8_BAR;
    PG8_BAR;
#undef PG8_SA
#undef PG8_SB
#undef PG8_STAGE
#undef PG8_LDA
#undef PG8_LDB
#undef PG8_MMA
#undef PG8_WAIT_V
#undef PG8_WAIT_L
#undef PG8_BAR
#undef PG8_SCHED
}
__device__ __forceinline__ void mfma8(f32x4& acc, const i32x8 b, const i32x8 a, int sc) {
    asm volatile("v_mfma_scale_f32_16x16x128_f8f6f4 %0, %1, %2, %0, %3, %3 op_sel_hi:[0,0,0]" : "+v"(acc) : "v"(b), "v"(a), "v"(sc)); }
__device__ __forceinline__ i32x8 cat8(const bf16x8 a, const bf16x8 b) { const i32x4 x = __builtin_bit_cast(i32x4, a), y = __builtin_bit_cast(i32x4, b); return __builtin_shufflevector(x, y, 0, 1, 2, 3, 4, 5, 6, 7); }
struct GUnit { const char* A; const char* B; int pm, pn, nkt, tag; };
template <class Epi, class Sched, bool F8 = false>
__device__ __forceinline__ void gemm_stream(LAS unsigned char* lds, const int K, const Sched& S, const Epi& E) {
    const int tid = otid(), wid = __builtin_amdgcn_readfirstlane(tid >> 6), lane = tid & 63, wr = wid >> 2, wc = wid & 3, fr = lane & 15, fq = lane >> 4;
    unsigned voffA[2], voffB[2];
    const int Kb = F8 ? K : 2 * K;
#pragma unroll
    for (int i = 0; i < 2; ++i) { int R, C; stage_rc(tid * 16 + i * 8192, R, C); const int Rb = Epi::PERM ? ((R & ~31) + perm32(R & 31)) : R;
        voffA[i] = (unsigned)(R * Kb + C * 2); voffB[i] = (unsigned)(Rb * Kb + C * 2); }
    int sc8 = 0x7F7F7F7F; asm volatile("" : "+v"(sc8));
    const size_t kstep = (size_t)(BK * 2);
    const size_t hstep = (size_t)HALF * Kb;
    const unsigned ldsw = (unsigned)wid * 1024u;
    const int aoff = lds_byte(wr * 64 + fr, fq * 8), boff = lds_byte(wc * 32 + fr, fq * 8);
#define PG8_SA(b, h) (((b) * 2 + (h)) * HTB)
#define PG8_SB(b, h) ((4 + (b) * 2 + (h)) * HTB)
#define PG8_STAGE(bufoff, gbase, voff) do { _Pragma("unroll") for (int _i = 0; _i < 2; ++_i) \
        __builtin_amdgcn_global_load_lds((const unsigned*)((const char*)(gbase) + (voff)[_i]), (LAS unsigned*)(lds + (bufoff) + ldsw + _i * 8192), 16, 0, 0); } while (0)
#define PG8_LDA(dst, b, h) do { _Pragma("unroll") for (int m = 0; m < 4; ++m) _Pragma("unroll") for (int k = 0; k < 2; ++k) dst[m][k] = *(const LAS bf16x8*)(lds + PG8_SA(b, h) + aoff + m * 2048 + k * 1024); } while (0)
#define PG8_LDB(dst, b, h) do { _Pragma("unroll") for (int n = 0; n < 2; ++n) _Pragma("unroll") for (int k = 0; k < 2; ++k) dst[n][k] = *(const LAS bf16x8*)(lds + PG8_SB(b, h) + boff + n * 2048 + k * 1024); } while (0)
#define PG8_MMA(ai, bj, At, Bt) do { __builtin_amdgcn_s_setprio(1); \
        if constexpr (F8) { _Pragma("unroll") for (int m = 0; m < 4; ++m) _Pragma("unroll") for (int n = 0; n < 2; ++n) \
            mfma8(acc[ai][bj][m][n], cat8(Bt[n][0], Bt[n][1]), cat8(At[m][0], At[m][1]), sc8); } \
        else { _Pragma("unroll") for (int m = 0; m < 4; ++m) _Pragma("unroll") for (int n = 0; n < 2; ++n) _Pragma("unroll") for (int k = 0; k < 2; ++k) \
            acc[ai][bj][m][n] = __builtin_amdgcn_mfma_f32_16x16x32_bf16(Bt[n][k], At[m][k], acc[ai][bj][m][n], 0, 0, 0); } \
        __builtin_amdgcn_s_setprio(0); } while (0)
#define PG8_WAIT_V(n) asm volatile("s_waitcnt vmcnt(" #n ")" ::: "memory")
#define PG8_WAIT_L(n) asm volatile("s_waitcnt lgkmcnt(" #n ")" ::: "memory")
#define PG8_BAR __builtin_amdgcn_s_barrier()
#define PG8_SCHED __builtin_amdgcn_sched_barrier(0)
    GUnit cur, nxt; int ui = 0;
    if (!S.next(0, cur)) return;
    f32x4 acc[2][2][4][2];
#pragma unroll
    for (int a = 0; a < 2; ++a)
#pragma unroll
        for (int b = 0; b < 2; ++b)
#pragma unroll
            for (int m = 0; m < 4; ++m)
#pragma unroll
                for (int n = 0; n < 2; ++n) acc[a][b][m][n] = (f32x4){0.f, 0.f, 0.f, 0.f};
    bf16x8 At[4][2], B0[2][2], B1[2][2];
    const char* cA = cur.A; const char* cB = cur.B;
    PG8_STAGE(PG8_SB(0, 0), cB, voffB); PG8_STAGE(PG8_SA(0, 0), cA, voffA); PG8_STAGE(PG8_SB(0, 1), cB + hstep, voffB); PG8_STAGE(PG8_SA(0, 1), cA + hstep, voffA);
    if (wr == 1) PG8_BAR;
    PG8_WAIT_V(4); PG8_BAR;
    PG8_STAGE(PG8_SB(1, 0), cB + kstep, voffB); PG8_STAGE(PG8_SA(1, 0), cA + kstep, voffA); PG8_STAGE(PG8_SB(1, 1), cB + hstep + kstep, voffB);
    PG8_WAIT_V(6); PG8_BAR;
    for (;;) {
        const bool has_next = S.next(ui + 1, nxt);
        const char* nA = has_next ? nxt.A : cA; const char* nB = has_next ? nxt.B : cB;
        const int nt = cur.nkt;
        for (int t = 0; t < nt; t += 2) {
            const bool last = (t == nt - 2);
            const char* a1 = cA + (size_t)(t + 1) * kstep;
            const char* a2 = last ? nA : cA + (size_t)(t + 2) * kstep; const char* b2 = last ? nB : cB + (size_t)(t + 2) * kstep;
            const char* a3 = a2 + kstep; const char* b3 = b2 + kstep;
            PG8_LDB(B0, 0, 0); PG8_SCHED; PG8_LDA(At, 0, 0); PG8_STAGE(PG8_SA(1, 1), a1 + hstep, voffA);
            PG8_WAIT_L(8); PG8_BAR; PG8_WAIT_L(0); PG8_MMA(0, 0, At, B0); PG8_BAR; PG8_SCHED;
            PG8_LDB(B1, 0, 1); PG8_STAGE(PG8_SB(0, 0), b2, voffB);
            PG8_BAR; PG8_WAIT_L(0); PG8_MMA(0, 1, At, B1); PG8_BAR;
            PG8_LDA(At, 0, 1); PG8_STAGE(PG8_SA(0, 0), a2, voffA);
            PG8_BAR; PG8_WAIT_L(0); PG8_MMA(1, 0, At, B0); PG8_BAR; PG8_SCHED;
            PG8_STAGE(PG8_SB(0, 1), b2 + hstep, voffB);
            PG8_WAIT_V(6); PG8_BAR; PG8_MMA(1, 1, At, B1); PG8_BAR;
            PG8_LDB(B0, 1, 0); PG8_SCHED; PG8_LDA(At, 1, 0); PG8_STAGE(PG8_SA(0, 1), a2 + hstep, voffA);
            PG8_WAIT_L(8); PG8_BAR; PG8_WAIT_L(0); PG8_MMA(0, 0, At, B0); PG8_BAR; PG8_SCHED;
            PG8_LDB(B1, 1, 1); PG8_STAGE(PG8_SB(1, 0), b3, voffB);
            PG8_BAR; PG8_WAIT_L(0); PG8_MMA(0, 1, At, B1); PG8_BAR;
            PG8_LDA(At, 1, 1); PG8_STAGE(PG8_SA(1, 0), a3, voffA);
            PG8_BAR; PG8_WAIT_L(0); PG8_MMA(1, 0, At, B0); PG8_BAR; PG8_SCHED;
            PG8_STAGE(PG8_SB(1, 1), b3 + hstep, voffB);
            PG8_WAIT_V(6); PG8_BAR; PG8_MMA(1, 1, At, B1); PG8_BAR;
        }
        if constexpr (F8) {
            asm volatile("s_nop 15\n\ts_nop 15" ::: "memory");
#pragma unroll
            for (int a = 0; a < 2; ++a)
#pragma unroll
                for (int b = 0; b < 2; ++b)
#pragma unroll
                    for (int m = 0; m < 4; ++m)
#pragma unroll
                        for (int n = 0; n < 2; ++n) acc[a][b][m][n] *= G8_OS; }
        E(acc, cur, wr, wc, fr, fq);
        if (!has_next) break;
#pragma unroll
        for (int a = 0; a < 2; ++a)
#pragma unroll
            for (int b = 0; b < 2; ++b)
#pragma unroll
                for (int m = 0; m < 4; ++m)
#pragma unroll
                    for (int n = 0; n < 2; ++n) acc[a][b][m][n] = (f32x4){0.f, 0.f, 0.f, 0.f};
        cur = nxt; cA = nA; cB = nB; ++ui;
    }
    PG8_WAIT_V(0);
    if (wr == 0) PG8_BAR;
    PG8_BAR;
#undef PG8_SA
#undef PG8_SB
#undef PG8_STAGE
#undef PG8_LDA
#undef PG8_LDB
#undef PG8_MMA
#undef PG8_WAIT_V
#undef PG8_WAIT_L
#undef PG8_BAR
#undef PG8_SCHED
}
}

namespace pg8 {
__device__ __forceinline__ void tile_map(int L, int nM, int nN, int& pm, int& pn) {
    const int nwg = nM * nN; int wgid = L; { const int q = nwg / NXCD, r = nwg % NXCD, xcd = wgid % NXCD, off = wgid / NXCD; wgid = (xcd < r ? xcd * (q + 1) : r * (q + 1) + (xcd - r) * q) + off; }
    const int nig = WGM * nN, gid = wgid / nig, fm = gid * WGM, gsz = (nM - fm) < WGM ? (nM - fm) : WGM;
    pm = fm + ((wgid % nig) % gsz); pn = (wgid % nig) / gsz;
}
constexpr size_t TROW = (size_t)256 * 2048 * 2;
template <bool PERM_>
__device__ __forceinline__ void store_f32_tile(const f32x4 (&acc)[2][2][4][2], float* C, int ldc, int wr, int wc, int fr, int fq) {
    const int row0 = wr * 64 + fr, col0 = wc * 32 + (PERM_ ? 8 : 4) * fq;
#pragma unroll
    for (int ai = 0; ai < 2; ++ai)
#pragma unroll
        for (int m = 0; m < 4; ++m) { float* rowp = C + (size_t)(row0 + ai * HALF + m * 16) * ldc + col0;
#pragma unroll
            for (int bj = 0; bj < 2; ++bj)
#pragma unroll
                for (int n = 0; n < 2; ++n) *(f32x4*)(rowp + bj * HALF + n * (PERM_ ? 4 : 16)) = acc[ai][bj][m][n]; }
}
template <class Epi1, int ESZ = 2> struct Sched2 {
    const char* A0; const char* B0; int nM0, nN0; const char* A1; const char* B1; int nM1, nN1; int G, c;
    static constexpr size_t TR = TROW * ESZ / 2; static constexpr int NKT = 16 * ESZ;
    __device__ __forceinline__ bool next(int i, GUnit& u) const {
        int L = i * G + c; const int n0 = nM0 * nN0;
        if (L < n0) { tile_map(L, nM0, nN0, u.pm, u.pn); u.A = A0 + (size_t)u.pm * TR; u.B = B0 + (size_t)u.pn * TR; u.nkt = NKT; u.tag = 0; return true; }
        L -= n0; if (L >= nM1 * nN1) return false;
        tile_map(L, nM1, nN1, u.pm, u.pn); u.A = A1 + (size_t)u.pm * TR; u.B = B1 + (size_t)u.pn * TR; u.nkt = NKT; u.tag = 1; return true;
    }
};
template <class Epi1> struct EpiS2 {
    static constexpr bool PERM = true;
    EpiBf16 e0; Epi1 e1;
    __device__ __forceinline__ void operator()(const f32x4 (&acc)[2][2][4][2], const GUnit& g, int wr, int wc, int fr, int fq) const {
        const Unit u{g.pm, g.pn}; if (g.tag == 0) e0(acc, u, wr, wc, fr, fq); else e1(acc, u, wr, wc, fr, fq); }
};
template <int ESZ> struct Sched1 {
    const char* A; const char* B; int nM, nN, G, c;
    static constexpr size_t TR = TROW * ESZ / 2; static constexpr int NKT = 16 * ESZ;
    __device__ __forceinline__ bool next(int i, GUnit& u) const {
        const int L = i * G + c; if (L >= nM * nN) return false;
        tile_map(L, nM, nN, u.pm, u.pn); u.A = A + (size_t)u.pm * TR; u.B = B + (size_t)u.pn * TR; u.nkt = NKT; u.tag = 0; return true;
    }
};
template <class Epi0> struct EpiG {
    static constexpr bool PERM = Epi0::PERM;
    Epi0 e0;
    __device__ __forceinline__ void operator()(const f32x4 (&acc)[2][2][4][2], const GUnit& g, int wr, int wc, int fr, int fq) const { const Unit u{g.pm, g.pn}; e0(acc, u, wr, wc, fr, fq); }
};
struct SchedTail {
    const char* A; const char* B; int nM, nN; bool ctx_is_row;
    int G, c;
    __device__ __forceinline__ bool next(int i, GUnit& u) const {
        int L = i * G + c; const int n0 = nM * nN;
        if (L < n0) { tile_map(L, nM, nN, u.pm, u.pn); u.A = A + (size_t)u.pm * TROW; u.B = B + (size_t)u.pn * TROW; u.nkt = 32; u.tag = 0; return true; }
        L -= n0; const int nt_ = ctx_is_row ? nN : nM; if (L >= nt_ * 8) return false;
        const int t = L >> 3, sl = L & 7;
        u.pm = ctx_is_row ? nM : t; u.pn = ctx_is_row ? t : nN;
        u.A = A + (size_t)u.pm * TROW + (size_t)sl * 512; u.B = B + (size_t)u.pn * TROW + (size_t)sl * 512; u.nkt = 4; u.tag = 1 + sl + 8 * t; return true;
    }
};
template <bool PERM_, class Epi0> struct EpiTail {
    static constexpr bool PERM = PERM_;
    Epi0 e0; float* slab;
    __device__ __forceinline__ void operator()(const f32x4 (&acc)[2][2][4][2], const GUnit& g, int wr, int wc, int fr, int fq) const {
        if (g.tag == 0) { const Unit u{g.pm, g.pn}; e0(acc, u, wr, wc, fr, fq); }
        else { const int sl = (g.tag - 1) & 7, t = (g.tag - 1) >> 3; store_f32_tile<PERM_>(acc, slab + ((size_t)(sl * 8 + t) << 16), 256, wr, wc, fr, fq); }
    }
};
}
template <class Epi>
__device__ __forceinline__ void run_gemm(LAS unsigned char* lds, const bf16_t* A, const bf16_t* Bt, int M, int N, int K, const Epi& E) {
    pg8::Gemm g{A, Bt, M, N, K};
    pg8::StaticOrder S; S.init(M, N, (int)gridDim.x, (int)blockIdx.x);
    pg8::gemm_phase(lds, g, S, E);
    __syncthreads();
}
struct Params {
    const float* in[32];
    float* out;
    unsigned char* ws;
};
__device__ __forceinline__ unsigned char* get_ws() { const __attribute__((address_space(4))) char* ka = (const __attribute__((address_space(4))) char*)__builtin_amdgcn_kernarg_segment_ptr();
    unsigned long long w = *(const __attribute__((address_space(4))) unsigned long long*)(ka + __builtin_offsetof(Params, ws)); asm volatile("" : "+s"(w));
    return (unsigned char*)(__attribute__((address_space(1))) unsigned char*)w; }
__device__ __forceinline__ Params fresh(const Params& p) { Params q = p; q.ws = get_ws(); return q; }
enum { I_X = 0, I_C, I_CTX, I_CCTX, I_ADAW, I_ADAB, I_LNW, I_LNB, I_ABWIN, I_HYCW, I_HYCB, I_FW1, I_FB1, I_FW2, I_FB2, I_FW3, I_FB3, I_FW4, I_HYSKIP, I_RPB, I_ABWOUT,
       I_MLWIN, I_MLBG, I_MLCW, I_MLCB, I_MLNW, I_MLWOUT, I_PWQ, I_PK1, I_PK2, I_PU, I_PV };

template <bool F8>
__device__ __forceinline__ void task_transpose(LAS float* tile, const float* __restrict__ src, int ld, int ncols, bf16_t* __restrict__ dst, int K, int k0, int n_src0, int n_dst0) {
    const int tid = otid();
    const int nn = tid & 63, kb = tid >> 6;
    const bool ok = n_src0 + nn < ncols;
    const float* sp = src + (size_t)(k0 + kb) * ld + n_src0 + nn;
#pragma unroll
    for (int h = 0; h < 2; ++h) { float v[16];
#pragma unroll
        for (int it = 0; it < 16; ++it) v[it] = ok ? sp[(size_t)((h * 16 + it) * 8) * ld] : 0.f;
#pragma unroll
        for (int it = 0; it < 16; ++it) tile[nn * 257 + (h * 16 + it) * 8 + kb] = v[it]; }
    __syncthreads();
    if (F8) {
        unsigned char* d8 = (unsigned char*)dst;
#pragma unroll
        for (int it = 0; it < 8; ++it) { const int i = tid + it * 512, n2 = i >> 6, kq = i & 63; const LAS float* tp = tile + n2 * 257 + 4 * kq;
            *(unsigned*)(d8 + (size_t)(n_dst0 + n2) * K + k0 + 4 * kq) = fp8x4(clamp8(tp[0] * G8_WS), clamp8(tp[1] * G8_WS), clamp8(tp[2] * G8_WS), clamp8(tp[3] * G8_WS)); }
    } else {
#pragma unroll
        for (int it = 0; it < 16; ++it) { const int i = tid + it * 512, n2 = i >> 7, kp = i & 127;
            const float a = tile[n2 * 257 + 2 * kp], b = tile[n2 * 257 + 2 * kp + 1];
            *(unsigned*)(dst + (size_t)(n_dst0 + n2) * K + k0 + 2 * kp) = pk_bf16(a, b); }
    }
    __syncthreads();
}
__device__ __forceinline__ void task_convert(const float* __restrict__ src, unsigned char* __restrict__ dst, float scale) {
    const int tid = otid();
#pragma unroll 2
    for (int it = 0; it < 8; ++it) { const size_t i = ((size_t)it * 512 + tid) * 16;
        u32x4 w;
#pragma unroll
        for (int q = 0; q < 4; ++q) { const f32x4 a = *(const f32x4*)(src + i + 4 * q) * scale;
            int v = 0; v = __builtin_amdgcn_cvt_pk_fp8_f32(a[0], a[1], v, false); v = __builtin_amdgcn_cvt_pk_fp8_f32(a[2], a[3], v, true);
            if (q == 0) w.x = (unsigned)v; else if (q == 1) w.y = (unsigned)v; else if (q == 2) w.z = (unsigned)v; else w.w = (unsigned)v; }
        *(u32x4*)(dst + i) = w; }
}
__device__ __forceinline__ void task_wqk(LAS float* lds, const float* __restrict__ wq, const float* __restrict__ keys, bf16_t* __restrict__ dstT, int hh, int jt) {
    LAS float* km = lds;
    LAS float* wt = lds + 128 * 129;
    const int tid = otid();
    for (int i = tid; i < 128 * 128; i += 512) { const int n = i >> 7, d = i & 127; km[n * 129 + d] = keys[i]; }
    for (int i = tid; i < 64 * 128; i += 512) { const int j = i >> 7, d = i & 127; wt[j * 129 + d] = wq[(size_t)(jt * 64 + j) * 2048 + hh * 128 + d]; }
    __syncthreads();
    const int ns = tid & 31, js = tid >> 5;
    float acc[4][4];
#pragma unroll
    for (int a = 0; a < 4; ++a)
#pragma unroll
        for (int b = 0; b < 4; ++b) acc[a][b] = 0.f;
    for (int d = 0; d < 128; ++d) {
        float kv[4], wv[4];
#pragma unroll
        for (int a = 0; a < 4; ++a) kv[a] = km[(ns + 32 * a) * 129 + d];
#pragma unroll
        for (int b = 0; b < 4; ++b) wv[b] = wt[(js + 16 * b) * 129 + d];
#pragma unroll
        for (int a = 0; a < 4; ++a)
#pragma unroll
            for (int b = 0; b < 4; ++b) acc[a][b] = fmaf(kv[a], wv[b], acc[a][b]);
    }
    __syncthreads();
    LAS float* ot = wt;
#pragma unroll
    for (int a = 0; a < 4; ++a)
#pragma unroll
        for (int b = 0; b < 4; ++b) ot[(ns + 32 * a) * 65 + js + 16 * b] = acc[a][b];
    __syncthreads();
#pragma unroll
    for (int it = 0; it < 8; ++it) { const int i = tid + it * 512, n = i >> 5, jp = i & 31;
        *(unsigned*)(dstT + (size_t)(hh * 128 + n) * 2048 + jt * 64 + 2 * jp) = pk_bf16(ot[n * 65 + 2 * jp], ot[n * 65 + 2 * jp + 1]); }
    __syncthreads();
}
__device__ __forceinline__ void task_ada(LAS float* lds, const float* __restrict__ c, const float* __restrict__ cc, const float* __restrict__ W, const float* __restrict__ bias,
                                         float* __restrict__ out_lat, float* __restrict__ out_ctx, int n0) {
    LAS float* sl = lds; LAS float* sc = lds + 2048; LAS float* red = lds + 4096;
    const int tid = otid(), w = tid >> 6, lane = tid & 63;
    for (int i = tid; i < 2048; i += 512) { sl[i] = silu_f(c[i]); sc[i] = silu_f(cc[i]); }
    __syncthreads();
    float al = 0.f, ac = 0.f;
    const float* wp = W + (size_t)(w * 256) * 12288 + n0 + lane;
#pragma unroll 8
    for (int k = 0; k < 256; ++k) { const float wv = wp[(size_t)k * 12288]; al = fmaf(sl[w * 256 + k], wv, al); ac = fmaf(sc[w * 256 + k], wv, ac); }
    red[(w * 64 + lane) * 2] = al; red[(w * 64 + lane) * 2 + 1] = ac;
    __syncthreads();
    if (tid < 64) { float a = 0.f, b = 0.f;
#pragma unroll
        for (int ww = 0; ww < 8; ++ww) { a += red[(ww * 64 + tid) * 2]; b += red[(ww * 64 + tid) * 2 + 1]; }
        out_lat[n0 + tid] = a + bias[n0 + tid]; out_ctx[n0 + tid] = b + bias[n0 + tid]; }
    __syncthreads();
}
__device__ __forceinline__ void task_a3(const Params& p, LAS float* lds, bf16_t* __restrict__ a3, int task) {
    const int tid = otid(), w = tid >> 6, lane = tid & 63;
    LAS float* W2s = lds; LAS float* W3s = lds + 4096; LAS float* hb = lds + 8192 + w * 128;
    for (int i = tid; i < 4096; i += 512) { W2s[i] = p.in[I_FW2][i]; W3s[i] = p.in[I_FW3][i]; }
    __syncthreads();
    const float* W1 = p.in[I_FW1];
    float w1[33];
#pragma unroll
    for (int f = 0; f < 33; ++f) w1[f] = W1[f * 64 + lane];
    const float b1 = p.in[I_FB1][lane], b2 = p.in[I_FB2][lane], b3 = p.in[I_FB3][lane];
    const float freq = 1e-4f + (float)(lane & 15) * ((15.0f - 1e-4f) / 15.0f);
#pragma unroll 1
    for (int i = 0; i < (w == 0 ? 9 : 8); ++i) {
        const int pos = task * 65 + (i < 8 ? w * 8 + i : 64);
        const int n = pos < TL ? pos : pos - TL; const int L = pos < TL ? TL : TCX;
        const float tl = (float)n / (float)(L - 1);
        const float omega = 6.283185307179586f * (float)n / (float)L;
        float sn, cs; sincosf(omega * freq, &sn, &cs);
        float h = fmaf(tl, w1[0], b1);
#pragma unroll
        for (int b = 0; b < 16; ++b) { h = fmaf(__shfl(cs, b), w1[1 + b], h); h = fmaf(-__shfl(sn, b), w1[17 + b], h); }
        hb[lane] = sinf(h);
        __builtin_amdgcn_wave_barrier();
        float g = b2;
#pragma unroll 8
        for (int j = 0; j < 64; ++j) g = fmaf(hb[j], W2s[j * 64 + lane], g);
        hb[64 + lane] = sinf(g);
        __builtin_amdgcn_wave_barrier();
        float q = b3;
#pragma unroll 8
        for (int j = 0; j < 64; ++j) q = fmaf(hb[64 + j], W3s[j * 64 + lane], q);
        a3[(size_t)pos * 64 + lane] = f2bf(sinf(q));
        __builtin_amdgcn_wave_barrier();
    }
    __syncthreads();
}

constexpr int P0_NT_TR0 = 8 * 96, P0_NT_TRO = 8 * 32, P0_NT_TR1 = 8 * 100;
constexpr int P0_T0 = 0;
constexpr int P0_T1 = P0_T0 + P0_NT_TR0;
constexpr int P0_T2 = P0_T1 + P0_NT_TRO;
constexpr int P0_T3 = P0_T2 + P0_NT_TR1;
constexpr int P0_T4 = P0_T3 + P0_NT_TRO;
constexpr int P0_T5 = P0_T4 + 4 * 512;
constexpr int P0_T6 = P0_T5 + 1024;
constexpr int P0_T7 = P0_T6 + 384;
constexpr int P0_T8 = P0_T7 + 256;
constexpr int P0_NT = P0_T8 + 1;
constexpr int P0_T5B = P0_T5 + 512;
constexpr int P0_T6B = P0_T6 + 192;

__device__ __forceinline__ void phase0(const Params& p, LAS unsigned char* lds, int t_begin = 0, int t_end = P0_NT, int skip_blocks = 0) {
    LAS float* ldsf = (LAS float*)lds;
    unsigned char* ws = p.ws;
    if ((int)blockIdx.x < skip_blocks) return;
    for (int task = t_begin + (int)blockIdx.x - skip_blocks; task < t_end; task += (int)gridDim.x - skip_blocks) {
        if (task < P0_T1) {
            const int t = task - P0_T0, kt = t & 7, nt = t >> 3; const int nd = nt * 64;
            const int nsrc = nd < 3072 ? nd : (nd < 4096 ? 5120 + (nd - 3072) : 3072 + (nd - 4096));
            task_transpose<F8_L0 != 0>(ldsf, p.in[I_ABWIN], 6144, 6144, (bf16_t*)(ws + OFF_W0T), 2048, kt * 256, nsrc, nd);
        } else if (task < P0_T2) {
            const int t = task - P0_T1, kt = t & 7, nt = t >> 3;
            task_transpose<false>(ldsf, p.in[I_ABWOUT], 2048, 2048, (bf16_t*)(ws + OFF_WO0T), 2048, kt * 256, nt * 64, nt * 64);
        } else if (task < P0_T3) {
            const int t = task - P0_T2, kt = t & 7, nt = t >> 3; const int nd = nt * 64;
            const int nsrc = nd < 2048 ? 2048 + nd : (nd < 4096 ? nd - 2048 : nd);
            task_transpose<F8_L1 != 0>(ldsf, p.in[I_MLWIN], 6176, 6176, (bf16_t*)(ws + OFF_W1T), 2048, kt * 256, nsrc, nd);
        } else if (task < P0_T4) {
            const int t = task - P0_T3, kt = t & 7, nt = t >> 3;
            task_transpose<F8_L1O != 0>(ldsf, p.in[I_MLWOUT], 2048, 2048, (bf16_t*)(ws + OFF_WO1T), 2048, kt * 256, nt * 64, nt * 64);
        } else if (task < P0_T5) {
            const int t = task - P0_T4, ti = t >> 9, ch = t & 511; const int layer = ti >> 1, which = ti & 1;
            task_convert((which ? p.in[I_PV] : p.in[I_PU]) + (size_t)layer * PEER_TBL + (size_t)ch * 65536, ws + OFF_PEER + (size_t)ti * PEER_TBL + (size_t)ch * 65536, which ? PEER_VSCALE : PEER_USCALE);
        } else if (task < P0_T6) {
            const int t = task - P0_T5, layer = t >> 9, hh = (t >> 5) & 15, jt = t & 31;
            task_wqk(ldsf, p.in[I_PWQ] + (size_t)layer * 2048 * 2048, ((hh & 1) ? p.in[I_PK2] : p.in[I_PK1]) + (size_t)layer * 16384, (bf16_t*)(ws + OFF_WQK) + (size_t)layer * 2048 * 2048, hh, jt);
        } else if (task < P0_T7) {
            const int t = task - P0_T6, layer = t / 192, ch = t % 192;
            float* mod = (float*)(ws + OFF_MOD) + (size_t)layer * 2 * 12288;
            task_ada(ldsf, p.in[I_C], p.in[I_CCTX], p.in[I_ADAW] + (size_t)layer * 2048 * 12288, p.in[I_ADAB] + (size_t)layer * 12288, mod, mod + 12288, ch * 64);
        } else if (task < P0_T8) {
            task_a3(p, ldsf, (bf16_t*)(ws + OFF_A3), task - P0_T7);
        } else {
            f32x2* rt = (f32x2*)(ws + OFF_ROPE);
            for (int i = otid(); i < 256 * 32; i += 512) { const int pos = i >> 5, q = i & 31;
                const float inv = expf(-(float)q * (9.210340371976184f / 32.0f)); float sn, cs; sincosf((float)pos * inv, &sn, &cs); rt[i] = (f32x2){cs, sn}; }
        }
    }
}

__device__ __forceinline__ void modulate_rows(const float* __restrict__ xlat, const float* __restrict__ xctx, const float* __restrict__ mod  , bf16_t* __restrict__ U) {
    const int tid = otid(), w = tid >> 6, lane = tid & 63;
    const int stride = gridDim.x * 8;
    for (int r0 = blockIdx.x * 8 + w; r0 < MT; r0 += 2 * stride) {
        f32x4 xa[2][4], xb[2][4];
#pragma unroll
        for (int k = 0; k < 2; ++k) { const int r = r0 + k * stride; if (r < MT) { const float* src = r < TL ? xlat + (size_t)r * DM : xctx + (size_t)(r - TL) * DM;
#pragma unroll
            for (int pc = 0; pc < 4; ++pc) { const int e = pc * 512 + lane * 8; xa[k][pc] = *(const f32x4*)(src + e); xb[k][pc] = *(const f32x4*)(src + e + 4); } } }
#pragma unroll
        for (int k = 0; k < 2; ++k) { const int r = r0 + k * stride; if (r < MT) { const float* md = mod + (r < TL ? 0 : 12288);
#pragma unroll
            for (int pc = 0; pc < 4; ++pc) { const int e = pc * 512 + lane * 8;
                const f32x4 s0 = *(const f32x4*)(md + 2048 + e), s1 = *(const f32x4*)(md + 2048 + e + 4), h0 = *(const f32x4*)(md + e), h1 = *(const f32x4*)(md + e + 4);
                const f32x4 x = xa[k][pc] * (s0 + 1.f) + h0, y = xb[k][pc] * (s1 + 1.f) + h1;
#if F8_L0
                u32x2 o; o.x = fp8x4(clamp8(x[0] * G8_XS), clamp8(x[1] * G8_XS), clamp8(x[2] * G8_XS), clamp8(x[3] * G8_XS)); o.y = fp8x4(clamp8(y[0] * G8_XS), clamp8(y[1] * G8_XS), clamp8(y[2] * G8_XS), clamp8(y[3] * G8_XS));
                *(u32x2*)((unsigned char*)U + (size_t)r * DM + e) = o; } } }
#else
                u32x4 o; o.x = pk_bf16(x[0], x[1]); o.y = pk_bf16(x[2], x[3]); o.z = pk_bf16(y[0], y[1]); o.w = pk_bf16(y[2], y[3]);
                *(u32x4*)(U + (size_t)r * DM + e) = o; } } }
#endif
    }
}
__device__ __forceinline__ void hyena_taps(const Params& p) {
    const int tid = otid(), w = tid >> 6, lane = tid & 63, fr = lane & 15, fq = lane >> 4;
    const bf16_t* a3 = (const bf16_t*)(p.ws + OFF_A3);
    const float* w4 = p.in[I_FW4];
    bf16_t* HmT = (bf16_t*)(p.ws + OFF_BIG1);
    bf16_t* HmC = HmT + (size_t)4096 * TL;
    const int NWT = 256 * 16 + 256;
    for (int wt = blockIdx.x * 8 + w; wt < NWT; wt += gridDim.x * 8) {
        const bool isctx = wt >= 4096;
        const int ct = isctx ? wt - 4096 : (wt >> 4), tch = isctx ? 0 : (wt & 15);
        const int col = ct * 16 + fr;
        bf16x8 bw[2];
#pragma unroll
        for (int ks = 0; ks < 2; ++ks)
#pragma unroll
            for (int j = 0; j < 8; ++j) bw[ks][j] = (short)f2bf(w4[(size_t)(ks * 32 + fq * 8 + j) * 4096 + col]);
        const int ch = col & 1023;
        const float mind = -3.0701134573253945f, maxd = -15.350567286626973f;
        const float delta = fabsf(mind + (maxd - mind) * ((float)ch / 1023.0f));
        const int nblk = isctx ? 4 : 16;
        const int t00 = isctx ? 0 : tch * 1024;
        const float invL1 = isctx ? (1.0f / 255.0f) : (1.0f / 16383.0f);
        for (int blk = 0; blk < nblk; ++blk) {
            const int t0 = t00 + blk * 64;
            f32x4 acc[4];
#pragma unroll
            for (int tau = 0; tau < 4; ++tau) {
                acc[tau] = (f32x4){0.f, 0.f, 0.f, 0.f};
                const int trow = t0 + 16 * (fr >> 2) + 4 * tau + (fr & 3);
                const bf16_t* ap = a3 + (size_t)((isctx ? TL : 0) + trow) * 64 + fq * 8;
                const bf16x8 a0 = *(const bf16x8*)(ap), a1 = *(const bf16x8*)(ap + 32);
                acc[tau] = __builtin_amdgcn_mfma_f32_16x16x32_bf16(a0, bw[0], acc[tau], 0, 0, 0);
                acc[tau] = __builtin_amdgcn_mfma_f32_16x16x32_bf16(a1, bw[1], acc[tau], 0, 0, 0);
            }
            unsigned o[8];
#pragma unroll
            for (int tau = 0; tau < 4; ++tau) {
                float v[4];
#pragma unroll
                for (int rg = 0; rg < 4; ++rg) { const int t = t0 + 16 * fq + 4 * tau + rg; v[rg] = acc[tau][rg] * __expf(-(float)t * invL1 * delta); }
                o[tau * 2] = pk_bf16(v[0], v[1]); o[tau * 2 + 1] = pk_bf16(v[2], v[3]);
            }
            bf16_t* dst = isctx ? HmC + (size_t)col * TCX + t0 + 16 * fq : HmT + (size_t)col * TL + t0 + 16 * fq;
            *(u32x4*)(dst) = (u32x4){o[0], o[1], o[2], o[3]};
            *(u32x4*)(dst + 8) = (u32x4){o[4], o[5], o[6], o[7]};
        }
    }
}
constexpr int HY_TW = 143360;
__device__ __forceinline__ f32x2 cmul(f32x2 a, f32x2 b) { return (f32x2){a.x * b.x - a.y * b.y, a.x * b.y + a.y * b.x}; }
__device__ __forceinline__ int fpad(int p) { return p + (p >> 4) + ((p >> 9) << 4); }
__device__ __forceinline__ int kpos(int k) { return fpad((k & 31) * 512 + ((k >> 5) & 31) * 16 + (k >> 10)); }
__host__ __device__ constexpr int brev_c(int q, int bits) { int r = 0; for (int i = 0; i < bits; ++i) r |= ((q >> i) & 1) << (bits - 1 - i); return r; }

template <int R, int LOGR, bool INV>
__device__ __forceinline__ void fft_regs(f32x2 (&v)[R]) {
    constexpr float C32[16] = {1.0f, 0.98078528040323043f, 0.92387953251128674f, 0.83146961230254524f, 0.70710678118654757f, 0.55557023301960229f, 0.38268343236508984f, 0.19509032201612833f,
                               0.0f, -0.19509032201612819f, -0.38268343236508973f, -0.55557023301960196f, -0.70710678118654746f, -0.83146961230254535f, -0.92387953251128674f, -0.98078528040323043f};
    constexpr float S32[16] = {0.0f, 0.19509032201612825f, 0.38268343236508978f, 0.55557023301960218f, 0.70710678118654746f, 0.83146961230254524f, 0.92387953251128674f, 0.98078528040323043f,
                               1.0f, 0.98078528040323043f, 0.92387953251128674f, 0.83146961230254546f, 0.70710678118654757f, 0.55557023301960218f, 0.38268343236508989f, 0.19509032201612861f};
#pragma unroll
    for (int s = 0; s < LOGR; ++s) {
        const int half = (R / 2) >> s;
#pragma unroll
        for (int start = 0; start < R; start += 2 * half) {
#pragma unroll
            for (int i = 0; i < half; ++i) {
                const f32x2 a = v[start + i], b = v[start + i + half];
                v[start + i] = a + b;
                const f32x2 d = a - b;
                const int e = i * (16 / half);
                if (e == 0) v[start + i + half] = d;
                else if (e == 8) v[start + i + half] = INV ? (f32x2){-d.y, d.x} : (f32x2){d.y, -d.x};
                else { const float c = C32[e], sn = INV ? S32[e] : -S32[e]; v[start + i + half] = (f32x2){d.x * c - d.y * sn, d.x * sn + d.y * c}; }
            }
        }
    }
}
template <int R, int LOGR, bool INV, bool TW>
__device__ __forceinline__ void fft_bfly(LAS f32x2* Z, int a0, int astride, f32x2 bw) {
    f32x2 v[R];
#pragma unroll
    for (int r = 0; r < R; ++r) v[r] = Z[a0 + r * astride];
    if (TW) {
        const f32x2 base = (f32x2){bw.x, INV ? -bw.y : bw.y};
        f32x2 tw = base;
        if (INV) {
#pragma unroll
            for (int q = 1; q < R; ++q) { v[q] = cmul(v[q], tw); tw = cmul(tw, base); }
            fft_regs<R, LOGR, INV>(v);
        } else {
            fft_regs<R, LOGR, INV>(v);
#pragma unroll
            for (int q = 1; q < R; ++q) { v[brev_c(q, LOGR)] = cmul(v[brev_c(q, LOGR)], tw); tw = cmul(tw, base); }
        }
    } else fft_regs<R, LOGR, INV>(v);
#pragma unroll
    for (int q = 0; q < R; ++q) Z[a0 + q * astride] = v[brev_c(q, LOGR)];
}
__device__ __forceinline__ void fft16k_fwd(LAS f32x2* Z) {
    const int tid = otid();
    const LAS f32x2* T1 = (const LAS f32x2*)((LAS unsigned char*)Z + HY_TW);
    fft_bfly<32, 5, false, true>(Z, tid + (tid >> 4), 560, T1[tid]);
    __syncthreads();
    { const int b = tid >> 4, j = tid & 15; fft_bfly<32, 5, false, true>(Z, 560 * b + j, 17, T1[32 * j]); }
    __syncthreads();
#pragma unroll
    for (int h = 0; h < 2; ++h) { const int bb = tid + 512 * h; fft_bfly<16, 4, false, false>(Z, 17 * bb + 16 * (bb >> 5), 1, (f32x2){1.f, 0.f}); }
    __syncthreads();
}
__device__ __forceinline__ void fft16k_inv(LAS f32x2* Z) {
    const int tid = otid();
#pragma unroll
    for (int h = 0; h < 2; ++h) { const int bb = tid + 512 * h; fft_bfly<16, 4, true, false>(Z, 17 * bb + 16 * (bb >> 5), 1, (f32x2){1.f, 0.f}); }
    __syncthreads();
    const LAS f32x2* T1 = (const LAS f32x2*)((LAS unsigned char*)Z + HY_TW);
    { const int b = tid >> 4, j = tid & 15; fft_bfly<32, 5, true, true>(Z, 560 * b + j, 17, T1[32 * j]); }
    __syncthreads();
    fft_bfly<32, 5, true, true>(Z, tid + (tid >> 4), 560, T1[tid]);
    __syncthreads();
}
__device__ __forceinline__ int pair_k(int tid, int jj) { return ((tid >> 8) * 16 + jj) + 32 * ((tid >> 3) & 31) + 1024 * (tid & 7); }

__device__ __forceinline__ void hy_stash(LAS f32x2* Z, f32x4 (&st)[16], f32x4& stx) {
    const int tid = otid();
#pragma unroll
    for (int jj = 0; jj < 16; ++jj) { const int k = pair_k(tid, jj), kp = (16384 - k) & 16383;
        const f32x2 A = Z[kpos(k)], Bc = Z[kpos(kp)]; const f32x2 B = (f32x2){Bc.x, -Bc.y};
        const f32x2 S = A + B, Dd = A - B;
        st[jj] = (f32x4){0.5f * S.x, 0.5f * S.y, 0.5f * Dd.y, -0.5f * Dd.x}; }
    { const f32x2 A = Z[kpos(8192)]; stx = (f32x4){A.x, 0.f, A.y, 0.f}; }
}
__device__ __forceinline__ void hy_pointwise_one(LAS f32x2* Z, int k, const f32x4 hh, bool do_write) {
    const int kp = (16384 - k) & 16383; const int pa = kpos(k), pb = kpos(kp);
    const f32x2 A = Z[pa], Bc = Z[pb]; const f32x2 B = (f32x2){Bc.x, -Bc.y};
    const f32x2 S = A + B, Dd = A - B;
    const f32x2 Xe = (f32x2){0.5f * S.x, 0.5f * S.y}, Xo = (f32x2){0.5f * Dd.y, -0.5f * Dd.x};
    const f32x2 He = (f32x2){hh.x, hh.y}, Ho = (f32x2){hh.z, hh.w};
    const LAS f32x2* T1 = (const LAS f32x2*)((LAS unsigned char*)Z + HY_TW);
    const f32x2 w2 = cmul(T1[k & 511], T1[512 + (k >> 9)]);
    const f32x2 P = cmul(Xe, He) + cmul(w2, cmul(Xo, Ho));
    const f32x2 Q = cmul(Xe, Ho) + cmul(Xo, He);
    if (do_write) { Z[pa] = (f32x2){P.x - Q.y, P.y + Q.x}; Z[pb] = (f32x2){P.x + Q.y, Q.x - P.y}; }
}
__device__ __forceinline__ void hy_pointwise(LAS f32x2* Z, const f32x4 (&st)[16], const f32x4& stx) {
    const int tid = otid();
#pragma unroll
    for (int jj = 0; jj < 16; ++jj) hy_pointwise_one(Z, pair_k(tid, jj), st[jj], true);
    hy_pointwise_one(Z, 8192, stx, tid == 0);
    __syncthreads();
}
__device__ __forceinline__ void ld32bf(const bf16_t* __restrict__ p, float (&o)[32]) {
#pragma unroll
    for (int q = 0; q < 4; ++q) { const u32x4 w = *(const u32x4*)(p + q * 8);
        o[q * 8 + 0] = bflo(w.x); o[q * 8 + 1] = bfhi(w.x); o[q * 8 + 2] = bflo(w.y); o[q * 8 + 3] = bfhi(w.y);
        o[q * 8 + 4] = bflo(w.z); o[q * 8 + 5] = bfhi(w.z); o[q * 8 + 6] = bflo(w.w); o[q * 8 + 7] = bfhi(w.w); }
}
__device__ __forceinline__ void conv32(const bf16_t* __restrict__ row, int t0, int len, float w0, float w1, float w2, float cb, float (&o)[32]) {
    float x[32]; ld32bf(row + t0, x);
    const float xm = t0 > 0 ? bf2f(row[t0 - 1]) : 0.f, xp = (t0 + 32 < len) ? bf2f(row[t0 + 32]) : 0.f;
#pragma unroll
    for (int i = 0; i < 32; ++i) { const float a = i > 0 ? x[i - 1] : xm, c = i < 31 ? x[i + 1] : xp; o[i] = cb + w0 * a + w1 * x[i] + w2 * c; }
}
__device__ __forceinline__ void hy_load_taps(LAS f32x2* Z, const bf16_t* __restrict__ hf, const bf16_t* __restrict__ hb) {
    const int tid = otid();
    { float x[32]; ld32bf(hf + 32 * tid, x);
#pragma unroll
      for (int i = 0; i < 16; ++i) Z[fpad(16 * tid + i)] = (f32x2){x[2 * i], x[2 * i + 1]}; }
    { const int e0 = 16384 - 32 * tid; float x[32]; ld32bf(hb + e0 - 32, x);
      const float ex = (e0 < 16384) ? bf2f(hb[e0]) : 0.f;
#pragma unroll
      for (int i = 0; i < 16; ++i) Z[fpad(8192 + 16 * tid + i)] = (f32x2){i == 0 ? ex : x[32 - 2 * i], x[31 - 2 * i]}; }
    __syncthreads();
}
__device__ __forceinline__ void hy_load_data(LAS f32x2* Z, const float (&zc)[32]) {
    const int tid = otid();
#pragma unroll
    for (int i = 0; i < 16; ++i) { Z[fpad(16 * tid + i)] = (f32x2){zc[2 * i], zc[2 * i + 1]}; Z[fpad(8192 + 16 * tid + i)] = (f32x2){0.f, 0.f}; }
    __syncthreads();
}
__device__ __forceinline__ void hy_get_z(const Params& p, int o, int c, int t0, float (&zc)[32]) {
    if (o == 0) { const bf16_t* PRE = (const bf16_t*)(p.ws + OFF_BIG2); const float* cw = p.in[I_HYCW];
        conv32(PRE + (size_t)c * MT, t0, TL, cw[c], cw[3072 + c], cw[6144 + c], p.in[I_HYCB][c], zc);
    } else { const float* ZS = (const float*)(p.ws + OFF_X) + (size_t)c * TL + t0;
#pragma unroll
        for (int q = 0; q < 8; ++q) { const f32x4 v = *(const f32x4*)(ZS + 4 * q); zc[4 * q] = v[0]; zc[4 * q + 1] = v[1]; zc[4 * q + 2] = v[2]; zc[4 * q + 3] = v[3]; } }
}
__device__ __forceinline__ void hyena_channel(const Params& p, LAS f32x2* Z, int c) {
    const int tid = otid();
    const bf16_t* PRE = (const bf16_t*)(p.ws + OFF_BIG2);
    const bf16_t* HmT = (const bf16_t*)(p.ws + OFF_BIG1);
    bf16_t* hyT = (bf16_t*)(p.ws + OFF_HYT);
    float* ZS = (float*)(p.ws + OFF_X);
    const float* cw = p.in[I_HYCW]; const float* cbias = p.in[I_HYCB]; const float* skip = p.in[I_HYSKIP];
    const int t0 = 32 * tid;
#pragma unroll 1
    for (int o = 0; o < 2; ++o) {
        f32x4 st[16], stx;
        hy_load_taps(Z, HmT + (size_t)(o * 1024 + c) * TL, HmT + (size_t)(2048 + o * 1024 + c) * TL);
        fft16k_fwd(Z);
        hy_stash(Z, st, stx);
        __syncthreads();
        { float zc[32]; hy_get_z(p, o, c, t0, zc); hy_load_data(Z, zc); }
        fft16k_fwd(Z);
        hy_pointwise(Z, st, stx);
        fft16k_inv(Z);
        {
            const int gr = (o + 1) * 1024 + c;
            float zc[32]; hy_get_z(p, o, c, t0, zc);
            float g[32]; conv32(PRE + (size_t)gr * MT, t0, TL, cw[gr], cw[3072 + gr], cw[6144 + gr], cbias[gr], g);
            const float sk = skip[o * 1024 + c];
#pragma unroll
            for (int i = 0; i < 16; ++i) { const f32x2 y = Z[fpad(16 * tid + i)];
                zc[2 * i] = g[2 * i] * (y.x * (1.0f / 16384.0f) + sk * zc[2 * i]); zc[2 * i + 1] = g[2 * i + 1] * (y.y * (1.0f / 16384.0f) + sk * zc[2 * i + 1]); }
            if (o == 0) {
#pragma unroll
                for (int q = 0; q < 8; ++q) *(f32x4*)(ZS + (size_t)c * TL + t0 + 4 * q) = (f32x4){zc[4 * q], zc[4 * q + 1], zc[4 * q + 2], zc[4 * q + 3]};
            } else {
                bf16_t* dst = hyT + (size_t)c * MT + t0;
#pragma unroll
                for (int q = 0; q < 4; ++q) { u32x4 w; w.x = pk_bf16(zc[q * 8], zc[q * 8 + 1]); w.y = pk_bf16(zc[q * 8 + 2], zc[q * 8 + 3]); w.z = pk_bf16(zc[q * 8 + 4], zc[q * 8 + 5]); w.w = pk_bf16(zc[q * 8 + 6], zc[q * 8 + 7]);
                    *(u32x4*)(dst + q * 8) = w; }
            }
        }
        __syncthreads();
    }
}
__device__ __forceinline__ void hyena_ctx_channel(const Params& p, LAS float* wl, int c) {
    const int lane = otid() & 63;
    const bf16_t* PRE = (const bf16_t*)(p.ws + OFF_BIG2);
    const bf16_t* HmC = (const bf16_t*)(p.ws + OFF_BIG1) + (size_t)4096 * TL;
    bf16_t* hyT = (bf16_t*)(p.ws + OFF_HYT);
    const float* cw = p.in[I_HYCW]; const float* cbias = p.in[I_HYCB]; const float* skip = p.in[I_HYSKIP];
    LAS float* zs = wl; LAS float* tp = wl + 256;
    float z[4];
    {
        const bf16_t* row = PRE + (size_t)c * MT + TL;
        float x[6];
#pragma unroll
        for (int i = 0; i < 6; ++i) { const int t = 4 * lane - 1 + i; x[i] = (t >= 0 && t < TCX) ? bf2f(row[t]) : 0.f; }
#pragma unroll
        for (int i = 0; i < 4; ++i) z[i] = cbias[c] + cw[c] * x[i] + cw[3072 + c] * x[i + 1] + cw[6144 + c] * x[i + 2];
    }
#pragma unroll 1
    for (int o = 0; o < 2; ++o) {
        const bf16_t* hf = HmC + (size_t)(o * 1024 + c) * TCX; const bf16_t* hb = HmC + (size_t)(2048 + o * 1024 + c) * TCX;
#pragma unroll
        for (int i = 0; i < 4; ++i) { const int d = 4 * lane + i; zs[d] = z[i]; tp[255 + d] = bf2f(hf[d]); if (d > 0) tp[255 - d] = bf2f(hb[d]); }
        __builtin_amdgcn_s_waitcnt(0);
        __builtin_amdgcn_wave_barrier();
        float y[4] = {0.f, 0.f, 0.f, 0.f};
        for (int s = 0; s < 256; ++s) { const float zv = zs[s];
#pragma unroll
            for (int i = 0; i < 4; ++i) y[i] = fmaf(tp[255 + 4 * lane + i - s], zv, y[i]); }
        const int gr = (o + 1) * 1024 + c;
        const bf16_t* row = PRE + (size_t)gr * MT + TL;
        float x[6];
#pragma unroll
        for (int i = 0; i < 6; ++i) { const int t = 4 * lane - 1 + i; x[i] = (t >= 0 && t < TCX) ? bf2f(row[t]) : 0.f; }
        const float sk = skip[o * 1024 + c];
#pragma unroll
        for (int i = 0; i < 4; ++i) { const float g = cbias[gr] + cw[gr] * x[i] + cw[3072 + gr] * x[i + 1] + cw[6144 + gr] * x[i + 2]; z[i] = g * (y[i] + sk * z[i]); }
        __builtin_amdgcn_wave_barrier();
    }
    *(u32x2*)(hyT + (size_t)c * MT + TL + 4 * lane) = (u32x2){pk_bf16(z[0], z[1]), pk_bf16(z[2], z[3])};
}

constexpr int NA_KS = 0;
constexpr int NA_VS = 34816;
__device__ __forceinline__ void na_block_task(const Params& p, LAS unsigned char* lds, int task) {
    const int tid = otid(), wv = __builtin_amdgcn_readfirstlane(tid >> 6), lane = tid & 63, fr = lane & 15, fq = lane >> 4;
    const bf16_t* QK = (const bf16_t*)(p.ws + OFF_QK);
    const bf16_t* VT = (const bf16_t*)(p.ws + OFF_BIG2) + (size_t)3072 * MT;
    bf16_t* A2 = (bf16_t*)(p.ws + OFF_A);
    const float* rpb = p.in[I_RPB];
    const float scale = 0.08838834764831845f;
    const int hl = wv >> 2;
    int hp, qrow, nlat, r = 0, g = 0, r0 = 0, cb = 0;
    if (task < 1024) { hp = task & 3; r = task >> 2; g = wv & 3; qrow = r * 64 + 16 * g + fr; nlat = 8;
        r0 = r - 4; r0 = r0 < 0 ? 0 : (r0 > 248 ? 248 : r0); cb = 16 * g - 8; cb = cb < 0 ? 0 : (cb > 32 ? 32 : cb);
    } else { const int t = task - 1024; hp = t & 3; qrow = TL + 16 * (4 * (t >> 2) + (wv & 3)) + fr; nlat = 0; }
    const int h = 2 * hp + hl;
    const unsigned so_k = (unsigned)((tid >> 3) * 2048 + (tid & 7) * 8);
    const unsigned so_v = (unsigned)((tid >> 1) * MT + (tid & 1) * 32);
    u32x4 sk[4], sv[4];
#define NA_LOAD(tk0_) do { const bf16_t* kb_ = QK + (size_t)(tk0_) * 2048 + 1024 + hp * 256; const bf16_t* vb_ = VT + (size_t)(hp * 256) * MT + (tk0_); \
        _Pragma("unroll") for (int j = 0; j < 4; ++j) { sk[j] = *(const u32x4*)(kb_ + so_k + 64u * j); sv[j] = *(const u32x4*)(vb_ + so_v + 8u * j); } } while (0)
#define NA_STORE() do { _Pragma("unroll") for (int j = 0; j < 4; ++j) { \
        *(LAS u32x4*)(lds + NA_KS + (j >> 1) * 17408 + (tid >> 3) * 272 + ((tid & 7) * 8 + 64 * (j & 1)) * 2) = sk[j]; \
        *(LAS u32x4*)(lds + NA_VS + (tid >> 1) * 144 + ((tid & 1) * 32 + 8 * j) * 2) = sv[j]; } } while (0)
    bf16x8 qf[4];
#pragma unroll
    for (int ks = 0; ks < 4; ++ks) qf[ks] = *(const bf16x8*)(QK + (size_t)qrow * 2048 + h * 128 + ks * 32 + fq * 8);
    f32x4 oacc[8];
#pragma unroll
    for (int dt = 0; dt < 8; ++dt) oacc[dt] = (f32x4){0.f, 0.f, 0.f, 0.f};
    float mrun = -1e30f, lrun = 0.f;
    const int c = 16 * g + fr;
    int cs = c - 8; cs = cs < 0 ? 0 : (cs > 48 ? 48 : cs);
    const int nsteps = nlat + 4;
    __syncthreads();
    { const int tk0 = nlat ? r0 * 64 : TL; NA_LOAD(tk0); NA_STORE(); }
    __syncthreads();
    LAS unsigned char* Kh = lds + NA_KS + hl * 17408;
    LAS unsigned char* Vh = lds + NA_VS + hl * 128 * 144;
#pragma unroll 1
    for (int step = 0; step < nsteps; ++step) {
        const bool lat = step < nlat;
        if (step + 1 < nsteps) { const int tk1 = (step + 1 < nlat) ? (r0 + step + 1) * 64 : TL + 64 * (step + 1 - nlat); NA_LOAD(tk1); }
        const int kr = r0 + step;
        const int nsub = lat ? 1 : 2;
#pragma unroll 1
        for (int sub = 0; sub < nsub; ++sub) {
            const int kb = lat ? cb : 32 * sub;
            f32x4 s[2];
#pragma unroll
            for (int tl = 0; tl < 2; ++tl) {
                s[tl] = (f32x4){0.f, 0.f, 0.f, 0.f};
#pragma unroll
                for (int ks = 0; ks < 4; ++ks) { const bf16x8 kf = *(const LAS bf16x8*)(Kh + (kb + 16 * tl + fr) * 272 + 64 * ks + 16 * fq);
                    s[tl] = __builtin_amdgcn_mfma_f32_16x16x32_bf16(kf, qf[ks], s[tl], 0, 0, 0); }
            }
            float svv[8]; float mx = -1e30f;
#pragma unroll
            for (int tl = 0; tl < 2; ++tl)
#pragma unroll
                for (int rg = 0; rg < 4; ++rg) {
                    float v = s[tl][rg] * scale;
                    if (lat) { const int kc = kb + 16 * tl + 4 * fq + rg; const bool ok = (kc >= cs) && (kc < cs + 16);
                        const int ro = kr - r + 7, co = kc - c + 15;
                        const float bias = ok ? rpb[(h * 15 + ro) * 31 + co] : 0.f;
                        v = ok ? v + bias : -1e30f; }
                    svv[tl * 4 + rg] = v; mx = fmaxf(mx, v);
                }
            mx = fmaxf(mx, __shfl_xor(mx, 16)); mx = fmaxf(mx, __shfl_xor(mx, 32));
            const float mnew = fmaxf(mrun, mx);
            const float alpha = __expf(mrun - mnew);
            float ps = 0.f; float pv[8];
#pragma unroll
            for (int i = 0; i < 8; ++i) { pv[i] = (svv[i] > -1e29f) ? __expf(svv[i] - mnew) : 0.f; ps += pv[i]; }
            ps += __shfl_xor(ps, 16); ps += __shfl_xor(ps, 32);
            lrun = lrun * alpha + ps; mrun = mnew;
            bf16x8 pf;
            { const u32x4 w = (u32x4){pk_bf16(pv[0], pv[1]), pk_bf16(pv[2], pv[3]), pk_bf16(pv[4], pv[5]), pk_bf16(pv[6], pv[7])}; pf = __builtin_bit_cast(bf16x8, w); }
#pragma unroll
            for (int dt = 0; dt < 8; ++dt) {
                oacc[dt] *= alpha;
                LAS unsigned char* vp = Vh + (dt * 16 + fr) * 144 + (kb + 4 * fq) * 2;
                const u32x2 va = *(const LAS u32x2*)(vp), vb = *(const LAS u32x2*)(vp + 32);
                const u32x4 vw = (u32x4){va.x, va.y, vb.x, vb.y};
                oacc[dt] = __builtin_amdgcn_mfma_f32_16x16x32_bf16(__builtin_bit_cast(bf16x8, vw), pf, oacc[dt], 0, 0, 0);
            }
        }
        __syncthreads();
        if (step + 1 < nsteps) NA_STORE();
        __syncthreads();
    }
#undef NA_LOAD
#undef NA_STORE
    const float inv = 1.0f / lrun;
#pragma unroll
    for (int dt = 0; dt < 8; ++dt) {
        const f32x4 o = oacc[dt] * inv;
        *(u32x2*)(A2 + (size_t)qrow * 2048 + 1024 + h * 128 + dt * 16 + 4 * fq) = (u32x2){pk_bf16(o[0], o[1]), pk_bf16(o[2], o[3])};
    }
}

__device__ __forceinline__ void phase3(const Params& p, LAS unsigned char* lds, int which = 7) {
    const int tid = otid(), w = tid >> 6;
    {
        LAS f32x2* T1 = (LAS f32x2*)(lds + HY_TW); float sn, cs;
        sincospif((float)tid * (1.0f / 8192.0f), &sn, &cs); T1[tid] = (f32x2){cs, -sn};
        if (tid < 17) { sincospif((float)tid * (1.0f / 16.0f), &sn, &cs); T1[512 + tid] = (f32x2){cs, -sn}; }
        __syncthreads();
    }
    if (which & 1) for (int c = blockIdx.x; c < 1024; c += gridDim.x) hyena_channel(p, (LAS f32x2*)lds, c);
    __syncthreads();
    if (which & 2) for (int c = blockIdx.x * 8 + w; c < 1024; c += gridDim.x * 8) hyena_ctx_channel(p, (LAS float*)lds + w * 768, c);
    __syncthreads();
    if (which & 4) for (int t = blockIdx.x; t < 1024 + 16; t += gridDim.x) na_block_task(p, lds, t);
}

__device__ __forceinline__ void phase4(const Params& p, LAS unsigned char* lds) {
    LAS unsigned short* tile = (LAS unsigned short*)lds;
    const bf16_t* hyT = (const bf16_t*)(p.ws + OFF_HYT);
    bf16_t* A2 = (bf16_t*)(p.ws + OFF_A);
    const int tid = otid();
    for (int task = blockIdx.x; task < 16 * 260; task += gridDim.x) {
        const int ct = task & 15, rt = task >> 4;
#pragma unroll
        for (int it = 0; it < 4; ++it) { const int i = tid + it * 512, cc = i >> 5, rp = i & 31;
            const unsigned v = *(const unsigned*)(hyT + (size_t)(ct * 64 + cc) * MT + rt * 64 + 2 * rp);
            tile[cc * 66 + 2 * rp] = (unsigned short)(v & 0xFFFFu); tile[cc * 66 + 2 * rp + 1] = (unsigned short)(v >> 16); }
        __syncthreads();
#pragma unroll
        for (int it = 0; it < 4; ++it) { const int i = tid + it * 512, rr = i >> 5, cp = i & 31;
            const unsigned lo = tile[(2 * cp) * 66 + rr], hi = tile[(2 * cp + 1) * 66 + rr];
            *(unsigned*)(A2 + (size_t)(rt * 64 + rr) * 2048 + ct * 64 + 2 * cp) = (lo | (hi << 16)); }
        __syncthreads();
    }
}
__device__ __forceinline__ void ld8(const float* __restrict__ p, float (&o)[8]) { const f32x4 a = *(const f32x4*)p, b = *(const f32x4*)(p + 4);
    o[0] = a[0]; o[1] = a[1]; o[2] = a[2]; o[3] = a[3]; o[4] = b[0]; o[5] = b[1]; o[6] = b[2]; o[7] = b[3]; }
__device__ __forceinline__ void st8(float* __restrict__ p, const float (&o)[8]) { *(f32x4*)p = (f32x4){o[0], o[1], o[2], o[3]}; *(f32x4*)(p + 4) = (f32x4){o[4], o[5], o[6], o[7]}; }
__device__ __forceinline__ void st8bf(bf16_t* __restrict__ p, const float (&o)[8]) { *(u32x4*)p = (u32x4){pk_bf16(o[0], o[1]), pk_bf16(o[2], o[3]), pk_bf16(o[4], o[5]), pk_bf16(o[6], o[7])}; }

__device__ __forceinline__ void ld8bf(const bf16_t* __restrict__ p, float (&o)[8]) { const u32x4 w = *(const u32x4*)p; o[0] = bflo(w.x); o[1] = bfhi(w.x); o[2] = bflo(w.y); o[3] = bfhi(w.y); o[4] = bflo(w.z); o[5] = bfhi(w.z); o[6] = bflo(w.w); o[7] = bfhi(w.w); }
__device__ __forceinline__ void ln_row(float (&v)[4][8], const float* __restrict__ lw, const float* __restrict__ lb, int lane) {
    float s = 0.f;
#pragma unroll
    for (int pc = 0; pc < 4; ++pc)
#pragma unroll
        for (int j = 0; j < 8; ++j) s += v[pc][j];
    const float mu = wave_sum(s) * (1.0f / 2048.0f);
    float q = 0.f;
#pragma unroll
    for (int pc = 0; pc < 4; ++pc)
#pragma unroll
        for (int j = 0; j < 8; ++j) { const float d = v[pc][j] - mu; q += d * d; }
    const float rs = rsqrtf(wave_sum(q) * (1.0f / 2048.0f) + LN_EPS);
#pragma unroll
    for (int pc = 0; pc < 4; ++pc) { float w[8], b[8]; ld8(lw + pc * 512 + lane * 8, w); ld8(lb + pc * 512 + lane * 8, b);
#pragma unroll
        for (int j = 0; j < 8; ++j) v[pc][j] = (v[pc][j] - mu) * rs * w[j] + b[j]; }
}

template <bool SLAB>
__device__ __forceinline__ void ln1_load(const Params& p, int layer, int r, int lane, const float* __restrict__ slab, float (&v)[4][8]) {
    const bf16_t* y = (const bf16_t*)(p.ws + OFF_BIG2); const bf16_t* H = (const bf16_t*)(p.ws + OFF_H);
    const float* hp = r < TL ? p.in[I_X] + (size_t)r * DM : p.in[I_CTX] + (size_t)(r - TL) * DM;
    const float* md = (const float*)(p.ws + OFF_MOD) + (size_t)layer * 2 * 12288 + (r < TL ? 0 : 12288);
#pragma unroll
    for (int pc = 0; pc < 4; ++pc) { const int e = pc * 512 + lane * 8; float hv[8], yv[8], gv[8];
        if (layer == 0) ld8(hp + e, hv); else ld8bf(H + (size_t)r * DM + e, hv);
        if (SLAB) {
#pragma unroll
            for (int j = 0; j < 8; ++j) yv[j] = 0.f;
#pragma unroll 1
            for (int sl = 0; sl < 8; ++sl) { float t8[8]; ld8(slab + ((size_t)(sl * 8 + (e >> 8)) << 16) + (size_t)(r - TL) * 256 + (e & 255), t8);
#pragma unroll
                for (int j = 0; j < 8; ++j) yv[j] += t8[j]; }
        } else ld8bf(y + (size_t)r * DM + e, yv);
        ld8(md + 2 * 2048 + e, gv);
#pragma unroll
        for (int j = 0; j < 8; ++j) v[pc][j] = DN_ALPHA * hv[j] + gv[j] * yv[j]; }
}
__device__ __forceinline__ void ln1_finish(const Params& p, int layer, int r, int lane, float (&v)[4][8]) {
    bf16_t* H = (bf16_t*)(p.ws + OFF_H); bf16_t* A = (bf16_t*)(p.ws + OFF_A);
    const float* lw = p.in[I_LNW] + (size_t)(layer * 2 + 0) * DM; const float* lb = p.in[I_LNB] + (size_t)(layer * 2 + 0) * DM;
    const float* md = (const float*)(p.ws + OFF_MOD) + (size_t)layer * 2 * 12288 + (r < TL ? 0 : 12288);
    ln_row(v, lw, lb, lane);
#pragma unroll
    for (int pc = 0; pc < 4; ++pc) { const int e = pc * 512 + lane * 8; st8bf(H + (size_t)r * DM + e, v[pc]);
        float sc[8], sh[8], o[8]; ld8(md + 4 * 2048 + e, sc); ld8(md + 3 * 2048 + e, sh);
#pragma unroll
        for (int j = 0; j < 8; ++j) o[j] = v[pc][j] * (1.f + sc[j]) + sh[j];
        st8bf(A + (size_t)r * DM + e, o); }
}
__device__ __forceinline__ void phase_ln1(const Params& p, int layer, int nrows, const float* __restrict__ slab) {
    const int tid = otid(), w = tid >> 6, lane = tid & 63;
    const int stride = gridDim.x * 8;
    const int nmain = slab != nullptr ? TL : nrows;
    for (int r = blockIdx.x * 8 + w; r < nmain; r += 2 * stride) {
        const int r2 = r + stride; const bool has2 = r2 < nmain;
        float v[4][8], v2[4][8];
        ln1_load<false>(p, layer, r, lane, slab, v);
        if (has2) ln1_load<false>(p, layer, r2, lane, slab, v2);
        ln1_finish(p, layer, r, lane, v);
        if (has2) ln1_finish(p, layer, r2, lane, v2);
    }
    if (slab != nullptr) {
#pragma unroll 1
        for (int r = TL + blockIdx.x * 8 + w; r < nrows; r += stride) { float v[4][8]; ln1_load<true>(p, layer, r, lane, slab, v); ln1_finish(p, layer, r, lane, v); }
    }
}

__device__ __forceinline__ unsigned fkey(float f) { const unsigned u = __float_as_uint(f); return (u & 0x80000000u) ? ~u : (u | 0x80000000u); }
__device__ __forceinline__ float kval(unsigned k) { const unsigned u = (k & 0x80000000u) ? (k & 0x7FFFFFFFu) : ~k; return __uint_as_float(u); }
__device__ __forceinline__ void kins(unsigned (&L)[16], unsigned x) {
#pragma unroll
    for (int i = 0; i < 16; ++i) { const unsigned hi = L[i] > x ? L[i] : x; x = L[i] > x ? x : L[i]; L[i] = hi; }
}
__device__ __forceinline__ unsigned wave_umax(unsigned v) {
#pragma unroll
    for (int o = 32; o > 0; o >>= 1) { const unsigned t = (unsigned)__shfl_xor((int)v, o); v = v > t ? v : t; }
    return v;
}
__device__ __forceinline__ void topk_ctx_wave(const Params& p, const float* __restrict__ slab) {
    const int tid = otid(), wv = tid >> 6, lane = tid & 63;
    int* EI = (int*)(p.ws + OFF_EXP); float* EG = (float*)(p.ws + OFF_EXP + (size_t)MT * 128 * 4);
    for (int item = blockIdx.x * 8 + wv; item < TCX * 8; item += gridDim.x * 8) {
        const int h = item & 7, rl = item >> 3, r = TL + rl;
        float s1a = 0.f, s1b = 0.f, s2a = 0.f, s2b = 0.f;
#pragma unroll
        for (int sl = 0; sl < 8; ++sl) { const float* sb = slab + ((size_t)(sl * 8 + h) << 16) + rl;
            s1a += sb[(size_t)lane * 256]; s1b += sb[(size_t)(lane + 64) * 256]; s2a += sb[(size_t)(128 + lane) * 256]; s2b += sb[(size_t)(192 + lane) * 256]; }
        unsigned k1a = (fkey(s1a) & ~0x7Fu) | (unsigned)(127 - lane), k1b = (fkey(s1b) & ~0x7Fu) | (unsigned)(63 - lane);
        unsigned k2a = (fkey(s2a) & ~0x7Fu) | (unsigned)(127 - lane), k2b = (fkey(s2b) & ~0x7Fu) | (unsigned)(63 - lane);
        unsigned vec1 = 0u, vec2 = 0u;
#pragma unroll
        for (int i = 0; i < 16; ++i) {
            const unsigned w1 = wave_umax(k1a > k1b ? k1a : k1b); if (k1a == w1) k1a = 0u; if (k1b == w1) k1b = 0u; vec1 = lane == i ? w1 : vec1;
            const unsigned w2 = wave_umax(k2a > k2b ? k2a : k2b); if (k2a == w2) k2a = 0u; if (k2b == w2) k2b = 0u; vec2 = lane == i ? w2 : vec2;
        }
        const float v1 = kval((unsigned)__shfl((int)vec1, lane >> 2) & ~0x7Fu);
        unsigned ck[4];
#pragma unroll
        for (int t = 0; t < 4; ++t) { const int i = lane >> 2, j = 4 * (lane & 3) + t; const float v2 = kval((unsigned)__shfl((int)vec2, j) & ~0x7Fu);
            ck[t] = ((i + 1) * (j + 1) <= 16) ? ((fkey(v1 + v2) & ~0xFFu) | (unsigned)(255 - (i * 16 + j))) : 0u; }
        unsigned vec3 = 0u;
#pragma unroll
        for (int s3 = 0; s3 < 16; ++s3) { unsigned m = ck[0] > ck[1] ? ck[0] : ck[1]; const unsigned m2 = ck[2] > ck[3] ? ck[2] : ck[3]; m = m > m2 ? m : m2;
            const unsigned w3 = wave_umax(m);
#pragma unroll
            for (int t = 0; t < 4; ++t) if (ck[t] == w3) ck[t] = 0u;
            vec3 = lane == s3 ? w3 : vec3; }
        const float top = kval((unsigned)__shfl((int)vec3, 0) & ~0xFFu);
        const float ev = lane < 16 ? __expf(kval(vec3 & ~0xFFu) - top) : 0.f;
        const float sum = wave_sum(ev);
        const unsigned id = 255u - (vec3 & 0xFFu); const int ii = (int)(id >> 4), jj = (int)(id & 15u);
        const unsigned kk1 = (unsigned)__shfl((int)vec1, ii), kk2 = (unsigned)__shfl((int)vec2, jj);
        if (lane < 16) { const int n1 = 127 - (int)(kk1 & 0x7Fu), n2 = 127 - (int)(kk2 & 0x7Fu);
            EI[(size_t)r * 128 + h * 16 + lane] = n1 * 128 + n2; EG[(size_t)r * 128 + h * 16 + lane] = ev / sum; }
    }
}

__device__ __forceinline__ void phase_topk(const Params& p, LAS unsigned char* lds, int nrows, const float* __restrict__ slab) {
    LAS unsigned short* nsel = (LAS unsigned short*)lds;
    const float* ST = (const float*)(p.ws + OFF_BIG1);
    int* EI = (int*)(p.ws + OFF_EXP); float* EG = (float*)(p.ws + OFF_EXP + (size_t)MT * 128 * 4);
    const int tid = otid();
    const int nch = slab != nullptr ? TL / 512 : (nrows + 511) / 512;
    for (int task = blockIdx.x; task < nch * 8; task += gridDim.x) {
        const int h = task & 7, r = (task >> 3) * 512 + tid;
        const bool act = r < nrows; const int rr = act ? r : nrows - 1;
        unsigned L1[16], L2[16], L3[16];
#pragma unroll
        for (int i = 0; i < 16; ++i) { L1[i] = 0u; L2[i] = 0u; L3[i] = 0u; }
        const float* s1 = ST + (size_t)(h * 256) * MT + rr; const float* s2 = s1 + (size_t)128 * MT;
#pragma unroll 1
        for (int n0 = 0; n0 < 128; n0 += 16) {
            float a[16], b[16];
#pragma unroll
            for (int j = 0; j < 16; ++j) { a[j] = s1[(size_t)(n0 + j) * MT]; b[j] = s2[(size_t)(n0 + j) * MT]; }
#pragma unroll
            for (int j = 0; j < 16; ++j) { kins(L1, (fkey(a[j]) & ~0x7Fu) | (unsigned)(127 - n0 - j)); kins(L2, (fkey(b[j]) & ~0x7Fu) | (unsigned)(127 - n0 - j)); }
        }
        float v1[16], v2[16];
#pragma unroll
        for (int i = 0; i < 16; ++i) { v1[i] = kval(L1[i] & ~0x7Fu); v2[i] = kval(L2[i] & ~0x7Fu);
            nsel[i * 512 + tid] = (unsigned short)(127u - (L1[i] & 0x7Fu)); nsel[(16 + i) * 512 + tid] = (unsigned short)(127u - (L2[i] & 0x7Fu)); }
#pragma unroll
        for (int i = 0; i < 16; ++i)
#pragma unroll
            for (int j = 0; j < 16; ++j)
                if ((i + 1) * (j + 1) <= 16) { const unsigned kc = (fkey(v1[i] + v2[j]) & ~0xFFu) | (unsigned)(255 - (i * 16 + j)); kins(L3, kc); }
        const float m = kval(L3[0] & ~0xFFu);
        float e[16], sum = 0.f;
#pragma unroll
        for (int s = 0; s < 16; ++s) { e[s] = __expf(kval(L3[s] & ~0xFFu) - m); sum += e[s]; }
        const float inv = 1.0f / sum;
        if (act) {
#pragma unroll
            for (int s = 0; s < 16; ++s) { const unsigned id = 255u - (L3[s] & 0xFFu); const unsigned i = id >> 4, j = id & 15u;
                const int n1 = nsel[i * 512 + tid], n2 = nsel[(16 + j) * 512 + tid];
                EI[(size_t)r * 128 + h * 16 + s] = n1 * 128 + n2; EG[(size_t)r * 128 + h * 16 + s] = e[s] * inv; }
        }
    }
    if (slab != nullptr) topk_ctx_wave(p, slab);
}

__device__ __forceinline__ float dpp_sum63(float v) {
    v += __builtin_bit_cast(float, __builtin_amdgcn_update_dpp(0, __builtin_bit_cast(int, v), 0x111, 0xf, 0xf, false));
    v += __builtin_bit_cast(float, __builtin_amdgcn_update_dpp(0, __builtin_bit_cast(int, v), 0x112, 0xf, 0xf, false));
    v += __builtin_bit_cast(float, __builtin_amdgcn_update_dpp(0, __builtin_bit_cast(int, v), 0x114, 0xf, 0xf, false));
    v += __builtin_bit_cast(float, __builtin_amdgcn_update_dpp(0, __builtin_bit_cast(int, v), 0x118, 0xf, 0xf, false));
    v += __builtin_bit_cast(float, __builtin_amdgcn_update_dpp(0, __builtin_bit_cast(int, v), 0x142, 0xa, 0xf, false));
    v += __builtin_bit_cast(float, __builtin_amdgcn_update_dpp(0, __builtin_bit_cast(int, v), 0x143, 0xc, 0xf, false));
    return v;
}
__device__ __forceinline__ float readlane_f(float v, int l) { return __builtin_bit_cast(float, __builtin_amdgcn_readlane(__builtin_bit_cast(int, v), l)); }
__device__ __forceinline__ float dot8(const u32x4 a, const u32x4 b, float acc) {
    const unsigned a0 = a.x, a1 = a.y, a2 = a.z, a3 = a.w, b0 = b.x, b1 = b.y, b2 = b.z, b3 = b.w;
    acc = __builtin_amdgcn_fdot2_f32_bf16(__builtin_bit_cast(bf2_t, a0), __builtin_bit_cast(bf2_t, b0), acc, false);
    acc = __builtin_amdgcn_fdot2_f32_bf16(__builtin_bit_cast(bf2_t, a1), __builtin_bit_cast(bf2_t, b1), acc, false);
    acc = __builtin_amdgcn_fdot2_f32_bf16(__builtin_bit_cast(bf2_t, a2), __builtin_bit_cast(bf2_t, b2), acc, false);
    acc = __builtin_amdgcn_fdot2_f32_bf16(__builtin_bit_cast(bf2_t, a3), __builtin_bit_cast(bf2_t, b3), acc, false);
    return acc;
}
__device__ __forceinline__ void axpy8(float (&o)[8], const u32x4 v, float c) {
    o[0] = fmaf(c, bflo(v.x), o[0]); o[1] = fmaf(c, bfhi(v.x), o[1]); o[2] = fmaf(c, bflo(v.y), o[2]); o[3] = fmaf(c, bfhi(v.y), o[3]);
    o[4] = fmaf(c, bflo(v.z), o[4]); o[5] = fmaf(c, bfhi(v.z), o[5]); o[6] = fmaf(c, bflo(v.w), o[6]); o[7] = fmaf(c, bfhi(v.w), o[7]);
}
__device__ __forceinline__ void cvt16(const u32x4 w, float (&o)[16]) {
    const int w0 = (int)w.x, w1 = (int)w.y, w2 = (int)w.z, w3 = (int)w.w;
    f32x2 t;
    t = __builtin_amdgcn_cvt_pk_f32_fp8(w0, false); o[0] = t.x; o[1] = t.y;   t = __builtin_amdgcn_cvt_pk_f32_fp8(w0, true); o[2] = t.x; o[3] = t.y;
    t = __builtin_amdgcn_cvt_pk_f32_fp8(w1, false); o[4] = t.x; o[5] = t.y;   t = __builtin_amdgcn_cvt_pk_f32_fp8(w1, true); o[6] = t.x; o[7] = t.y;
    t = __builtin_amdgcn_cvt_pk_f32_fp8(w2, false); o[8] = t.x; o[9] = t.y;   t = __builtin_amdgcn_cvt_pk_f32_fp8(w2, true); o[10] = t.x; o[11] = t.y;
    t = __builtin_amdgcn_cvt_pk_f32_fp8(w3, false); o[12] = t.x; o[13] = t.y; t = __builtin_amdgcn_cvt_pk_f32_fp8(w3, true); o[14] = t.x; o[15] = t.y;
}
__device__ __forceinline__ void ld16(const float* __restrict__ p, float (&o)[16]) {
#pragma unroll
    for (int q = 0; q < 4; ++q) { const f32x4 a = *(const f32x4*)(p + 4 * q); o[4 * q] = a[0]; o[4 * q + 1] = a[1]; o[4 * q + 2] = a[2]; o[4 * q + 3] = a[3]; }
}
__device__ __forceinline__ void peer_finish(const Params& p, int layer, int r, int lane, float (&f)[2][16]) {
    bf16_t* H = (bf16_t*)(p.ws + OFF_H); bf16_t* A = (bf16_t*)(p.ws + OFF_A);
    const float* lw = p.in[I_LNW] + (size_t)(layer * 2 + 1) * DM; const float* lb = p.in[I_LNB] + (size_t)(layer * 2 + 1) * DM;
    const float* md = (const float*)(p.ws + OFF_MOD) + (size_t)layer * 2 * 12288 + (r < TL ? 0 : 12288);
    float s = 0.f;
#pragma unroll
    for (int pc = 0; pc < 2; ++pc) { const int e = pc * 1024 + lane * 16; float hv[16], gv[16]; { float t0[8], t1[8]; ld8bf(H + (size_t)r * DM + e, t0); ld8bf(H + (size_t)r * DM + e + 8, t1);
#pragma unroll
            for (int j = 0; j < 8; ++j) { hv[j] = t0[j]; hv[8 + j] = t1[j]; } } ld16(md + 5 * 2048 + e, gv);
#pragma unroll
        for (int j = 0; j < 16; ++j) { f[pc][j] = DN_ALPHA * hv[j] + gv[j] * f[pc][j]; s += f[pc][j]; } }
    const float mu = wave_sum(s) * (1.0f / 2048.0f);
    float qv = 0.f;
#pragma unroll
    for (int pc = 0; pc < 2; ++pc)
#pragma unroll
        for (int j = 0; j < 16; ++j) { const float d = f[pc][j] - mu; qv += d * d; }
    const float rs = rsqrtf(wave_sum(qv) * (1.0f / 2048.0f) + LN_EPS);
    const float* md1 = (const float*)(p.ws + OFF_MOD) + (size_t)2 * 12288 + (r < TL ? 0 : 12288);
#pragma unroll
    for (int pc = 0; pc < 2; ++pc) { const int e = pc * 1024 + lane * 16; float wv[16], bv[16]; ld16(lw + e, wv); ld16(lb + e, bv);
        float o[16];
#pragma unroll
        for (int j = 0; j < 16; ++j) o[j] = (f[pc][j] - mu) * rs * wv[j] + bv[j];
        if (layer == 0) {
            *(u32x4*)(H + (size_t)r * DM + e) = (u32x4){pk_bf16(o[0], o[1]), pk_bf16(o[2], o[3]), pk_bf16(o[4], o[5]), pk_bf16(o[6], o[7])};
            *(u32x4*)(H + (size_t)r * DM + e + 8) = (u32x4){pk_bf16(o[8], o[9]), pk_bf16(o[10], o[11]), pk_bf16(o[12], o[13]), pk_bf16(o[14], o[15])};
            float sc[16], sh[16]; ld16(md1 + 2048 + e, sc); ld16(md1 + e, sh);
#pragma unroll
            for (int j = 0; j < 16; ++j) o[j] = o[j] * (1.f + sc[j]) + sh[j];
#if F8_L1
            unsigned char* ap = p.ws + OFF_X + (size_t)r * DM + e;
            *(u32x4*)ap = (u32x4){fp8x4(clamp8(o[0] * G8_XS), clamp8(o[1] * G8_XS), clamp8(o[2] * G8_XS), clamp8(o[3] * G8_XS)), fp8x4(clamp8(o[4] * G8_XS), clamp8(o[5] * G8_XS), clamp8(o[6] * G8_XS), clamp8(o[7] * G8_XS)),
                                  fp8x4(clamp8(o[8] * G8_XS), clamp8(o[9] * G8_XS), clamp8(o[10] * G8_XS), clamp8(o[11] * G8_XS)), fp8x4(clamp8(o[12] * G8_XS), clamp8(o[13] * G8_XS), clamp8(o[14] * G8_XS), clamp8(o[15] * G8_XS))};
#else
            bf16_t* ap = A + (size_t)r * DM + e;
            *(u32x4*)ap = (u32x4){pk_bf16(o[0], o[1]), pk_bf16(o[2], o[3]), pk_bf16(o[4], o[5]), pk_bf16(o[6], o[7])};
            *(u32x4*)(ap + 8) = (u32x4){pk_bf16(o[8], o[9]), pk_bf16(o[10], o[11]), pk_bf16(o[12], o[13]), pk_bf16(o[14], o[15])};
#endif
        } else {
#pragma unroll
            for (int q = 0; q < 4; ++q) *(f32x4*)(p.out + (size_t)r * DM + e + 4 * q) = (f32x4){o[4 * q], o[4 * q + 1], o[4 * q + 2], o[4 * q + 3]};
        }
    }
}
typedef long i64_t;
constexpr float PEER_XS = 16.0f;
__device__ __forceinline__ i64_t mk64(unsigned lo, unsigned hi) { return (i64_t)(((unsigned long long)hi << 32) | (unsigned long long)lo); }
__device__ __forceinline__ void peer_load_x8(const bf16_t* __restrict__ A, int r, int lane, u32x4 (&xh)[2], u32x4 (&xl)[2]) {
#pragma unroll
    for (int pc = 0; pc < 2; ++pc) { const bf16_t* ap = A + (size_t)r * DM + pc * 1024 + lane * 16;
        const u32x4 a = *(const u32x4*)ap, b = *(const u32x4*)(ap + 8);
        const unsigned w[8] = {a.x, a.y, a.z, a.w, b.x, b.y, b.z, b.w};
        unsigned h[4], l[4];
#pragma unroll
        for (int q = 0; q < 4; ++q) { const float v0 = bflo(w[2 * q]) * PEER_XS, v1 = bfhi(w[2 * q]) * PEER_XS, v2 = bflo(w[2 * q + 1]) * PEER_XS, v3 = bfhi(w[2 * q + 1]) * PEER_XS;
            h[q] = fp8x4(__builtin_amdgcn_fmed3f(v0, -448.f, 448.f), __builtin_amdgcn_fmed3f(v1, -448.f, 448.f), __builtin_amdgcn_fmed3f(v2, -448.f, 448.f), __builtin_amdgcn_fmed3f(v3, -448.f, 448.f));
            const f32x2 d0 = __builtin_amdgcn_cvt_pk_f32_fp8((int)h[q], false), d1 = __builtin_amdgcn_cvt_pk_f32_fp8((int)h[q], true);
            l[q] = fp8x4(__builtin_amdgcn_fmed3f(v0 - d0.x, -448.f, 448.f), __builtin_amdgcn_fmed3f(v1 - d0.y, -448.f, 448.f), __builtin_amdgcn_fmed3f(v2 - d1.x, -448.f, 448.f), __builtin_amdgcn_fmed3f(v3 - d1.y, -448.f, 448.f)); }
        xh[pc] = (u32x4){h[0], h[1], h[2], h[3]}; xl[pc] = (u32x4){l[0], l[1], l[2], l[3]}; }
}
template <int nb4, int NLO>
__device__ __forceinline__ void peer_acc3(const unsigned char* __restrict__ U, const unsigned char* __restrict__ V, int lane, int myid, float myg, const u32x4 (&xh)[2], const u32x4 (&xl)[2], float (&f)[2][16]) {
    float actv = 0.f;
    const bool dg = (((lane & 15) >> 2) == (lane >> 4));
    const float w0 = (dg && (lane & 3) == 0) ? 1.f : 0.f, w1 = (dg && (lane & 3) == 1) ? 1.f : 0.f, w2 = (dg && (lane & 3) == 2) ? 1.f : 0.f, w3 = (dg && (lane & 3) == 3) ? 1.f : 0.f;
    const i32x8 bh = {(int)xh[0].x, (int)xh[0].y, (int)xh[0].z, (int)xh[0].w, (int)xh[1].x, (int)xh[1].y, (int)xh[1].z, (int)xh[1].w};
    const i32x8 bl = {(int)xl[0].x, (int)xl[0].y, (int)xl[0].z, (int)xl[0].w, (int)xl[1].x, (int)xl[1].y, (int)xl[1].z, (int)xl[1].w};
    int sc = 0x7F7F7F7F; asm volatile("" : "+v"(sc));
#pragma unroll 1
    for (int e4 = 0; e4 < nb4; ++e4) {
        u32x4 raw[4][2];
#pragma unroll
        for (int q = 0; q < 4; ++q) { const int eid = __builtin_amdgcn_readlane(myid, e4 * 4 + q);
            const unsigned char* row = U + (size_t)eid * DM + lane * 16;
            raw[q][0] = *(const u32x4*)row; raw[q][1] = *(const u32x4*)(row + 1024); }
#pragma unroll
        for (int q = 0; q < 4; ++q) { f32x4 acc = (f32x4){0.f, 0.f, 0.f, 0.f};
            const i32x8 a = {(int)raw[q][0].x, (int)raw[q][0].y, (int)raw[q][0].z, (int)raw[q][0].w, (int)raw[q][1].x, (int)raw[q][1].y, (int)raw[q][1].z, (int)raw[q][1].w};
            acc = __builtin_amdgcn_mfma_scale_f32_16x16x128_f8f6f4(a, bh, acc, 0, 0, 0, sc, 0, sc);
            if (NLO) acc = __builtin_amdgcn_mfma_scale_f32_16x16x128_f8f6f4(a, bl, acc, 0, 0, 0, sc, 0, sc);
            const float dv = fmaf(acc[0], w0, fmaf(acc[1], w1, fmaf(acc[2], w2, acc[3] * w3)));
            const float tot = readlane_f(dpp_sum63(dv), 63); actv = (lane == e4 * 4 + q) ? tot : actv; }
    }
    actv *= (1.0f / (PEER_XS * PEER_USCALE));
    const float coef = myg * (0.5f / PEER_VSCALE) * actv * (1.0f + erff(actv * 0.70710678118654752f));
#pragma unroll 1
    for (int e4 = 0; e4 < nb4; ++e4) {
        u32x4 raw[4][2]; float cf[4];
#pragma unroll
        for (int q = 0; q < 4; ++q) { const int eid = __builtin_amdgcn_readlane(myid, e4 * 4 + q); cf[q] = readlane_f(coef, e4 * 4 + q);
            const unsigned char* row = V + (size_t)eid * DM + lane * 16;
            raw[q][0] = *(const u32x4*)row; raw[q][1] = *(const u32x4*)(row + 1024); }
#pragma unroll
        for (int q = 0; q < 4; ++q)
#pragma unroll
            for (int pc = 0; pc < 2; ++pc) { float vv[16]; cvt16(raw[q][pc], vv);
#pragma unroll
                for (int j = 0; j < 16; ++j) f[pc][j] = fmaf(cf[q], vv[j], f[pc][j]); }
    }
}
__device__ __forceinline__ void phase_peer(const Params& p, LAS unsigned char* lds, int layer, int nrows) {
    const int tid = otid(), w = tid >> 6, lane = tid & 63;
    const unsigned char* U = p.ws + OFF_PEER + (size_t)(layer * 2) * PEER_TBL; const unsigned char* V = U + PEER_TBL;
    const int* EI = (const int*)(p.ws + OFF_EXP); const float* EG = (const float*)(p.ws + OFF_EXP + (size_t)MT * 128 * 4);
    const bf16_t* A = (const bf16_t*)(p.ws + OFF_A);
    const int xg = blockIdx.x & 7, cnt8 = (((int)gridDim.x - xg + 7) >> 3) * 8;
    for (int rl = (blockIdx.x >> 3) * 8 + w; rl < TL / 8; rl += cnt8) {
        const int r = xg * (TL / 8) + rl;
        u32x4 xh[2], xl[2]; peer_load_x8(A, r, lane, xh, xl);
        float f[2][16];
#pragma unroll
        for (int pc = 0; pc < 2; ++pc)
#pragma unroll
            for (int j = 0; j < 16; ++j) f[pc][j] = 0.f;
#pragma unroll
        for (int hf = 0; hf < 2; ++hf) peer_acc3<16, 1>(U, V, lane, EI[(size_t)r * 128 + hf * 64 + lane], EG[(size_t)r * 128 + hf * 64 + lane], xh, xl, f);
        peer_finish(p, layer, r, lane, f);
    }
    if (nrows > TL) {
        LAS float* fb = (LAS float*)lds;
        for (int rc = blockIdx.x; rc < nrows - TL; rc += gridDim.x) {
            const int r = TL + rc;
            u32x4 xh[2], xl[2]; peer_load_x8(A, r, lane, xh, xl);
            float f[2][16];
#pragma unroll
            for (int pc = 0; pc < 2; ++pc)
#pragma unroll
                for (int j = 0; j < 16; ++j) f[pc][j] = 0.f;
            const int li = lane & 15;
            peer_acc3<4, 1>(U, V, lane, EI[(size_t)r * 128 + w * 16 + li], EG[(size_t)r * 128 + w * 16 + li], xh, xl, f);
            __syncthreads();
#pragma unroll
            for (int pc = 0; pc < 2; ++pc)
#pragma unroll
                for (int q = 0; q < 4; ++q) *(LAS f32x4*)(fb + w * 2048 + pc * 1024 + lane * 16 + 4 * q) = (f32x4){f[pc][4 * q], f[pc][4 * q + 1], f[pc][4 * q + 2], f[pc][4 * q + 3]};
            __syncthreads();
            if (w == 0) {
#pragma unroll
                for (int pc = 0; pc < 2; ++pc)
#pragma unroll
                    for (int j = 0; j < 16; ++j) f[pc][j] = 0.f;
#pragma unroll 1
                for (int ww = 0; ww < 8; ++ww)
#pragma unroll
                    for (int pc = 0; pc < 2; ++pc)
#pragma unroll
                        for (int q = 0; q < 4; ++q) { const f32x4 t = *(const LAS f32x4*)(fb + ww * 2048 + pc * 1024 + lane * 16 + 4 * q);
                            f[pc][4 * q] += t[0]; f[pc][4 * q + 1] += t[1]; f[pc][4 * q + 2] += t[2]; f[pc][4 * q + 3] += t[3]; }
                peer_finish(p, layer, r, lane, f);
            }
        }
        __syncthreads();
    }
}

constexpr size_t L1_OFF_OB = OFF_BIG2 + (size_t)2048 * MT * 2;
constexpr size_t L1_OFF_QS = OFF_BIG1;
constexpr size_t L1_OFF_KS = L1_OFF_QS + (size_t)TL * 1024 * 2;
constexpr size_t L1_OFF_KT = L1_OFF_KS + (size_t)MT * 1024 * 2;
static_assert(L1_OFF_KT + (size_t)MT * 1024 * 2 <= OFF_BIG1 + BIG_BYTES, "BIG1 overflow");
static_assert(L1_OFF_OB + (size_t)MT * 2048 * 2 <= OFF_BIG2 + BIG_BYTES, "BIG2 overflow");

__device__ __forceinline__ float logsig_f(float x) { return fminf(x, 0.f) - log1pf(expf(-fabsf(x))); }
__device__ __forceinline__ int chunk_row0(int cidx) { return cidx < 256 ? cidx * 64 : TL + (cidx - 256) * 64; }
__device__ __forceinline__ int chunk_of(int sc, int dir, int i) { return sc == 0 ? (dir ? 259 - i : 256 + i) : (dir ? 255 - (sc - 1) * 16 - i : (sc - 1) * 16 + i); }

__device__ __forceinline__ void unpack8(const u32x4 w, float (&o)[8]) { o[0] = bflo(w.x); o[1] = bfhi(w.x); o[2] = bflo(w.y); o[3] = bfhi(w.y); o[4] = bflo(w.z); o[5] = bfhi(w.z); o[6] = bflo(w.w); o[7] = bfhi(w.w); }
__device__ __forceinline__ void l1_qk_task(const Params& p, LAS unsigned char* lds, int task) {
    const int tid = otid();
    int tile, isk, hq, nh, h0;
    if (task < 32) { tile = 256 + (task >> 3); isk = 1; h0 = task & 7; nh = 1; hq = h0 >> 2; } else { const int t = task - 32; tile = t >> 2; isk = (t >> 1) & 1; hq = t & 1; h0 = hq * 4; nh = 4; }
    const bool lat = tile < 256;
    const int r0 = lat ? tile * 64 : TL + (tile - 256) * 64;
    const int sq0 = lat ? 0 : TL, sq1 = lat ? TL : MT;
    const bf16_t* QKp = (const bf16_t*)(p.ws + OFF_QK);
    bf16_t* QS = (bf16_t*)(p.ws + L1_OFF_QS); bf16_t* KS = (bf16_t*)(p.ws + L1_OFF_KS); bf16_t* KT = (bf16_t*)(p.ws + L1_OFF_KT);
    const float* cw = p.in[I_MLCW]; const float* cb = p.in[I_MLCB];
    const f32x2* rope = (const f32x2*)(p.ws + OFF_ROPE);
    LAS unsigned short* tl_ = (LAS unsigned short*)lds;
    LAS float* wl = (LAS float*)(lds + 4 * 128 * 66 * 2);
    { const int c = tid, col = isk * 1024 + hq * 512 + c;
#pragma unroll
      for (int j = 0; j < 4; ++j) wl[j * 512 + c] = j < 3 ? cw[j * 2048 + col] : cb[col]; }
    __syncthreads();
    const int tl = tid >> 3, pc = tid & 7, half = pc >> 2, cc = pc & 3;
    const int d1 = half * 64 + cc * 8, d2 = d1 + 32;
    const int r = r0 + tl;
    const int pos = half == 0 ? (r >> 6) : (r & 63);
    f32x2 csn[8];
#pragma unroll
    for (int j = 0; j < 8; ++j) csn[j] = lat ? rope[pos * 32 + cc * 8 + j] : (f32x2){1.f, 0.f};
    const u32x4 z4 = (u32x4){0u, 0u, 0u, 0u};
#pragma unroll 1
    for (int hh = h0 - hq * 4; hh < h0 - hq * 4 + nh; ++hh) {
        const int h = hq * 4 + hh;
        const bf16_t* x0 = QKp + (size_t)r * 2048 + isk * 1024 + h * 128;
        const u32x4 a0 = *(const u32x4*)(x0 + d1), b0 = *(const u32x4*)(x0 + d2);
        const u32x4 am = r > sq0 ? *(const u32x4*)(x0 + d1 - 2048) : z4, bm = r > sq0 ? *(const u32x4*)(x0 + d2 - 2048) : z4;
        const u32x4 ap = r + 1 < sq1 ? *(const u32x4*)(x0 + d1 + 2048) : z4, bp = r + 1 < sq1 ? *(const u32x4*)(x0 + d2 + 2048) : z4;
        float A0[8], B0[8], AM[8], BM[8], AP[8], BP[8];
        unpack8(a0, A0); unpack8(b0, B0); unpack8(am, AM); unpack8(bm, BM); unpack8(ap, AP); unpack8(bp, BP);
        float o1[8], o2[8];
        const int w1 = hh * 128 + d1, w2 = hh * 128 + d2;
#pragma unroll
        for (int j = 0; j < 8; ++j) {
            const float y1 = silu_f(wl[1536 + w1 + j] + wl[w1 + j] * AM[j] + wl[512 + w1 + j] * A0[j] + wl[1024 + w1 + j] * AP[j]);
            const float y2 = silu_f(wl[1536 + w2 + j] + wl[w2 + j] * BM[j] + wl[512 + w2 + j] * B0[j] + wl[1024 + w2 + j] * BP[j]);
            float q1 = y1 * csn[j].x - y2 * csn[j].y, q2 = y1 * csn[j].y + y2 * csn[j].x;
            if (isk) { q1 *= 0.08838834764831845f; q2 *= 0.08838834764831845f; }
            o1[j] = q1; o2[j] = q2;
        }
        const u32x4 v1 = (u32x4){pk_bf16(o1[0], o1[1]), pk_bf16(o1[2], o1[3]), pk_bf16(o1[4], o1[5]), pk_bf16(o1[6], o1[7])};
        const u32x4 v2 = (u32x4){pk_bf16(o2[0], o2[1]), pk_bf16(o2[2], o2[3]), pk_bf16(o2[4], o2[5]), pk_bf16(o2[6], o2[7])};
        if (isk) {
            bf16_t* dst = KS + (size_t)r * 1024 + h * 128;
            *(u32x4*)(dst + d1) = v1; *(u32x4*)(dst + d2) = v2;
            LAS unsigned short* th = tl_ + hh * 128 * 66;
            const unsigned u1[4] = {v1.x, v1.y, v1.z, v1.w}, u2[4] = {v2.x, v2.y, v2.z, v2.w};
#pragma unroll
            for (int j = 0; j < 4; ++j) { th[(d1 + 2 * j) * 66 + tl] = (unsigned short)(u1[j] & 0xFFFFu); th[(d1 + 2 * j + 1) * 66 + tl] = (unsigned short)(u1[j] >> 16);
                                          th[(d2 + 2 * j) * 66 + tl] = (unsigned short)(u2[j] & 0xFFFFu); th[(d2 + 2 * j + 1) * 66 + tl] = (unsigned short)(u2[j] >> 16); }
        } else {
            bf16_t* dst = QS + (size_t)r * 1024 + h * 128;
            *(u32x4*)(dst + d1) = v1; *(u32x4*)(dst + d2) = v2;
        }
    }
    if (isk) {
        __syncthreads();
#pragma unroll 4
        for (int it = (h0 - hq * 4) * 8; it < (h0 - hq * 4 + nh) * 8; ++it) { const int i = tid + 512 * it, d = i >> 5, tp = i & 31;
            const unsigned lo = tl_[d * 66 + 2 * tp], hi = tl_[d * 66 + 2 * tp + 1];
            *(unsigned*)(KT + (size_t)(hq * 512 + d) * MT + r0 + 2 * tp) = lo | (hi << 16); }
    }
    __syncthreads();
}
__device__ __forceinline__ void l1_gate_items(const Params& p) {
    const int tid = otid(), wv = tid >> 6, lane = tid & 63;
    const float* G = (const float*)(p.ws + OFF_GATE); const float* bg = p.in[I_MLBG];
    float* GA = (float*)(p.ws + OFF_GX); float* GC = GA + GX_STRIDE; float* GW = GC + GX_STRIDE; float* DEC = GW + GX_STRIDE;
    for (int item = blockIdx.x * 8 + wv; item < 260 * 16; item += gridDim.x * 8) {
        const int cidx = item >> 4, hd = item & 15, h = hd >> 1, dir = hd & 1;
        const int r = chunk_row0(cidx) + lane;
        const int ci = (dir ? 2 : 0) * 8 + h, cf = (dir ? 3 : 1) * 8 + h;
        const float lf = logsig_f(G[(size_t)r * 32 + cf] + bg[cf]), li = G[(size_t)r * 32 + ci] + bg[ci];
        float b = lf;
        if (dir == 0) {
#pragma unroll
            for (int o = 1; o < 64; o <<= 1) { const float t = __shfl_up(b, o); if (lane >= o) b += t; }
        } else {
#pragma unroll
            for (int o = 1; o < 64; o <<= 1) { const float t = __shfl_down(b, o); if (lane + o < 64) b += t; }
        }
        const float bend = __shfl(b, dir ? 0 : 63);
        const size_t gb = (size_t)(dir * 8 + h) * MT;
        GA[gb + r] = expf(b); GC[gb + r] = expf(li - b); GW[gb + r] = expf(bend - b + li);
        if (lane == 0) DEC[(dir * 8 + h) * 260 + cidx] = expf(bend);
    }
}
__device__ __forceinline__ void phase_l1_prep(const Params& p, LAS unsigned char* lds) {
    l1_gate_items(p);
    for (int task = blockIdx.x; task < 32 + 1024; task += gridDim.x) l1_qk_task(p, lds, task);
}

__device__ __forceinline__ void phase_l1_passB(const Params& p) {
    const float* DEC = (const float*)(p.ws + OFF_GX) + 3 * GX_STRIDE;
    float* CST = (float*)(p.ws + OFF_HYT); float* NST = (float*)(p.ws + OFF_NST);
    const int NE = 16 * 32768 + 16 * 128;
    for (int g = blockIdx.x * 512 + otid(); g < NE; g += gridDim.x * 512) {
        const bool isn = g >= 16 * 32768;
        const int hd = isn ? (g - 16 * 32768) >> 7 : g >> 15, idx = isn ? (g - 16 * 32768) & 127 : g & 32767;
        const int h = hd >> 1, dir = hd & 1;
        float cin = 0.f;
        for (int sc = 0; sc < 17; ++sc) {
            float dsc = 1.f; const int nc = sc == 0 ? 4 : 16;
            for (int c = 0; c < nc; ++c) dsc *= DEC[(dir * 8 + h) * 260 + chunk_of(sc, dir, c)];
            float* ptr = isn ? NST + (size_t)(sc * 16 + hd) * 128 + idx : CST + (size_t)(sc * 16 + hd) * 32768 + idx;
            const float loc = sc < 16 ? *ptr : 0.f; *ptr = cin; cin = dsc * cin + loc;
        }
    }
}
constexpr int PC_QS = 0;
constexpr int PC_KS = 16896;
constexpr int PC_KT = 33792;
constexpr int PC_VS = 52224;
constexpr int PC_OS = 89088;
constexpr int PC_WT = 130048;
constexpr int PC_NL = 130816;
__device__ __forceinline__ bf16x8 pack8(const f32x16& v, int o) {
    u32x4 w; w.x = pk_bf16(v[o], v[o + 1]); w.y = pk_bf16(v[o + 2], v[o + 3]); w.z = pk_bf16(v[o + 4], v[o + 5]); w.w = pk_bf16(v[o + 6], v[o + 7]);
    return __builtin_bit_cast(bf16x8, w);
}
struct PcStage { u32x4 q0, q1, k0, k1, t0, t1, v0, v1, v2, v3; float wt; };
__device__ __forceinline__ bf16x8 lds_frag2(LAS unsigned char* base, int byteoff) {
    const u32x2 a = *(const LAS u32x2*)(base + byteoff), b = *(const LAS u32x2*)(base + byteoff + 16);
    const u32x4 w = (u32x4){a.x, a.y, b.x, b.y}; return __builtin_bit_cast(bf16x8, w);
}
__device__ __forceinline__ void phase_l1_passC(const Params& p, LAS unsigned char* lds) {
    const int tid = otid(), wv = __builtin_amdgcn_readfirstlane(tid >> 6), lane = tid & 63, l31 = lane & 31, hh = lane >> 5;
    const bf16_t* QS = (const bf16_t*)(p.ws + L1_OFF_QS); const bf16_t* KS = (const bf16_t*)(p.ws + L1_OFF_KS); const bf16_t* KT = (const bf16_t*)(p.ws + L1_OFF_KT);
    const bf16_t* VT = (const bf16_t*)(p.ws + OFF_BIG2);
    const unsigned so_q = (unsigned)((tid >> 3) * 1024 + (tid & 7) * 8), so_t = (unsigned)((tid >> 2) * MT + (tid & 3) * 8), so_v = (unsigned)((lane >> 1) * MT + (lane & 1) * 32), so_w = (unsigned)((tid >> 6) * (int)GX_STRIDE + (tid & 63));
    const float* GX = (const float*)(p.ws + OFF_GX); const float* DEC = GX + 3 * GX_STRIDE;
    const float* CST = (const float*)(p.ws + OFF_HYT); const float* NST = (const float*)(p.ws + OFF_NST);
    bf16_t* HF = (bf16_t*)(p.ws + OFF_A); bf16_t* HB = (bf16_t*)(p.ws + OFF_X);
    const u32x4 ones_u = (u32x4){0x3F803F80u, 0x3F803F80u, 0x3F803F80u, 0x3F803F80u};
    const bf16x8 ones = __builtin_bit_cast(bf16x8, ones_u);
    LAS float* WT = (LAS float*)(lds + PC_WT);
    LAS unsigned char* VSw = lds + PC_VS + wv * 4608;
    LAS unsigned char* OSw = lds + PC_OS + wv * 5120;
    for (int task = blockIdx.x; task < 16 * 16; task += gridDim.x) {
        const int hd = task & 15, sc = 1 + (task >> 4), h = hd >> 1, dir = hd & 1, w = wv;
        const size_t gb = (size_t)(dir * 8 + h) * MT;
        bf16_t* HO = dir ? HB : HF;
        f32x16 X[4];
        { const float* src = CST + (size_t)((sc * 16 + hd) * 8 + w) * 4096;
#pragma unroll
          for (int i = 0; i < 4; ++i)
#pragma unroll
              for (int q = 0; q < 16; ++q) X[i][q] = src[(i * 16 + q) * 64 + lane]; }
        LAS float* nlc = (LAS float*)(lds + PC_NL); LAS float* nln = nlc + 128;
        if (tid < 128) nlc[tid] = NST[(size_t)(sc * 16 + hd) * 128 + tid];
        PcStage sg;
#define PC_LOAD(cidx_) do { const int rw_ = (cidx_) * 64; \
            const bf16_t* qb_ = QS + (size_t)rw_ * 1024 + h * 128; sg.q0 = *(const u32x4*)(qb_ + so_q); sg.q1 = *(const u32x4*)(qb_ + so_q + 64u); \
            const bf16_t* kb_ = KS + (size_t)rw_ * 1024 + h * 128; sg.k0 = *(const u32x4*)(kb_ + so_q); sg.k1 = *(const u32x4*)(kb_ + so_q + 64u); \
            const bf16_t* tb_ = KT + (size_t)(h * 128) * MT + rw_; sg.t0 = *(const u32x4*)(tb_ + so_t); sg.t1 = *(const u32x4*)(tb_ + so_t + 32u); \
            const bf16_t* vb2_ = VT + (size_t)(h * 256 + 32 * w) * MT + rw_; sg.v0 = *(const u32x4*)(vb2_ + so_v); sg.v1 = *(const u32x4*)(vb2_ + so_v + 8u); sg.v2 = *(const u32x4*)(vb2_ + so_v + 16u); sg.v3 = *(const u32x4*)(vb2_ + so_v + 24u); \
            sg.wt = tid < 192 ? (GX + gb + rw_)[so_w] : 0.f; } while (0)
#define PC_ST64(base_, off_, v_) do { *(LAS u32x2*)((base_) + (off_)) = (u32x2){(v_).x, (v_).y}; *(LAS u32x2*)((base_) + (off_) + 8) = (u32x2){(v_).z, (v_).w}; } while (0)
#define PC_STORE() do { \
            PC_ST64(lds + PC_QS, (tid >> 3) * 264 + (tid & 7) * 16, sg.q0); PC_ST64(lds + PC_QS, (tid >> 3) * 264 + (tid & 7) * 16 + 128, sg.q1); \
            PC_ST64(lds + PC_KS, (tid >> 3) * 264 + (tid & 7) * 16, sg.k0); PC_ST64(lds + PC_KS, (tid >> 3) * 264 + (tid & 7) * 16 + 128, sg.k1); \
            *(LAS u32x4*)(lds + PC_KT + (tid >> 2) * 144 + (tid & 3) * 16) = sg.t0; *(LAS u32x4*)(lds + PC_KT + (tid >> 2) * 144 + (tid & 3) * 16 + 64) = sg.t1; \
            { LAS unsigned char* vb_ = VSw + (lane >> 1) * 144 + (lane & 1) * 64; *(LAS u32x4*)vb_ = sg.v0; *(LAS u32x4*)(vb_ + 16) = sg.v1; *(LAS u32x4*)(vb_ + 32) = sg.v2; *(LAS u32x4*)(vb_ + 48) = sg.v3; } \
            if (tid < 192) WT[tid] = sg.wt; } while (0)
        __syncthreads();
        PC_LOAD(chunk_of(sc, dir, 0)); PC_STORE();
        __syncthreads();
#pragma unroll 1
        for (int c = 0; c < 16; ++c) {
            const int cidx = chunk_of(sc, dir, c), rw0 = cidx * 64;
#pragma unroll 1
            for (int tt = 0; tt < 2; ++tt) {
                const int qoff = PC_QS + (32 * tt + l31) * 264 + 8 * hh;
                f32x16 num, den;
#pragma unroll
                for (int q = 0; q < 16; ++q) { num[q] = 0.f; den[q] = 0.f; }
#pragma unroll
                for (int st = 0; st < 2; ++st) {
                    f32x16 S;
#pragma unroll
                    for (int q = 0; q < 16; ++q) S[q] = 0.f;
#pragma unroll
                    for (int ks = 0; ks < 8; ++ks) { const bf16x8 qf = lds_frag2(lds, qoff + 32 * ks); const bf16x8 kf = lds_frag2(lds, PC_KS + (32 * st + l31) * 264 + 8 * hh + 32 * ks);
                        S = __builtin_amdgcn_mfma_f32_32x32x16_bf16(kf, qf, S, 0, 0, 0); }
                    const int t = 32 * tt + l31;
#pragma unroll
                    for (int g = 0; g < 4; ++g) { const f32x4 c4 = *(const LAS f32x4*)(WT + 64 + 32 * st + 8 * g + 4 * hh);
#pragma unroll
                        for (int q = 0; q < 4; ++q) { const int s_ = 32 * st + 8 * g + 4 * hh + q; const bool ok = dir ? (s_ >= t) : (s_ <= t);
                            S[4 * g + q] = ok ? S[4 * g + q] * c4[q] : 0.f; } }
#pragma unroll
                    for (int kk = 0; kk < 2; ++kk) {
                        const bf16x8 xf = pack8(S, 8 * kk);
                        const bf16x8 vf = lds_frag2(VSw, l31 * 144 + (32 * st + 16 * kk + 4 * hh) * 2);
                        num = __builtin_amdgcn_mfma_f32_32x32x16_bf16(xf, vf, num, 0, 0, 0);
                        den = __builtin_amdgcn_mfma_f32_32x32x16_bf16(xf, ones, den, 0, 0, 0);
                    }
                }
#pragma unroll
                for (int i = 0; i < 4; ++i)
#pragma unroll
                    for (int s2 = 0; s2 < 2; ++s2) {
                        const bf16x8 bx = pack8(X[i], 8 * s2);
                        const bf16x8 qf = lds_frag2(lds, qoff + 32 * (2 * i + s2));
                        num = __builtin_amdgcn_mfma_f32_32x32x16_bf16(qf, bx, num, 0, 0, 0);
                        const f32x4 na = *(const LAS f32x4*)(nlc + 32 * i + 16 * s2 + 4 * hh), nb = *(const LAS f32x4*)(nlc + 32 * i + 16 * s2 + 8 + 4 * hh);
                        u32x4 nw; nw.x = pk_bf16(na[0], na[1]); nw.y = pk_bf16(na[2], na[3]); nw.z = pk_bf16(nb[0], nb[1]); nw.w = pk_bf16(nb[2], nb[3]);
                        den = __builtin_amdgcn_mfma_f32_32x32x16_bf16(qf, __builtin_bit_cast(bf16x8, nw), den, 0, 0, 0);
                    }
#pragma unroll
                for (int g = 0; g < 4; ++g) { const f32x4 a4 = *(const LAS f32x4*)(WT + 32 * tt + 8 * g + 4 * hh);
#pragma unroll
                    for (int q = 0; q < 4; ++q) { const float a = a4[q]; const float hv = a * num[4 * g + q] / fmaxf(fabsf(a * den[4 * g + q]), 1.0f);
                        *(LAS unsigned short*)(OSw + (32 * tt + 8 * g + 4 * hh + q) * 80 + l31 * 2) = f2bf(hv); } }
            }
#pragma unroll
            for (int it = 0; it < 4; ++it) { const int tok = it * 16 + (lane >> 2), sgm = lane & 3;
                const u32x4 ov = *(const LAS u32x4*)(OSw + tok * 80 + sgm * 16);
                *(u32x4*)((HO + (size_t)rw0 * 2048 + h * 256 + 32 * w) + (unsigned)(tok * 2048 + sgm * 8)) = ov; }
            const float dec = DEC[(dir * 8 + h) * 260 + cidx];
#pragma unroll
            for (int i = 0; i < 4; ++i) X[i] *= dec;
#pragma unroll
            for (int ks = 0; ks < 4; ++ks) {
                const u32x4 vr = *(const LAS u32x4*)(VSw + l31 * 144 + 32 * ks + 16 * hh);
                const f32x4 wa = *(const LAS f32x4*)(WT + 128 + 16 * ks + 8 * hh), wb = *(const LAS f32x4*)(WT + 128 + 16 * ks + 8 * hh + 4);
                u32x4 vs; vs.x = pk_bf16(bflo(vr.x) * wa[0], bfhi(vr.x) * wa[1]); vs.y = pk_bf16(bflo(vr.y) * wa[2], bfhi(vr.y) * wa[3]);
                vs.z = pk_bf16(bflo(vr.z) * wb[0], bfhi(vr.z) * wb[1]); vs.w = pk_bf16(bflo(vr.w) * wb[2], bfhi(vr.w) * wb[3]);
                const bf16x8 bfr = __builtin_bit_cast(bf16x8, vs);
#pragma unroll
                for (int i = 0; i < 4; ++i) { const u32x4 ar = *(const LAS u32x4*)(lds + PC_KT + (32 * i + l31) * 144 + 32 * ks + 16 * hh);
                    X[i] = __builtin_amdgcn_mfma_f32_32x32x16_bf16(__builtin_bit_cast(bf16x8, ar), bfr, X[i], 0, 0, 0); }
            }
            if (tid < 128) { float a = 0.f;
#pragma unroll
                for (int q = 0; q < 8; ++q) { const u32x4 kr = *(const LAS u32x4*)(lds + PC_KT + tid * 144 + 16 * q);
                    const f32x4 wa = *(const LAS f32x4*)(WT + 128 + 8 * q), wb = *(const LAS f32x4*)(WT + 128 + 8 * q + 4);
                    a = fmaf(wa[0], bflo(kr.x), a); a = fmaf(wa[1], bfhi(kr.x), a); a = fmaf(wa[2], bflo(kr.y), a); a = fmaf(wa[3], bfhi(kr.y), a);
                    a = fmaf(wb[0], bflo(kr.z), a); a = fmaf(wb[1], bfhi(kr.z), a); a = fmaf(wb[2], bflo(kr.w), a); a = fmaf(wb[3], bfhi(kr.w), a); }
                nln[tid] = dec * nlc[tid] + a; }
            __syncthreads();
            if (c + 1 < 16) { PC_LOAD(chunk_of(sc, dir, c + 1)); PC_STORE(); }
            { LAS float* t_ = nlc; nlc = nln; nln = t_; }
            __syncthreads();
        }
#undef PC_LOAD
#undef PC_ST64
#undef PC_STORE
    }
}
__device__ __forceinline__ void phase_l1_passA2(const Params& p, LAS unsigned char* lds) {
    const int tid = otid(), wv = __builtin_amdgcn_readfirstlane(tid >> 6), lane = tid & 63, l31 = lane & 31, hh = lane >> 5;
    const bf16_t* KT = (const bf16_t*)(p.ws + L1_OFF_KT); const bf16_t* VT = (const bf16_t*)(p.ws + OFF_BIG2);
    const float* GX = (const float*)(p.ws + OFF_GX); const float* DEC = GX + 3 * GX_STRIDE;
    float* CST = (float*)(p.ws + OFF_HYT); float* NST = (float*)(p.ws + OFF_NST);
    const unsigned so_t = (unsigned)((tid >> 2) * MT + (tid & 3) * 8), so_v = (unsigned)((lane >> 1) * MT + (lane & 1) * 32);
    LAS float* WT = (LAS float*)(lds + PC_WT);
    LAS unsigned char* VSw = lds + PC_VS + wv * 4608;
    for (int task = blockIdx.x; task < 16 * 16; task += gridDim.x) {
        const int hd = task & 15, sc = task >> 4, h = hd >> 1, dir = hd & 1, w = wv;
        const size_t gb = (size_t)(dir * 8 + h) * MT;
        f32x16 X[4];
#pragma unroll
        for (int i = 0; i < 4; ++i)
#pragma unroll
            for (int q = 0; q < 16; ++q) X[i][q] = 0.f;
        float nacc = 0.f;
        const int nc = sc == 0 ? 4 : 16;
#pragma unroll 1
        for (int c = 0; c < nc; ++c) {
            const int cidx = chunk_of(sc, dir, c), rw0 = chunk_row0(cidx);
            __syncthreads();
            { const bf16_t* tb_ = KT + (size_t)(h * 128) * MT + rw0; const u32x4 t0 = *(const u32x4*)(tb_ + so_t), t1 = *(const u32x4*)(tb_ + so_t + 32u);
              const bf16_t* vb_ = VT + (size_t)(h * 256 + 32 * w) * MT + rw0; const u32x4 v0 = *(const u32x4*)(vb_ + so_v), v1 = *(const u32x4*)(vb_ + so_v + 8u), v2 = *(const u32x4*)(vb_ + so_v + 16u), v3 = *(const u32x4*)(vb_ + so_v + 24u);
              const float wt = tid < 64 ? (GX + 2 * GX_STRIDE + gb + rw0)[tid] : 0.f;
              *(LAS u32x4*)(lds + PC_KT + (tid >> 2) * 144 + (tid & 3) * 16) = t0; *(LAS u32x4*)(lds + PC_KT + (tid >> 2) * 144 + (tid & 3) * 16 + 64) = t1;
              LAS unsigned char* vb2 = VSw + (lane >> 1) * 144 + (lane & 1) * 64; *(LAS u32x4*)vb2 = v0; *(LAS u32x4*)(vb2 + 16) = v1; *(LAS u32x4*)(vb2 + 32) = v2; *(LAS u32x4*)(vb2 + 48) = v3;
              if (tid < 64) WT[128 + tid] = wt; }
            __syncthreads();
            const float dec = DEC[(dir * 8 + h) * 260 + cidx];
#pragma unroll
            for (int i = 0; i < 4; ++i) X[i] *= dec;
#pragma unroll
            for (int ks = 0; ks < 4; ++ks) {
                const u32x4 vr = *(const LAS u32x4*)(VSw + l31 * 144 + 32 * ks + 16 * hh);
                const f32x4 wa = *(const LAS f32x4*)(WT + 128 + 16 * ks + 8 * hh), wb = *(const LAS f32x4*)(WT + 128 + 16 * ks + 8 * hh + 4);
                u32x4 vs; vs.x = pk_bf16(bflo(vr.x) * wa[0], bfhi(vr.x) * wa[1]); vs.y = pk_bf16(bflo(vr.y) * wa[2], bfhi(vr.y) * wa[3]);
                vs.z = pk_bf16(bflo(vr.z) * wb[0], bfhi(vr.z) * wb[1]); vs.w = pk_bf16(bflo(vr.w) * wb[2], bfhi(vr.w) * wb[3]);
                const bf16x8 bfr = __builtin_bit_cast(bf16x8, vs);
#pragma unroll
                for (int i = 0; i < 4; ++i) { const u32x4 ar = *(const LAS u32x4*)(lds + PC_KT + (32 * i + l31) * 144 + 32 * ks + 16 * hh);
                    X[i] = __builtin_amdgcn_mfma_f32_32x32x16_bf16(__builtin_bit_cast(bf16x8, ar), bfr, X[i], 0, 0, 0); }
            }
            if (tid < 128) { float a = 0.f;
#pragma unroll
                for (int q = 0; q < 8; ++q) { const u32x4 kr = *(const LAS u32x4*)(lds + PC_KT + tid * 144 + 16 * q);
                    const f32x4 wa = *(const LAS f32x4*)(WT + 128 + 8 * q), wb = *(const LAS f32x4*)(WT + 128 + 8 * q + 4);
                    a = fmaf(wa[0], bflo(kr.x), a); a = fmaf(wa[1], bfhi(kr.x), a); a = fmaf(wa[2], bflo(kr.y), a); a = fmaf(wa[3], bfhi(kr.y), a);
                    a = fmaf(wb[0], bflo(kr.z), a); a = fmaf(wb[1], bfhi(kr.z), a); a = fmaf(wb[2], bflo(kr.w), a); a = fmaf(wb[3], bfhi(kr.w), a); }
                nacc = dec * nacc + a; }
        }
        float* dst = CST + (size_t)((sc * 16 + hd) * 8 + w) * 4096;
#pragma unroll
        for (int i = 0; i < 4; ++i)
#pragma unroll
            for (int q = 0; q < 16; ++q) dst[(i * 16 + q) * 64 + lane] = X[i][q];
        if (tid < 128) NST[(size_t)(sc * 16 + hd) * 128 + tid] = nacc;
    }
    __syncthreads();
}
__device__ __forceinline__ void phase_l1_merge(const Params& p) {
    const int tid = otid(), wv = tid >> 6, lane = tid & 63;
    const bf16_t* HF = (const bf16_t*)(p.ws + OFF_A); const bf16_t* HB = (const bf16_t*)(p.ws + OFF_X); const bf16_t* Ob = (const bf16_t*)(p.ws + L1_OFF_OB);
    bf16_t* OUT = (bf16_t*)(p.ws + OFF_QK);
    const float* nw = p.in[I_MLNW];
    for (int t = blockIdx.x * 8 + wv; t < TL; t += gridDim.x * 8) {
#pragma unroll
        for (int pc = 0; pc < 4; ++pc) { const int e = pc * 512 + lane * 8;
            const u32x4 a = *(const u32x4*)(HF + (size_t)t * 2048 + e), b = *(const u32x4*)(HB + (size_t)t * 2048 + e), o = *(const u32x4*)(Ob + (size_t)t * 2048 + e);
            float hv[8] = {bflo(a.x) + bflo(b.x), bfhi(a.x) + bfhi(b.x), bflo(a.y) + bflo(b.y), bfhi(a.y) + bfhi(b.y), bflo(a.z) + bflo(b.z), bfhi(a.z) + bfhi(b.z), bflo(a.w) + bflo(b.w), bfhi(a.w) + bfhi(b.w)};
            const float ov[8] = {bflo(o.x), bfhi(o.x), bflo(o.y), bfhi(o.y), bflo(o.z), bfhi(o.z), bflo(o.w), bfhi(o.w)};
            float s = 0.f;
#pragma unroll
            for (int j = 0; j < 8; ++j) s += hv[j];
#pragma unroll
            for (int of = 16; of > 0; of >>= 1) s += __shfl_xor(s, of);
            const float mu = s * (1.0f / 256.0f);
            float q = 0.f;
#pragma unroll
            for (int j = 0; j < 8; ++j) { const float d = hv[j] - mu; q += d * d; }
#pragma unroll
            for (int of = 16; of > 0; of >>= 1) q += __shfl_xor(q, of);
            const float rs = rsqrtf(q * (1.0f / 256.0f) + LN_EPS);
            float wn[8], r8[8]; ld8(nw + e, wn);
#pragma unroll
            for (int j = 0; j < 8; ++j) { const float hn = bf2f(f2bf((hv[j] - mu) * rs * wn[j])); r8[j] = hn * sigmoid_f(ov[j]); }
#if F8_L1O
            *(u32x2*)((unsigned char*)OUT + (size_t)t * 2048 + e) = (u32x2){fp8x4(clamp8(r8[0] * G8_XS), clamp8(r8[1] * G8_XS), clamp8(r8[2] * G8_XS), clamp8(r8[3] * G8_XS)), fp8x4(clamp8(r8[4] * G8_XS), clamp8(r8[5] * G8_XS), clamp8(r8[6] * G8_XS), clamp8(r8[7] * G8_XS))}; }
#else
            st8bf(OUT + (size_t)t * 2048 + e, r8); }
#endif
    }
}
__global__ void __launch_bounds__(NTHREADS, 2) hybrid_fwd_megakernel(Params p) {
    extern __shared__ __attribute__((aligned(16))) unsigned char smem_raw[];
    LAS unsigned char* lds = (LAS unsigned char*)smem_raw;
    volatile LAS unsigned* bst = (volatile LAS unsigned*)(lds + LDS_BYTES - 16);
    if (threadIdx.x < 4) bst[threadIdx.x] = 0u;
    __syncthreads();
    XcdBarrier bar = xcd_barrier_post((unsigned*)(p.ws + OFF_BAR), bst);
#define ws (get_ws())
#define Abuf ((bf16_t*)(ws + OFF_A))
    phase0(fresh(p), lds, P0_T0, P0_T2);
    phase0(fresh(p), lds, P0_T4, P0_T5);
    phase0(fresh(p), lds, P0_T5, P0_T6);
    phase0(fresh(p), lds, P0_T6, P0_T7);
    phase0(fresh(p), lds, P0_T7, P0_NT);
    xcd_barrier(bar);
    modulate_rows(p.in[I_X], p.in[I_CTX], (const float*)(ws + OFF_MOD), Abuf);
    hyena_taps(fresh(p));
    xcd_barrier(bar);
    {
        unsigned char* w_ = ws;
        constexpr int ES = F8_L0 ? 1 : 2;
        pg8::Sched2<pg8::EpiBf16, ES> S{(const char*)(w_ + OFF_W0T), (const char*)(w_ + OFF_A), 16, 65, (const char*)(w_ + OFF_A), (const char*)(w_ + OFF_W0T) + (size_t)4096 * 2048 * ES, 65, 8, (int)gridDim.x, (int)blockIdx.x};
        pg8::EpiS2<pg8::EpiBf16> E{pg8::EpiBf16{(bf16_t*)(w_ + OFF_BIG2), MT}, pg8::EpiBf16{(bf16_t*)(w_ + OFF_QK), 2048}};
        pg8::gemm_stream<pg8::EpiS2<pg8::EpiBf16>, pg8::Sched2<pg8::EpiBf16, ES>, ES == 1>(lds, 2048, S, E); __syncthreads();
    }
    xcd_barrier(bar);
    phase3(fresh(p), lds);
    xcd_barrier(bar);
    phase4(fresh(p), lds);
    xcd_barrier(bar);
    {
        unsigned char* w_ = ws;
        pg8::SchedTail S{(const char*)(w_ + OFF_A), (const char*)(w_ + OFF_WO0T), 64, 8, true, (int)gridDim.x, (int)blockIdx.x};
        pg8::EpiTail<true, pg8::EpiBf16> E{pg8::EpiBf16{(bf16_t*)(w_ + OFF_BIG2), 2048}, (float*)(w_ + OFF_X)};
        pg8::gemm_stream(lds, 2048, S, E); __syncthreads();
    }
    phase0(fresh(p), lds, P0_T2, P0_T4, 8);
    xcd_barrier(bar);
    phase_ln1(fresh(p), 0, MT, (const float*)(ws + OFF_X));
    xcd_barrier(bar);
    {
        unsigned char* w_ = ws;
        pg8::SchedTail S{(const char*)(w_ + OFF_WQK), (const char*)(w_ + OFF_A), 8, 64, false, (int)gridDim.x, (int)blockIdx.x};
        pg8::EpiTail<false, pg8::EpiF32> E{pg8::EpiF32{(float*)(w_ + OFF_BIG1), MT}, (float*)(w_ + OFF_X)};
        pg8::gemm_stream(lds, 2048, S, E); __syncthreads();
    }
    xcd_barrier(bar);
    phase_topk(fresh(p), lds, MT, (const float*)(ws + OFF_X));
    xcd_barrier(bar);
    phase_peer(fresh(p), lds, 0, MT);
    xcd_barrier(bar);
    {
        unsigned char* w_ = ws;
        constexpr int ES = F8_L1 ? 1 : 2;
        const char* u1 = (const char*)(w_ + (F8_L1 ? OFF_X : OFF_A));
        pg8::Sched2<pg8::EpiL1, ES> S{(const char*)(w_ + OFF_W1T), u1, 8, 65, u1, (const char*)(w_ + OFF_W1T) + (size_t)2048 * 2048 * ES, 65, 17, (int)gridDim.x, (int)blockIdx.x};
        pg8::EpiS2<pg8::EpiL1> E{pg8::EpiBf16{(bf16_t*)(w_ + OFF_BIG2), MT}, pg8::EpiL1{(bf16_t*)(w_ + OFF_QK), (bf16_t*)(w_ + L1_OFF_OB), (float*)(w_ + OFF_GATE)}};
        pg8::gemm_stream<pg8::EpiS2<pg8::EpiL1>, pg8::Sched2<pg8::EpiL1, ES>, ES == 1>(lds, 2048, S, E); __syncthreads();
    }
    xcd_barrier(bar);
    phase_l1_prep(fresh(p), lds);
    xcd_barrier(bar);
    phase_l1_passA2(fresh(p), lds);
    xcd_barrier(bar);
    phase_l1_passB(fresh(p));
    xcd_barrier(bar);
    phase_l1_passC(fresh(p), lds);
    xcd_barrier(bar);
    phase_l1_merge(fresh(p));
    xcd_barrier(bar);
#if F8_L1O
    {   unsigned char* w_ = ws;
        pg8::Sched1<1> S{(const char*)(w_ + OFF_QK), (const char*)(w_ + OFF_WO1T), TL / 256, 8, (int)gridDim.x, (int)blockIdx.x};
        pg8::EpiG<pg8::EpiBf16> E{pg8::EpiBf16{(bf16_t*)(w_ + OFF_BIG2), 2048}};
        pg8::gemm_stream<pg8::EpiG<pg8::EpiBf16>, pg8::Sched1<1>, true>(lds, 2048, S, E); __syncthreads();
    }
#else
    run_gemm(lds, (const bf16_t*)(ws + OFF_QK), (const bf16_t*)(ws + OFF_WO1T), TL, 2048, 2048, pg8::EpiBf16{(bf16_t*)(ws + OFF_BIG2), 2048});
#endif
    xcd_barrier(bar);
    phase_ln1(fresh(p), 1, TL, nullptr);
    xcd_barrier(bar);
    run_gemm(lds, (const bf16_t*)(ws + OFF_WQK) + (size_t)2048 * 2048, Abuf, 2048, TL, 2048, pg8::EpiF32{(float*)(ws + OFF_BIG1), MT});
    xcd_barrier(bar);
    phase_topk(fresh(p), lds, TL, nullptr);
    xcd_barrier(bar);
    phase_peer(fresh(p), lds, 1, TL);
#undef ws
#undef Abuf
}

extern "C" void kernel_launch(void* const* d_in, const int* in_sizes, int n_in, void* d_out, int out_size, void* d_ws, size_t ws_size, hipStream_t stream) {
    static int grid = 0;
    if (grid == 0) {
        int dev = 0, cus = 0;
        if (hipGetDevice(&dev) != hipSuccess || hipDeviceGetAttribute(&cus, hipDeviceAttributeMultiprocessorCount, dev) != hipSuccess) { fprintf(stderr, "kernel_launch: device query failed\n"); grid = -1; return; }
        if (hipFuncSetAttribute((const void*)hybrid_fwd_megakernel, hipFuncAttributeMaxDynamicSharedMemorySize, LDS_BYTES) != hipSuccess) { fprintf(stderr, "kernel_launch: hipFuncSetAttribute failed\n"); grid = -1; return; }
        int per_cu = 0;
        if (hipOccupancyMaxActiveBlocksPerMultiprocessor(&per_cu, (const void*)hybrid_fwd_megakernel, NTHREADS, LDS_BYTES) != hipSuccess || per_cu < 1) { fprintf(stderr, "kernel_launch: occupancy query says %d blocks/CU\n", per_cu); (void)hipGetLastError(); }
        if (n_in != 32 || ws_size < WS_END) { fprintf(stderr, "kernel_launch: unexpected n_in %d / ws_size %zu (need %zu)\n", n_in, ws_size, (size_t)WS_END); grid = -1; return; }
        grid = cus;
    }
    if (grid < 0) return;
    (void)hipMemsetAsync((char*)d_ws + OFF_BAR, 0, 16384, stream);
    Params prm{};
    for (int i = 0; i < 32; ++i) prm.in[i] = (const float*)d_in[i];
    prm.out = (float*)d_out; prm.ws = (unsigned char*)d_ws;
    void* args[] = {&prm};
    hipError_t e = hipLaunchCooperativeKernel((const void*)hybrid_fwd_megakernel, dim3(grid), dim3(NTHREADS), args, LDS_BYTES, stream);
    if (e != hipSuccess) fprintf(stderr, "kernel_launch: cooperative launch failed: %s (grid %d)\n", hipGetErrorString(e), grid);
}
```

```cpp
#include <hip/hip_runtime.h>
#include <cstdio>
#include <cstdint>

#define LAS __attribute__((address_space(3)))
typedef unsigned short bf16_t;
typedef short bf16x8 __attribute__((ext_vector_type(8)));
typedef short bf16x4 __attribute__((ext_vector_type(4)));
typedef float f32x2 __attribute__((ext_vector_type(2)));
typedef float f32x4 __attribute__((ext_vector_type(4)));
typedef float f32x16 __attribute__((ext_vector_type(16)));
typedef unsigned u32x2 __attribute__((ext_vector_type(2)));
typedef unsigned u32x4 __attribute__((ext_vector_type(4)));
typedef __bf16 bf2_t __attribute__((ext_vector_type(2)));

constexpr int DM = 2048;
constexpr int TL = 16384;
constexpr int TCX = 256;
constexpr int MT = TL + TCX;
constexpr int NTHREADS = 512;
constexpr int LDS_BYTES = 151552;
constexpr float LN_EPS = 1e-6f;
constexpr float DN_ALPHA = 1.41421356237309515f;

constexpr size_t al256(size_t x) { return (x + 255) & ~(size_t)255; }
constexpr size_t OFF_BAR   = 0;
constexpr size_t OFF_MOD   = 16384;
constexpr size_t OFF_ROPE  = OFF_MOD + al256((size_t)2 * 2 * 12288 * 4);
constexpr size_t OFF_A3    = OFF_ROPE + al256((size_t)256 * 32 * 8);
constexpr size_t OFF_GATE  = OFF_A3 + al256((size_t)MT * 64 * 2);
constexpr size_t OFF_GX    = OFF_GATE + al256((size_t)MT * 32 * 4);
constexpr size_t GX_STRIDE = (size_t)2 * 8 * MT;
constexpr size_t OFF_NST   = OFF_GX + al256((3 * GX_STRIDE + 2 * 8 * 260 + 64) * 4);
constexpr size_t OFF_W0T   = OFF_NST + al256((size_t)17 * 16 * 128 * 4);
constexpr size_t OFF_WO0T  = OFF_W0T + (size_t)6144 * 2048 * 2;
constexpr size_t OFF_W1T   = OFF_WO0T + (size_t)2048 * 2048 * 2;
constexpr size_t OFF_WO1T  = OFF_W1T + (size_t)6400 * 2048 * 2;
constexpr size_t OFF_WQK   = OFF_WO1T + (size_t)2048 * 2048 * 2;
constexpr size_t OFF_PEER  = OFF_WQK + (size_t)2 * 2048 * 2048 * 2;
constexpr size_t PEER_TBL  = (size_t)16384 * 2048;
constexpr float PEER_USCALE = 64.0f, PEER_VSCALE = 4.0f;
constexpr size_t OFF_BIG1  = OFF_PEER + 4 * PEER_TBL * 2;
constexpr size_t BIG_BYTES = al256((size_t)140000000);
constexpr size_t OFF_BIG2  = OFF_BIG1 + BIG_BYTES;
constexpr size_t OFF_H     = OFF_BIG2 + BIG_BYTES;
constexpr size_t OFF_A     = OFF_H + (size_t)MT * DM * 4;
constexpr size_t OFF_QK    = OFF_A + (size_t)MT * DM * 2;
constexpr size_t OFF_HYT   = OFF_QK + (size_t)MT * DM * 2;
constexpr size_t OFF_EXP   = OFF_HYT + al256((size_t)40000000);
constexpr size_t OFF_X     = OFF_EXP + (size_t)MT * 128 * 8;
constexpr size_t WS_END    = OFF_X + (size_t)MT * DM * 2;
static_assert(WS_END <= (size_t)1073741824, "workspace map exceeds 1 GiB");

__device__ __forceinline__ int opq(int v) { asm volatile("" : "+s"(v)); return v; }
__device__ __forceinline__ int otid() { int t = threadIdx.x; asm volatile("" : "+v"(t)); return t; }
__device__ __forceinline__ bf16_t f2bf(float f) { unsigned u = __float_as_uint(f); u += 0x7FFFu + ((u >> 16) & 1u); return (bf16_t)(u >> 16); }
__device__ __forceinline__ float bf2f(bf16_t b) { return __uint_as_float(((unsigned)b) << 16); }
__device__ __forceinline__ unsigned pk_bf16(float lo, float hi) { unsigned r; asm volatile("v_cvt_pk_bf16_f32 %0, %1, %2" : "=v"(r) : "v"(lo), "v"(hi)); return r; }
typedef int i32x4 __attribute__((ext_vector_type(4)));
typedef int i32x8 __attribute__((ext_vector_type(8)));
__device__ __forceinline__ unsigned fp8x4(float a, float b, float c, float d) { int v = 0; v = __builtin_amdgcn_cvt_pk_fp8_f32(a, b, v, false); v = __builtin_amdgcn_cvt_pk_fp8_f32(c, d, v, true); return (unsigned)v; }
__device__ __forceinline__ float clamp8(float v) { return __builtin_amdgcn_fmed3f(v, -448.f, 448.f); }
constexpr float G8_XS = 16.0f, G8_WS = 64.0f, G8_OS = 1.0f / (16.0f * 64.0f);
#define F8_L0 0
#define F8_L0NA 1
#define F8_L1 1
#define F8_L1O 1
__device__ __forceinline__ float bflo(unsigned u) { return __uint_as_float(u << 16); }
__device__ __forceinline__ float bfhi(unsigned u) { return __uint_as_float(u & 0xFFFF0000u); }
__device__ __forceinline__ float wave_sum(float v) {
#pragma unroll
    for (int o = 32; o > 0; o >>= 1) v += __shfl_xor(v, o);
    return v;
}
__device__ __forceinline__ float wave_max(float v) {
#pragma unroll
    for (int o = 32; o > 0; o >>= 1) v = fmaxf(v, __shfl_xor(v, o));
    return v;
}
__device__ __forceinline__ float silu_f(float x) { return x / (1.f + __expf(-x)); }
__device__ __forceinline__ float sigmoid_f(float x) { return 1.f / (1.f + __expf(-x)); }

#define XB_TMO      128
#define XB_XCNT(j)  (256  + 64 * (j))
#define XB_XSUB(j)  (1280 + 64 * (j))
#define XB_XGEN(j)  (2304 + 64 * (j))
#define XB_TOP      3328
#define XB_TOPGEN   3392
#define XCD_BAR_WORDS 3456
#define XB_SPIN_CAP (1u << 30)
__device__ __forceinline__ unsigned xb_ld(unsigned* p)              { return __hip_atomic_load(p, __ATOMIC_RELAXED, __HIP_MEMORY_SCOPE_AGENT); }
__device__ __forceinline__ unsigned xb_add(unsigned* p, unsigned v) { return __hip_atomic_fetch_add(p, v, __ATOMIC_RELAXED, __HIP_MEMORY_SCOPE_AGENT); }
__device__ __forceinline__ unsigned xb_xcc_id() { return (unsigned)__builtin_amdgcn_s_getreg((3 << 11) | 20) & 0xFu; }
#define XB_SPIN(cond, bar) do { unsigned _sp = 0; while (cond) { __builtin_amdgcn_s_sleep(1); \
    if ((++_sp & 255u) == 0u) { if (xb_ld(&(bar)[XB_TMO])) break; if (_sp > XB_SPIN_CAP) { atomicAdd(&(bar)[XB_TMO], 1u); break; } } } } while (0)
struct XcdBarrier { unsigned* bar; unsigned x; volatile LAS unsigned* st; };
__device__ __forceinline__ XcdBarrier xcd_barrier_post(unsigned* bar, volatile LAS unsigned* st) {
    XcdBarrier b; b.bar = bar; b.x = xb_xcc_id(); b.st = st;
    if (threadIdx.x == 0) (void)xb_add(&bar[XB_XCNT(b.x)], 1u);
    return b;
}
__device__ __forceinline__ void xcd_barrier_complete(unsigned* bar, unsigned x, unsigned& nloc, unsigned& nx) {
    const unsigned G = gridDim.x * gridDim.y * gridDim.z;
    unsigned sum, cnt, mine, sp = 0u;
    for (;;) {
        sum = 0u; cnt = 0u; mine = 0u;
#pragma unroll
        for (unsigned j = 0; j < 16; ++j) { const unsigned c = xb_ld(&bar[XB_XCNT(j)]); sum += c; cnt += (c > 0u) ? 1u : 0u; mine = (j == x) ? c : mine; }
        if (sum == G) break;
        __builtin_amdgcn_s_sleep(1);
        if ((++sp & 255u) == 0u) { if (xb_ld(&bar[XB_TMO])) break; if (sp > XB_SPIN_CAP) { atomicAdd(&bar[XB_TMO], 1u); break; } }
    }
    nloc = mine > 0u ? mine : 1u; nx = cnt > 0u ? cnt : 1u;
}
__device__ __forceinline__ void xcd_barrier(const XcdBarrier& b) {
    asm volatile("s_waitcnt vmcnt(0)" ::: "memory");
    __syncthreads();
    if (threadIdx.x == 0) {
        unsigned* bar = b.bar;
        __builtin_amdgcn_s_waitcnt(0);
        unsigned nloc = b.st[0], nx = b.st[1];
        if (nloc == 0u) { xcd_barrier_complete(bar, b.x, nloc, nx); b.st[0] = nloc; b.st[1] = nx; }
        const unsigned old = xb_add(&bar[XB_XSUB(b.x)], 1u);
        const unsigned gen = old / nloc;
        if (old + 1u == (gen + 1u) * nloc) {
            __builtin_amdgcn_fence(__ATOMIC_RELEASE, "agent");
            asm volatile("s_waitcnt vmcnt(0)" ::: "memory");
            const unsigned og = xb_add(&bar[XB_TOP], 1u);
            const unsigned tg = og / nx;
            if (og + 1u == (tg + 1u) * nx) xb_add(&bar[XB_TOPGEN], 1u);
            else XB_SPIN(xb_ld(&bar[XB_TOPGEN]) == tg, bar);
            __builtin_amdgcn_fence(__ATOMIC_ACQUIRE, "agent");
            xb_add(&bar[XB_XGEN(b.x)], 1u);
            asm volatile("s_waitcnt vmcnt(0)" ::: "memory");
        } else {
            XB_SPIN(xb_ld(&bar[XB_XGEN(b.x)]) == gen, bar);
            __builtin_amdgcn_fence(__ATOMIC_ACQUIRE, "agent");
            asm volatile("s_waitcnt vmcnt(0)" ::: "memory");
        }
    }
    __syncthreads();
}

namespace pg8 {
constexpr int BM = 256, BK = 64, HALF = 128, HTB = HALF * BK * 2, STAGE_BYTES = 8 * HTB, NXCD = 8, WGM = 8;
__host__ __device__ __forceinline__ int lds_byte(int r, int c) { const int st = (r >> 4) * 2 + (c >> 5), rr = r & 15, cc = c & 31, ob = rr * 64 + cc * 2; return st * 1024 + (ob ^ (((ob >> 9) & 1) << 5)); }
__host__ __device__ __forceinline__ void stage_rc(int b, int& R, int& C) { const int st = b / 1024, sb = b % 1024, swz = sb ^ (((sb >> 9) & 1) << 5); R = (st >> 1) * 16 + swz / 64; C = (st & 1) * 32 + (swz % 64) / 2; }
__host__ __device__ __forceinline__ int perm32(int rho) { const int n = rho >> 4, i = rho & 15; return 8 * (i >> 2) + 4 * n + (i & 3); }
struct Unit { int pm, pn; };
struct Gemm { const bf16_t* A; const bf16_t* Bt; int M, N, K; };
struct StaticOrder {
    int nM, nN, nwg, G, c;
    __host__ __device__ void init(int M, int N, int G_, int c_) { nM = M / BM; nN = N / BM; nwg = nM * nN; G = G_; c = c_; }
    __host__ __device__ bool next(int i, Unit& u) const {
        const long L = (long)i * G + c; if (L >= nwg) return false;
        int wgid = (int)L; { const int q = nwg / NXCD, r = nwg % NXCD, xcd = wgid % NXCD, off = wgid / NXCD; wgid = (xcd < r ? xcd * (q + 1) : r * (q + 1) + (xcd - r) * q) + off; }
        const int nig = WGM * nN, gid = wgid / nig, fm = gid * WGM, gsz = (nM - fm) < WGM ? (nM - fm) : WGM;
        u.pm = fm + ((wgid % nig) % gsz); u.pn = (wgid % nig) / gsz; return true;
    }
    __device__ __forceinline__ void a_ready(const Unit&) const {}
    __device__ __forceinline__ void done(const Unit&) const {}
};
struct EpiF32 {
    static constexpr bool PERM = false;
    float* C; int ldc;
    __device__ __forceinline__ void operator()(const f32x4 (&acc)[2][2][4][2], const Unit& u, int wr, int wc, int fr, int fq) const {
        const int row0 = u.pm * BM + wr * 64 + fr, col0 = u.pn * BM + wc * 32 + 4 * fq;
#pragma unroll
        for (int ai = 0; ai < 2; ++ai)
#pragma unroll
            for (int m = 0; m < 4; ++m) { float* rowp = C + (size_t)(row0 + ai * HALF + m * 16) * ldc + col0;
#pragma unroll
                for (int bj = 0; bj < 2; ++bj)
#pragma unroll
                    for (int n = 0; n < 2; ++n) *(f32x4*)(rowp + bj * HALF + n * 16) = acc[ai][bj][m][n]; }
    }
};
struct EpiBf16 {
    static constexpr bool PERM = true;
    bf16_t* O; int ldc;
    __device__ __forceinline__ void operator()(const f32x4 (&acc)[2][2][4][2], const Unit& u, int wr, int wc, int fr, int fq) const {
        const int row0 = u.pm * BM + wr * 64 + fr, col0 = u.pn * BM + wc * 32 + 8 * fq;
#pragma unroll
        for (int ai = 0; ai < 2; ++ai)
#pragma unroll
            for (int m = 0; m < 4; ++m) { bf16_t* rowp = O + (size_t)(row0 + ai * HALF + m * 16) * ldc + col0;
#pragma unroll
                for (int bj = 0; bj < 2; ++bj) { const f32x4 v0 = acc[ai][bj][m][0], v1 = acc[ai][bj][m][1];
                    u32x4 w; w.x = pk_bf16(v0[0], v0[1]); w.y = pk_bf16(v0[2], v0[3]); w.z = pk_bf16(v1[0], v1[1]); w.w = pk_bf16(v1[2], v1[3]);
                    *(u32x4*)(rowp + bj * HALF) = w; } }
    }
};
struct EpiL1 {
    static constexpr bool PERM = true;
    bf16_t* QKp; bf16_t* Ob; float* G;
    __device__ __forceinline__ void operator()(const f32x4 (&acc)[2][2][4][2], const Unit& u, int wr, int wc, int fr, int fq) const {
        const int row0 = u.pm * BM + wr * 64 + fr;
        if (u.pn < 16) {
            bf16_t* base = (u.pn < 8) ? QKp : Ob; const int col0 = (u.pn & 7) * BM + wc * 32 + 8 * fq;
#pragma unroll
            for (int ai = 0; ai < 2; ++ai)
#pragma unroll
                for (int m = 0; m < 4; ++m) { bf16_t* rowp = base + (size_t)(row0 + ai * HALF + m * 16) * 2048 + col0;
#pragma unroll
                    for (int bj = 0; bj < 2; ++bj) { const f32x4 v0 = acc[ai][bj][m][0], v1 = acc[ai][bj][m][1];
                        u32x4 w; w.x = pk_bf16(v0[0], v0[1]); w.y = pk_bf16(v0[2], v0[3]); w.z = pk_bf16(v1[0], v1[1]); w.w = pk_bf16(v1[2], v1[3]);
                        *(u32x4*)(rowp + bj * HALF) = w; } }
        } else if (wc == 0) {
#pragma unroll
            for (int ai = 0; ai < 2; ++ai)
#pragma unroll
                for (int m = 0; m < 4; ++m) { float* rowp = G + (size_t)(row0 + ai * HALF + m * 16) * 32 + 8 * fq;
                    *(f32x4*)(rowp) = acc[ai][0][m][0]; *(f32x4*)(rowp + 4) = acc[ai][0][m][1]; }
        }
    }
};

template <class Epi, class Sched>
__device__ __forceinline__ void gemm_phase(LAS unsigned char* lds, const Gemm g, const Sched& S, const Epi& E) {
    const int tid = otid(), wid = __builtin_amdgcn_readfirstlane(tid >> 6), lane = tid & 63, wr = wid >> 2, wc = wid & 3, fr = lane & 15, fq = lane >> 4;
    const int K = g.K, nt = K / BK;
    unsigned voffA[2], voffB[2];
#pragma unroll
    for (int i = 0; i < 2; ++i) { int R, C; stage_rc(tid * 16 + i * 8192, R, C); const int Rb = Epi::PERM ? ((R & ~31) + perm32(R & 31)) : R;
        voffA[i] = (unsigned)(R * K + C) * 2u; voffB[i] = (unsigned)(Rb * K + C) * 2u; }
    const size_t kstep = (size_t)(BK * 2);
    const size_t hstep = (size_t)HALF * K * 2;
    const size_t tstep = 2 * hstep;
    const unsigned ldsw = (unsigned)wid * 1024u;
    const int aoff = lds_byte(wr * 64 + fr, fq * 8), boff = lds_byte(wc * 32 + fr, fq * 8);
#define PG8_SA(b, h) (((b) * 2 + (h)) * HTB)
#define PG8_SB(b, h) ((4 + (b) * 2 + (h)) * HTB)
#define PG8_STAGE(bufoff, gbase, voff) do { _Pragma("unroll") for (int _i = 0; _i < 2; ++_i) \
        __builtin_amdgcn_global_load_lds((const unsigned*)((const char*)(gbase) + (voff)[_i]), (LAS unsigned*)(lds + (bufoff) + ldsw + _i * 8192), 16, 0, 0); } while (0)
#define PG8_LDA(dst, b, h) do { _Pragma("unroll") for (int m = 0; m < 4; ++m) _Pragma("unroll") for (int k = 0; k < 2; ++k) dst[m][k] = *(const LAS bf16x8*)(lds + PG8_SA(b, h) + aoff + m * 2048 + k * 1024); } while (0)
#define PG8_LDB(dst, b, h) do { _Pragma("unroll") for (int n = 0; n < 2; ++n) _Pragma("unroll") for (int k = 0; k < 2; ++k) dst[n][k] = *(const LAS bf16x8*)(lds + PG8_SB(b, h) + boff + n * 2048 + k * 1024); } while (0)
#define PG8_MMA(ai, bj, At, Bt) do { __builtin_amdgcn_s_setprio(1); _Pragma("unroll") for (int m = 0; m < 4; ++m) _Pragma("unroll") for (int n = 0; n < 2; ++n) _Pragma("unroll") for (int k = 0; k < 2; ++k) \
        acc[ai][bj][m][n] = __builtin_amdgcn_mfma_f32_16x16x32_bf16(Bt[n][k], At[m][k], acc[ai][bj][m][n], 0, 0, 0); __builtin_amdgcn_s_setprio(0); } while (0)
#define PG8_WAIT_V(n) asm volatile("s_waitcnt vmcnt(" #n ")" ::: "memory")
#define PG8_WAIT_L(n) asm volatile("s_waitcnt lgkmcnt(" #n ")" ::: "memory")
#define PG8_BAR __builtin_amdgcn_s_barrier()
#define PG8_SCHED __builtin_amdgcn_sched_barrier(0)
    Unit cur, nxt; int ui = 0;
    if (!S.next(0, cur)) return;
    f32x4 acc[2][2][4][2];
#pragma unroll
    for (int a = 0; a < 2; ++a)
#pragma unroll
        for (int b = 0; b < 2; ++b)
#pragma unroll
            for (int m = 0; m < 4; ++m)
#pragma unroll
                for (int n = 0; n < 2; ++n) acc[a][b][m][n] = (f32x4){0.f, 0.f, 0.f, 0.f};
    bf16x8 At[4][2], B0[2][2], B1[2][2];
    const char* cA = (const char*)g.A + (size_t)cur.pm * tstep; const char* cB = (const char*)g.Bt + (size_t)cur.pn * tstep;
    S.a_ready(cur);
    PG8_STAGE(PG8_SB(0, 0), cB, voffB); PG8_STAGE(PG8_SA(0, 0), cA, voffA); PG8_STAGE(PG8_SB(0, 1), cB + hstep, voffB); PG8_STAGE(PG8_SA(0, 1), cA + hstep, voffA);
    if (wr == 1) PG8_BAR;
    PG8_WAIT_V(4); PG8_BAR;
    PG8_STAGE(PG8_SB(1, 0), cB + kstep, voffB); PG8_STAGE(PG8_SA(1, 0), cA + kstep, voffA); PG8_STAGE(PG8_SB(1, 1), cB + hstep + kstep, voffB);
    PG8_WAIT_V(6); PG8_BAR;
    for (;;) {
        const bool has_next = S.next(ui + 1, nxt);
        const char* nA = has_next ? (const char*)g.A + (size_t)nxt.pm * tstep : cA; const char* nB = has_next ? (const char*)g.Bt + (size_t)nxt.pn * tstep : cB;
        for (int t = 0; t < nt; t += 2) {
            const bool last = (t == nt - 2);
            const char* a1 = cA + (size_t)(t + 1) * kstep;
            const char* a2 = last ? nA : cA + (size_t)(t + 2) * kstep; const char* b2 = last ? nB : cB + (size_t)(t + 2) * kstep;
            const char* a3 = a2 + kstep; const char* b3 = b2 + kstep;
            if (last && has_next) S.a_ready(nxt);
            PG8_LDB(B0, 0, 0); PG8_SCHED; PG8_LDA(At, 0, 0); PG8_STAGE(PG8_SA(1, 1), a1 + hstep, voffA);
            PG8_WAIT_L(8); PG8_BAR; PG8_WAIT_L(0); PG8_MMA(0, 0, At, B0); PG8_BAR; PG8_SCHED;
            PG8_LDB(B1, 0, 1); PG8_STAGE(PG8_SB(0, 0), b2, voffB);
            PG8_BAR; PG8_WAIT_L(0); PG8_MMA(0, 1, At, B1); PG8_BAR;
            PG8_LDA(At, 0, 1); PG8_STAGE(PG8_SA(0, 0), a2, voffA);
            PG8_BAR; PG8_WAIT_L(0); PG8_MMA(1, 0, At, B0); PG8_BAR; PG8_SCHED;
            PG8_STAGE(PG8_SB(0, 1), b2 + hstep, voffB);
            PG8_WAIT_V(6); PG8_BAR; PG8_MMA(1, 1, At, B1); PG8_BAR;
            PG8_LDB(B0, 1, 0); PG8_SCHED; PG8_LDA(At, 1, 0); PG8_STAGE(PG8_SA(0, 1), a2 + hstep, voffA);
            PG8_WAIT_L(8); PG8_BAR; PG8_WAIT_L(0); PG8_MMA(0, 0, At, B0); PG8_BAR; PG8_SCHED;
            PG8_LDB(B1, 1, 1); PG8_STAGE(PG8_SB(1, 0), b3, voffB);
            PG8_BAR; PG8_WAIT_L(0); PG8_MMA(0, 1, At, B1); PG8_BAR;
            PG8_LDA(At, 1, 1); PG8_STAGE(PG8_SA(1, 0), a3, voffA);
            PG8_BAR; PG8_WAIT_L(0); PG8_MMA(1, 0, At, B0); PG8_BAR; PG8_SCHED;
            PG8_STAGE(PG8_SB(1, 1), b3 + hstep, voffB);
            PG8_WAIT_V(6); PG8_BAR; PG8_MMA(1, 1, At, B1); PG8_BAR;
        }
        E(acc, cur, wr, wc, fr, fq); S.done(cur);
        if (!has_next) break;
#pragma unroll
        for (int a = 0; a < 2; ++a)
#pragma unroll
            for (int b = 0; b < 2; ++b)
#pragma unroll
                for (int m = 0; m < 4; ++m)
#pragma unroll
                    for (int n = 0; n < 2; ++n) acc[a][b][m][n] = (f32x4){0.f, 0.f, 0.f, 0.f};
        cur = nxt; cA = nA; cB = nB; ++ui;
    }
    PG8_WAIT_V(0);
    if (wr == 0) PG8_BAR;
    PG8_BAR;
#undef PG8_SA
#undef PG8_SB
#undef PG8_STAGE
#undef PG8_LDA
#undef PG8_LDB
#undef PG8_MMA
#undef PG8_WAIT_V
#undef PG8_WAIT_L
#undef PG8_BAR
#undef PG8_SCHED
}
__device__ __forceinline__ void mfma8(f32x4& acc, const i32x8 b, const i32x8 a, int sc) {
    asm volatile("v_mfma_scale_f32_16x16x128_f8f6f4 %0, %1, %2, %0, %3, %3 op_sel_hi:[0,0,0]" : "+v"(acc) : "v"(b), "v"(a), "v"(sc)); }
__device__ __forceinline__ i32x8 cat8(const bf16x8 a, const bf16x8 b) { const i32x4 x = __builtin_bit_cast(i32x4, a), y = __builtin_bit_cast(i32x4, b); return __builtin_shufflevector(x, y, 0, 1, 2, 3, 4, 5, 6, 7); }
struct GUnit { const char* A; const char* B; int pm, pn, nkt, tag; };
template <class Epi, class Sched, bool F8 = false>
__device__ __forceinline__ void gemm_stream(LAS unsigned char* lds, const int K, const Sched& S, const Epi& E) {
    const int tid = otid(), wid = __builtin_amdgcn_readfirstlane(tid >> 6), lane = tid & 63, wr = wid >> 2, wc = wid & 3, fr = lane & 15, fq = lane >> 4;
    unsigned voffA[2], voffB[2];
    const int Kb = F8 ? K : 2 * K;
#pragma unroll
    for (int i = 0; i < 2; ++i) { int R, C; stage_rc(tid * 16 + i * 8192, R, C); const int Rb = Epi::PERM ? ((R & ~31) + perm32(R & 31)) : R;
        voffA[i] = (unsigned)(R * Kb + C * 2); voffB[i] = (unsigned)(Rb * Kb + C * 2); }
    int sc8 = 0x7F7F7F7F; asm volatile("" : "+v"(sc8));
    const size_t kstep = (size_t)(BK * 2);
    const size_t hstep = (size_t)HALF * Kb;
    const unsigned ldsw = (unsigned)wid * 1024u;
    const int aoff = lds_byte(wr * 64 + fr, fq * 8), boff = lds_byte(wc * 32 + fr, fq * 8);
#define PG8_SA(b, h) (((b) * 2 + (h)) * HTB)
#define PG8_SB(b, h) ((4 + (b) * 2 + (h)) * HTB)
#define PG8_STAGE(bufoff, gbase, voff) do { _Pragma("unroll") for (int _i = 0; _i < 2; ++_i) \
        __builtin_amdgcn_global_load_lds((const unsigned*)((const char*)(gbase) + (voff)[_i]), (LAS unsigned*)(lds + (bufoff) + ldsw + _i * 8192), 16, 0, 0); } while (0)
#define PG8_LDA(dst, b, h) do { _Pragma("unroll") for (int m = 0; m < 4; ++m) _Pragma("unroll") for (int k = 0; k < 2; ++k) dst[m][k] = *(const LAS bf16x8*)(lds + PG8_SA(b, h) + aoff + m * 2048 + k * 1024); } while (0)
#define PG8_LDB(dst, b, h) do { _Pragma("unroll") for (int n = 0; n < 2; ++n) _Pragma("unroll") for (int k = 0; k < 2; ++k) dst[n][k] = *(const LAS bf16x8*)(lds + PG8_SB(b, h) + boff + n * 2048 + k * 1024); } while (0)
#define PG8_MMA(ai, bj, At, Bt) do { __builtin_amdgcn_s_setprio(1); \
        if constexpr (F8) { _Pragma("unroll") for (int m = 0; m < 4; ++m) _Pragma("unroll") for (int n = 0; n < 2; ++n) \
            mfma8(acc[ai][bj][m][n], cat8(Bt[n][0], Bt[n][1]), cat8(At[m][0], At[m][1]), sc8); } \
        else { _Pragma("unroll") for (int m = 0; m < 4; ++m) _Pragma("unroll") for (int n = 0; n < 2; ++n) _Pragma("unroll") for (int k = 0; k < 2; ++k) \
            acc[ai][bj][m][n] = __builtin_amdgcn_mfma_f32_16x16x32_bf16(Bt[n][k], At[m][k], acc[ai][bj][m][n], 0, 0, 0); } \
        __builtin_amdgcn_s_setprio(0); } while (0)
#define PG8_WAIT_V(n) asm volatile("s_waitcnt vmcnt(" #n ")" ::: "memory")
#define PG8_WAIT_L(n) asm volatile("s_waitcnt lgkmcnt(" #n ")" ::: "memory")
#define PG8_BAR __builtin_amdgcn_s_barrier()
#define PG8_SCHED __builtin_amdgcn_sched_barrier(0)
    GUnit cur, nxt; int ui = 0;
    if (!S.next(0, cur)) return;
    f32x4 acc[2][2][4][2];
#pragma unroll
    for (int a = 0; a < 2; ++a)
#pragma unroll
        for (int b = 0; b < 2; ++b)
#pragma unroll
            for (int m = 0; m < 4; ++m)
#pragma unroll
                for (int n = 0; n < 2; ++n) acc[a][b][m][n] = (f32x4){0.f, 0.f, 0.f, 0.f};
    bf16x8 At[4][2], B0[2][2], B1[2][2];
    const char* cA = cur.A; const char* cB = cur.B;
    PG8_STAGE(PG8_SB(0, 0), cB, voffB); PG8_STAGE(PG8_SA(0, 0), cA, voffA); PG8_STAGE(PG8_SB(0, 1), cB + hstep, voffB); PG8_STAGE(PG8_SA(0, 1), cA + hstep, voffA);
    if (wr == 1) PG8_BAR;
    PG8_WAIT_V(4); PG8_BAR;
    PG8_STAGE(PG8_SB(1, 0), cB + kstep, voffB); PG8_STAGE(PG8_SA(1, 0), cA + kstep, voffA); PG8_STAGE(PG8_SB(1, 1), cB + hstep + kstep, voffB);
    PG8_WAIT_V(6); PG8_BAR;
    for (;;) {
        const bool has_next = S.next(ui + 1, nxt);
        const char* nA = has_next ? nxt.A : cA; const char* nB = has_next ? nxt.B : cB;
        const int nt = cur.nkt;
        for (int t = 0; t < nt; t += 2) {
            const bool last = (t == nt - 2);
            const char* a1 = cA + (size_t)(t + 1) * kstep;
            const char* a2 = last ? nA : cA + (size_t)(t + 2) * kstep; const char* b2 = last ? nB : cB + (size_t)(t + 2) * kstep;
            const char* a3 = a2 + kstep; const char* b3 = b2 + kstep;
            PG8_LDB(B0, 0, 0); PG8_SCHED; PG8_LDA(At, 0, 0); PG8_STAGE(PG8_SA(1, 1), a1 + hstep, voffA);
            PG8_WAIT_L(8); PG8_BAR; PG8_WAIT_L(0); PG8_MMA(0, 0, At, B0); PG8_BAR; PG8_SCHED;
            PG8_LDB(B1, 0, 1); PG8_STAGE(PG8_SB(0, 0), b2, voffB);
            PG8_BAR; PG8_WAIT_L(0); PG8_MMA(0, 1, At, B1); PG8_BAR;
            PG8_LDA(At, 0, 1); PG8_STAGE(PG8_SA(0, 0), a2, voffA);
            PG8_BAR; PG8_WAIT_L(0); PG8_MMA(1, 0, At, B0); PG8_BAR; PG8_SCHED;
            PG8_STAGE(PG8_SB(0, 1), b2 + hstep, voffB);
            PG8_WAIT_V(6); PG8_BAR; PG8_MMA(1, 1, At, B1); PG8_BAR;
            PG8_LDB(B0, 1, 0); PG8_SCHED; PG8_LDA(At, 1, 0); PG8_STAGE(PG8_SA(0, 1), a2 + hstep, voffA);
            PG8_WAIT_L(8); PG8_BAR; PG8_WAIT_L(0); PG8_MMA(0, 0, At, B0); PG8_BAR; PG8_SCHED;
            PG8_LDB(B1, 1, 1); PG8_STAGE(PG8_SB(1, 0), b3, voffB);
            PG8_BAR; PG8_WAIT_L(0); PG8_MMA(0, 1, At, B1); PG8_BAR;
            PG8_LDA(At, 1, 1); PG8_STAGE(PG8_SA(1, 0), a3, voffA);
            PG8_BAR; PG8_WAIT_L(0); PG8_MMA(1, 0, At, B0); PG8_BAR; PG8_SCHED;
            PG8_STAGE(PG8_SB(1, 1), b3 + hstep, voffB);
            PG8_WAIT_V(6); PG8_BAR; PG8_MMA(1, 1, At, B1); PG8_BAR;
        }
        if constexpr (F8) {
            asm volatile("s_nop 15\n\ts_nop 15" ::: "memory");
#pragma unroll
            for (int a = 0; a < 2; ++a)
#pragma unroll
                for (int b = 0; b < 2; ++b)
#pragma unroll
                    for (int m = 0; m < 4; ++m)
#pragma unroll
                        for (int n = 0; n < 2; ++n) acc[a][b][m][n] *= G8_OS; }
        E(acc, cur, wr, wc, fr, fq);
        if (!has_next) break;
#pragma unroll
        for (int a = 0; a < 2; ++a)
#pragma unroll
            for (int b = 0; b < 2; ++b)
#pragma unroll
                for (int m = 0; m < 4; ++m)
#pragma unroll
                    for (int n = 0; n < 2; ++n) acc[a][b][m][n] = (f32x4){0.f, 0.f, 0.f, 0.f};
        cur = nxt; cA = nA; cB = nB; ++ui;
    }
    PG8_WAIT_V(0);
    if (wr == 0) PG8_BAR;
    PG8_BAR;
#undef PG8_SA
#undef PG8_SB
#undef PG8_STAGE
#undef PG8_LDA
#undef PG8_LDB
#undef PG8_MMA
#undef PG8_WAIT_V
#undef PG8_WAIT_L
#undef PG8_BAR
#undef PG8_SCHED
}
}

namespace pg8 {
__device__ __forceinline__ void tile_map(int L, int nM, int nN, int& pm, int& pn) {
    const int nwg = nM * nN; int wgid = L; { const int q = nwg / NXCD, r = nwg % NXCD, xcd = wgid % NXCD, off = wgid / NXCD; wgid = (xcd < r ? xcd * (q + 1) : r * (q + 1) + (xcd - r) * q) + off; }
    const int nig = WGM * nN, gid = wgid / nig, fm = gid * WGM, gsz = (nM - fm) < WGM ? (nM - fm) : WGM;
    pm = fm + ((wgid % nig) % gsz); pn = (wgid % nig) / gsz;
}
constexpr size_t TROW = (size_t)256 * 2048 * 2;
template <bool PERM_>
__device__ __forceinline__ void store_f32_tile(const f32x4 (&acc)[2][2][4][2], float* C, int ldc, int wr, int wc, int fr, int fq) {
    const int row0 = wr * 64 + fr, col0 = wc * 32 + (PERM_ ? 8 : 4) * fq;
#pragma unroll
    for (int ai = 0; ai < 2; ++ai)
#pragma unroll
        for (int m = 0; m < 4; ++m) { float* rowp = C + (size_t)(row0 + ai * HALF + m * 16) * ldc + col0;
#pragma unroll
            for (int bj = 0; bj < 2; ++bj)
#pragma unroll
                for (int n = 0; n < 2; ++n) *(f32x4*)(rowp + bj * HALF + n * (PERM_ ? 4 : 16)) = acc[ai][bj][m][n]; }
}
template <class Epi1, int ESZ = 2> struct Sched2 {
    const char* A0; const char* B0; int nM0, nN0; const char* A1; const char* B1; int nM1, nN1; int G, c;
    static constexpr size_t TR = TROW * ESZ / 2; static constexpr int NKT = 16 * ESZ;
    __device__ __forceinline__ bool next(int i, GUnit& u) const {
        int L = i * G + c; const int n0 = nM0 * nN0;
        if (L < n0) { tile_map(L, nM0, nN0, u.pm, u.pn); u.A = A0 + (size_t)u.pm * TR; u.B = B0 + (size_t)u.pn * TR; u.nkt = NKT; u.tag = 0; return true; }
        L -= n0; if (L >= nM1 * nN1) return false;
        tile_map(L, nM1, nN1, u.pm, u.pn); u.A = A1 + (size_t)u.pm * TR; u.B = B1 + (size_t)u.pn * TR; u.nkt = NKT; u.tag = 1; return true;
    }
};
template <class Epi1> struct EpiS2 {
    static constexpr bool PERM = true;
    EpiBf16 e0; Epi1 e1;
    __device__ __forceinline__ void operator()(const f32x4 (&acc)[2][2][4][2], const GUnit& g, int wr, int wc, int fr, int fq) const {
        const Unit u{g.pm, g.pn}; if (g.tag == 0) e0(acc, u, wr, wc, fr, fq); else e1(acc, u, wr, wc, fr, fq); }
};
template <int ESZ> struct Sched1 {
    const char* A; const char* B; int nM, nN, G, c;
    static constexpr size_t TR = TROW * ESZ / 2; static constexpr int NKT = 16 * ESZ;
    __device__ __forceinline__ bool next(int i, GUnit& u) const {
        const int L = i * G + c; if (L >= nM * nN) return false;
        tile_map(L, nM, nN, u.pm, u.pn); u.A = A + (size_t)u.pm * TR; u.B = B + (size_t)u.pn * TR; u.nkt = NKT; u.tag = 0; return true;
    }
};
template <class Epi0> struct EpiG {
    static constexpr bool PERM = Epi0::PERM;
    Epi0 e0;
    __device__ __forceinline__ void operator()(const f32x4 (&acc)[2][2][4][2], const GUnit& g, int wr, int wc, int fr, int fq) const { const Unit u{g.pm, g.pn}; e0(acc, u, wr, wc, fr, fq); }
};
struct SchedTail {
    const char* A; const char* B; int nM, nN; bool ctx_is_row;
    int G, c;
    __device__ __forceinline__ bool next(int i, GUnit& u) const {
        int L = i * G + c; const int n0 = nM * nN;
        if (L < n0) { tile_map(L, nM, nN, u.pm, u.pn); u.A = A + (size_t)u.pm * TROW; u.B = B + (size_t)u.pn * TROW; u.nkt = 32; u.tag = 0; return true; }
        L -= n0; const int nt_ = ctx_is_row ? nN : nM; if (L >= nt_ * 8) return false;
        const int t = L >> 3, sl = L & 7;
        u.pm = ctx_is_row ? nM : t; u.pn = ctx_is_row ? t : nN;
        u.A = A + (size_t)u.pm * TROW + (size_t)sl * 512; u.B = B + (size_t)u.pn * TROW + (size_t)sl * 512; u.nkt = 4; u.tag = 1 + sl + 8 * t; return true;
    }
};
template <bool PERM_, class Epi0> struct EpiTail {
    static constexpr bool PERM = PERM_;
    Epi0 e0; float* slab;
    __device__ __forceinline__ void operator()(const f32x4 (&acc)[2][2][4][2], const GUnit& g, int wr, int wc, int fr, int fq) const {
        if (g.tag == 0) { const Unit u{g.pm, g.pn}; e0(acc, u, wr, wc, fr, fq); }
        else { const int sl = (g.tag - 1) & 7, t = (g.tag - 1) >> 3; store_f32_tile<PERM_>(acc, slab + ((size_t)(sl * 8 + t) << 16), 256, wr, wc, fr, fq); }
    }
};
}
template <class Epi>
__device__ __forceinline__ void run_gemm(LAS unsigned char* lds, const bf16_t* A, const bf16_t* Bt, int M, int N, int K, const Epi& E) {
    pg8::Gemm g{A, Bt, M, N, K};
    pg8::StaticOrder S; S.init(M, N, (int)gridDim.x, (int)blockIdx.x);
    pg8::gemm_phase(lds, g, S, E);
    __syncthreads();
}
struct Params {
    const float* in[32];
    float* out;
    unsigned char* ws;
};
__device__ __forceinline__ unsigned char* get_ws() { const __attribute__((address_space(4))) char* ka = (const __attribute__((address_space(4))) char*)__builtin_amdgcn_kernarg_segment_ptr();
    unsigned long long w = *(const __attribute__((address_space(4))) unsigned long long*)(ka + __builtin_offsetof(Params, ws)); asm volatile("" : "+s"(w));
    return (unsigned char*)(__attribute__((address_space(1))) unsigned char*)w; }
__device__ __forceinline__ Params fresh(const Params& p) { Params q = p; q.ws = get_ws(); return q; }
enum { I_X = 0, I_C, I_CTX, I_CCTX, I_ADAW, I_ADAB, I_LNW, I_LNB, I_ABWIN, I_HYCW, I_HYCB, I_FW1, I_FB1, I_FW2, I_FB2, I_FW3, I_FB3, I_FW4, I_HYSKIP, I_RPB, I_ABWOUT,
       I_MLWIN, I_MLBG, I_MLCW, I_MLCB, I_MLNW, I_MLWOUT, I_PWQ, I_PK1, I_PK2, I_PU, I_PV };

template <bool F8>
__device__ __forceinline__ void task_transpose(LAS float* tile, const float* __restrict__ src, int ld, int ncols, bf16_t* __restrict__ dst, int K, int k0, int n_src0, int n_dst0) {
    const int tid = otid();
    const int nn = tid & 63, kb = tid >> 6;
    const bool ok = n_src0 + nn < ncols;
    const float* sp = src + (size_t)(k0 + kb) * ld + n_src0 + nn;
#pragma unroll
    for (int h = 0; h < 2; ++h) { float v[16];
#pragma unroll
        for (int it = 0; it < 16; ++it) v[it] = ok ? sp[(size_t)((h * 16 + it) * 8) * ld] : 0.f;
#pragma unroll
        for (int it = 0; it < 16; ++it) tile[nn * 257 + (h * 16 + it) * 8 + kb] = v[it]; }
    __syncthreads();
    if (F8) {
        unsigned char* d8 = (unsigned char*)dst;
#pragma unroll
        for (int it = 0; it < 8; ++it) { const int i = tid + it * 512, n2 = i >> 6, kq = i & 63; const LAS float* tp = tile + n2 * 257 + 4 * kq;
            *(unsigned*)(d8 + (size_t)(n_dst0 + n2) * K + k0 + 4 * kq) = fp8x4(clamp8(tp[0] * G8_WS), clamp8(tp[1] * G8_WS), clamp8(tp[2] * G8_WS), clamp8(tp[3] * G8_WS)); }
    } else {
#pragma unroll
        for (int it = 0; it < 16; ++it) { const int i = tid + it * 512, n2 = i >> 7, kp = i & 127;
            const float a = tile[n2 * 257 + 2 * kp], b = tile[n2 * 257 + 2 * kp + 1];
            *(unsigned*)(dst + (size_t)(n_dst0 + n2) * K + k0 + 2 * kp) = pk_bf16(a, b); }
    }
    __syncthreads();
}
__device__ __forceinline__ void task_convert(const float* __restrict__ src, unsigned char* __restrict__ dst, float scale) {
    const int tid = otid();
#pragma unroll 2
    for (int it = 0; it < 8; ++it) { const size_t i = ((size_t)it * 512 + tid) * 16;
        u32x4 w;
#pragma unroll
        for (int q = 0; q < 4; ++q) { const f32x4 a = *(const f32x4*)(src + i + 4 * q) * scale;
            int v = 0; v = __builtin_amdgcn_cvt_pk_fp8_f32(a[0], a[1], v, false); v = __builtin_amdgcn_cvt_pk_fp8_f32(a[2], a[3], v, true);
            if (q == 0) w.x = (unsigned)v; else if (q == 1) w.y = (unsigned)v; else if (q == 2) w.z = (unsigned)v; else w.w = (unsigned)v; }
        *(u32x4*)(dst + i) = w; }
}
__device__ __forceinline__ void task_wqk(LAS float* lds, const float* __restrict__ wq, const float* __restrict__ keys, bf16_t* __restrict__ dstT, int hh, int jt) {
    LAS float* km = lds;
    LAS float* wt = lds + 128 * 129;
    const int tid = otid();
    for (int i = tid; i < 128 * 128; i += 512) { const int n = i >> 7, d = i & 127; km[n * 129 + d] = keys[i]; }
    for (int i = tid; i < 64 * 128; i += 512) { const int j = i >> 7, d = i & 127; wt[j * 129 + d] = wq[(size_t)(jt * 64 + j) * 2048 + hh * 128 + d]; }
    __syncthreads();
    const int ns = tid & 31, js = tid >> 5;
    float acc[4][4];
#pragma unroll
    for (int a = 0; a < 4; ++a)
#pragma unroll
        for (int b = 0; b < 4; ++b) acc[a][b] = 0.f;
    for (int d = 0; d < 128; ++d) {
        float kv[4], wv[4];
#pragma unroll
        for (int a = 0; a < 4; ++a) kv[a] = km[(ns + 32 * a) * 129 + d];
#pragma unroll
        for (int b = 0; b < 4; ++b) wv[b] = wt[(js + 16 * b) * 129 + d];
#pragma unroll
        for (int a = 0; a < 4; ++a)
#pragma unroll
            for (int b = 0; b < 4; ++b) acc[a][b] = fmaf(kv[a], wv[b], acc[a][b]);
    }
    __syncthreads();
    LAS float* ot = wt;
#pragma unroll
    for (int a = 0; a < 4; ++a)
#pragma unroll
        for (int b = 0; b < 4; ++b) ot[(ns + 32 * a) * 65 + js + 16 * b] = acc[a][b];
    __syncthreads();
#pragma unroll
    for (int it = 0; it < 8; ++it) { const int i = tid + it * 512, n = i >> 5, jp = i & 31;
        *(unsigned*)(dstT + (size_t)(hh * 128 + n) * 2048 + jt * 64 + 2 * jp) = pk_bf16(ot[n * 65 + 2 * jp], ot[n * 65 + 2 * jp + 1]); }
    __syncthreads();
}
__device__ __forceinline__ void task_ada(LAS float* lds, const float* __restrict__ c, const float* __restrict__ cc, const float* __restrict__ W, const float* __restrict__ bias,
                                         float* __restrict__ out_lat, float* __restrict__ out_ctx, int n0) {
    LAS float* sl = lds; LAS float* sc = lds + 2048; LAS float* red = lds + 4096;
    const int tid = otid(), w = tid >> 6, lane = tid & 63;
    for (int i = tid; i < 2048; i += 512) { sl[i] = silu_f(c[i]); sc[i] = silu_f(cc[i]); }
    __syncthreads();
    float al = 0.f, ac = 0.f;
    const float* wp = W + (size_t)(w * 256) * 12288 + n0 + lane;
#pragma unroll 8
    for (int k = 0; k < 256; ++k) { const float wv = wp[(size_t)k * 12288]; al = fmaf(sl[w * 256 + k], wv, al); ac = fmaf(sc[w * 256 + k], wv, ac); }
    red[(w * 64 + lane) * 2] = al; red[(w * 64 + lane) * 2 + 1] = ac;
    __syncthreads();
    if (tid < 64) { float a = 0.f, b = 0.f;
#pragma unroll
        for (int ww = 0; ww < 8; ++ww) { a += red[(ww * 64 + tid) * 2]; b += red[(ww * 64 + tid) * 2 + 1]; }
        out_lat[n0 + tid] = a + bias[n0 + tid]; out_ctx[n0 + tid] = b + bias[n0 + tid]; }
    __syncthreads();
}
__device__ __forceinline__ void task_a3(const Params& p, LAS float* lds, bf16_t* __restrict__ a3, int task) {
    const int tid = otid(), w = tid >> 6, lane = tid & 63;
    LAS float* W2s = lds; LAS float* W3s = lds + 4096; LAS float* hb = lds + 8192 + w * 128;
    for (int i = tid; i < 4096; i += 512) { W2s[i] = p.in[I_FW2][i]; W3s[i] = p.in[I_FW3][i]; }
    __syncthreads();
    const float* W1 = p.in[I_FW1];
    float w1[33];
#pragma unroll
    for (int f = 0; f < 33; ++f) w1[f] = W1[f * 64 + lane];
    const float b1 = p.in[I_FB1][lane], b2 = p.in[I_FB2][lane], b3 = p.in[I_FB3][lane];
    const float freq = 1e-4f + (float)(lane & 15) * ((15.0f - 1e-4f) / 15.0f);
#pragma unroll 1
    for (int i = 0; i < (w == 0 ? 9 : 8); ++i) {
        const int pos = task * 65 + (i < 8 ? w * 8 + i : 64);
        const int n = pos < TL ? pos : pos - TL; const int L = pos < TL ? TL : TCX;
        const float tl = (float)n / (float)(L - 1);
        const float omega = 6.283185307179586f * (float)n / (float)L;
        float sn, cs; sincosf(omega * freq, &sn, &cs);
        float h = fmaf(tl, w1[0], b1);
#pragma unroll
        for (int b = 0; b < 16; ++b) { h = fmaf(__shfl(cs, b), w1[1 + b], h); h = fmaf(-__shfl(sn, b), w1[17 + b], h); }
        hb[lane] = sinf(h);
        __builtin_amdgcn_wave_barrier();
        float g = b2;
#pragma unroll 8
        for (int j = 0; j < 64; ++j) g = fmaf(hb[j], W2s[j * 64 + lane], g);
        hb[64 + lane] = sinf(g);
        __builtin_amdgcn_wave_barrier();
        float q = b3;
#pragma unroll 8
        for (int j = 0; j < 64; ++j) q = fmaf(hb[64 + j], W3s[j * 64 + lane], q);
        a3[(size_t)pos * 64 + lane] = f2bf(sinf(q));
        __builtin_amdgcn_wave_barrier();
    }
    __syncthreads();
}

constexpr int P0_NT_TR0 = 8 * 96, P0_NT_TRO = 8 * 32, P0_NT_TR1 = 8 * 100;
constexpr int P0_T0 = 0;
constexpr int P0_T1 = P0_T0 + P0_NT_TR0;
constexpr int P0_T2 = P0_T1 + P0_NT_TRO;
constexpr int P0_T3 = P0_T2 + P0_NT_TR1;
constexpr int P0_T4 = P0_T3 + P0_NT_TRO;
constexpr int P0_T5 = P0_T4 + 4 * 512;
constexpr int P0_T6 = P0_T5 + 1024;
constexpr int P0_T7 = P0_T6 + 384;
constexpr int P0_T8 = P0_T7 + 256;
constexpr int P0_NT = P0_T8 + 1;
constexpr int P0_T5B = P0_T5 + 512;
constexpr int P0_T6B = P0_T6 + 192;

__device__ __forceinline__ void phase0(const Params& p, LAS unsigned char* lds, int t_begin = 0, int t_end = P0_NT, int skip_blocks = 0) {
    LAS float* ldsf = (LAS float*)lds;
    unsigned char* ws = p.ws;
    if ((int)blockIdx.x < skip_blocks) return;
    for (int task = t_begin + (int)blockIdx.x - skip_blocks; task < t_end; task += (int)gridDim.x - skip_blocks) {
        if (task < P0_T1) {
            const int t = task - P0_T0, kt = t & 7, nt = t >> 3; const int nd = nt * 64;
            const int nsrc = nd < 3072 ? nd : (nd < 4096 ? 5120 + (nd - 3072) : 3072 + (nd - 4096));
#if F8_L0NA
            if (nd >= 3072) task_transpose<true>(ldsf, p.in[I_ABWIN], 6144, 6144, (bf16_t*)(ws + OFF_W0T + (size_t)3072 * 4096), 2048, kt * 256, nsrc, nd - 3072);
            else task_transpose<false>(ldsf, p.in[I_ABWIN], 6144, 6144, (bf16_t*)(ws + OFF_W0T), 2048, kt * 256, nsrc, nd);
#else
            task_transpose<F8_L0 != 0>(ldsf, p.in[I_ABWIN], 6144, 6144, (bf16_t*)(ws + OFF_W0T), 2048, kt * 256, nsrc, nd);
#endif
        } else if (task < P0_T2) {
            const int t = task - P0_T1, kt = t & 7, nt = t >> 3;
            task_transpose<false>(ldsf, p.in[I_ABWOUT], 2048, 2048, (bf16_t*)(ws + OFF_WO0T), 2048, kt * 256, nt * 64, nt * 64);
        } else if (task < P0_T3) {
            const int t = task - P0_T2, kt = t & 7, nt = t >> 3; const int nd = nt * 64;
            const int nsrc = nd < 2048 ? 2048 + nd : (nd < 4096 ? nd - 2048 : nd);
            task_transpose<F8_L1 != 0>(ldsf, p.in[I_MLWIN], 6176, 6176, (bf16_t*)(ws + OFF_W1T), 2048, kt * 256, nsrc, nd);
        } else if (task < P0_T4) {
            const int t = task - P0_T3, kt = t & 7, nt = t >> 3;
            task_transpose<F8_L1O != 0>(ldsf, p.in[I_MLWOUT], 2048, 2048, (bf16_t*)(ws + OFF_WO1T), 2048, kt * 256, nt * 64, nt * 64);
        } else if (task < P0_T5) {
            const int t = task - P0_T4, ti = t >> 9, ch = t & 511; const int layer = ti >> 1, which = ti & 1;
            task_convert((which ? p.in[I_PV] : p.in[I_PU]) + (size_t)layer * PEER_TBL + (size_t)ch * 65536, ws + OFF_PEER + (size_t)ti * PEER_TBL + (size_t)ch * 65536, which ? PEER_VSCALE : PEER_USCALE);
        } else if (task < P0_T6) {
            const int t = task - P0_T5, layer = t >> 9, hh = (t >> 5) & 15, jt = t & 31;
            task_wqk(ldsf, p.in[I_PWQ] + (size_t)layer * 2048 * 2048, ((hh & 1) ? p.in[I_PK2] : p.in[I_PK1]) + (size_t)layer * 16384, (bf16_t*)(ws + OFF_WQK) + (size_t)layer * 2048 * 2048, hh, jt);
        } else if (task < P0_T7) {
            const int t = task - P0_T6, layer = t / 192, ch = t % 192;
            float* mod = (float*)(ws + OFF_MOD) + (size_t)layer * 2 * 12288;
            task_ada(ldsf, p.in[I_C], p.in[I_CCTX], p.in[I_ADAW] + (size_t)layer * 2048 * 12288, p.in[I_ADAB] + (size_t)layer * 12288, mod, mod + 12288, ch * 64);
        } else if (task < P0_T8) {
            task_a3(p, ldsf, (bf16_t*)(ws + OFF_A3), task - P0_T7);
        } else {
            f32x2* rt = (f32x2*)(ws + OFF_ROPE);
            for (int i = otid(); i < 256 * 32; i += 512) { const int pos = i >> 5, q = i & 31;
                const float inv = expf(-(float)q * (9.210340371976184f / 32.0f)); float sn, cs; sincosf((float)pos * inv, &sn, &cs); rt[i] = (f32x2){cs, sn}; }
        }
    }
}

__device__ __forceinline__ void modulate_rows(const float* __restrict__ xlat, const float* __restrict__ xctx, const float* __restrict__ mod  , bf16_t* __restrict__ U, unsigned char* __restrict__ U8 = nullptr) {
    const int tid = otid(), w = tid >> 6, lane = tid & 63;
    const int stride = gridDim.x * 8;
    for (int r0 = blockIdx.x * 8 + w; r0 < MT; r0 += 2 * stride) {
        f32x4 xa[2][4], xb[2][4];
#pragma unroll
        for (int k = 0; k < 2; ++k) { const int r = r0 + k * stride; if (r < MT) { const float* src = r < TL ? xlat + (size_t)r * DM : xctx + (size_t)(r - TL) * DM;
#pragma unroll
            for (int pc = 0; pc < 4; ++pc) { const int e = pc * 512 + lane * 8; xa[k][pc] = *(const f32x4*)(src + e); xb[k][pc] = *(const f32x4*)(src + e + 4); } } }
#pragma unroll
        for (int k = 0; k < 2; ++k) { const int r = r0 + k * stride; if (r < MT) { const float* md = mod + (r < TL ? 0 : 12288);
#pragma unroll
            for (int pc = 0; pc < 4; ++pc) { const int e = pc * 512 + lane * 8;
                const f32x4 s0 = *(const f32x4*)(md + 2048 + e), s1 = *(const f32x4*)(md + 2048 + e + 4), h0 = *(const f32x4*)(md + e), h1 = *(const f32x4*)(md + e + 4);
                const f32x4 x = xa[k][pc] * (s0 + 1.f) + h0, y = xb[k][pc] * (s1 + 1.f) + h1;
#if F8_L0
                u32x2 o; o.x = fp8x4(clamp8(x[0] * G8_XS), clamp8(x[1] * G8_XS), clamp8(x[2] * G8_XS), clamp8(x[3] * G8_XS)); o.y = fp8x4(clamp8(y[0] * G8_XS), clamp8(y[1] * G8_XS), clamp8(y[2] * G8_XS), clamp8(y[3] * G8_XS));
                *(u32x2*)((unsigned char*)U + (size_t)r * DM + e) = o; } } }
#else
                u32x4 o; o.x = pk_bf16(x[0], x[1]); o.y = pk_bf16(x[2], x[3]); o.z = pk_bf16(y[0], y[1]); o.w = pk_bf16(y[2], y[3]);
                *(u32x4*)(U + (size_t)r * DM + e) = o;
#if F8_L0NA
                { u32x2 o8; o8.x = fp8x4(clamp8(x[0] * G8_XS), clamp8(x[1] * G8_XS), clamp8(x[2] * G8_XS), clamp8(x[3] * G8_XS)); o8.y = fp8x4(clamp8(y[0] * G8_XS), clamp8(y[1] * G8_XS), clamp8(y[2] * G8_XS), clamp8(y[3] * G8_XS));
                  *(u32x2*)(U8 + (size_t)r * DM + e) = o8; }
#endif
                } } }
#endif
    }
}
__device__ __forceinline__ void hyena_taps(const Params& p) {
    const int tid = otid(), w = tid >> 6, lane = tid & 63, fr = lane & 15, fq = lane >> 4;
    const bf16_t* a3 = (const bf16_t*)(p.ws + OFF_A3);
    const float* w4 = p.in[I_FW4];
    bf16_t* HmT = (bf16_t*)(p.ws + OFF_BIG1);
    bf16_t* HmC = HmT + (size_t)4096 * TL;
    const int NWT = 256 * 16 + 256;
    for (int wt = blockIdx.x * 8 + w; wt < NWT; wt += gridDim.x * 8) {
        const bool isctx = wt >= 4096;
        const int ct = isctx ? wt - 4096 : (wt >> 4), tch = isctx ? 0 : (wt & 15);
        const int col = ct * 16 + fr;
        bf16x8 bw[2];
#pragma unroll
        for (int ks = 0; ks < 2; ++ks)
#pragma unroll
            for (int j = 0; j < 8; ++j) bw[ks][j] = (short)f2bf(w4[(size_t)(ks * 32 + fq * 8 + j) * 4096 + col]);
        const int ch = col & 1023;
        const float mind = -3.0701134573253945f, maxd = -15.350567286626973f;
        const float delta = fabsf(mind + (maxd - mind) * ((float)ch / 1023.0f));
        const int nblk = isctx ? 4 : 16;
        const int t00 = isctx ? 0 : tch * 1024;
        const float invL1 = isctx ? (1.0f / 255.0f) : (1.0f / 16383.0f);
        for (int blk = 0; blk < nblk; ++blk) {
            const int t0 = t00 + blk * 64;
            f32x4 acc[4];
#pragma unroll
            for (int tau = 0; tau < 4; ++tau) {
                acc[tau] = (f32x4){0.f, 0.f, 0.f, 0.f};
                const int trow = t0 + 16 * (fr >> 2) + 4 * tau + (fr & 3);
                const bf16_t* ap = a3 + (size_t)((isctx ? TL : 0) + trow) * 64 + fq * 8;
                const bf16x8 a0 = *(const bf16x8*)(ap), a1 = *(const bf16x8*)(ap + 32);
                acc[tau] = __builtin_amdgcn_mfma_f32_16x16x32_bf16(a0, bw[0], acc[tau], 0, 0, 0);
                acc[tau] = __builtin_amdgcn_mfma_f32_16x16x32_bf16(a1, bw[1], acc[tau], 0, 0, 0);
            }
            unsigned o[8];
#pragma unroll
            for (int tau = 0; tau < 4; ++tau) {
                float v[4];
#pragma unroll
                for (int rg = 0; rg < 4; ++rg) { const int t = t0 + 16 * fq + 4 * tau + rg; v[rg] = acc[tau][rg] * __expf(-(float)t * invL1 * delta); }
                o[tau * 2] = pk_bf16(v[0], v[1]); o[tau * 2 + 1] = pk_bf16(v[2], v[3]);
            }
            bf16_t* dst = isctx ? HmC + (size_t)col * TCX + t0 + 16 * fq : HmT + (size_t)col * TL + t0 + 16 * fq;
            *(u32x4*)(dst) = (u32x4){o[0], o[1], o[2], o[3]};
            *(u32x4*)(dst + 8) = (u32x4){o[4], o[5], o[6], o[7]};
        }
    }
}
constexpr int HY_TW = 143360;
__device__ __forceinline__ f32x2 cmul(f32x2 a, f32x2 b) { return (f32x2){a.x * b.x - a.y * b.y, a.x * b.y + a.y * b.x}; }
__device__ __forceinline__ int fpad(int p) { return p + (p >> 4) + ((p >> 9) << 4); }
__device__ __forceinline__ int kpos(int k) { return fpad((k & 31) * 512 + ((k >> 5) & 31) * 16 + (k >> 10)); }
__host__ __device__ constexpr int brev_c(int q, int bits) { int r = 0; for (int i = 0; i < bits; ++i) r |= ((q >> i) & 1) << (bits - 1 - i); return r; }

template <int R, int LOGR, bool INV>
__device__ __forceinline__ void fft_regs(f32x2 (&v)[R]) {
    constexpr float C32[16] = {1.0f, 0.98078528040323043f, 0.92387953251128674f, 0.83146961230254524f, 0.70710678118654757f, 0.55557023301960229f, 0.38268343236508984f, 0.19509032201612833f,
                               0.0f, -0.19509032201612819f, -0.38268343236508973f, -0.55557023301960196f, -0.70710678118654746f, -0.83146961230254535f, -0.92387953251128674f, -0.98078528040323043f};
    constexpr float S32[16] = {0.0f, 0.19509032201612825f, 0.38268343236508978f, 0.55557023301960218f, 0.70710678118654746f, 0.83146961230254524f, 0.92387953251128674f, 0.98078528040323043f,
                               1.0f, 0.98078528040323043f, 0.92387953251128674f, 0.83146961230254546f, 0.70710678118654757f, 0.55557023301960218f, 0.38268343236508989f, 0.19509032201612861f};
#pragma unroll
    for (int s = 0; s < LOGR; ++s) {
        const int half = (R / 2) >> s;
#pragma unroll
        for (int start = 0; start < R; start += 2 * half) {
#pragma unroll
            for (int i = 0; i < half; ++i) {
                const f32x2 a = v[start + i], b = v[start + i + half];
                v[start + i] = a + b;
                const f32x2 d = a - b;
                const int e = i * (16 / half);
                if (e == 0) v[start + i + half] = d;
                else if (e == 8) v[start + i + half] = INV ? (f32x2){-d.y, d.x} : (f32x2){d.y, -d.x};
                else { const float c = C32[e], sn = INV ? S32[e] : -S32[e]; v[start + i + half] = (f32x2){d.x * c - d.y * sn, d.x * sn + d.y * c}; }
            }
        }
    }
}
template <int R, int LOGR, bool INV, bool TW>
__device__ __forceinline__ void fft_bfly(LAS f32x2* Z, int a0, int astride, f32x2 bw) {
    f32x2 v[R];
#pragma unroll
    for (int r = 0; r < R; ++r) v[r] = Z[a0 + r * astride];
    if (TW) {
        const f32x2 base = (f32x2){bw.x, INV ? -bw.y : bw.y};
        f32x2 tw = base;
        if (INV) {
#pragma unroll
            for (int q = 1; q < R; ++q) { v[q] = cmul(v[q], tw); tw = cmul(tw, base); }
            fft_regs<R, LOGR, INV>(v);
        } else {
            fft_regs<R, LOGR, INV>(v);
#pragma unroll
            for (int q = 1; q < R; ++q) { v[brev_c(q, LOGR)] = cmul(v[brev_c(q, LOGR)], tw); tw = cmul(tw, base); }
        }
    } else fft_regs<R, LOGR, INV>(v);
#pragma unroll
    for (int q = 0; q < R; ++q) Z[a0 + q * astride] = v[brev_c(q, LOGR)];
}
__device__ __forceinline__ void fft16k_fwd(LAS f32x2* Z) {
    const int tid = otid();
    const LAS f32x2* T1 = (const LAS f32x2*)((LAS unsigned char*)Z + HY_TW);
    fft_bfly<32, 5, false, true>(Z, tid + (tid >> 4), 560, T1[tid]);
    __syncthreads();
    { const int b = tid >> 4, j = tid & 15; fft_bfly<32, 5, false, true>(Z, 560 * b + j, 17, T1[32 * j]); }
    __syncthreads();
#pragma unroll
    for (int h = 0; h < 2; ++h) { const int bb = tid + 512 * h; fft_bfly<16, 4, false, false>(Z, 17 * bb + 16 * (bb >> 5), 1, (f32x2){1.f, 0.f}); }
    __syncthreads();
}
__device__ __forceinline__ void fft16k_inv(LAS f32x2* Z) {
    const int tid = otid();
#pragma unroll
    for (int h = 0; h < 2; ++h) { const int bb = tid + 512 * h; fft_bfly<16, 4, true, false>(Z, 17 * bb + 16 * (bb >> 5), 1, (f32x2){1.f, 0.f}); }
    __syncthreads();
    const LAS f32x2* T1 = (const LAS f32x2*)((LAS unsigned char*)Z + HY_TW);
    { const int b = tid >> 4, j = tid & 15; fft_bfly<32, 5, true, true>(Z, 560 * b + j, 17, T1[32 * j]); }
    __syncthreads();
    fft_bfly<32, 5, true, true>(Z, tid + (tid >> 4), 560, T1[tid]);
    __syncthreads();
}
__device__ __forceinline__ int pair_k(int tid, int jj) { return ((tid >> 8) * 16 + jj) + 32 * ((tid >> 3) & 31) + 1024 * (tid & 7); }

__device__ __forceinline__ void hy_stash(LAS f32x2* Z, f32x4 (&st)[16], f32x4& stx) {
    const int tid = otid();
#pragma unroll
    for (int jj = 0; jj < 16; ++jj) { const int k = pair_k(tid, jj), kp = (16384 - k) & 16383;
        const f32x2 A = Z[kpos(k)], Bc = Z[kpos(kp)]; const f32x2 B = (f32x2){Bc.x, -Bc.y};
        const f32x2 S = A + B, Dd = A - B;
        st[jj] = (f32x4){0.5f * S.x, 0.5f * S.y, 0.5f * Dd.y, -0.5f * Dd.x}; }
    { const f32x2 A = Z[kpos(8192)]; stx = (f32x4){A.x, 0.f, A.y, 0.f}; }
}
__device__ __forceinline__ void hy_pointwise_one(LAS f32x2* Z, int k, const f32x4 hh, bool do_write) {
    const int kp = (16384 - k) & 16383; const int pa = kpos(k), pb = kpos(kp);
    const f32x2 A = Z[pa], Bc = Z[pb]; const f32x2 B = (f32x2){Bc.x, -Bc.y};
    const f32x2 S = A + B, Dd = A - B;
    const f32x2 Xe = (f32x2){0.5f * S.x, 0.5f * S.y}, Xo = (f32x2){0.5f * Dd.y, -0.5f * Dd.x};
    const f32x2 He = (f32x2){hh.x, hh.y}, Ho = (f32x2){hh.z, hh.w};
    const LAS f32x2* T1 = (const LAS f32x2*)((LAS unsigned char*)Z + HY_TW);
    const f32x2 w2 = cmul(T1[k & 511], T1[512 + (k >> 9)]);
    const f32x2 P = cmul(Xe, He) + cmul(w2, cmul(Xo, Ho));
    const f32x2 Q = cmul(Xe, Ho) + cmul(Xo, He);
    if (do_write) { Z[pa] = (f32x2){P.x - Q.y, P.y + Q.x}; Z[pb] = (f32x2){P.x + Q.y, Q.x - P.y}; }
}
__device__ __forceinline__ void hy_pointwise(LAS f32x2* Z, const f32x4 (&st)[16], const f32x4& stx) {
    const int tid = otid();
#pragma unroll
    for (int jj = 0; jj < 16; ++jj) hy_pointwise_one(Z, pair_k(tid, jj), st[jj], true);
    hy_pointwise_one(Z, 8192, stx, tid == 0);
    __syncthreads();
}
__device__ __forceinline__ void ld32bf(const bf16_t* __restrict__ p, float (&o)[32]) {
#pragma unroll
    for (int q = 0; q < 4; ++q) { const u32x4 w = *(const u32x4*)(p + q * 8);
        o[q * 8 + 0] = bflo(w.x); o[q * 8 + 1] = bfhi(w.x); o[q * 8 + 2] = bflo(w.y); o[q * 8 + 3] = bfhi(w.y);
        o[q * 8 + 4] = bflo(w.z); o[q * 8 + 5] = bfhi(w.z); o[q * 8 + 6] = bflo(w.w); o[q * 8 + 7] = bfhi(w.w); }
}
__device__ __forceinline__ void conv32(const bf16_t* __restrict__ row, int t0, int len, float w0, float w1, float w2, float cb, float (&o)[32]) {
    float x[32]; ld32bf(row + t0, x);
    const float xm = t0 > 0 ? bf2f(row[t0 - 1]) : 0.f, xp = (t0 + 32 < len) ? bf2f(row[t0 + 32]) : 0.f;
#pragma unroll
    for (int i = 0; i < 32; ++i) { const float a = i > 0 ? x[i - 1] : xm, c = i < 31 ? x[i + 1] : xp; o[i] = cb + w0 * a + w1 * x[i] + w2 * c; }
}
__device__ __forceinline__ void hy_load_taps(LAS f32x2* Z, const bf16_t* __restrict__ hf, const bf16_t* __restrict__ hb) {
    const int tid = otid();
    { float x[32]; ld32bf(hf + 32 * tid, x);
#pragma unroll
      for (int i = 0; i < 16; ++i) Z[fpad(16 * tid + i)] = (f32x2){x[2 * i], x[2 * i + 1]}; }
    { const int e0 = 16384 - 32 * tid; float x[32]; ld32bf(hb + e0 - 32, x);
      const float ex = (e0 < 16384) ? bf2f(hb[e0]) : 0.f;
#pragma unroll
      for (int i = 0; i < 16; ++i) Z[fpad(8192 + 16 * tid + i)] = (f32x2){i == 0 ? ex : x[32 - 2 * i], x[31 - 2 * i]}; }
    __syncthreads();
}
__device__ __forceinline__ void hy_load_data(LAS f32x2* Z, const float (&zc)[32]) {
    const int tid = otid();
#pragma unroll
    for (int i = 0; i < 16; ++i) { Z[fpad(16 * tid + i)] = (f32x2){zc[2 * i], zc[2 * i + 1]}; Z[fpad(8192 + 16 * tid + i)] = (f32x2){0.f, 0.f}; }
    __syncthreads();
}
__device__ __forceinline__ void hy_get_z(const Params& p, int o, int c, int t0, float (&zc)[32]) {
    if (o == 0) { const bf16_t* PRE = (const bf16_t*)(p.ws + OFF_BIG2); const float* cw = p.in[I_HYCW];
        conv32(PRE + (size_t)c * MT, t0, TL, cw[c], cw[3072 + c], cw[6144 + c], p.in[I_HYCB][c], zc);
    } else { const float* ZS = (const float*)(p.ws + OFF_X) + (size_t)c * TL + t0;
#pragma unroll
        for (int q = 0; q < 8; ++q) { const f32x4 v = *(const f32x4*)(ZS + 4 * q); zc[4 * q] = v[0]; zc[4 * q + 1] = v[1]; zc[4 * q + 2] = v[2]; zc[4 * q + 3] = v[3]; } }
}
__device__ __forceinline__ void hyena_channel(const Params& p, LAS f32x2* Z, int c) {
    const int tid = otid();
    const bf16_t* PRE = (const bf16_t*)(p.ws + OFF_BIG2);
    const bf16_t* HmT = (const bf16_t*)(p.ws + OFF_BIG1);
    bf16_t* hyT = (bf16_t*)(p.ws + OFF_HYT);
    float* ZS = (float*)(p.ws + OFF_X);
    const float* cw = p.in[I_HYCW]; const float* cbias = p.in[I_HYCB]; const float* skip = p.in[I_HYSKIP];
    const int t0 = 32 * tid;
#pragma unroll 1
    for (int o = 0; o < 2; ++o) {
        f32x4 st[16], stx;
        hy_load_taps(Z, HmT + (size_t)(o * 1024 + c) * TL, HmT + (size_t)(2048 + o * 1024 + c) * TL);
        fft16k_fwd(Z);
        hy_stash(Z, st, stx);
        __syncthreads();
        { float zc[32]; hy_get_z(p, o, c, t0, zc); hy_load_data(Z, zc); }
        fft16k_fwd(Z);
        hy_pointwise(Z, st, stx);
        fft16k_inv(Z);
        {
            const int gr = (o + 1) * 1024 + c;
            float zc[32]; hy_get_z(p, o, c, t0, zc);
            float g[32]; conv32(PRE + (size_t)gr * MT, t0, TL, cw[gr], cw[3072 + gr], cw[6144 + gr], cbias[gr], g);
            const float sk = skip[o * 1024 + c];
#pragma unroll
            for (int i = 0; i < 16; ++i) { const f32x2 y = Z[fpad(16 * tid + i)];
                zc[2 * i] = g[2 * i] * (y.x * (1.0f / 16384.0f) + sk * zc[2 * i]); zc[2 * i + 1] = g[2 * i + 1] * (y.y * (1.0f / 16384.0f) + sk * zc[2 * i + 1]); }
            if (o == 0) {
#pragma unroll
                for (int q = 0; q < 8; ++q) *(f32x4*)(ZS + (size_t)c * TL + t0 + 4 * q) = (f32x4){zc[4 * q], zc[4 * q + 1], zc[4 * q + 2], zc[4 * q + 3]};
            } else {
                bf16_t* dst = hyT + (size_t)c * MT + t0;
#pragma unroll
                for (int q = 0; q < 4; ++q) { u32x4 w; w.x = pk_bf16(zc[q * 8], zc[q * 8 + 1]); w.y = pk_bf16(zc[q * 8 + 2], zc[q * 8 + 3]); w.z = pk_bf16(zc[q * 8 + 4], zc[q * 8 + 5]); w.w = pk_bf16(zc[q * 8 + 6], zc[q * 8 + 7]);
                    *(u32x4*)(dst + q * 8) = w; }
            }
        }
        __syncthreads();
    }
}
__device__ __forceinline__ void hyena_ctx_channel(const Params& p, LAS float* wl, int c) {
    const int lane = otid() & 63;
    const bf16_t* PRE = (const bf16_t*)(p.ws + OFF_BIG2);
    const bf16_t* HmC = (const bf16_t*)(p.ws + OFF_BIG1) + (size_t)4096 * TL;
    bf16_t* hyT = (bf16_t*)(p.ws + OFF_HYT);
    const float* cw = p.in[I_HYCW]; const float* cbias = p.in[I_HYCB]; const float* skip = p.in[I_HYSKIP];
    LAS float* zs = wl; LAS float* tp = wl + 256;
    float z[4];
    {
        const bf16_t* row = PRE + (size_t)c * MT + TL;
        float x[6];
#pragma unroll
        for (int i = 0; i < 6; ++i) { const int t = 4 * lane - 1 + i; x[i] = (t >= 0 && t < TCX) ? bf2f(row[t]) : 0.f; }
#pragma unroll
        for (int i = 0; i < 4; ++i) z[i] = cbias[c] + cw[c] * x[i] + cw[3072 + c] * x[i + 1] + cw[6144 + c] * x[i + 2];
    }
#pragma unroll 1
    for (int o = 0; o < 2; ++o) {
        const bf16_t* hf = HmC + (size_t)(o * 1024 + c) * TCX; const bf16_t* hb = HmC + (size_t)(2048 + o * 1024 + c) * TCX;
#pragma unroll
        for (int i = 0; i < 4; ++i) { const int d = 4 * lane + i; zs[d] = z[i]; tp[255 + d] = bf2f(hf[d]); if (d > 0) tp[255 - d] = bf2f(hb[d]); }
        __builtin_amdgcn_s_waitcnt(0);
        __builtin_amdgcn_wave_barrier();
        float y[4] = {0.f, 0.f, 0.f, 0.f};
        for (int s = 0; s < 256; ++s) { const float zv = zs[s];
#pragma unroll
            for (int i = 0; i < 4; ++i) y[i] = fmaf(tp[255 + 4 * lane + i - s], zv, y[i]); }
        const int gr = (o + 1) * 1024 + c;
        const bf16_t* row = PRE + (size_t)gr * MT + TL;
        float x[6];
#pragma unroll
        for (int i = 0; i < 6; ++i) { const int t = 4 * lane - 1 + i; x[i] = (t >= 0 && t < TCX) ? bf2f(row[t]) : 0.f; }
        const float sk = skip[o * 1024 + c];
#pragma unroll
        for (int i = 0; i < 4; ++i) { const float g = cbias[gr] + cw[gr] * x[i] + cw[3072 + gr] * x[i + 1] + cw[6144 + gr] * x[i + 2]; z[i] = g * (y[i] + sk * z[i]); }
        __builtin_amdgcn_wave_barrier();
    }
    *(u32x2*)(hyT + (size_t)c * MT + TL + 4 * lane) = (u32x2){pk_bf16(z[0], z[1]), pk_bf16(z[2], z[3])};
}

constexpr int NA_KS = 0;
constexpr int NA_VS = 34816;
__device__ __forceinline__ void na_block_task(const Params& p, LAS unsigned char* lds, int task) {
    const int tid = otid(), wv = __builtin_amdgcn_readfirstlane(tid >> 6), lane = tid & 63, fr = lane & 15, fq = lane >> 4;
    const bf16_t* QK = (const bf16_t*)(p.ws + OFF_QK);
    const bf16_t* VT = (const bf16_t*)(p.ws + OFF_BIG2) + (size_t)3072 * MT;
    bf16_t* A2 = (bf16_t*)(p.ws + OFF_A);
    const float* rpb = p.in[I_RPB];
    const float scale = 0.08838834764831845f;
    const int hl = wv >> 2;
    int hp, qrow, nlat, r = 0, g = 0, r0 = 0, cb = 0;
    if (task < 1024) { hp = task & 3; r = task >> 2; g = wv & 3; qrow = r * 64 + 16 * g + fr; nlat = 8;
        r0 = r - 4; r0 = r0 < 0 ? 0 : (r0 > 248 ? 248 : r0); cb = 16 * g - 8; cb = cb < 0 ? 0 : (cb > 32 ? 32 : cb);
    } else { const int t = task - 1024; hp = t & 3; qrow = TL + 16 * (4 * (t >> 2) + (wv & 3)) + fr; nlat = 0; }
    const int h = 2 * hp + hl;
    const unsigned so_k = (unsigned)((tid >> 3) * 2048 + (tid & 7) * 8);
    const unsigned so_v = (unsigned)((tid >> 1) * MT + (tid & 1) * 32);
    u32x4 sk[4], sv[4];
#define NA_LOAD(tk0_) do { const bf16_t* kb_ = QK + (size_t)(tk0_) * 2048 + 1024 + hp * 256; const bf16_t* vb_ = VT + (size_t)(hp * 256) * MT + (tk0_); \
        _Pragma("unroll") for (int j = 0; j < 4; ++j) { sk[j] = *(const u32x4*)(kb_ + so_k + 64u * j); sv[j] = *(const u32x4*)(vb_ + so_v + 8u * j); } } while (0)
#define NA_STORE() do { _Pragma("unroll") for (int j = 0; j < 4; ++j) { \
        *(LAS u32x4*)(lds + NA_KS + (j >> 1) * 17408 + (tid >> 3) * 272 + ((tid & 7) * 8 + 64 * (j & 1)) * 2) = sk[j]; \
        *(LAS u32x4*)(lds + NA_VS + (tid >> 1) * 144 + ((tid & 1) * 32 + 8 * j) * 2) = sv[j]; } } while (0)
    bf16x8 qf[4];
#pragma unroll
    for (int ks = 0; ks < 4; ++ks) qf[ks] = *(const bf16x8*)(QK + (size_t)qrow * 2048 + h * 128 + ks * 32 + fq * 8);
    f32x4 oacc[8];
#pragma unroll
    for (int dt = 0; dt < 8; ++dt) oacc[dt] = (f32x4){0.f, 0.f, 0.f, 0.f};
    float mrun = -1e30f, lrun = 0.f;
    const int c = 16 * g + fr;
    int cs = c - 8; cs = cs < 0 ? 0 : (cs > 48 ? 48 : cs);
    const int nsteps = nlat + 4;
    __syncthreads();
    { const int tk0 = nlat ? r0 * 64 : TL; NA_LOAD(tk0); NA_STORE(); }
    __syncthreads();
    LAS unsigned char* Kh = lds + NA_KS + hl * 17408;
    LAS unsigned char* Vh = lds + NA_VS + hl * 128 * 144;
#pragma unroll 1
    for (int step = 0; step < nsteps; ++step) {
        const bool lat = step < nlat;
        if (step + 1 < nsteps) { const int tk1 = (step + 1 < nlat) ? (r0 + step + 1) * 64 : TL + 64 * (step + 1 - nlat); NA_LOAD(tk1); }
        const int kr = r0 + step;
        const int nsub = lat ? 1 : 2;
#pragma unroll 1
        for (int sub = 0; sub < nsub; ++sub) {
            const int kb = lat ? cb : 32 * sub;
            f32x4 s[2];
#pragma unroll
            for (int tl = 0; tl < 2; ++tl) {
                s[tl] = (f32x4){0.f, 0.f, 0.f, 0.f};
#pragma unroll
                for (int ks = 0; ks < 4; ++ks) { const bf16x8 kf = *(const LAS bf16x8*)(Kh + (kb + 16 * tl + fr) * 272 + 64 * ks + 16 * fq);
                    s[tl] = __builtin_amdgcn_mfma_f32_16x16x32_bf16(kf, qf[ks], s[tl], 0, 0, 0); }
            }
            float svv[8]; float mx = -1e30f;
#pragma unroll
            for (int tl = 0; tl < 2; ++tl)
#pragma unroll
                for (int rg = 0; rg < 4; ++rg) {
                    float v = s[tl][rg] * scale;
                    if (lat) { const int kc = kb + 16 * tl + 4 * fq + rg; const bool ok = (kc >= cs) && (kc < cs + 16);
                        const int ro = kr - r + 7, co = kc - c + 15;
                        const float bias = ok ? rpb[(h * 15 + ro) * 31 + co] : 0.f;
                        v = ok ? v + bias : -1e30f; }
                    svv[tl * 4 + rg] = v; mx = fmaxf(mx, v);
                }
            mx = fmaxf(mx, __shfl_xor(mx, 16)); mx = fmaxf(mx, __shfl_xor(mx, 32));
            const float mnew = fmaxf(mrun, mx);
            const float alpha = __expf(mrun - mnew);
            float ps = 0.f; float pv[8];
#pragma unroll
            for (int i = 0; i < 8; ++i) { pv[i] = (svv[i] > -1e29f) ? __expf(svv[i] - mnew) : 0.f; ps += pv[i]; }
            ps += __shfl_xor(ps, 16); ps += __shfl_xor(ps, 32);
            lrun = lrun * alpha + ps; mrun = mnew;
            bf16x8 pf;
            { const u32x4 w = (u32x4){pk_bf16(pv[0], pv[1]), pk_bf16(pv[2], pv[3]), pk_bf16(pv[4], pv[5]), pk_bf16(pv[6], pv[7])}; pf = __builtin_bit_cast(bf16x8, w); }
#pragma unroll
            for (int dt = 0; dt < 8; ++dt) {
                oacc[dt] *= alpha;
                LAS unsigned char* vp = Vh + (dt * 16 + fr) * 144 + (kb + 4 * fq) * 2;
                const u32x2 va = *(const LAS u32x2*)(vp), vb = *(const LAS u32x2*)(vp + 32);
                const u32x4 vw = (u32x4){va.x, va.y, vb.x, vb.y};
                oacc[dt] = __builtin_amdgcn_mfma_f32_16x16x32_bf16(__builtin_bit_cast(bf16x8, vw), pf, oacc[dt], 0, 0, 0);
            }
        }
        __syncthreads();
        if (step + 1 < nsteps) NA_STORE();
        __syncthreads();
    }
#undef NA_LOAD
#undef NA_STORE
    const float inv = 1.0f / lrun;
#pragma unroll
    for (int dt = 0; dt < 8; ++dt) {
        const f32x4 o = oacc[dt] * inv;
        *(u32x2*)(A2 + (size_t)qrow * 2048 + 1024 + h * 128 + dt * 16 + 4 * fq) = (u32x2){pk_bf16(o[0], o[1]), pk_bf16(o[2], o[3])};
    }
}

__device__ __forceinline__ void phase3(const Params& p, LAS unsigned char* lds, int which = 7) {
    const int tid = otid(), w = tid >> 6;
    {
        LAS f32x2* T1 = (LAS f32x2*)(lds + HY_TW); float sn, cs;
        sincospif((float)tid * (1.0f / 8192.0f), &sn, &cs); T1[tid] = (f32x2){cs, -sn};
        if (tid < 17) { sincospif((float)tid * (1.0f / 16.0f), &sn, &cs); T1[512 + tid] = (f32x2){cs, -sn}; }
        __syncthreads();
    }
    if (which & 1) for (int c = blockIdx.x; c < 1024; c += gridDim.x) hyena_channel(p, (LAS f32x2*)lds, c);
    __syncthreads();
    if (which & 2) for (int c = blockIdx.x * 8 + w; c < 1024; c += gridDim.x * 8) hyena_ctx_channel(p, (LAS float*)lds + w * 768, c);
    __syncthreads();
    if (which & 4) for (int t = blockIdx.x; t < 1024 + 16; t += gridDim.x) na_block_task(p, lds, t);
}

__device__ __forceinline__ void phase4(const Params& p, LAS unsigned char* lds) {
    LAS unsigned short* tile = (LAS unsigned short*)lds;
    const bf16_t* hyT = (const bf16_t*)(p.ws + OFF_HYT);
    bf16_t* A2 = (bf16_t*)(p.ws + OFF_A);
    const int tid = otid();
    for (int task = blockIdx.x; task < 16 * 260; task += gridDim.x) {
        const int ct = task & 15, rt = task >> 4;
#pragma unroll
        for (int it = 0; it < 4; ++it) { const int i = tid + it * 512, cc = i >> 5, rp = i & 31;
            const unsigned v = *(const unsigned*)(hyT + (size_t)(ct * 64 + cc) * MT + rt * 64 + 2 * rp);
            tile[cc * 66 + 2 * rp] = (unsigned short)(v & 0xFFFFu); tile[cc * 66 + 2 * rp + 1] = (unsigned short)(v >> 16); }
        __syncthreads();
#pragma unroll
        for (int it = 0; it < 4; ++it) { const int i = tid + it * 512, rr = i >> 5, cp = i & 31;
            const unsigned lo = tile[(2 * cp) * 66 + rr], hi = tile[(2 * cp + 1) * 66 + rr];
            *(unsigned*)(A2 + (size_t)(rt * 64 + rr) * 2048 + ct * 64 + 2 * cp) = (lo | (hi << 16)); }
        __syncthreads();
    }
}
__device__ __forceinline__ void ld8(const float* __restrict__ p, float (&o)[8]) { const f32x4 a = *(const f32x4*)p, b = *(const f32x4*)(p + 4);
    o[0] = a[0]; o[1] = a[1]; o[2] = a[2]; o[3] = a[3]; o[4] = b[0]; o[5] = b[1]; o[6] = b[2]; o[7] = b[3]; }
__device__ __forceinline__ void st8(float* __restrict__ p, const float (&o)[8]) { *(f32x4*)p = (f32x4){o[0], o[1], o[2], o[3]}; *(f32x4*)(p + 4) = (f32x4){o[4], o[5], o[6], o[7]}; }
__device__ __forceinline__ void st8bf(bf16_t* __restrict__ p, const float (&o)[8]) { *(u32x4*)p = (u32x4){pk_bf16(o[0], o[1]), pk_bf16(o[2], o[3]), pk_bf16(o[4], o[5]), pk_bf16(o[6], o[7])}; }

__device__ __forceinline__ void ld8bf(const bf16_t* __restrict__ p, float (&o)[8]) { const u32x4 w = *(const u32x4*)p; o[0] = bflo(w.x); o[1] = bfhi(w.x); o[2] = bflo(w.y); o[3] = bfhi(w.y); o[4] = bflo(w.z); o[5] = bfhi(w.z); o[6] = bflo(w.w); o[7] = bfhi(w.w); }
__device__ __forceinline__ void ln_row(float (&v)[4][8], const float* __restrict__ lw, const float* __restrict__ lb, int lane) {
    float s = 0.f;
#pragma unroll
    for (int pc = 0; pc < 4; ++pc)
#pragma unroll
        for (int j = 0; j < 8; ++j) s += v[pc][j];
    const float mu = wave_sum(s) * (1.0f / 2048.0f);
    float q = 0.f;
#pragma unroll
    for (int pc = 0; pc < 4; ++pc)
#pragma unroll
        for (int j = 0; j < 8; ++j) { const float d = v[pc][j] - mu; q += d * d; }
    const float rs = rsqrtf(wave_sum(q) * (1.0f / 2048.0f) + LN_EPS);
#pragma unroll
    for (int pc = 0; pc < 4; ++pc) { float w[8], b[8]; ld8(lw + pc * 512 + lane * 8, w); ld8(lb + pc * 512 + lane * 8, b);
#pragma unroll
        for (int j = 0; j < 8; ++j) v[pc][j] = (v[pc][j] - mu) * rs * w[j] + b[j]; }
}

template <bool SLAB>
__device__ __forceinline__ void ln1_load(const Params& p, int layer, int r, int lane, const float* __restrict__ slab, float (&v)[4][8]) {
    const bf16_t* y = (const bf16_t*)(p.ws + OFF_BIG2); const bf16_t* H = (const bf16_t*)(p.ws + OFF_H);
    const float* hp = r < TL ? p.in[I_X] + (size_t)r * DM : p.in[I_CTX] + (size_t)(r - TL) * DM;
    const float* md = (const float*)(p.ws + OFF_MOD) + (size_t)layer * 2 * 12288 + (r < TL ? 0 : 12288);
#pragma unroll
    for (int pc = 0; pc < 4; ++pc) { const int e = pc * 512 + lane * 8; float hv[8], yv[8], gv[8];
        if (layer == 0) ld8(hp + e, hv); else ld8bf(H + (size_t)r * DM + e, hv);
        if (SLAB) {
#pragma unroll
            for (int j = 0; j < 8; ++j) yv[j] = 0.f;
#pragma unroll 1
            for (int sl = 0; sl < 8; ++sl) { float t8[8]; ld8(slab + ((size_t)(sl * 8 + (e >> 8)) << 16) + (size_t)(r - TL) * 256 + (e & 255), t8);
#pragma unroll
                for (int j = 0; j < 8; ++j) yv[j] += t8[j]; }
        } else ld8bf(y + (size_t)r * DM + e, yv);
        ld8(md + 2 * 2048 + e, gv);
#pragma unroll
        for (int j = 0; j < 8; ++j) v[pc][j] = DN_ALPHA * hv[j] + gv[j] * yv[j]; }
}
__device__ __forceinline__ void ln1_finish(const Params& p, int layer, int r, int lane, float (&v)[4][8]) {
    bf16_t* H = (bf16_t*)(p.ws + OFF_H); bf16_t* A = (bf16_t*)(p.ws + OFF_A);
    const float* lw = p.in[I_LNW] + (size_t)(layer * 2 + 0) * DM; const float* lb = p.in[I_LNB] + (size_t)(layer * 2 + 0) * DM;
    const float* md = (const float*)(p.ws + OFF_MOD) + (size_t)layer * 2 * 12288 + (r < TL ? 0 : 12288);
    ln_row(v, lw, lb, lane);
#pragma unroll
    for (int pc = 0; pc < 4; ++pc) { const int e = pc * 512 + lane * 8; st8bf(H + (size_t)r * DM + e, v[pc]);
        float sc[8], sh[8], o[8]; ld8(md + 4 * 2048 + e, sc); ld8(md + 3 * 2048 + e, sh);
#pragma unroll
        for (int j = 0; j < 8; ++j) o[j] = v[pc][j] * (1.f + sc[j]) + sh[j];
        st8bf(A + (size_t)r * DM + e, o); }
}
__device__ __forceinline__ void phase_ln1(const Params& p, int layer, int nrows, const float* __restrict__ slab) {
    const int tid = otid(), w = tid >> 6, lane = tid & 63;
    const int stride = gridDim.x * 8;
    const int nmain = slab != nullptr ? TL : nrows;
    for (int r = blockIdx.x * 8 + w; r < nmain; r += 2 * stride) {
        const int r2 = r + stride; const bool has2 = r2 < nmain;
        float v[4][8], v2[4][8];
        ln1_load<false>(p, layer, r, lane, slab, v);
        if (has2) ln1_load<false>(p, layer, r2, lane, slab, v2);
        ln1_finish(p, layer, r, lane, v);
        if (has2) ln1_finish(p, layer, r2, lane, v2);
    }
    if (slab != nullptr) {
#pragma unroll 1
        for (int r = TL + blockIdx.x * 8 + w; r < nrows; r += stride) { float v[4][8]; ln1_load<true>(p, layer, r, lane, slab, v); ln1_finish(p, layer, r, lane, v); }
    }
}

__device__ __forceinline__ unsigned fkey(float f) { const unsigned u = __float_as_uint(f); return (u & 0x80000000u) ? ~u : (u | 0x80000000u); }
__device__ __forceinline__ float kval(unsigned k) { const unsigned u = (k & 0x80000000u) ? (k & 0x7FFFFFFFu) : ~k; return __uint_as_float(u); }
__device__ __forceinline__ void kins(unsigned (&L)[16], unsigned x) {
#pragma unroll
    for (int i = 0; i < 16; ++i) { const unsigned hi = L[i] > x ? L[i] : x; x = L[i] > x ? x : L[i]; L[i] = hi; }
}
__device__ __forceinline__ unsigned wave_umax(unsigned v) {
#pragma unroll
    for (int o = 32; o > 0; o >>= 1) { const unsigned t = (unsigned)__shfl_xor((int)v, o); v = v > t ? v : t; }
    return v;
}
__device__ __forceinline__ void topk_ctx_wave(const Params& p, const float* __restrict__ slab) {
    const int tid = otid(), wv = tid >> 6, lane = tid & 63;
    int* EI = (int*)(p.ws + OFF_EXP); float* EG = (float*)(p.ws + OFF_EXP + (size_t)MT * 128 * 4);
    for (int item = blockIdx.x * 8 + wv; item < TCX * 8; item += gridDim.x * 8) {
        const int h = item & 7, rl = item >> 3, r = TL + rl;
        float s1a = 0.f, s1b = 0.f, s2a = 0.f, s2b = 0.f;
#pragma unroll
        for (int sl = 0; sl < 8; ++sl) { const float* sb = slab + ((size_t)(sl * 8 + h) << 16) + rl;
            s1a += sb[(size_t)lane * 256]; s1b += sb[(size_t)(lane + 64) * 256]; s2a += sb[(size_t)(128 + lane) * 256]; s2b += sb[(size_t)(192 + lane) * 256]; }
        unsigned k1a = (fkey(s1a) & ~0x7Fu) | (unsigned)(127 - lane), k1b = (fkey(s1b) & ~0x7Fu) | (unsigned)(63 - lane);
        unsigned k2a = (fkey(s2a) & ~0x7Fu) | (unsigned)(127 - lane), k2b = (fkey(s2b) & ~0x7Fu) | (unsigned)(63 - lane);
        unsigned vec1 = 0u, vec2 = 0u;
#pragma unroll
        for (int i = 0; i < 16; ++i) {
            const unsigned w1 = wave_umax(k1a > k1b ? k1a : k1b); if (k1a == w1) k1a = 0u; if (k1b == w1) k1b = 0u; vec1 = lane == i ? w1 : vec1;
            const unsigned w2 = wave_umax(k2a > k2b ? k2a : k2b); if (k2a == w2) k2a = 0u; if (k2b == w2) k2b = 0u; vec2 = lane == i ? w2 : vec2;
        }
        const float v1 = kval((unsigned)__shfl((int)vec1, lane >> 2) & ~0x7Fu);
        unsigned ck[4];
#pragma unroll
        for (int t = 0; t < 4; ++t) { const int i = lane >> 2, j = 4 * (lane & 3) + t; const float v2 = kval((unsigned)__shfl((int)vec2, j) & ~0x7Fu);
            ck[t] = ((i + 1) * (j + 1) <= 16) ? ((fkey(v1 + v2) & ~0xFFu) | (unsigned)(255 - (i * 16 + j))) : 0u; }
        unsigned vec3 = 0u;
#pragma unroll
        for (int s3 = 0; s3 < 16; ++s3) { unsigned m = ck[0] > ck[1] ? ck[0] : ck[1]; const unsigned m2 = ck[2] > ck[3] ? ck[2] : ck[3]; m = m > m2 ? m : m2;
            const unsigned w3 = wave_umax(m);
#pragma unroll
            for (int t = 0; t < 4; ++t) if (ck[t] == w3) ck[t] = 0u;
            vec3 = lane == s3 ? w3 : vec3; }
        const float top = kval((unsigned)__shfl((int)vec3, 0) & ~0xFFu);
        const float ev = lane < 16 ? __expf(kval(vec3 & ~0xFFu) - top) : 0.f;
        const float sum = wave_sum(ev);
        const unsigned id = 255u - (vec3 & 0xFFu); const int ii = (int)(id >> 4), jj = (int)(id & 15u);
        const unsigned kk1 = (unsigned)__shfl((int)vec1, ii), kk2 = (unsigned)__shfl((int)vec2, jj);
        if (lane < 16) { const int n1 = 127 - (int)(kk1 & 0x7Fu), n2 = 127 - (int)(kk2 & 0x7Fu);
            EI[(size_t)r * 128 + h * 16 + lane] = n1 * 128 + n2; EG[(size_t)r * 128 + h * 16 + lane] = ev / sum; }
    }
}

__device__ __forceinline__ void phase_topk(const Params& p, LAS unsigned char* lds, int nrows, const float* __restrict__ slab) {
    LAS unsigned short* nsel = (LAS unsigned short*)lds;
    const float* ST = (const float*)(p.ws + OFF_BIG1);
    int* EI = (int*)(p.ws + OFF_EXP); float* EG = (float*)(p.ws + OFF_EXP + (size_t)MT * 128 * 4);
    const int tid = otid();
    const int nch = slab != nullptr ? TL / 512 : (nrows + 511) / 512;
    for (int task = blockIdx.x; task < nch * 8; task += gridDim.x) {
        const int h = task & 7, r = (task >> 3) * 512 + tid;
        const bool act = r < nrows; const int rr = act ? r : nrows - 1;
        unsigned L1[16], L2[16], L3[16];
#pragma unroll
        for (int i = 0; i < 16; ++i) { L1[i] = 0u; L2[i] = 0u; L3[i] = 0u; }
        const float* s1 = ST + (size_t)(h * 256) * MT + rr; const float* s2 = s1 + (size_t)128 * MT;
#pragma unroll 1
        for (int n0 = 0; n0 < 128; n0 += 16) {
            float a[16], b[16];
#pragma unroll
            for (int j = 0; j < 16; ++j) { a[j] = s1[(size_t)(n0 + j) * MT]; b[j] = s2[(size_t)(n0 + j) * MT]; }
#pragma unroll
            for (int j = 0; j < 16; ++j) { kins(L1, (fkey(a[j]) & ~0x7Fu) | (unsigned)(127 - n0 - j)); kins(L2, (fkey(b[j]) & ~0x7Fu) | (unsigned)(127 - n0 - j)); }
        }
        float v1[16], v2[16];
#pragma unroll
        for (int i = 0; i < 16; ++i) { v1[i] = kval(L1[i] & ~0x7Fu); v2[i] = kval(L2[i] & ~0x7Fu);
            nsel[i * 512 + tid] = (unsigned short)(127u - (L1[i] & 0x7Fu)); nsel[(16 + i) * 512 + tid] = (unsigned short)(127u - (L2[i] & 0x7Fu)); }
#pragma unroll
        for (int i = 0; i < 16; ++i)
#pragma unroll
            for (int j = 0; j < 16; ++j)
                if ((i + 1) * (j + 1) <= 16) { const unsigned kc = (fkey(v1[i] + v2[j]) & ~0xFFu) | (unsigned)(255 - (i * 16 + j)); kins(L3, kc); }
        const float m = kval(L3[0] & ~0xFFu);
        float e[16], sum = 0.f;
#pragma unroll
        for (int s = 0; s < 16; ++s) { e[s] = __expf(kval(L3[s] & ~0xFFu) - m); sum += e[s]; }
        const float inv = 1.0f / sum;
        if (act) {
#pragma unroll
            for (int s = 0; s < 16; ++s) { const unsigned id = 255u - (L3[s] & 0xFFu); const unsigned i = id >> 4, j = id & 15u;
                const int n1 = nsel[i * 512 + tid], n2 = nsel[(16 + j) * 512 + tid];
                EI[(size_t)r * 128 + h * 16 + s] = n1 * 128 + n2; EG[(size_t)r * 128 + h * 16 + s] = e[s] * inv; }
        }
    }
    if (slab != nullptr) topk_ctx_wave(p, slab);
}

__device__ __forceinline__ float dpp_sum63(float v) {
    v += __builtin_bit_cast(float, __builtin_amdgcn_update_dpp(0, __builtin_bit_cast(int, v), 0x111, 0xf, 0xf, false));
    v += __builtin_bit_cast(float, __builtin_amdgcn_update_dpp(0, __builtin_bit_cast(int, v), 0x112, 0xf, 0xf, false));
    v += __builtin_bit_cast(float, __builtin_amdgcn_update_dpp(0, __builtin_bit_cast(int, v), 0x114, 0xf, 0xf, false));
    v += __builtin_bit_cast(float, __builtin_amdgcn_update_dpp(0, __builtin_bit_cast(int, v), 0x118, 0xf, 0xf, false));
    v += __builtin_bit_cast(float, __builtin_amdgcn_update_dpp(0, __builtin_bit_cast(int, v), 0x142, 0xa, 0xf, false));
    v += __builtin_bit_cast(float, __builtin_amdgcn_update_dpp(0, __builtin_bit_cast(int, v), 0x143, 0xc, 0xf, false));
    return v;
}
__device__ __forceinline__ float readlane_f(float v, int l) { return __builtin_bit_cast(float, __builtin_amdgcn_readlane(__builtin_bit_cast(int, v), l)); }
__device__ __forceinline__ float dot8(const u32x4 a, const u32x4 b, float acc) {
    const unsigned a0 = a.x, a1 = a.y, a2 = a.z, a3 = a.w, b0 = b.x, b1 = b.y, b2 = b.z, b3 = b.w;
    acc = __builtin_amdgcn_fdot2_f32_bf16(__builtin_bit_cast(bf2_t, a0), __builtin_bit_cast(bf2_t, b0), acc, false);
    acc = __builtin_amdgcn_fdot2_f32_bf16(__builtin_bit_cast(bf2_t, a1), __builtin_bit_cast(bf2_t, b1), acc, false);
    acc = __builtin_amdgcn_fdot2_f32_bf16(__builtin_bit_cast(bf2_t, a2), __builtin_bit_cast(bf2_t, b2), acc, false);
    acc = __builtin_amdgcn_fdot2_f32_bf16(__builtin_bit_cast(bf2_t, a3), __builtin_bit_cast(bf2_t, b3), acc, false);
    return acc;
}
__device__ __forceinline__ void axpy8(float (&o)[8], const u32x4 v, float c) {
    o[0] = fmaf(c, bflo(v.x), o[0]); o[1] = fmaf(c, bfhi(v.x), o[1]); o[2] = fmaf(c, bflo(v.y), o[2]); o[3] = fmaf(c, bfhi(v.y), o[3]);
    o[4] = fmaf(c, bflo(v.z), o[4]); o[5] = fmaf(c, bfhi(v.z), o[5]); o[6] = fmaf(c, bflo(v.w), o[6]); o[7] = fmaf(c, bfhi(v.w), o[7]);
}
__device__ __forceinline__ void cvt16(const u32x4 w, float (&o)[16]) {
    const int w0 = (int)w.x, w1 = (int)w.y, w2 = (int)w.z, w3 = (int)w.w;
    f32x2 t;
    t = __builtin_amdgcn_cvt_pk_f32_fp8(w0, false); o[0] = t.x; o[1] = t.y;   t = __builtin_amdgcn_cvt_pk_f32_fp8(w0, true); o[2] = t.x; o[3] = t.y;
    t = __builtin_amdgcn_cvt_pk_f32_fp8(w1, false); o[4] = t.x; o[5] = t.y;   t = __builtin_amdgcn_cvt_pk_f32_fp8(w1, true); o[6] = t.x; o[7] = t.y;
    t = __builtin_amdgcn_cvt_pk_f32_fp8(w2, false); o[8] = t.x; o[9] = t.y;   t = __builtin_amdgcn_cvt_pk_f32_fp8(w2, true); o[10] = t.x; o[11] = t.y;
    t = __builtin_amdgcn_cvt_pk_f32_fp8(w3, false); o[12] = t.x; o[13] = t.y; t = __builtin_amdgcn_cvt_pk_f32_fp8(w3, true); o[14] = t.x; o[15] = t.y;
}
__device__ __forceinline__ void ld16(const float* __restrict__ p, float (&o)[16]) {
#pragma unroll
    for (int q = 0; q < 4; ++q) { const f32x4 a = *(const f32x4*)(p + 4 * q); o[4 * q] = a[0]; o[4 * q + 1] = a[1]; o[4 * q + 2] = a[2]; o[4 * q + 3] = a[3]; }
}
__device__ __forceinline__ void peer_finish(const Params& p, int layer, int r, int lane, float (&f)[2][16]) {
    bf16_t* H = (bf16_t*)(p.ws + OFF_H); bf16_t* A = (bf16_t*)(p.ws + OFF_A);
    const float* lw = p.in[I_LNW] + (size_t)(layer * 2 + 1) * DM; const float* lb = p.in[I_LNB] + (size_t)(layer * 2 + 1) * DM;
    const float* md = (const float*)(p.ws + OFF_MOD) + (size_t)layer * 2 * 12288 + (r < TL ? 0 : 12288);
    float s = 0.f;
#pragma unroll
    for (int pc = 0; pc < 2; ++pc) { const int e = pc * 1024 + lane * 16; float hv[16], gv[16]; { float t0[8], t1[8]; ld8bf(H + (size_t)r * DM + e, t0); ld8bf(H + (size_t)r * DM + e + 8, t1);
#pragma unroll
            for (int j = 0; j < 8; ++j) { hv[j] = t0[j]; hv[8 + j] = t1[j]; } } ld16(md + 5 * 2048 + e, gv);
#pragma unroll
        for (int j = 0; j < 16; ++j) { f[pc][j] = DN_ALPHA * hv[j] + gv[j] * f[pc][j]; s += f[pc][j]; } }
    const float mu = wave_sum(s) * (1.0f / 2048.0f);
    float qv = 0.f;
#pragma unroll
    for (int pc = 0; pc < 2; ++pc)
#pragma unroll
        for (int j = 0; j < 16; ++j) { const float d = f[pc][j] - mu; qv += d * d; }
    const float rs = rsqrtf(wave_sum(qv) * (1.0f / 2048.0f) + LN_EPS);
    const float* md1 = (const float*)(p.ws + OFF_MOD) + (size_t)2 * 12288 + (r < TL ? 0 : 12288);
#pragma unroll
    for (int pc = 0; pc < 2; ++pc) { const int e = pc * 1024 + lane * 16; float wv[16], bv[16]; ld16(lw + e, wv); ld16(lb + e, bv);
        float o[16];
#pragma unroll
        for (int j = 0; j < 16; ++j) o[j] = (f[pc][j] - mu) * rs * wv[j] + bv[j];
        if (layer == 0) {
            *(u32x4*)(H + (size_t)r * DM + e) = (u32x4){pk_bf16(o[0], o[1]), pk_bf16(o[2], o[3]), pk_bf16(o[4], o[5]), pk_bf16(o[6], o[7])};
            *(u32x4*)(H + (size_t)r * DM + e + 8) = (u32x4){pk_bf16(o[8], o[9]), pk_bf16(o[10], o[11]), pk_bf16(o[12], o[13]), pk_bf16(o[14], o[15])};
            float sc[16], sh[16]; ld16(md1 + 2048 + e, sc); ld16(md1 + e, sh);
#pragma unroll
            for (int j = 0; j < 16; ++j) o[j] = o[j] * (1.f + sc[j]) + sh[j];
#if F8_L1
            unsigned char* ap = p.ws + OFF_X + (size_t)r * DM + e;
            *(u32x4*)ap = (u32x4){fp8x4(clamp8(o[0] * G8_XS), clamp8(o[1] * G8_XS), clamp8(o[2] * G8_XS), clamp8(o[3] * G8_XS)), fp8x4(clamp8(o[4] * G8_XS), clamp8(o[5] * G8_XS), clamp8(o[6] * G8_XS), clamp8(o[7] * G8_XS)),
                                  fp8x4(clamp8(o[8] * G8_XS), clamp8(o[9] * G8_XS), clamp8(o[10] * G8_XS), clamp8(o[11] * G8_XS)), fp8x4(clamp8(o[12] * G8_XS), clamp8(o[13] * G8_XS), clamp8(o[14] * G8_XS), clamp8(o[15] * G8_XS))};
#else
            bf16_t* ap = A + (size_t)r * DM + e;
            *(u32x4*)ap = (u32x4){pk_bf16(o[0], o[1]), pk_bf16(o[2], o[3]), pk_bf16(o[4], o[5]), pk_bf16(o[6], o[7])};
            *(u32x4*)(ap + 8) = (u32x4){pk_bf16(o[8], o[9]), pk_bf16(o[10], o[11]), pk_bf16(o[12], o[13]), pk_bf16(o[14], o[15])};
#endif
        } else {
#pragma unroll
            for (int q = 0; q < 4; ++q) *(f32x4*)(p.out + (size_t)r * DM + e + 4 * q) = (f32x4){o[4 * q], o[4 * q + 1], o[4 * q + 2], o[4 * q + 3]};
        }
    }
}
typedef long i64_t;
constexpr float PEER_XS = 16.0f;
__device__ __forceinline__ i64_t mk64(unsigned lo, unsigned hi) { return (i64_t)(((unsigned long long)hi << 32) | (unsigned long long)lo); }
__device__ __forceinline__ void peer_load_x8(const bf16_t* __restrict__ A, int r, int lane, u32x4 (&xh)[2], u32x4 (&xl)[2]) {
#pragma unroll
    for (int pc = 0; pc < 2; ++pc) { const bf16_t* ap = A + (size_t)r * DM + pc * 1024 + lane * 16;
        const u32x4 a = *(const u32x4*)ap, b = *(const u32x4*)(ap + 8);
        const unsigned w[8] = {a.x, a.y, a.z, a.w, b.x, b.y, b.z, b.w};
        unsigned h[4], l[4];
#pragma unroll
        for (int q = 0; q < 4; ++q) { const float v0 = bflo(w[2 * q]) * PEER_XS, v1 = bfhi(w[2 * q]) * PEER_XS, v2 = bflo(w[2 * q + 1]) * PEER_XS, v3 = bfhi(w[2 * q + 1]) * PEER_XS;
            h[q] = fp8x4(__builtin_amdgcn_fmed3f(v0, -448.f, 448.f), __builtin_amdgcn_fmed3f(v1, -448.f, 448.f), __builtin_amdgcn_fmed3f(v2, -448.f, 448.f), __builtin_amdgcn_fmed3f(v3, -448.f, 448.f));
            const f32x2 d0 = __builtin_amdgcn_cvt_pk_f32_fp8((int)h[q], false), d1 = __builtin_amdgcn_cvt_pk_f32_fp8((int)h[q], true);
            l[q] = fp8x4(__builtin_amdgcn_fmed3f(v0 - d0.x, -448.f, 448.f), __builtin_amdgcn_fmed3f(v1 - d0.y, -448.f, 448.f), __builtin_amdgcn_fmed3f(v2 - d1.x, -448.f, 448.f), __builtin_amdgcn_fmed3f(v3 - d1.y, -448.f, 448.f)); }
        xh[pc] = (u32x4){h[0], h[1], h[2], h[3]}; xl[pc] = (u32x4){l[0], l[1], l[2], l[3]}; }
}
template <int nb4, int NLO>
__device__ __forceinline__ void peer_acc3(const unsigned char* __restrict__ U, const unsigned char* __restrict__ V, int lane, int myid, float myg, const u32x4 (&xh)[2], const u32x4 (&xl)[2], float (&f)[2][16]) {
    float actv = 0.f;
    const bool dg = (((lane & 15) >> 2) == (lane >> 4));
    const float w0 = (dg && (lane & 3) == 0) ? 1.f : 0.f, w1 = (dg && (lane & 3) == 1) ? 1.f : 0.f, w2 = (dg && (lane & 3) == 2) ? 1.f : 0.f, w3 = (dg && (lane & 3) == 3) ? 1.f : 0.f;
    const i32x8 bh = {(int)xh[0].x, (int)xh[0].y, (int)xh[0].z, (int)xh[0].w, (int)xh[1].x, (int)xh[1].y, (int)xh[1].z, (int)xh[1].w};
    const i32x8 bl = {(int)xl[0].x, (int)xl[0].y, (int)xl[0].z, (int)xl[0].w, (int)xl[1].x, (int)xl[1].y, (int)xl[1].z, (int)xl[1].w};
    int sc = 0x7F7F7F7F; asm volatile("" : "+v"(sc));
#pragma unroll 1
    for (int e4 = 0; e4 < nb4; ++e4) {
        u32x4 raw[4][2];
#pragma unroll
        for (int q = 0; q < 4; ++q) { const int eid = __builtin_amdgcn_readlane(myid, e4 * 4 + q);
            const unsigned char* row = U + (size_t)eid * DM + lane * 16;
            raw[q][0] = *(const u32x4*)row; raw[q][1] = *(const u32x4*)(row + 1024); }
#pragma unroll
        for (int q = 0; q < 4; ++q) { f32x4 acc = (f32x4){0.f, 0.f, 0.f, 0.f};
            const i32x8 a = {(int)raw[q][0].x, (int)raw[q][0].y, (int)raw[q][0].z, (int)raw[q][0].w, (int)raw[q][1].x, (int)raw[q][1].y, (int)raw[q][1].z, (int)raw[q][1].w};
            acc = __builtin_amdgcn_mfma_scale_f32_16x16x128_f8f6f4(a, bh, acc, 0, 0, 0, sc, 0, sc);
            if (NLO) acc = __builtin_amdgcn_mfma_scale_f32_16x16x128_f8f6f4(a, bl, acc, 0, 0, 0, sc, 0, sc);
            const float dv = fmaf(acc[0], w0, fmaf(acc[1], w1, fmaf(acc[2], w2, acc[3] * w3)));
            const float tot = readlane_f(dpp_sum63(dv), 63); actv = (lane == e4 * 4 + q) ? tot : actv; }
    }
    actv *= (1.0f / (PEER_XS * PEER_USCALE));
    const float coef = myg * (0.5f / PEER_VSCALE) * actv * (1.0f + erff(actv * 0.70710678118654752f));
#pragma unroll 1
    for (int e4 = 0; e4 < nb4; ++e4) {
        u32x4 raw[4][2]; float cf[4];
#pragma unroll
        for (int q = 0; q < 4; ++q) { const int eid = __builtin_amdgcn_readlane(myid, e4 * 4 + q); cf[q] = readlane_f(coef, e4 * 4 + q);
            const unsigned char* row = V + (size_t)eid * DM + lane * 16;
            raw[q][0] = *(const u32x4*)row; raw[q][1] = *(const u32x4*)(row + 1024); }
#pragma unroll
        for (int q = 0; q < 4; ++q)
#pragma unroll
            for (int pc = 0; pc < 2; ++pc) { float vv[16]; cvt16(raw[q][pc], vv);
#pragma unroll
                for (int j = 0; j < 16; ++j) f[pc][j] = fmaf(cf[q], vv[j], f[pc][j]); }
    }
}
__device__ __forceinline__ void phase_peer(const Params& p, LAS unsigned char* lds, int layer, int nrows) {
    const int tid = otid(), w = tid >> 6, lane = tid & 63;
    const unsigned char* U = p.ws + OFF_PEER + (size_t)(layer * 2) * PEER_TBL; const unsigned char* V = U + PEER_TBL;
    const int* EI = (const int*)(p.ws + OFF_EXP); const float* EG = (const float*)(p.ws + OFF_EXP + (size_t)MT * 128 * 4);
    const bf16_t* A = (const bf16_t*)(p.ws + OFF_A);
    const int xg = blockIdx.x & 7, cnt8 = (((int)gridDim.x - xg + 7) >> 3) * 8;
    for (int rl = (blockIdx.x >> 3) * 8 + w; rl < TL / 8; rl += cnt8) {
        const int r = xg * (TL / 8) + rl;
        u32x4 xh[2], xl[2]; peer_load_x8(A, r, lane, xh, xl);
        float f[2][16];
#pragma unroll
        for (int pc = 0; pc < 2; ++pc)
#pragma unroll
            for (int j = 0; j < 16; ++j) f[pc][j] = 0.f;
#pragma unroll
        for (int hf = 0; hf < 2; ++hf) peer_acc3<16, 1>(U, V, lane, EI[(size_t)r * 128 + hf * 64 + lane], EG[(size_t)r * 128 + hf * 64 + lane], xh, xl, f);
        peer_finish(p, layer, r, lane, f);
    }
    if (nrows > TL) {
        LAS float* fb = (LAS float*)lds;
        for (int rc = blockIdx.x; rc < nrows - TL; rc += gridDim.x) {
            const int r = TL + rc;
            u32x4 xh[2], xl[2]; peer_load_x8(A, r, lane, xh, xl);
            float f[2][16];
#pragma unroll
            for (int pc = 0; pc < 2; ++pc)
#pragma unroll
                for (int j = 0; j < 16; ++j) f[pc][j] = 0.f;
            const int li = lane & 15;
            peer_acc3<4, 1>(U, V, lane, EI[(size_t)r * 128 + w * 16 + li], EG[(size_t)r * 128 + w * 16 + li], xh, xl, f);
            __syncthreads();
#pragma unroll
            for (int pc = 0; pc < 2; ++pc)
#pragma unroll
                for (int q = 0; q < 4; ++q) *(LAS f32x4*)(fb + w * 2048 + pc * 1024 + lane * 16 + 4 * q) = (f32x4){f[pc][4 * q], f[pc][4 * q + 1], f[pc][4 * q + 2], f[pc][4 * q + 3]};
            __syncthreads();
            if (w == 0) {
#pragma unroll
                for (int pc = 0; pc < 2; ++pc)
#pragma unroll
                    for (int j = 0; j < 16; ++j) f[pc][j] = 0.f;
#pragma unroll 1
                for (int ww = 0; ww < 8; ++ww)
#pragma unroll
                    for (int pc = 0; pc < 2; ++pc)
#pragma unroll
                        for (int q = 0; q < 4; ++q) { const f32x4 t = *(const LAS f32x4*)(fb + ww * 2048 + pc * 1024 + lane * 16 + 4 * q);
                            f[pc][4 * q] += t[0]; f[pc][4 * q + 1] += t[1]; f[pc][4 * q + 2] += t[2]; f[pc][4 * q + 3] += t[3]; }
                peer_finish(p, layer, r, lane, f);
            }
        }
        __syncthreads();
    }
}

constexpr size_t L1_OFF_OB = OFF_BIG2 + (size_t)2048 * MT * 2;
constexpr size_t L1_OFF_QS = OFF_BIG1;
constexpr size_t L1_OFF_KS = L1_OFF_QS + (size_t)TL * 1024 * 2;
constexpr size_t L1_OFF_KT = L1_OFF_KS + (size_t)MT * 1024 * 2;
static_assert(L1_OFF_KT + (size_t)MT * 1024 * 2 <= OFF_BIG1 + BIG_BYTES, "BIG1 overflow");
static_assert(L1_OFF_OB + (size_t)MT * 2048 * 2 <= OFF_BIG2 + BIG_BYTES, "BIG2 overflow");

__device__ __forceinline__ float logsig_f(float x) { return fminf(x, 0.f) - log1pf(expf(-fabsf(x))); }
__device__ __forceinline__ int chunk_row0(int cidx) { return cidx < 256 ? cidx * 64 : TL + (cidx - 256) * 64; }
__device__ __forceinline__ int chunk_of(int sc, int dir, int i) { return sc == 0 ? (dir ? 259 - i : 256 + i) : (dir ? 255 - (sc - 1) * 16 - i : (sc - 1) * 16 + i); }

__device__ __forceinline__ void unpack8(const u32x4 w, float (&o)[8]) { o[0] = bflo(w.x); o[1] = bfhi(w.x); o[2] = bflo(w.y); o[3] = bfhi(w.y); o[4] = bflo(w.z); o[5] = bfhi(w.z); o[6] = bflo(w.w); o[7] = bfhi(w.w); }
__device__ __forceinline__ void l1_qk_task(const Params& p, LAS unsigned char* lds, int task) {
    const int tid = otid();
    int tile, isk, hq, nh, h0;
    if (task < 32) { tile = 256 + (task >> 3); isk = 1; h0 = task & 7; nh = 1; hq = h0 >> 2; } else { const int t = task - 32; tile = t >> 2; isk = (t >> 1) & 1; hq = t & 1; h0 = hq * 4; nh = 4; }
    const bool lat = tile < 256;
    const int r0 = lat ? tile * 64 : TL + (tile - 256) * 64;
    const int sq0 = lat ? 0 : TL, sq1 = lat ? TL : MT;
    const bf16_t* QKp = (const bf16_t*)(p.ws + OFF_QK);
    bf16_t* QS = (bf16_t*)(p.ws + L1_OFF_QS); bf16_t* KS = (bf16_t*)(p.ws + L1_OFF_KS); bf16_t* KT = (bf16_t*)(p.ws + L1_OFF_KT);
    const float* cw = p.in[I_MLCW]; const float* cb = p.in[I_MLCB];
    const f32x2* rope = (const f32x2*)(p.ws + OFF_ROPE);
    LAS unsigned short* tl_ = (LAS unsigned short*)lds;
    LAS float* wl = (LAS float*)(lds + 4 * 128 * 66 * 2);
    { const int c = tid, col = isk * 1024 + hq * 512 + c;
#pragma unroll
      for (int j = 0; j < 4; ++j) wl[j * 512 + c] = j < 3 ? cw[j * 2048 + col] : cb[col]; }
    __syncthreads();
    const int tl = tid >> 3, pc = tid & 7, half = pc >> 2, cc = pc & 3;
    const int d1 = half * 64 + cc * 8, d2 = d1 + 32;
    const int r = r0 + tl;
    const int pos = half == 0 ? (r >> 6) : (r & 63);
    f32x2 csn[8];
#pragma unroll
    for (int j = 0; j < 8; ++j) csn[j] = lat ? rope[pos * 32 + cc * 8 + j] : (f32x2){1.f, 0.f};
    const u32x4 z4 = (u32x4){0u, 0u, 0u, 0u};
#pragma unroll 1
    for (int hh = h0 - hq * 4; hh < h0 - hq * 4 + nh; ++hh) {
        const int h = hq * 4 + hh;
        const bf16_t* x0 = QKp + (size_t)r * 2048 + isk * 1024 + h * 128;
        const u32x4 a0 = *(const u32x4*)(x0 + d1), b0 = *(const u32x4*)(x0 + d2);
        const u32x4 am = r > sq0 ? *(const u32x4*)(x0 + d1 - 2048) : z4, bm = r > sq0 ? *(const u32x4*)(x0 + d2 - 2048) : z4;
        const u32x4 ap = r + 1 < sq1 ? *(const u32x4*)(x0 + d1 + 2048) : z4, bp = r + 1 < sq1 ? *(const u32x4*)(x0 + d2 + 2048) : z4;
        float A0[8], B0[8], AM[8], BM[8], AP[8], BP[8];
        unpack8(a0, A0); unpack8(b0, B0); unpack8(am, AM); unpack8(bm, BM); unpack8(ap, AP); unpack8(bp, BP);
        float o1[8], o2[8];
        const int w1 = hh * 128 + d1, w2 = hh * 128 + d2;
#pragma unroll
        for (int j = 0; j < 8; ++j) {
            const float y1 = silu_f(wl[1536 + w1 + j] + wl[w1 + j] * AM[j] + wl[512 + w1 + j] * A0[j] + wl[1024 + w1 + j] * AP[j]);
            const float y2 = silu_f(wl[1536 + w2 + j] + wl[w2 + j] * BM[j] + wl[512 + w2 + j] * B0[j] + wl[1024 + w2 + j] * BP[j]);
            float q1 = y1 * csn[j].x - y2 * csn[j].y, q2 = y1 * csn[j].y + y2 * csn[j].x;
            if (isk) { q1 *= 0.08838834764831845f; q2 *= 0.08838834764831845f; }
            o1[j] = q1; o2[j] = q2;
        }
        const u32x4 v1 = (u32x4){pk_bf16(o1[0], o1[1]), pk_bf16(o1[2], o1[3]), pk_bf16(o1[4], o1[5]), pk_bf16(o1[6], o1[7])};
        const u32x4 v2 = (u32x4){pk_bf16(o2[0], o2[1]), pk_bf16(o2[2], o2[3]), pk_bf16(o2[4], o2[5]), pk_bf16(o2[6], o2[7])};
        if (isk) {
            bf16_t* dst = KS + (size_t)r * 1024 + h * 128;
            *(u32x4*)(dst + d1) = v1; *(u32x4*)(dst + d2) = v2;
            LAS unsigned short* th = tl_ + hh * 128 * 66;
            const unsigned u1[4] = {v1.x, v1.y, v1.z, v1.w}, u2[4] = {v2.x, v2.y, v2.z, v2.w};
#pragma unroll
            for (int j = 0; j < 4; ++j) { th[(d1 + 2 * j) * 66 + tl] = (unsigned short)(u1[j] & 0xFFFFu); th[(d1 + 2 * j + 1) * 66 + tl] = (unsigned short)(u1[j] >> 16);
                                          th[(d2 + 2 * j) * 66 + tl] = (unsigned short)(u2[j] & 0xFFFFu); th[(d2 + 2 * j + 1) * 66 + tl] = (unsigned short)(u2[j] >> 16); }
        } else {
            bf16_t* dst = QS + (size_t)r * 1024 + h * 128;
            *(u32x4*)(dst + d1) = v1; *(u32x4*)(dst + d2) = v2;
        }
    }
    if (isk) {
        __syncthreads();
#pragma unroll 4
        for (int it = (h0 - hq * 4) * 8; it < (h0 - hq * 4 + nh) * 8; ++it) { const int i = tid + 512 * it, d = i >> 5, tp = i & 31;
            const unsigned lo = tl_[d * 66 + 2 * tp], hi = tl_[d * 66 + 2 * tp + 1];
            *(unsigned*)(KT + (size_t)(hq * 512 + d) * MT + r0 + 2 * tp) = lo | (hi << 16); }
    }
    __syncthreads();
}
__device__ __forceinline__ void l1_gate_items(const Params& p) {
    const int tid = otid(), wv = tid >> 6, lane = tid & 63;
    const float* G = (const float*)(p.ws + OFF_GATE); const float* bg = p.in[I_MLBG];
    float* GA = (float*)(p.ws + OFF_GX); float* GC = GA + GX_STRIDE; float* GW = GC + GX_STRIDE; float* DEC = GW + GX_STRIDE;
    for (int item = blockIdx.x * 8 + wv; item < 260 * 16; item += gridDim.x * 8) {
        const int cidx = item >> 4, hd = item & 15, h = hd >> 1, dir = hd & 1;
        const int r = chunk_row0(cidx) + lane;
        const int ci = (dir ? 2 : 0) * 8 + h, cf = (dir ? 3 : 1) * 8 + h;
        const float lf = logsig_f(G[(size_t)r * 32 + cf] + bg[cf]), li = G[(size_t)r * 32 + ci] + bg[ci];
        float b = lf;
        if (dir == 0) {
#pragma unroll
            for (int o = 1; o < 64; o <<= 1) { const float t = __shfl_up(b, o); if (lane >= o) b += t; }
        } else {
#pragma unroll
            for (int o = 1; o < 64; o <<= 1) { const float t = __shfl_down(b, o); if (lane + o < 64) b += t; }
        }
        const float bend = __shfl(b, dir ? 0 : 63);
        const size_t gb = (size_t)(dir * 8 + h) * MT;
        GA[gb + r] = expf(b); GC[gb + r] = expf(li - b); GW[gb + r] = expf(bend - b + li);
        if (lane == 0) DEC[(dir * 8 + h) * 260 + cidx] = expf(bend);
    }
}
__device__ __forceinline__ void phase_l1_prep(const Params& p, LAS unsigned char* lds) {
    l1_gate_items(p);
    for (int task = blockIdx.x; task < 32 + 1024; task += gridDim.x) l1_qk_task(p, lds, task);
}

__device__ __forceinline__ void phase_l1_passB(const Params& p) {
    const float* DEC = (const float*)(p.ws + OFF_GX) + 3 * GX_STRIDE;
    float* CST = (float*)(p.ws + OFF_HYT); float* NST = (float*)(p.ws + OFF_NST);
    const int NE = 16 * 32768 + 16 * 128;
    for (int g = blockIdx.x * 512 + otid(); g < NE; g += gridDim.x * 512) {
        const bool isn = g >= 16 * 32768;
        const int hd = isn ? (g - 16 * 32768) >> 7 : g >> 15, idx = isn ? (g - 16 * 32768) & 127 : g & 32767;
        const int h = hd >> 1, dir = hd & 1;
        float cin = 0.f;
        for (int sc = 0; sc < 17; ++sc) {
            float dsc = 1.f; const int nc = sc == 0 ? 4 : 16;
            for (int c = 0; c < nc; ++c) dsc *= DEC[(dir * 8 + h) * 260 + chunk_of(sc, dir, c)];
            float* ptr = isn ? NST + (size_t)(sc * 16 + hd) * 128 + idx : CST + (size_t)(sc * 16 + hd) * 32768 + idx;
            const float loc = sc < 16 ? *ptr : 0.f; *ptr = cin; cin = dsc * cin + loc;
        }
    }
}
constexpr int PC_QS = 0;
constexpr int PC_KS = 16896;
constexpr int PC_KT = 33792;
constexpr int PC_VS = 52224;
constexpr int PC_OS = 89088;
constexpr int PC_WT = 130048;
constexpr int PC_NL = 130816;
__device__ __forceinline__ bf16x8 pack8(const f32x16& v, int o) {
    u32x4 w; w.x = pk_bf16(v[o], v[o + 1]); w.y = pk_bf16(v[o + 2], v[o + 3]); w.z = pk_bf16(v[o + 4], v[o + 5]); w.w = pk_bf16(v[o + 6], v[o + 7]);
    return __builtin_bit_cast(bf16x8, w);
}
struct PcStage { u32x4 q0, q1, k0, k1, t0, t1, v0, v1, v2, v3; float wt; };
__device__ __forceinline__ bf16x8 lds_frag2(LAS unsigned char* base, int byteoff) {
    const u32x2 a = *(const LAS u32x2*)(base + byteoff), b = *(const LAS u32x2*)(base + byteoff + 16);
    const u32x4 w = (u32x4){a.x, a.y, b.x, b.y}; return __builtin_bit_cast(bf16x8, w);
}
__device__ __forceinline__ void phase_l1_passC(const Params& p, LAS unsigned char* lds) {
    const int tid = otid(), wv = __builtin_amdgcn_readfirstlane(tid >> 6), lane = tid & 63, l31 = lane & 31, hh = lane >> 5;
    const bf16_t* QS = (const bf16_t*)(p.ws + L1_OFF_QS); const bf16_t* KS = (const bf16_t*)(p.ws + L1_OFF_KS); const bf16_t* KT = (const bf16_t*)(p.ws + L1_OFF_KT);
    const bf16_t* VT = (const bf16_t*)(p.ws + OFF_BIG2);
    const unsigned so_q = (unsigned)((tid >> 3) * 1024 + (tid & 7) * 8), so_t = (unsigned)((tid >> 2) * MT + (tid & 3) * 8), so_v = (unsigned)((lane >> 1) * MT + (lane & 1) * 32), so_w = (unsigned)((tid >> 6) * (int)GX_STRIDE + (tid & 63));
    const float* GX = (const float*)(p.ws + OFF_GX); const float* DEC = GX + 3 * GX_STRIDE;
    const float* CST = (const float*)(p.ws + OFF_HYT); const float* NST = (const float*)(p.ws + OFF_NST);
    bf16_t* HF = (bf16_t*)(p.ws + OFF_A); bf16_t* HB = (bf16_t*)(p.ws + OFF_X);
    const u32x4 ones_u = (u32x4){0x3F803F80u, 0x3F803F80u, 0x3F803F80u, 0x3F803F80u};
    const bf16x8 ones = __builtin_bit_cast(bf16x8, ones_u);
    LAS float* WT = (LAS float*)(lds + PC_WT);
    LAS unsigned char* VSw = lds + PC_VS + wv * 4608;
    LAS unsigned char* OSw = lds + PC_OS + wv * 5120;
    for (int task = blockIdx.x; task < 16 * 16; task += gridDim.x) {
        const int hd = task & 15, sc = 1 + (task >> 4), h = hd >> 1, dir = hd & 1, w = wv;
        const size_t gb = (size_t)(dir * 8 + h) * MT;
        bf16_t* HO = dir ? HB : HF;
        f32x16 X[4];
        { const float* src = CST + (size_t)((sc * 16 + hd) * 8 + w) * 4096;
#pragma unroll
          for (int i = 0; i < 4; ++i)
#pragma unroll
              for (int q = 0; q < 16; ++q) X[i][q] = src[(i * 16 + q) * 64 + lane]; }
        LAS float* nlc = (LAS float*)(lds + PC_NL); LAS float* nln = nlc + 128;
        if (tid < 128) nlc[tid] = NST[(size_t)(sc * 16 + hd) * 128 + tid];
        PcStage sg;
#define PC_LOAD(cidx_) do { const int rw_ = (cidx_) * 64; \
            const bf16_t* qb_ = QS + (size_t)rw_ * 1024 + h * 128; sg.q0 = *(const u32x4*)(qb_ + so_q); sg.q1 = *(const u32x4*)(qb_ + so_q + 64u); \
            const bf16_t* kb_ = KS + (size_t)rw_ * 1024 + h * 128; sg.k0 = *(const u32x4*)(kb_ + so_q); sg.k1 = *(const u32x4*)(kb_ + so_q + 64u); \
            const bf16_t* tb_ = KT + (size_t)(h * 128) * MT + rw_; sg.t0 = *(const u32x4*)(tb_ + so_t); sg.t1 = *(const u32x4*)(tb_ + so_t + 32u); \
            const bf16_t* vb2_ = VT + (size_t)(h * 256 + 32 * w) * MT + rw_; sg.v0 = *(const u32x4*)(vb2_ + so_v); sg.v1 = *(const u32x4*)(vb2_ + so_v + 8u); sg.v2 = *(const u32x4*)(vb2_ + so_v + 16u); sg.v3 = *(const u32x4*)(vb2_ + so_v + 24u); \
            sg.wt = tid < 192 ? (GX + gb + rw_)[so_w] : 0.f; } while (0)
#define PC_ST64(base_, off_, v_) do { *(LAS u32x2*)((base_) + (off_)) = (u32x2){(v_).x, (v_).y}; *(LAS u32x2*)((base_) + (off_) + 8) = (u32x2){(v_).z, (v_).w}; } while (0)
#define PC_STORE() do { \
            PC_ST64(lds + PC_QS, (tid >> 3) * 264 + (tid & 7) * 16, sg.q0); PC_ST64(lds + PC_QS, (tid >> 3) * 264 + (tid & 7) * 16 + 128, sg.q1); \
            PC_ST64(lds + PC_KS, (tid >> 3) * 264 + (tid & 7) * 16, sg.k0); PC_ST64(lds + PC_KS, (tid >> 3) * 264 + (tid & 7) * 16 + 128, sg.k1); \
            *(LAS u32x4*)(lds + PC_KT + (tid >> 2) * 144 + (tid & 3) * 16) = sg.t0; *(LAS u32x4*)(lds + PC_KT + (tid >> 2) * 144 + (tid & 3) * 16 + 64) = sg.t1; \
            { LAS unsigned char* vb_ = VSw + (lane >> 1) * 144 + (lane & 1) * 64; *(LAS u32x4*)vb_ = sg.v0; *(LAS u32x4*)(vb_ + 16) = sg.v1; *(LAS u32x4*)(vb_ + 32) = sg.v2; *(LAS u32x4*)(vb_ + 48) = sg.v3; } \
            if (tid < 192) WT[tid] = sg.wt; } while (0)
        __syncthreads();
        PC_LOAD(chunk_of(sc, dir, 0)); PC_STORE();
        __syncthreads();
#pragma unroll 1
        for (int c = 0; c < 16; ++c) {
            const int cidx = chunk_of(sc, dir, c), rw0 = cidx * 64;
#pragma unroll 1
            for (int tt = 0; tt < 2; ++tt) {
                const int qoff = PC_QS + (32 * tt + l31) * 264 + 8 * hh;
                f32x16 num, den;
#pragma unroll
                for (int q = 0; q < 16; ++q) { num[q] = 0.f; den[q] = 0.f; }
#pragma unroll
                for (int st = 0; st < 2; ++st) {
                    f32x16 S;
#pragma unroll
                    for (int q = 0; q < 16; ++q) S[q] = 0.f;
#pragma unroll
                    for (int ks = 0; ks < 8; ++ks) { const bf16x8 qf = lds_frag2(lds, qoff + 32 * ks); const bf16x8 kf = lds_frag2(lds, PC_KS + (32 * st + l31) * 264 + 8 * hh + 32 * ks);
                        S = __builtin_amdgcn_mfma_f32_32x32x16_bf16(kf, qf, S, 0, 0, 0); }
                    const int t = 32 * tt + l31;
#pragma unroll
                    for (int g = 0; g < 4; ++g) { const f32x4 c4 = *(const LAS f32x4*)(WT + 64 + 32 * st + 8 * g + 4 * hh);
#pragma unroll
                        for (int q = 0; q < 4; ++q) { const int s_ = 32 * st + 8 * g + 4 * hh + q; const bool ok = dir ? (s_ >= t) : (s_ <= t);
                            S[4 * g + q] = ok ? S[4 * g + q] * c4[q] : 0.f; } }
#pragma unroll
                    for (int kk = 0; kk < 2; ++kk) {
                        const bf16x8 xf = pack8(S, 8 * kk);
                        const bf16x8 vf = lds_frag2(VSw, l31 * 144 + (32 * st + 16 * kk + 4 * hh) * 2);
                        num = __builtin_amdgcn_mfma_f32_32x32x16_bf16(xf, vf, num, 0, 0, 0);
                        den = __builtin_amdgcn_mfma_f32_32x32x16_bf16(xf, ones, den, 0, 0, 0);
                    }
                }
#pragma unroll
                for (int i = 0; i < 4; ++i)
#pragma unroll
                    for (int s2 = 0; s2 < 2; ++s2) {
                        const bf16x8 bx = pack8(X[i], 8 * s2);
                        const bf16x8 qf = lds_frag2(lds, qoff + 32 * (2 * i + s2));
                        num = __builtin_amdgcn_mfma_f32_32x32x16_bf16(qf, bx, num, 0, 0, 0);
                        const f32x4 na = *(const LAS f32x4*)(nlc + 32 * i + 16 * s2 + 4 * hh), nb = *(const LAS f32x4*)(nlc + 32 * i + 16 * s2 + 8 + 4 * hh);
                        u32x4 nw; nw.x = pk_bf16(na[0], na[1]); nw.y = pk_bf16(na[2], na[3]); nw.z = pk_bf16(nb[0], nb[1]); nw.w = pk_bf16(nb[2], nb[3]);
                        den = __builtin_amdgcn_mfma_f32_32x32x16_bf16(qf, __builtin_bit_cast(bf16x8, nw), den, 0, 0, 0);
                    }
#pragma unroll
                for (int g = 0; g < 4; ++g) { const f32x4 a4 = *(const LAS f32x4*)(WT + 32 * tt + 8 * g + 4 * hh);
#pragma unroll
                    for (int q = 0; q < 4; ++q) { const float a = a4[q]; const float hv = a * num[4 * g + q] / fmaxf(fabsf(a * den[4 * g + q]), 1.0f);
                        *(LAS unsigned short*)(OSw + (32 * tt + 8 * g + 4 * hh + q) * 80 + l31 * 2) = f2bf(hv); } }
            }
#pragma unroll
            for (int it = 0; it < 4; ++it) { const int tok = it * 16 + (lane >> 2), sgm = lane & 3;
                const u32x4 ov = *(const LAS u32x4*)(OSw + tok * 80 + sgm * 16);
                *(u32x4*)((HO + (size_t)rw0 * 2048 + h * 256 + 32 * w) + (unsigned)(tok * 2048 + sgm * 8)) = ov; }
            const float dec = DEC[(dir * 8 + h) * 260 + cidx];
#pragma unroll
            for (int i = 0; i < 4; ++i) X[i] *= dec;
#pragma unroll
            for (int ks = 0; ks < 4; ++ks) {
                const u32x4 vr = *(const LAS u32x4*)(VSw + l31 * 144 + 32 * ks + 16 * hh);
                const f32x4 wa = *(const LAS f32x4*)(WT + 128 + 16 * ks + 8 * hh), wb = *(const LAS f32x4*)(WT + 128 + 16 * ks + 8 * hh + 4);
                u32x4 vs; vs.x = pk_bf16(bflo(vr.x) * wa[0], bfhi(vr.x) * wa[1]); vs.y = pk_bf16(bflo(vr.y) * wa[2], bfhi(vr.y) * wa[3]);
                vs.z = pk_bf16(bflo(vr.z) * wb[0], bfhi(vr.z) * wb[1]); vs.w = pk_bf16(bflo(vr.w) * wb[2], bfhi(vr.w) * wb[3]);
                const bf16x8 bfr = __builtin_bit_cast(bf16x8, vs);
#pragma unroll
                for (int i = 0; i < 4; ++i) { const u32x4 ar = *(const LAS u32x4*)(lds + PC_KT + (32 * i + l31) * 144 + 32 * ks + 16 * hh);
                    X[i] = __builtin_amdgcn_mfma_f32_32x32x16_bf16(__builtin_bit_cast(bf16x8, ar), bfr, X[i], 0, 0, 0); }
            }
            if (tid < 128) { float a = 0.f;
#pragma unroll
                for (int q = 0; q < 8; ++q) { const u32x4 kr = *(const LAS u32x4*)(lds + PC_KT + tid * 144 + 16 * q);
                    const f32x4 wa = *(const LAS f32x4*)(WT + 128 + 8 * q), wb = *(const LAS f32x4*)(WT + 128 + 8 * q + 4);
                    a = fmaf(wa[0], bflo(kr.x), a); a = fmaf(wa[1], bfhi(kr.x), a); a = fmaf(wa[2], bflo(kr.y), a); a = fmaf(wa[3], bfhi(kr.y), a);
                    a = fmaf(wb[0], bflo(kr.z), a); a = fmaf(wb[1], bfhi(kr.z), a); a = fmaf(wb[2], bflo(kr.w), a); a = fmaf(wb[3], bfhi(kr.w), a); }
                nln[tid] = dec * nlc[tid] + a; }
            __syncthreads();
            if (c + 1 < 16) { PC_LOAD(chunk_of(sc, dir, c + 1)); PC_STORE(); }
            { LAS float* t_ = nlc; nlc = nln; nln = t_; }
            __syncthreads();
        }
#undef PC_LOAD
#undef PC_ST64
#undef PC_STORE
    }
}
__device__ __forceinline__ void phase_l1_passA2(const Params& p, LAS unsigned char* lds) {
    const int tid = otid(), wv = __builtin_amdgcn_readfirstlane(tid >> 6), lane = tid & 63, l31 = lane & 31, hh = lane >> 5;
    const bf16_t* KT = (const bf16_t*)(p.ws + L1_OFF_KT); const bf16_t* VT = (const bf16_t*)(p.ws + OFF_BIG2);
    const float* GX = (const float*)(p.ws + OFF_GX); const float* DEC = GX + 3 * GX_STRIDE;
    float* CST = (float*)(p.ws + OFF_HYT); float* NST = (float*)(p.ws + OFF_NST);
    const unsigned so_t = (unsigned)((tid >> 2) * MT + (tid & 3) * 8), so_v = (unsigned)((lane >> 1) * MT + (lane & 1) * 32);
    LAS float* WT = (LAS float*)(lds + PC_WT);
    LAS unsigned char* VSw = lds + PC_VS + wv * 4608;
    for (int task = blockIdx.x; task < 16 * 16; task += gridDim.x) {
        const int hd = task & 15, sc = task >> 4, h = hd >> 1, dir = hd & 1, w = wv;
        const size_t gb = (size_t)(dir * 8 + h) * MT;
        f32x16 X[4];
#pragma unroll
        for (int i = 0; i < 4; ++i)
#pragma unroll
            for (int q = 0; q < 16; ++q) X[i][q] = 0.f;
        float nacc = 0.f;
        const int nc = sc == 0 ? 4 : 16;
#pragma unroll 1
        for (int c = 0; c < nc; ++c) {
            const int cidx = chunk_of(sc, dir, c), rw0 = chunk_row0(cidx);
            __syncthreads();
            { const bf16_t* tb_ = KT + (size_t)(h * 128) * MT + rw0; const u32x4 t0 = *(const u32x4*)(tb_ + so_t), t1 = *(const u32x4*)(tb_ + so_t + 32u);
              const bf16_t* vb_ = VT + (size_t)(h * 256 + 32 * w) * MT + rw0; const u32x4 v0 = *(const u32x4*)(vb_ + so_v), v1 = *(const u32x4*)(vb_ + so_v + 8u), v2 = *(const u32x4*)(vb_ + so_v + 16u), v3 = *(const u32x4*)(vb_ + so_v + 24u);
              const float wt = tid < 64 ? (GX + 2 * GX_STRIDE + gb + rw0)[tid] : 0.f;
              *(LAS u32x4*)(lds + PC_KT + (tid >> 2) * 144 + (tid & 3) * 16) = t0; *(LAS u32x4*)(lds + PC_KT + (tid >> 2) * 144 + (tid & 3) * 16 + 64) = t1;
              LAS unsigned char* vb2 = VSw + (lane >> 1) * 144 + (lane & 1) * 64; *(LAS u32x4*)vb2 = v0; *(LAS u32x4*)(vb2 + 16) = v1; *(LAS u32x4*)(vb2 + 32) = v2; *(LAS u32x4*)(vb2 + 48) = v3;
              if (tid < 64) WT[128 + tid] = wt; }
            __syncthreads();
            const float dec = DEC[(dir * 8 + h) * 260 + cidx];
#pragma unroll
            for (int i = 0; i < 4; ++i) X[i] *= dec;
#pragma unroll
            for (int ks = 0; ks < 4; ++ks) {
                const u32x4 vr = *(const LAS u32x4*)(VSw + l31 * 144 + 32 * ks + 16 * hh);
                const f32x4 wa = *(const LAS f32x4*)(WT + 128 + 16 * ks + 8 * hh), wb = *(const LAS f32x4*)(WT + 128 + 16 * ks + 8 * hh + 4);
                u32x4 vs; vs.x = pk_bf16(bflo(vr.x) * wa[0], bfhi(vr.x) * wa[1]); vs.y = pk_bf16(bflo(vr.y) * wa[2], bfhi(vr.y) * wa[3]);
                vs.z = pk_bf16(bflo(vr.z) * wb[0], bfhi(vr.z) * wb[1]); vs.w = pk_bf16(bflo(vr.w) * wb[2], bfhi(vr.w) * wb[3]);
                const bf16x8 bfr = __builtin_bit_cast(bf16x8, vs);
#pragma unroll
                for (int i = 0; i < 4; ++i) { const u32x4 ar = *(const LAS u32x4*)(lds + PC_KT + (32 * i + l31) * 144 + 32 * ks + 16 * hh);
                    X[i] = __builtin_amdgcn_mfma_f32_32x32x16_bf16(__builtin_bit_cast(bf16x8, ar), bfr, X[i], 0, 0, 0); }
            }
            if (tid < 128) { float a = 0.f;
#pragma unroll
                for (int q = 0; q < 8; ++q) { const u32x4 kr = *(const LAS u32x4*)(lds + PC_KT + tid * 144 + 16 * q);
                    const f32x4 wa = *(const LAS f32x4*)(WT + 128 + 8 * q), wb = *(const LAS f32x4*)(WT + 128 + 8 * q + 4);
                    a = fmaf(wa[0], bflo(kr.x), a); a = fmaf(wa[1], bfhi(kr.x), a); a = fmaf(wa[2], bflo(kr.y), a); a = fmaf(wa[3], bfhi(kr.y), a);
                    a = fmaf(wb[0], bflo(kr.z), a); a = fmaf(wb[1], bfhi(kr.z), a); a = fmaf(wb[2], bflo(kr.w), a); a = fmaf(wb[3], bfhi(kr.w), a); }
                nacc = dec * nacc + a; }
        }
        float* dst = CST + (size_t)((sc * 16 + hd) * 8 + w) * 4096;
#pragma unroll
        for (int i = 0; i < 4; ++i)
#pragma unroll
            for (int q = 0; q < 16; ++q) dst[(i * 16 + q) * 64 + lane] = X[i][q];
        if (tid < 128) NST[(size_t)(sc * 16 + hd) * 128 + tid] = nacc;
    }
    __syncthreads();
}
__device__ __forceinline__ void phase_l1_merge(const Params& p) {
    const int tid = otid(), wv = tid >> 6, lane = tid & 63;
    const bf16_t* HF = (const bf16_t*)(p.ws + OFF_A); const bf16_t* HB = (const bf16_t*)(p.ws + OFF_X); const bf16_t* Ob = (const bf16_t*)(p.ws + L1_OFF_OB);
    bf16_t* OUT = (bf16_t*)(p.ws + OFF_QK);
    const float* nw = p.in[I_MLNW];
    for (int t = blockIdx.x * 8 + wv; t < TL; t += gridDim.x * 8) {
#pragma unroll
        for (int pc = 0; pc < 4; ++pc) { const int e = pc * 512 + lane * 8;
            const u32x4 a = *(const u32x4*)(HF + (size_t)t * 2048 + e), b = *(const u32x4*)(HB + (size_t)t * 2048 + e), o = *(const u32x4*)(Ob + (size_t)t * 2048 + e);
            float hv[8] = {bflo(a.x) + bflo(b.x), bfhi(a.x) + bfhi(b.x), bflo(a.y) + bflo(b.y), bfhi(a.y) + bfhi(b.y), bflo(a.z) + bflo(b.z), bfhi(a.z) + bfhi(b.z), bflo(a.w) + bflo(b.w), bfhi(a.w) + bfhi(b.w)};
            const float ov[8] = {bflo(o.x), bfhi(o.x), bflo(o.y), bfhi(o.y), bflo(o.z), bfhi(o.z), bflo(o.w), bfhi(o.w)};
            float s = 0.f;
#pragma unroll
            for (int j = 0; j < 8; ++j) s += hv[j];
#pragma unroll
            for (int of = 16; of > 0; of >>= 1) s += __shfl_xor(s, of);
            const float mu = s * (1.0f / 256.0f);
            float q = 0.f;
#pragma unroll
            for (int j = 0; j < 8; ++j) { const float d = hv[j] - mu; q += d * d; }
#pragma unroll
            for (int of = 16; of > 0; of >>= 1) q += __shfl_xor(q, of);
            const float rs = rsqrtf(q * (1.0f / 256.0f) + LN_EPS);
            float wn[8], r8[8]; ld8(nw + e, wn);
#pragma unroll
            for (int j = 0; j < 8; ++j) { const float hn = bf2f(f2bf((hv[j] - mu) * rs * wn[j])); r8[j] = hn * sigmoid_f(ov[j]); }
#if F8_L1O
            *(u32x2*)((unsigned char*)OUT + (size_t)t * 2048 + e) = (u32x2){fp8x4(clamp8(r8[0] * G8_XS), clamp8(r8[1] * G8_XS), clamp8(r8[2] * G8_XS), clamp8(r8[3] * G8_XS)), fp8x4(clamp8(r8[4] * G8_XS), clamp8(r8[5] * G8_XS), clamp8(r8[6] * G8_XS), clamp8(r8[7] * G8_XS))}; }
#else
            st8bf(OUT + (size_t)t * 2048 + e, r8); }
#endif
    }
}
__global__ void __launch_bounds__(NTHREADS, 2) hybrid_fwd_megakernel(Params p) {
    extern __shared__ __attribute__((aligned(16))) unsigned char smem_raw[];
    LAS unsigned char* lds = (LAS unsigned char*)smem_raw;
    volatile LAS unsigned* bst = (volatile LAS unsigned*)(lds + LDS_BYTES - 16);
    if (threadIdx.x < 4) bst[threadIdx.x] = 0u;
    __syncthreads();
    XcdBarrier bar = xcd_barrier_post((unsigned*)(p.ws + OFF_BAR), bst);
#define ws (get_ws())
#define Abuf ((bf16_t*)(ws + OFF_A))
    phase0(fresh(p), lds, P0_T0, P0_T2);
    phase0(fresh(p), lds, P0_T4, P0_T5);
    phase0(fresh(p), lds, P0_T5, P0_T6);
    phase0(fresh(p), lds, P0_T6, P0_T7);
    phase0(fresh(p), lds, P0_T7, P0_NT);
    xcd_barrier(bar);
    modulate_rows(p.in[I_X], p.in[I_CTX], (const float*)(ws + OFF_MOD), Abuf, ws + OFF_X);
    hyena_taps(fresh(p));
    xcd_barrier(bar);
    {
        unsigned char* w_ = ws;
#if F8_L0NA
        {
            pg8::Sched2<pg8::EpiBf16, 2> S{(const char*)(w_ + OFF_W0T), (const char*)(w_ + OFF_A), 12, 65, nullptr, nullptr, 0, 0, (int)gridDim.x, (int)blockIdx.x};
            pg8::EpiS2<pg8::EpiBf16> E{pg8::EpiBf16{(bf16_t*)(w_ + OFF_BIG2), MT}, pg8::EpiBf16{(bf16_t*)(w_ + OFF_QK), 2048}};
            pg8::gemm_stream<pg8::EpiS2<pg8::EpiBf16>, pg8::Sched2<pg8::EpiBf16, 2>, false>(lds, 2048, S, E); __syncthreads(); }
        {
            const char* w8 = (const char*)(w_ + OFF_W0T + (size_t)3072 * 4096); const char* u8 = (const char*)(w_ + OFF_X);
            pg8::Sched2<pg8::EpiBf16, 1> S{w8, u8, 4, 65, u8, w8 + (size_t)1024 * 2048, 65, 8, (int)gridDim.x, (int)gridDim.x - 1 - (int)blockIdx.x};
            pg8::EpiS2<pg8::EpiBf16> E{pg8::EpiBf16{(bf16_t*)(w_ + OFF_BIG2) + (size_t)3072 * MT, MT}, pg8::EpiBf16{(bf16_t*)(w_ + OFF_QK), 2048}};
            pg8::gemm_stream<pg8::EpiS2<pg8::EpiBf16>, pg8::Sched2<pg8::EpiBf16, 1>, true>(lds, 2048, S, E); __syncthreads(); }
#else
        constexpr int ES = F8_L0 ? 1 : 2;
        pg8::Sched2<pg8::EpiBf16, ES> S{(const char*)(w_ + OFF_W0T), (const char*)(w_ + OFF_A), 16, 65, (const char*)(w_ + OFF_A), (const char*)(w_ + OFF_W0T) + (size_t)4096 * 2048 * ES, 65, 8, (int)gridDim.x, (int)blockIdx.x};
        pg8::EpiS2<pg8::EpiBf16> E{pg8::EpiBf16{(bf16_t*)(w_ + OFF_BIG2), MT}, pg8::EpiBf16{(bf16_t*)(w_ + OFF_QK), 2048}};
        pg8::gemm_stream<pg8::EpiS2<pg8::EpiBf16>, pg8::Sched2<pg8::EpiBf16, ES>, ES == 1>(lds, 2048, S, E); __syncthreads();
#endif
    }
    xcd_barrier(bar);
    phase3(fresh(p), lds);
    xcd_barrier(bar);
    phase4(fresh(p), lds);
    xcd_barrier(bar);
    {
        unsigned char* w_ = ws;
        pg8::SchedTail S{(const char*)(w_ + OFF_A), (const char*)(w_ + OFF_WO0T), 64, 8, true, (int)gridDim.x, (int)blockIdx.x};
        pg8::EpiTail<true, pg8::EpiBf16> E{pg8::EpiBf16{(bf16_t*)(w_ + OFF_BIG2), 2048}, (float*)(w_ + OFF_X)};
        pg8::gemm_stream(lds, 2048, S, E); __syncthreads();
    }
    phase0(fresh(p), lds, P0_T2, P0_T4, 8);
    xcd_barrier(bar);
    phase_ln1(fresh(p), 0, MT, (const float*)(ws + OFF_X));
    xcd_barrier(bar);
    {
        unsigned char* w_ = ws;
        pg8::SchedTail S{(const char*)(w_ + OFF_WQK), (const char*)(w_ + OFF_A), 8, 64, false, (int)gridDim.x, (int)blockIdx.x};
        pg8::EpiTail<false, pg8::EpiF32> E{pg8::EpiF32{(float*)(w_ + OFF_BIG1), MT}, (float*)(w_ + OFF_X)};
        pg8::gemm_stream(lds, 2048, S, E); __syncthreads();
    }
    xcd_barrier(bar);
    phase_topk(fresh(p), lds, MT, (const float*)(ws + OFF_X));
    xcd_barrier(bar);
    phase_peer(fresh(p), lds, 0, MT);
    xcd_barrier(bar);
    {
        unsigned char* w_ = ws;
        constexpr int ES = F8_L1 ? 1 : 2;
        const char* u1 = (const char*)(w_ + (F8_L1 ? OFF_X : OFF_A));
        pg8::Sched2<pg8::EpiL1, ES> S{(const char*)(w_ + OFF_W1T), u1, 8, 65, u1, (const char*)(w_ + OFF_W1T) + (size_t)2048 * 2048 * ES, 65, 17, (int)gridDim.x, (int)blockIdx.x};
        pg8::EpiS2<pg8::EpiL1> E{pg8::EpiBf16{(bf16_t*)(w_ + OFF_BIG2), MT}, pg8::EpiL1{(bf16_t*)(w_ + OFF_QK), (bf16_t*)(w_ + L1_OFF_OB), (float*)(w_ + OFF_GATE)}};
        pg8::gemm_stream<pg8::EpiS2<pg8::EpiL1>, pg8::Sched2<pg8::EpiL1, ES>, ES == 1>(lds, 2048, S, E); __syncthreads();
    }
    xcd_barrier(bar);
    phase_l1_prep(fresh(p), lds);
    xcd_barrier(bar);
    phase_l1_passA2(fresh(p), lds);
    xcd_barrier(bar);
    phase_l1_passB(fresh(p));
    xcd_barrier(bar);
    phase_l1_passC(fresh(p), lds);
    xcd_barrier(bar);
    phase_l1_merge(fresh(p));
    xcd_barrier(bar);
#if F8_L1O
    {   unsigned char* w_ = ws;
        pg8::Sched1<1> S{(const char*)(w_ + OFF_QK), (const char*)(w_ + OFF_WO1T), TL / 256, 8, (int)gridDim.x, (int)blockIdx.x};
        pg8::EpiG<pg8::EpiBf16> E{pg8::EpiBf16{(bf16_t*)(w_ + OFF_BIG2), 2048}};
        pg8::gemm_stream<pg8::EpiG<pg8::EpiBf16>, pg8::Sched1<1>, true>(lds, 2048, S, E); __syncthreads();
    }
#else
    run_gemm(lds, (const bf16_t*)(ws + OFF_QK), (const bf16_t*)(ws + OFF_WO1T), TL, 2048, 2048, pg8::EpiBf16{(bf16_t*)(ws + OFF_BIG2), 2048});
#endif
    xcd_barrier(bar);
    phase_ln1(fresh(p), 1, TL, nullptr);
    xcd_barrier(bar);
    run_gemm(lds, (const bf16_t*)(ws + OFF_WQK) + (size_t)2048 * 2048, Abuf, 2048, TL, 2048, pg8::EpiF32{(float*)(ws + OFF_BIG1), MT});
    xcd_barrier(bar);
    phase_topk(fresh(p), lds, TL, nullptr);
    xcd_barrier(bar);
    phase_peer(fresh(p), lds, 1, TL);
#undef ws
#undef Abuf
}

extern "C" void kernel_launch(void* const* d_in, const int* in_sizes, int n_in, void* d_out, int out_size, void* d_ws, size_t ws_size, hipStream_t stream) {
    static int grid = 0;
    if (grid == 0) {
        int dev = 0, cus = 0;
        if (hipGetDevice(&dev) != hipSuccess || hipDeviceGetAttribute(&cus, hipDeviceAttributeMultiprocessorCount, dev) != hipSuccess) { fprintf(stderr, "kernel_launch: device query failed\n"); grid = -1; return; }
        if (hipFuncSetAttribute((const void*)hybrid_fwd_megakernel, hipFuncAttributeMaxDynamicSharedMemorySize, LDS_BYTES) != hipSuccess) { fprintf(stderr, "kernel_launch: hipFuncSetAttribute failed\n"); grid = -1; return; }
        int per_cu = 0;
        if (hipOccupancyMaxActiveBlocksPerMultiprocessor(&per_cu, (const void*)hybrid_fwd_megakernel, NTHREADS, LDS_BYTES) != hipSuccess || per_cu < 1) { fprintf(stderr, "kernel_launch: occupancy query says %d blocks/CU\n", per_cu); (void)hipGetLastError(); }
        if (n_in != 32 || ws_size < WS_END) { fprintf(stderr, "kernel_launch: unexpected n_in %d / ws_size %zu (need %zu)\n", n_in, ws_size, (size_t)WS_END); grid = -1; return; }
        grid = cus;
    }
    if (grid < 0) return;
    (void)hipMemsetAsync((char*)d_ws + OFF_BAR, 0, 16384, stream);
    Params prm{};
    for (int i = 0; i < 32; ++i) prm.in[i] = (const float*)d_in[i];
    prm.out = (float*)d_out; prm.ws = (unsigned char*)d_ws;
    void* args[] = {&prm};
    hipError_t e = hipLaunchCooperativeKernel((const void*)hybrid_fwd_megakernel, dim3(grid), dim3(NTHREADS), args, LDS_BYTES, stream);
    if (e != hipSuccess) fprintf(stderr, "kernel_launch: cooperative launch failed: %s (grid %d)\n", hipGetErrorString(e), grid);
}
```

```cpp
#include <hip/hip_runtime.h>
#include <cstdio>
#include <cstdint>

#define LAS __attribute__((address_space(3)))
typedef unsigned short bf16_t;
typedef short bf16x8 __attribute__((ext_vector_type(8)));
typedef short bf16x4 __attribute__((ext_vector_type(4)));
typedef float f32x2 __attribute__((ext_vector_type(2)));
typedef float f32x4 __attribute__((ext_vector_type(4)));
typedef float f32x16 __attribute__((ext_vector_type(16)));
typedef unsigned u32x2 __attribute__((ext_vector_type(2)));
typedef unsigned u32x4 __attribute__((ext_vector_type(4)));
typedef __bf16 bf2_t __attribute__((ext_vector_type(2)));

constexpr int DM = 2048;
constexpr int TL = 16384;
constexpr int TCX = 256;
constexpr int MT = TL + TCX;
constexpr int NTHREADS = 512;
constexpr int LDS_BYTES = 151552;
constexpr float LN_EPS = 1e-6f;
constexpr float DN_ALPHA = 1.41421356237309515f;

constexpr size_t al256(size_t x) { return (x + 255) & ~(size_t)255; }
constexpr size_t OFF_BAR   = 0;
constexpr size_t OFF_MOD   = 16384;
constexpr size_t OFF_ROPE  = OFF_MOD + al256((size_t)2 * 2 * 12288 * 4);
constexpr size_t OFF_A3    = OFF_ROPE + al256((size_t)256 * 32 * 8);
constexpr size_t OFF_GATE  = OFF_A3 + al256((size_t)MT * 64 * 2);
constexpr size_t OFF_GX    = OFF_GATE + al256((size_t)MT * 32 * 4);
constexpr size_t GX_STRIDE = (size_t)2 * 8 * MT;
constexpr size_t OFF_NST   = OFF_GX + al256((3 * GX_STRIDE + 2 * 8 * 260 + 64) * 4);
constexpr size_t OFF_W0T   = OFF_NST + al256((size_t)17 * 16 * 128 * 4);
constexpr size_t OFF_WO0T  = OFF_W0T + (size_t)6144 * 2048 * 2;
constexpr size_t OFF_W1T   = OFF_WO0T + (size_t)2048 * 2048 * 2;
constexpr size_t OFF_WO1T  = OFF_W1T + (size_t)6400 * 2048 * 2;
constexpr size_t OFF_WQK   = OFF_WO1T + (size_t)2048 * 2048 * 2;
constexpr size_t OFF_PEER  = OFF_WQK + (size_t)2 * 2048 * 2048 * 2;
constexpr size_t PEER_TBL  = (size_t)16384 * 2048;
constexpr float PEER_USCALE = 64.0f, PEER_VSCALE = 4.0f, PEER_VSCALE6 = 3.0f;
constexpr size_t OFF_BIG1  = OFF_PEER + 4 * PEER_TBL * 2;
constexpr size_t BIG_BYTES = al256((size_t)140000000);
constexpr size_t OFF_BIG2  = OFF_BIG1 + BIG_BYTES;
constexpr size_t OFF_H     = OFF_BIG2 + BIG_BYTES;
constexpr size_t OFF_A     = OFF_H + (size_t)MT * DM * 4;
constexpr size_t OFF_QK    = OFF_A + (size_t)MT * DM * 2;
constexpr size_t OFF_HYT   = OFF_QK + (size_t)MT * DM * 2;
constexpr size_t OFF_EXP   = OFF_HYT + al256((size_t)40000000);
constexpr size_t OFF_X     = OFF_EXP + (size_t)MT * 128 * 8;
constexpr size_t WS_END    = OFF_X + (size_t)MT * DM * 2;
static_assert(WS_END <= (size_t)1073741824, "workspace map exceeds 1 GiB");

__device__ __forceinline__ int opq(int v) { asm volatile("" : "+s"(v)); return v; }
__device__ __forceinline__ int otid() { int t = threadIdx.x; asm volatile("" : "+v"(t)); return t; }
__device__ __forceinline__ bf16_t f2bf(float f) { unsigned u = __float_as_uint(f); u += 0x7FFFu + ((u >> 16) & 1u); return (bf16_t)(u >> 16); }
__device__ __forceinline__ float bf2f(bf16_t b) { return __uint_as_float(((unsigned)b) << 16); }
__device__ __forceinline__ unsigned pk_bf16(float lo, float hi) { unsigned r; asm volatile("v_cvt_pk_bf16_f32 %0, %1, %2" : "=v"(r) : "v"(lo), "v"(hi)); return r; }
typedef int i32x4 __attribute__((ext_vector_type(4)));
typedef int i32x8 __attribute__((ext_vector_type(8)));
typedef unsigned u32x6 __attribute__((ext_vector_type(6)));
typedef float f32x32 __attribute__((ext_vector_type(32)));
__device__ __forceinline__ unsigned fp8x4(float a, float b, float c, float d) { int v = 0; v = __builtin_amdgcn_cvt_pk_fp8_f32(a, b, v, false); v = __builtin_amdgcn_cvt_pk_fp8_f32(c, d, v, true); return (unsigned)v; }
__device__ __forceinline__ float clamp8(float v) { return __builtin_amdgcn_fmed3f(v, -448.f, 448.f); }
constexpr float G8_XS = 16.0f, G8_WS = 64.0f, G8_OS = 1.0f / (16.0f * 64.0f);
#define PEER_F6U 1
#define PEER_F6V 1
typedef float f32x16_t __attribute__((ext_vector_type(16)));
__device__ __forceinline__ void fp6enc32(const float (&v)[32], unsigned (&w)[6]) {
    f32x16_t a, b;
#pragma unroll
    for (int i = 0; i < 16; ++i) { a[i] = __builtin_amdgcn_fmed3f(v[2 * i], -7.5f, 7.5f); b[i] = __builtin_amdgcn_fmed3f(v[2 * i + 1], -7.5f, 7.5f); }
    const u32x6 p = __builtin_amdgcn_cvt_scalef32_2xpk16_fp6_f32(a, b, 1.0f);
#pragma unroll
    for (int k = 0; k < 6; ++k) w[k] = p[k];
}
#define F8_L0 0
#define F8_L0NA 1
#define F8_L1 1
#define F8_L1O 1
__device__ __forceinline__ float bflo(unsigned u) { return __uint_as_float(u << 16); }
__device__ __forceinline__ float bfhi(unsigned u) { return __uint_as_float(u & 0xFFFF0000u); }
__device__ __forceinline__ float wave_sum(float v) {
#pragma unroll
    for (int o = 32; o > 0; o >>= 1) v += __shfl_xor(v, o);
    return v;
}
__device__ __forceinline__ float wave_max(float v) {
#pragma unroll
    for (int o = 32; o > 0; o >>= 1) v = fmaxf(v, __shfl_xor(v, o));
    return v;
}
__device__ __forceinline__ float silu_f(float x) { return x / (1.f + __expf(-x)); }
__device__ __forceinline__ float sigmoid_f(float x) { return 1.f / (1.f + __expf(-x)); }

#define XB_TMO      128
#define XB_XCNT(j)  (256  + 64 * (j))
#define XB_XSUB(j)  (1280 + 64 * (j))
#define XB_XGEN(j)  (2304 + 64 * (j))
#define XB_TOP      3328
#define XB_TOPGEN   3392
#define XCD_BAR_WORDS 3456
#define XB_SPIN_CAP (1u << 30)
__device__ __forceinline__ unsigned xb_ld(unsigned* p)              { return __hip_atomic_load(p, __ATOMIC_RELAXED, __HIP_MEMORY_SCOPE_AGENT); }
__device__ __forceinline__ unsigned xb_add(unsigned* p, unsigned v) { return __hip_atomic_fetch_add(p, v, __ATOMIC_RELAXED, __HIP_MEMORY_SCOPE_AGENT); }
__device__ __forceinline__ unsigned xb_xcc_id() { return (unsigned)__builtin_amdgcn_s_getreg((3 << 11) | 20) & 0xFu; }
#define XB_SPIN(cond, bar) do { unsigned _sp = 0; while (cond) { __builtin_amdgcn_s_sleep(1); \
    if ((++_sp & 255u) == 0u) { if (xb_ld(&(bar)[XB_TMO])) break; if (_sp > XB_SPIN_CAP) { atomicAdd(&(bar)[XB_TMO], 1u); break; } } } } while (0)
struct XcdBarrier { unsigned* bar; unsigned x; volatile LAS unsigned* st; };
__device__ __forceinline__ XcdBarrier xcd_barrier_post(unsigned* bar, volatile LAS unsigned* st) {
    XcdBarrier b; b.bar = bar; b.x = xb_xcc_id(); b.st = st;
    if (threadIdx.x == 0) (void)xb_add(&bar[XB_XCNT(b.x)], 1u);
    return b;
}
__device__ __forceinline__ void xcd_barrier_complete(unsigned* bar, unsigned x, unsigned& nloc, unsigned& nx) {
    const unsigned G = gridDim.x * gridDim.y * gridDim.z;
    unsigned sum, cnt, mine, sp = 0u;
    for (;;) {
        sum = 0u; cnt = 0u; mine = 0u;
#pragma unroll
        for (unsigned j = 0; j < 16; ++j) { const unsigned c = xb_ld(&bar[XB_XCNT(j)]); sum += c; cnt += (c > 0u) ? 1u : 0u; mine = (j == x) ? c : mine; }
        if (sum == G) break;
        __builtin_amdgcn_s_sleep(1);
        if ((++sp & 255u) == 0u) { if (xb_ld(&bar[XB_TMO])) break; if (sp > XB_SPIN_CAP) { atomicAdd(&bar[XB_TMO], 1u); break; } }
    }
    nloc = mine > 0u ? mine : 1u; nx = cnt > 0u ? cnt : 1u;
}
__device__ __forceinline__ void xcd_barrier(const XcdBarrier& b) {
    asm volatile("s_waitcnt vmcnt(0)" ::: "memory");
    __syncthreads();
    if (threadIdx.x == 0) {
        unsigned* bar = b.bar;
        __builtin_amdgcn_s_waitcnt(0);
        unsigned nloc = b.st[0], nx = b.st[1];
        if (nloc == 0u) { xcd_barrier_complete(bar, b.x, nloc, nx); b.st[0] = nloc; b.st[1] = nx; }
        const unsigned old = xb_add(&bar[XB_XSUB(b.x)], 1u);
        const unsigned gen = old / nloc;
        if (old + 1u == (gen + 1u) * nloc) {
            __builtin_amdgcn_fence(__ATOMIC_RELEASE, "agent");
            asm volatile("s_waitcnt vmcnt(0)" ::: "memory");
            const unsigned og = xb_add(&bar[XB_TOP], 1u);
            const unsigned tg = og / nx;
            if (og + 1u == (tg + 1u) * nx) xb_add(&bar[XB_TOPGEN], 1u);
            else XB_SPIN(xb_ld(&bar[XB_TOPGEN]) == tg, bar);
            __builtin_amdgcn_fence(__ATOMIC_ACQUIRE, "agent");
            xb_add(&bar[XB_XGEN(b.x)], 1u);
            asm volatile("s_waitcnt vmcnt(0)" ::: "memory");
        } else {
            XB_SPIN(xb_ld(&bar[XB_XGEN(b.x)]) == gen, bar);
            __builtin_amdgcn_fence(__ATOMIC_ACQUIRE, "agent");
            asm volatile("s_waitcnt vmcnt(0)" ::: "memory");
        }
    }
    __syncthreads();
}

namespace pg8 {
constexpr int BM = 256, BK = 64, HALF = 128, HTB = HALF * BK * 2, STAGE_BYTES = 8 * HTB, NXCD = 8, WGM = 8;
__host__ __device__ __forceinline__ int lds_byte(int r, int c) { const int st = (r >> 4) * 2 + (c >> 5), rr = r & 15, cc = c & 31, ob = rr * 64 + cc * 2; return st * 1024 + (ob ^ (((ob >> 9) & 1) << 5)); }
__host__ __device__ __forceinline__ void stage_rc(int b, int& R, int& C) { const int st = b / 1024, sb = b % 1024, swz = sb ^ (((sb >> 9) & 1) << 5); R = (st >> 1) * 16 + swz / 64; C = (st & 1) * 32 + (swz % 64) / 2; }
__host__ __device__ __forceinline__ int perm32(int rho) { const int n = rho >> 4, i = rho & 15; return 8 * (i >> 2) + 4 * n + (i & 3); }
struct Unit { int pm, pn; };
struct Gemm { const bf16_t* A; const bf16_t* Bt; int M, N, K; };
struct StaticOrder {
    int nM, nN, nwg, G, c;
    __host__ __device__ void init(int M, int N, int G_, int c_) { nM = M / BM; nN = N / BM; nwg = nM * nN; G = G_; c = c_; }
    __host__ __device__ bool next(int i, Unit& u) const {
        const long L = (long)i * G + c; if (L >= nwg) return false;
        int wgid = (int)L; { const int q = nwg / NXCD, r = nwg % NXCD, xcd = wgid % NXCD, off = wgid / NXCD; wgid = (xcd < r ? xcd * (q + 1) : r * (q + 1) + (xcd - r) * q) + off; }
        const int nig = WGM * nN, gid = wgid / nig, fm = gid * WGM, gsz = (nM - fm) < WGM ? (nM - fm) : WGM;
        u.pm = fm + ((wgid % nig) % gsz); u.pn = (wgid % nig) / gsz; return true;
    }
    __device__ __forceinline__ void a_ready(const Unit&) const {}
    __device__ __forceinline__ void done(const Unit&) const {}
};
struct EpiF32 {
    static constexpr bool PERM = false;
    float* C; int ldc;
    __device__ __forceinline__ void operator()(const f32x4 (&acc)[2][2][4][2], const Unit& u, int wr, int wc, int fr, int fq) const {
        const int row0 = u.pm * BM + wr * 64 + fr, col0 = u.pn * BM + wc * 32 + 4 * fq;
#pragma unroll
        for (int ai = 0; ai < 2; ++ai)
#pragma unroll
            for (int m = 0; m < 4; ++m) { float* rowp = C + (size_t)(row0 + ai * HALF + m * 16) * ldc + col0;
#pragma unroll
                for (int bj = 0; bj < 2; ++bj)
#pragma unroll
                    for (int n = 0; n < 2; ++n) *(f32x4*)(rowp + bj * HALF + n * 16) = acc[ai][bj][m][n]; }
    }
};
struct EpiBf16 {
    static constexpr bool PERM = true;
    bf16_t* O; int ldc;
    __device__ __forceinline__ void operator()(const f32x4 (&acc)[2][2][4][2], const Unit& u, int wr, int wc, int fr, int fq) const {
        const int row0 = u.pm * BM + wr * 64 + fr, col0 = u.pn * BM + wc * 32 + 8 * fq;
#pragma unroll
        for (int ai = 0; ai < 2; ++ai)
#pragma unroll
            for (int m = 0; m < 4; ++m) { bf16_t* rowp = O + (size_t)(row0 + ai * HALF + m * 16) * ldc + col0;
#pragma unroll
                for (int bj = 0; bj < 2; ++bj) { const f32x4 v0 = acc[ai][bj][m][0], v1 = acc[ai][bj][m][1];
                    u32x4 w; w.x = pk_bf16(v0[0], v0[1]); w.y = pk_bf16(v0[2], v0[3]); w.z = pk_bf16(v1[0], v1[1]); w.w = pk_bf16(v1[2], v1[3]);
                    *(u32x4*)(rowp + bj * HALF) = w; } }
    }
};
struct EpiL1 {
    static constexpr bool PERM = true;
    bf16_t* QKp; bf16_t* Ob; float* G;
    __device__ __forceinline__ void operator()(const f32x4 (&acc)[2][2][4][2], const Unit& u, int wr, int wc, int fr, int fq) const {
        const int row0 = u.pm * BM + wr * 64 + fr;
        if (u.pn < 16) {
            bf16_t* base = (u.pn < 8) ? QKp : Ob; const int col0 = (u.pn & 7) * BM + wc * 32 + 8 * fq;
#pragma unroll
            for (int ai = 0; ai < 2; ++ai)
#pragma unroll
                for (int m = 0; m < 4; ++m) { bf16_t* rowp = base + (size_t)(row0 + ai * HALF + m * 16) * 2048 + col0;
#pragma unroll
                    for (int bj = 0; bj < 2; ++bj) { const f32x4 v0 = acc[ai][bj][m][0], v1 = acc[ai][bj][m][1];
                        u32x4 w; w.x = pk_bf16(v0[0], v0[1]); w.y = pk_bf16(v0[2], v0[3]); w.z = pk_bf16(v1[0], v1[1]); w.w = pk_bf16(v1[2], v1[3]);
                        *(u32x4*)(rowp + bj * HALF) = w; } }
        } else if (wc == 0) {
#pragma unroll
            for (int ai = 0; ai < 2; ++ai)
#pragma unroll
                for (int m = 0; m < 4; ++m) { float* rowp = G + (size_t)(row0 + ai * HALF + m * 16) * 32 + 8 * fq;
                    *(f32x4*)(rowp) = acc[ai][0][m][0]; *(f32x4*)(rowp + 4) = acc[ai][0][m][1]; }
        }
    }
};

template <class Epi, class Sched>
__device__ __forceinline__ void gemm_phase(LAS unsigned char* lds, const Gemm g, const Sched& S, const Epi& E) {
    const int tid = otid(), wid = __builtin_amdgcn_readfirstlane(tid >> 6), lane = tid & 63, wr = wid >> 2, wc = wid & 3, fr = lane & 15, fq = lane >> 4;
    const int K = g.K, nt = K / BK;
    unsigned voffA[2], voffB[2];
#pragma unroll
    for (int i = 0; i < 2; ++i) { int R, C; stage_rc(tid * 16 + i * 8192, R, C); const int Rb = Epi::PERM ? ((R & ~31) + perm32(R & 31)) : R;
        voffA[i] = (unsigned)(R * K + C) * 2u; voffB[i] = (unsigned)(Rb * K + C) * 2u; }
    const size_t kstep = (size_t)(BK * 2);
    const size_t hstep = (size_t)HALF * K * 2;
    const size_t tstep = 2 * hstep;
    const unsigned ldsw = (unsigned)wid * 1024u;
    const int aoff = lds_byte(wr * 64 + fr, fq * 8), boff = lds_byte(wc * 32 + fr, fq * 8);
#define PG8_SA(b, h) (((b) * 2 + (h)) * HTB)
#define PG8_SB(b, h) ((4 + (b) * 2 + (h)) * HTB)
#define PG8_STAGE(bufoff, gbase, voff) do { _Pragma("unroll") for (int _i = 0; _i < 2; ++_i) \
        __builtin_amdgcn_global_load_lds((const unsigned*)((const char*)(gbase) + (voff)[_i]), (LAS unsigned*)(lds + (bufoff) + ldsw + _i * 8192), 16, 0, 0); } while (0)
#define PG8_LDA(dst, b, h) do { _Pragma("unroll") for (int m = 0; m < 4; ++m) _Pragma("unroll") for (int k = 0; k < 2; ++k) dst[m][k] = *(const LAS bf16x8*)(lds + PG8_SA(b, h) + aoff + m * 2048 + k * 1024); } while (0)
#define PG8_LDB(dst, b, h) do { _Pragma("unroll") for (int n = 0; n < 2; ++n) _Pragma("unroll") for (int k = 0; k < 2; ++k) dst[n][k] = *(const LAS bf16x8*)(lds + PG8_SB(b, h) + boff + n * 2048 + k * 1024); } while (0)
#define PG8_MMA(ai, bj, At, Bt) do { __builtin_amdgcn_s_setprio(1); _Pragma("unroll") for (int m = 0; m < 4; ++m) _Pragma("unroll") for (int n = 0; n < 2; ++n) _Pragma("unroll") for (int k = 0; k < 2; ++k) \
        acc[ai][bj][m][n] = __builtin_amdgcn_mfma_f32_16x16x32_bf16(Bt[n][k], At[m][k], acc[ai][bj][m][n], 0, 0, 0); __builtin_amdgcn_s_setprio(0); } while (0)
#define PG8_WAIT_V(n) asm volatile("s_waitcnt vmcnt(" #n ")" ::: "memory")
#define PG8_WAIT_L(n) asm volatile("s_waitcnt lgkmcnt(" #n ")" ::: "memory")
#define PG8_BAR __builtin_amdgcn_s_barrier()
#define PG8_SCHED __builtin_amdgcn_sched_barrier(0)
    Unit cur, nxt; int ui = 0;
    if (!S.next(0, cur)) return;
    f32x4 acc[2][2][4][2];
#pragma unroll
    for (int a = 0; a < 2; ++a)
#pragma unroll
        for (int b = 0; b < 2; ++b)
#pragma unroll
            for (int m = 0; m < 4; ++m)
#pragma unroll
                for (int n = 0; n < 2; ++n) acc[a][b][m][n] = (f32x4){0.f, 0.f, 0.f, 0.f};
    bf16x8 At[4][2], B0[2][2], B1[2][2];
    const char* cA = (const char*)g.A + (size_t)cur.pm * tstep; const char* cB = (const char*)g.Bt + (size_t)cur.pn * tstep;
    S.a_ready(cur);
    PG8_STAGE(PG8_SB(0, 0), cB, voffB); PG8_STAGE(PG8_SA(0, 0), cA, voffA); PG8_STAGE(PG8_SB(0, 1), cB + hstep, voffB); PG8_STAGE(PG8_SA(0, 1), cA + hstep, voffA);
    if (wr == 1) PG8_BAR;
    PG8_WAIT_V(4); PG8_BAR;
    PG8_STAGE(PG8_SB(1, 0), cB + kstep, voffB); PG8_STAGE(PG8_SA(1, 0), cA + kstep, voffA); PG8_STAGE(PG8_SB(1, 1), cB + hstep + kstep, voffB);
    PG8_WAIT_V(6); PG8_BAR;
    for (;;) {
        const bool has_next = S.next(ui + 1, nxt);
        const char* nA = has_next ? (const char*)g.A + (size_t)nxt.pm * tstep : cA; const char* nB = has_next ? (const char*)g.Bt + (size_t)nxt.pn * tstep : cB;
        for (int t = 0; t < nt; t += 2) {
            const bool last = (t == nt - 2);
            const char* a1 = cA + (size_t)(t + 1) * kstep;
            const char* a2 = last ? nA : cA + (size_t)(t + 2) * kstep; const char* b2 = last ? nB : cB + (size_t)(t + 2) * kstep;
            const char* a3 = a2 + kstep; const char* b3 = b2 + kstep;
            if (last && has_next) S.a_ready(nxt);
            PG8_LDB(B0, 0, 0); PG8_SCHED; PG8_LDA(At, 0, 0); PG8_STAGE(PG8_SA(1, 1), a1 + hstep, voffA);
            PG8_WAIT_L(8); PG8_BAR; PG8_WAIT_L(0); PG8_MMA(0, 0, At, B0); PG8_BAR; PG8_SCHED;
            PG8_LDB(B1, 0, 1); PG8_STAGE(PG8_SB(0, 0), b2, voffB);
            PG8_BAR; PG8_WAIT_L(0); PG8_MMA(0, 1, At, B1); PG8_BAR;
            PG8_LDA(At, 0, 1); PG8_STAGE(PG8_SA(0, 0), a2, voffA);
            PG8_BAR; PG8_WAIT_L(0); PG8_MMA(1, 0, At, B0); PG8_BAR; PG8_SCHED;
            PG8_STAGE(PG8_SB(0, 1), b2 + hstep, voffB);
            PG8_WAIT_V(6); PG8_BAR; PG8_MMA(1, 1, At, B1); PG8_BAR;
            PG8_LDB(B0, 1, 0); PG8_SCHED; PG8_LDA(At, 1, 0); PG8_STAGE(PG8_SA(0, 1), a2 + hstep, voffA);
            PG8_WAIT_L(8); PG8_BAR; PG8_WAIT_L(0); PG8_MMA(0, 0, At, B0); PG8_BAR; PG8_SCHED;
            PG8_LDB(B1, 1, 1); PG8_STAGE(PG8_SB(1, 0), b3, voffB);
            PG8_BAR; PG8_WAIT_L(0); PG8_MMA(0, 1, At, B1); PG8_BAR;
            PG8_LDA(At, 1, 1); PG8_STAGE(PG8_SA(1, 0), a3, voffA);
            PG8_BAR; PG8_WAIT_L(0); PG8_MMA(1, 0, At, B0); PG8_BAR; PG8_SCHED;
            PG8_STAGE(PG8_SB(1, 1), b3 + hstep, voffB);
            PG8_WAIT_V(6); PG8_BAR; PG8_MMA(1, 1, At, B1); PG8_BAR;
        }
        E(acc, cur, wr, wc, fr, fq); S.done(cur);
        if (!has_next) break;
#pragma unroll
        for (int a = 0; a < 2; ++a)
#pragma unroll
            for (int b = 0; b < 2; ++b)
#pragma unroll
                for (int m = 0; m < 4; ++m)
#pragma unroll
                    for (int n = 0; n < 2; ++n) acc[a][b][m][n] = (f32x4){0.f, 0.f, 0.f, 0.f};
        cur = nxt; cA = nA; cB = nB; ++ui;
    }
    PG8_WAIT_V(0);
    if (wr == 0) PG8_BAR;
    PG8_BAR;
#undef PG8_SA
#undef PG8_SB
#undef PG8_STAGE
#undef PG8_LDA
#undef PG8_LDB
#undef PG8_MMA
#undef PG8_WAIT_V
#undef PG8_WAIT_L
#undef PG8_BAR
#undef PG8_SCHED
}
__device__ __forceinline__ void mfma8(f32x4& acc, const i32x8 b, const i32x8 a, int sc) {
    asm volatile("v_mfma_scale_f32_16x16x128_f8f6f4 %0, %1, %2, %0, %3, %3 op_sel_hi:[0,0,0]" : "+v"(acc) : "v"(b), "v"(a), "v"(sc)); }
__device__ __forceinline__ i32x8 cat8(const bf16x8 a, const bf16x8 b) { const i32x4 x = __builtin_bit_cast(i32x4, a), y = __builtin_bit_cast(i32x4, b); return __builtin_shufflevector(x, y, 0, 1, 2, 3, 4, 5, 6, 7); }
struct GUnit { const char* A; const char* B; int pm, pn, nkt, tag; };
template <class Epi, class Sched, bool F8 = false>
__device__ __forceinline__ void gemm_stream(LAS unsigned char* lds, const int K, const Sched& S, const Epi& E) {
    const int tid = otid(), wid = __builtin_amdgcn_readfirstlane(tid >> 6), lane = tid & 63, wr = wid >> 2, wc = wid & 3, fr = lane & 15, fq = lane >> 4;
    unsigned voffA[2], voffB[2];
    const int Kb = F8 ? K : 2 * K;
#pragma unroll
    for (int i = 0; i < 2; ++i) { int R, C; stage_rc(tid * 16 + i * 8192, R, C); const int Rb = Epi::PERM ? ((R & ~31) + perm32(R & 31)) : R;
        voffA[i] = (unsigned)(R * Kb + C * 2); voffB[i] = (unsigned)(Rb * Kb + C * 2); }
    int sc8 = 0x7F7F7F7F; asm volatile("" : "+v"(sc8));
    const size_t kstep = (size_t)(BK * 2);
    const size_t hstep = (size_t)HALF * Kb;
    const unsigned ldsw = (unsigned)wid * 1024u;
    const int aoff = lds_byte(wr * 64 + fr, fq * 8), boff = lds_byte(wc * 32 + fr, fq * 8);
#define PG8_SA(b, h) (((b) * 2 + (h)) * HTB)
#define PG8_SB(b, h) ((4 + (b) * 2 + (h)) * HTB)
#define PG8_STAGE(bufoff, gbase, voff) do { _Pragma("unroll") for (int _i = 0; _i < 2; ++_i) \
        __builtin_amdgcn_global_load_lds((const unsigned*)((const char*)(gbase) + (voff)[_i]), (LAS unsigned*)(lds + (bufoff) + ldsw + _i * 8192), 16, 0, 0); } while (0)
#define PG8_LDA(dst, b, h) do { _Pragma("unroll") for (int m = 0; m < 4; ++m) _Pragma("unroll") for (int k = 0; k < 2; ++k) dst[m][k] = *(const LAS bf16x8*)(lds + PG8_SA(b, h) + aoff + m * 2048 + k * 1024); } while (0)
#define PG8_LDB(dst, b, h) do { _Pragma("unroll") for (int n = 0; n < 2; ++n) _Pragma("unroll") for (int k = 0; k < 2; ++k) dst[n][k] = *(const LAS bf16x8*)(lds + PG8_SB(b, h) + boff + n * 2048 + k * 1024); } while (0)
#define PG8_MMA(ai, bj, At, Bt) do { __builtin_amdgcn_s_setprio(1); \
        if constexpr (F8) { _Pragma("unroll") for (int m = 0; m < 4; ++m) _Pragma("unroll") for (int n = 0; n < 2; ++n) \
            mfma8(acc[ai][bj][m][n], cat8(Bt[n][0], Bt[n][1]), cat8(At[m][0], At[m][1]), sc8); } \
        else { _Pragma("unroll") for (int m = 0; m < 4; ++m) _Pragma("unroll") for (int n = 0; n < 2; ++n) _Pragma("unroll") for (int k = 0; k < 2; ++k) \
            acc[ai][bj][m][n] = __builtin_amdgcn_mfma_f32_16x16x32_bf16(Bt[n][k], At[m][k], acc[ai][bj][m][n], 0, 0, 0); } \
        __builtin_amdgcn_s_setprio(0); } while (0)
#define PG8_WAIT_V(n) asm volatile("s_waitcnt vmcnt(" #n ")" ::: "memory")
#define PG8_WAIT_L(n) asm volatile("s_waitcnt lgkmcnt(" #n ")" ::: "memory")
#define PG8_BAR __builtin_amdgcn_s_barrier()
#define PG8_SCHED __builtin_amdgcn_sched_barrier(0)
    GUnit cur, nxt; int ui = 0;
    if (!S.next(0, cur)) return;
    f32x4 acc[2][2][4][2];
#pragma unroll
    for (int a = 0; a < 2; ++a)
#pragma unroll
        for (int b = 0; b < 2; ++b)
#pragma unroll
            for (int m = 0; m < 4; ++m)
#pragma unroll
                for (int n = 0; n < 2; ++n) acc[a][b][m][n] = (f32x4){0.f, 0.f, 0.f, 0.f};
    bf16x8 At[4][2], B0[2][2], B1[2][2];
    const char* cA = cur.A; const char* cB = cur.B;
    PG8_STAGE(PG8_SB(0, 0), cB, voffB); PG8_STAGE(PG8_SA(0, 0), cA, voffA); PG8_STAGE(PG8_SB(0, 1), cB + hstep, voffB); PG8_STAGE(PG8_SA(0, 1), cA + hstep, voffA);
    if (wr == 1) PG8_BAR;
    PG8_WAIT_V(4); PG8_BAR;
    PG8_STAGE(PG8_SB(1, 0), cB + kstep, voffB); PG8_STAGE(PG8_SA(1, 0), cA + kstep, voffA); PG8_STAGE(PG8_SB(1, 1), cB + hstep + kstep, voffB);
    PG8_WAIT_V(6); PG8_BAR;
    for (;;) {
        const bool has_next = S.next(ui + 1, nxt);
        const char* nA = has_next ? nxt.A : cA; const char* nB = has_next ? nxt.B : cB;
        const int nt = cur.nkt;
        for (int t = 0; t < nt; t += 2) {
            const bool last = (t == nt - 2);
            const char* a1 = cA + (size_t)(t + 1) * kstep;
            const char* a2 = last ? nA : cA + (size_t)(t + 2) * kstep; const char* b2 = last ? nB : cB + (size_t)(t + 2) * kstep;
            const char* a3 = a2 + kstep; const char* b3 = b2 + kstep;
            PG8_LDB(B0, 0, 0); PG8_SCHED; PG8_LDA(At, 0, 0); PG8_STAGE(PG8_SA(1, 1), a1 + hstep, voffA);
            PG8_WAIT_L(8); PG8_BAR; PG8_WAIT_L(0); PG8_MMA(0, 0, At, B0); PG8_BAR; PG8_SCHED;
            PG8_LDB(B1, 0, 1); PG8_STAGE(PG8_SB(0, 0), b2, voffB);
            PG8_BAR; PG8_WAIT_L(0); PG8_MMA(0, 1, At, B1); PG8_BAR;
            PG8_LDA(At, 0, 1); PG8_STAGE(PG8_SA(0, 0), a2, voffA);
            PG8_BAR; PG8_WAIT_L(0); PG8_MMA(1, 0, At, B0); PG8_BAR; PG8_SCHED;
            PG8_STAGE(PG8_SB(0, 1), b2 + hstep, voffB);
            PG8_WAIT_V(6); PG8_BAR; PG8_MMA(1, 1, At, B1); PG8_BAR;
            PG8_LDB(B0, 1, 0); PG8_SCHED; PG8_LDA(At, 1, 0); PG8_STAGE(PG8_SA(0, 1), a2 + hstep, voffA);
            PG8_WAIT_L(8); PG8_BAR; PG8_WAIT_L(0); PG8_MMA(0, 0, At, B0); PG8_BAR; PG8_SCHED;
            PG8_LDB(B1, 1, 1); PG8_STAGE(PG8_SB(1, 0), b3, voffB);
            PG8_BAR; PG8_WAIT_L(0); PG8_MMA(0, 1, At, B1); PG8_BAR;
            PG8_LDA(At, 1, 1); PG8_STAGE(PG8_SA(1, 0), a3, voffA);
            PG8_BAR; PG8_WAIT_L(0); PG8_MMA(1, 0, At, B0); PG8_BAR; PG8_SCHED;
            PG8_STAGE(PG8_SB(1, 1), b3 + hstep, voffB);
            PG8_WAIT_V(6); PG8_BAR; PG8_MMA(1, 1, At, B1); PG8_BAR;
        }
        if constexpr (F8) {
            asm volatile("s_nop 15\n\ts_nop 15" ::: "memory");
#pragma unroll
            for (int a = 0; a < 2; ++a)
#pragma unroll
                for (int b = 0; b < 2; ++b)
#pragma unroll
                    for (int m = 0; m < 4; ++m)
#pragma unroll
                        for (int n = 0; n < 2; ++n) acc[a][b][m][n] *= G8_OS; }
        E(acc, cur, wr, wc, fr, fq);
        if (!has_next) break;
#pragma unroll
        for (int a = 0; a < 2; ++a)
#pragma unroll
            for (int b = 0; b < 2; ++b)
#pragma unroll
                for (int m = 0; m < 4; ++m)
#pragma unroll
                    for (int n = 0; n < 2; ++n) acc[a][b][m][n] = (f32x4){0.f, 0.f, 0.f, 0.f};
        cur = nxt; cA = nA; cB = nB; ++ui;
    }
    PG8_WAIT_V(0);
    if (wr == 0) PG8_BAR;
    PG8_BAR;
#undef PG8_SA
#undef PG8_SB
#undef PG8_STAGE
#undef PG8_LDA
#undef PG8_LDB
#undef PG8_MMA
#undef PG8_WAIT_V
#undef PG8_WAIT_L
#undef PG8_BAR
#undef PG8_SCHED
}
}

namespace pg8 {
__device__ __forceinline__ void tile_map(int L, int nM, int nN, int& pm, int& pn) {
    const int nwg = nM * nN; int wgid = L; { const int q = nwg / NXCD, r = nwg % NXCD, xcd = wgid % NXCD, off = wgid / NXCD; wgid = (xcd < r ? xcd * (q + 1) : r * (q + 1) + (xcd - r) * q) + off; }
    const int nig = WGM * nN, gid = wgid / nig, fm = gid * WGM, gsz = (nM - fm) < WGM ? (nM - fm) : WGM;
    pm = fm + ((wgid % nig) % gsz); pn = (wgid % nig) / gsz;
}
constexpr size_t TROW = (size_t)256 * 2048 * 2;
template <bool PERM_>
__device__ __forceinline__ void store_f32_tile(const f32x4 (&acc)[2][2][4][2], float* C, int ldc, int wr, int wc, int fr, int fq) {
    const int row0 = wr * 64 + fr, col0 = wc * 32 + (PERM_ ? 8 : 4) * fq;
#pragma unroll
    for (int ai = 0; ai < 2; ++ai)
#pragma unroll
        for (int m = 0; m < 4; ++m) { float* rowp = C + (size_t)(row0 + ai * HALF + m * 16) * ldc + col0;
#pragma unroll
            for (int bj = 0; bj < 2; ++bj)
#pragma unroll
                for (int n = 0; n < 2; ++n) *(f32x4*)(rowp + bj * HALF + n * (PERM_ ? 4 : 16)) = acc[ai][bj][m][n]; }
}
template <class Epi1, int ESZ = 2> struct Sched2 {
    const char* A0; const char* B0; int nM0, nN0; const char* A1; const char* B1; int nM1, nN1; int G, c;
    static constexpr size_t TR = TROW * ESZ / 2; static constexpr int NKT = 16 * ESZ;
    __device__ __forceinline__ bool next(int i, GUnit& u) const {
        int L = i * G + c; const int n0 = nM0 * nN0;
        if (L < n0) { tile_map(L, nM0, nN0, u.pm, u.pn); u.A = A0 + (size_t)u.pm * TR; u.B = B0 + (size_t)u.pn * TR; u.nkt = NKT; u.tag = 0; return true; }
        L -= n0; if (L >= nM1 * nN1) return false;
        tile_map(L, nM1, nN1, u.pm, u.pn); u.A = A1 + (size_t)u.pm * TR; u.B = B1 + (size_t)u.pn * TR; u.nkt = NKT; u.tag = 1; return true;
    }
};
template <class Epi1> struct EpiS2 {
    static constexpr bool PERM = true;
    EpiBf16 e0; Epi1 e1;
    __device__ __forceinline__ void operator()(const f32x4 (&acc)[2][2][4][2], const GUnit& g, int wr, int wc, int fr, int fq) const {
        const Unit u{g.pm, g.pn}; if (g.tag == 0) e0(acc, u, wr, wc, fr, fq); else e1(acc, u, wr, wc, fr, fq); }
};
template <int ESZ> struct Sched1 {
    const char* A; const char* B; int nM, nN, G, c;
    static constexpr size_t TR = TROW * ESZ / 2; static constexpr int NKT = 16 * ESZ;
    __device__ __forceinline__ bool next(int i, GUnit& u) const {
        const int L = i * G + c; if (L >= nM * nN) return false;
        tile_map(L, nM, nN, u.pm, u.pn); u.A = A + (size_t)u.pm * TR; u.B = B + (size_t)u.pn * TR; u.nkt = NKT; u.tag = 0; return true;
    }
};
template <class Epi0> struct EpiG {
    static constexpr bool PERM = Epi0::PERM;
    Epi0 e0;
    __device__ __forceinline__ void operator()(const f32x4 (&acc)[2][2][4][2], const GUnit& g, int wr, int wc, int fr, int fq) const { const Unit u{g.pm, g.pn}; e0(acc, u, wr, wc, fr, fq); }
};
struct SchedTail {
    const char* A; const char* B; int nM, nN; bool ctx_is_row;
    int G, c;
    __device__ __forceinline__ bool next(int i, GUnit& u) const {
        int L = i * G + c; const int n0 = nM * nN;
        if (L < n0) { tile_map(L, nM, nN, u.pm, u.pn); u.A = A + (size_t)u.pm * TROW; u.B = B + (size_t)u.pn * TROW; u.nkt = 32; u.tag = 0; return true; }
        L -= n0; const int nt_ = ctx_is_row ? nN : nM; if (L >= nt_ * 8) return false;
        const int t = L >> 3, sl = L & 7;
        u.pm = ctx_is_row ? nM : t; u.pn = ctx_is_row ? t : nN;
        u.A = A + (size_t)u.pm * TROW + (size_t)sl * 512; u.B = B + (size_t)u.pn * TROW + (size_t)sl * 512; u.nkt = 4; u.tag = 1 + sl + 8 * t; return true;
    }
};
template <bool PERM_, class Epi0> struct EpiTail {
    static constexpr bool PERM = PERM_;
    Epi0 e0; float* slab;
    __device__ __forceinline__ void operator()(const f32x4 (&acc)[2][2][4][2], const GUnit& g, int wr, int wc, int fr, int fq) const {
        if (g.tag == 0) { const Unit u{g.pm, g.pn}; e0(acc, u, wr, wc, fr, fq); }
        else { const int sl = (g.tag - 1) & 7, t = (g.tag - 1) >> 3; store_f32_tile<PERM_>(acc, slab + ((size_t)(sl * 8 + t) << 16), 256, wr, wc, fr, fq); }
    }
};
}
template <class Epi>
__device__ __forceinline__ void run_gemm(LAS unsigned char* lds, const bf16_t* A, const bf16_t* Bt, int M, int N, int K, const Epi& E) {
    pg8::Gemm g{A, Bt, M, N, K};
    pg8::StaticOrder S; S.init(M, N, (int)gridDim.x, (int)blockIdx.x);
    pg8::gemm_phase(lds, g, S, E);
    __syncthreads();
}
struct Params {
    const float* in[32];
    float* out;
    unsigned char* ws;
};
__device__ __forceinline__ unsigned char* get_ws() { const __attribute__((address_space(4))) char* ka = (const __attribute__((address_space(4))) char*)__builtin_amdgcn_kernarg_segment_ptr();
    unsigned long long w = *(const __attribute__((address_space(4))) unsigned long long*)(ka + __builtin_offsetof(Params, ws)); asm volatile("" : "+s"(w));
    return (unsigned char*)(__attribute__((address_space(1))) unsigned char*)w; }
__device__ __forceinline__ Params fresh(const Params& p) { Params q = p; q.ws = get_ws(); return q; }
enum { I_X = 0, I_C, I_CTX, I_CCTX, I_ADAW, I_ADAB, I_LNW, I_LNB, I_ABWIN, I_HYCW, I_HYCB, I_FW1, I_FB1, I_FW2, I_FB2, I_FW3, I_FB3, I_FW4, I_HYSKIP, I_RPB, I_ABWOUT,
       I_MLWIN, I_MLBG, I_MLCW, I_MLCB, I_MLNW, I_MLWOUT, I_PWQ, I_PK1, I_PK2, I_PU, I_PV };

template <bool F8>
__device__ __forceinline__ void task_transpose(LAS float* tile, const float* __restrict__ src, int ld, int ncols, bf16_t* __restrict__ dst, int K, int k0, int n_src0, int n_dst0) {
    const int tid = otid();
    const int nn = tid & 63, kb = tid >> 6;
    const bool ok = n_src0 + nn < ncols;
    const float* sp = src + (size_t)(k0 + kb) * ld + n_src0 + nn;
#pragma unroll
    for (int h = 0; h < 2; ++h) { float v[16];
#pragma unroll
        for (int it = 0; it < 16; ++it) v[it] = ok ? sp[(size_t)((h * 16 + it) * 8) * ld] : 0.f;
#pragma unroll
        for (int it = 0; it < 16; ++it) tile[nn * 257 + (h * 16 + it) * 8 + kb] = v[it]; }
    __syncthreads();
    if (F8) {
        unsigned char* d8 = (unsigned char*)dst;
#pragma unroll
        for (int it = 0; it < 8; ++it) { const int i = tid + it * 512, n2 = i >> 6, kq = i & 63; const LAS float* tp = tile + n2 * 257 + 4 * kq;
            *(unsigned*)(d8 + (size_t)(n_dst0 + n2) * K + k0 + 4 * kq) = fp8x4(clamp8(tp[0] * G8_WS), clamp8(tp[1] * G8_WS), clamp8(tp[2] * G8_WS), clamp8(tp[3] * G8_WS)); }
    } else {
#pragma unroll
        for (int it = 0; it < 16; ++it) { const int i = tid + it * 512, n2 = i >> 7, kp = i & 127;
            const float a = tile[n2 * 257 + 2 * kp], b = tile[n2 * 257 + 2 * kp + 1];
            *(unsigned*)(dst + (size_t)(n_dst0 + n2) * K + k0 + 2 * kp) = pk_bf16(a, b); }
    }
    __syncthreads();
}
__device__ __forceinline__ void task_convert(const float* __restrict__ src, unsigned char* __restrict__ dst, float scale) {
    const int tid = otid();
#pragma unroll 2
    for (int it = 0; it < 8; ++it) { const size_t i = ((size_t)it * 512 + tid) * 16;
        u32x4 w;
#pragma unroll
        for (int q = 0; q < 4; ++q) { const f32x4 a = *(const f32x4*)(src + i + 4 * q) * scale;
            int v = 0; v = __builtin_amdgcn_cvt_pk_fp8_f32(a[0], a[1], v, false); v = __builtin_amdgcn_cvt_pk_fp8_f32(a[2], a[3], v, true);
            if (q == 0) w.x = (unsigned)v; else if (q == 1) w.y = (unsigned)v; else if (q == 2) w.z = (unsigned)v; else w.w = (unsigned)v; }
        *(u32x4*)(dst + i) = w; }
}
__device__ __forceinline__ void task_convert6(const float* __restrict__ src, unsigned char* __restrict__ dst, float scale) {
    const int tid = otid(), w = tid >> 6, lane = tid & 63;
#pragma unroll 1
    for (int rr = w; rr < 32; rr += 8) { const float* sp = src + (size_t)rr * 2048 + lane * 32;
        float c[32];
#pragma unroll
        for (int q = 0; q < 8; ++q) { const f32x4 a = *(const f32x4*)(sp + 4 * q) * scale; c[4 * q] = a[0]; c[4 * q + 1] = a[1]; c[4 * q + 2] = a[2]; c[4 * q + 3] = a[3]; }
        unsigned wd[6]; fp6enc32(c, wd);
        unsigned char* dp = dst + (size_t)rr * 1536;
        *(u32x4*)(dp + lane * 16) = (u32x4){wd[0], wd[1], wd[2], wd[3]}; *(u32x2*)(dp + 1024 + lane * 8) = (u32x2){wd[4], wd[5]}; }
}
__device__ __forceinline__ void task_wqk(LAS float* lds, const float* __restrict__ wq, const float* __restrict__ keys, bf16_t* __restrict__ dstT, int hh, int jt) {
    LAS float* km = lds;
    LAS float* wt = lds + 128 * 129;
    const int tid = otid();
    for (int i = tid; i < 128 * 128; i += 512) { const int n = i >> 7, d = i & 127; km[n * 129 + d] = keys[i]; }
    for (int i = tid; i < 64 * 128; i += 512) { const int j = i >> 7, d = i & 127; wt[j * 129 + d] = wq[(size_t)(jt * 64 + j) * 2048 + hh * 128 + d]; }
    __syncthreads();
    const int ns = tid & 31, js = tid >> 5;
    float acc[4][4];
#pragma unroll
    for (int a = 0; a < 4; ++a)
#pragma unroll
        for (int b = 0; b < 4; ++b) acc[a][b] = 0.f;
    for (int d = 0; d < 128; ++d) {
        float kv[4], wv[4];
#pragma unroll
        for (int a = 0; a < 4; ++a) kv[a] = km[(ns + 32 * a) * 129 + d];
#pragma unroll
        for (int b = 0; b < 4; ++b) wv[b] = wt[(js + 16 * b) * 129 + d];
#pragma unroll
        for (int a = 0; a < 4; ++a)
#pragma unroll
            for (int b = 0; b < 4; ++b) acc[a][b] = fmaf(kv[a], wv[b], acc[a][b]);
    }
    __syncthreads();
    LAS float* ot = wt;
#pragma unroll
    for (int a = 0; a < 4; ++a)
#pragma unroll
        for (int b = 0; b < 4; ++b) ot[(ns + 32 * a) * 65 + js + 16 * b] = acc[a][b];
    __syncthreads();
#pragma unroll
    for (int it = 0; it < 8; ++it) { const int i = tid + it * 512, n = i >> 5, jp = i & 31;
        *(unsigned*)(dstT + (size_t)(hh * 128 + n) * 2048 + jt * 64 + 2 * jp) = pk_bf16(ot[n * 65 + 2 * jp], ot[n * 65 + 2 * jp + 1]); }
    __syncthreads();
}
__device__ __forceinline__ void task_ada(LAS float* lds, const float* __restrict__ c, const float* __restrict__ cc, const float* __restrict__ W, const float* __restrict__ bias,
                                         float* __restrict__ out_lat, float* __restrict__ out_ctx, int n0) {
    LAS float* sl = lds; LAS float* sc = lds + 2048; LAS float* red = lds + 4096;
    const int tid = otid(), w = tid >> 6, lane = tid & 63;
    for (int i = tid; i < 2048; i += 512) { sl[i] = silu_f(c[i]); sc[i] = silu_f(cc[i]); }
    __syncthreads();
    float al = 0.f, ac = 0.f;
    const float* wp = W + (size_t)(w * 256) * 12288 + n0 + lane;
#pragma unroll 8
    for (int k = 0; k < 256; ++k) { const float wv = wp[(size_t)k * 12288]; al = fmaf(sl[w * 256 + k], wv, al); ac = fmaf(sc[w * 256 + k], wv, ac); }
    red[(w * 64 + lane) * 2] = al; red[(w * 64 + lane) * 2 + 1] = ac;
    __syncthreads();
    if (tid < 64) { float a = 0.f, b = 0.f;
#pragma unroll
        for (int ww = 0; ww < 8; ++ww) { a += red[(ww * 64 + tid) * 2]; b += red[(ww * 64 + tid) * 2 + 1]; }
        out_lat[n0 + tid] = a + bias[n0 + tid]; out_ctx[n0 + tid] = b + bias[n0 + tid]; }
    __syncthreads();
}
__device__ __forceinline__ void task_a3(const Params& p, LAS float* lds, bf16_t* __restrict__ a3, int task) {
    const int tid = otid(), w = tid >> 6, lane = tid & 63;
    LAS float* W2s = lds; LAS float* W3s = lds + 4096; LAS float* hb = lds + 8192 + w * 128;
    for (int i = tid; i < 4096; i += 512) { W2s[i] = p.in[I_FW2][i]; W3s[i] = p.in[I_FW3][i]; }
    __syncthreads();
    const float* W1 = p.in[I_FW1];
    float w1[33];
#pragma unroll
    for (int f = 0; f < 33; ++f) w1[f] = W1[f * 64 + lane];
    const float b1 = p.in[I_FB1][lane], b2 = p.in[I_FB2][lane], b3 = p.in[I_FB3][lane];
    const float freq = 1e-4f + (float)(lane & 15) * ((15.0f - 1e-4f) / 15.0f);
#pragma unroll 1
    for (int i = 0; i < (w == 0 ? 9 : 8); ++i) {
        const int pos = task * 65 + (i < 8 ? w * 8 + i : 64);
        const int n = pos < TL ? pos : pos - TL; const int L = pos < TL ? TL : TCX;
        const float tl = (float)n / (float)(L - 1);
        const float omega = 6.283185307179586f * (float)n / (float)L;
        float sn, cs; sincosf(omega * freq, &sn, &cs);
        float h = fmaf(tl, w1[0], b1);
#pragma unroll
        for (int b = 0; b < 16; ++b) { h = fmaf(__shfl(cs, b), w1[1 + b], h); h = fmaf(-__shfl(sn, b), w1[17 + b], h); }
        hb[lane] = sinf(h);
        __builtin_amdgcn_wave_barrier();
        float g = b2;
#pragma unroll 8
        for (int j = 0; j < 64; ++j) g = fmaf(hb[j], W2s[j * 64 + lane], g);
        hb[64 + lane] = sinf(g);
        __builtin_amdgcn_wave_barrier();
        float q = b3;
#pragma unroll 8
        for (int j = 0; j < 64; ++j) q = fmaf(hb[64 + j], W3s[j * 64 + lane], q);
        a3[(size_t)pos * 64 + lane] = f2bf(sinf(q));
        __builtin_amdgcn_wave_barrier();
    }
    __syncthreads();
}

constexpr int P0_NT_TR0 = 8 * 96, P0_NT_TRO = 8 * 32, P0_NT_TR1 = 8 * 100;
constexpr int P0_T0 = 0;
constexpr int P0_T1 = P0_T0 + P0_NT_TR0;
constexpr int P0_T2 = P0_T1 + P0_NT_TRO;
constexpr int P0_T3 = P0_T2 + P0_NT_TR1;
constexpr int P0_T4 = P0_T3 + P0_NT_TRO;
constexpr int P0_T5 = P0_T4 + 4 * 512;
constexpr int P0_T6 = P0_T5 + 1024;
constexpr int P0_T7 = P0_T6 + 384;
constexpr int P0_T8 = P0_T7 + 256;
constexpr int P0_NT = P0_T8 + 1;
constexpr int P0_T5B = P0_T5 + 512;
constexpr int P0_T6B = P0_T6 + 192;

__device__ __forceinline__ void phase0(const Params& p, LAS unsigned char* lds, int t_begin = 0, int t_end = P0_NT, int skip_blocks = 0) {
    LAS float* ldsf = (LAS float*)lds;
    unsigned char* ws = p.ws;
    if ((int)blockIdx.x < skip_blocks) return;
    for (int task = t_begin + (int)blockIdx.x - skip_blocks; task < t_end; task += (int)gridDim.x - skip_blocks) {
        if (task < P0_T1) {
            const int t = task - P0_T0, kt = t & 7, nt = t >> 3; const int nd = nt * 64;
            const int nsrc = nd < 3072 ? nd : (nd < 4096 ? 5120 + (nd - 3072) : 3072 + (nd - 4096));
#if F8_L0NA
            if (nd >= 3072) task_transpose<true>(ldsf, p.in[I_ABWIN], 6144, 6144, (bf16_t*)(ws + OFF_W0T + (size_t)3072 * 4096), 2048, kt * 256, nsrc, nd - 3072);
            else task_transpose<false>(ldsf, p.in[I_ABWIN], 6144, 6144, (bf16_t*)(ws + OFF_W0T), 2048, kt * 256, nsrc, nd);
#else
            task_transpose<F8_L0 != 0>(ldsf, p.in[I_ABWIN], 6144, 6144, (bf16_t*)(ws + OFF_W0T), 2048, kt * 256, nsrc, nd);
#endif
        } else if (task < P0_T2) {
            const int t = task - P0_T1, kt = t & 7, nt = t >> 3;
            task_transpose<false>(ldsf, p.in[I_ABWOUT], 2048, 2048, (bf16_t*)(ws + OFF_WO0T), 2048, kt * 256, nt * 64, nt * 64);
        } else if (task < P0_T3) {
            const int t = task - P0_T2, kt = t & 7, nt = t >> 3; const int nd = nt * 64;
            const int nsrc = nd < 2048 ? 2048 + nd : (nd < 4096 ? nd - 2048 : nd);
            task_transpose<F8_L1 != 0>(ldsf, p.in[I_MLWIN], 6176, 6176, (bf16_t*)(ws + OFF_W1T), 2048, kt * 256, nsrc, nd);
        } else if (task < P0_T4) {
            const int t = task - P0_T3, kt = t & 7, nt = t >> 3;
            task_transpose<F8_L1O != 0>(ldsf, p.in[I_MLWOUT], 2048, 2048, (bf16_t*)(ws + OFF_WO1T), 2048, kt * 256, nt * 64, nt * 64);
        } else if (task < P0_T5) {
            const int t = task - P0_T4, ti = t >> 9, ch = t & 511; const int layer = ti >> 1, which = ti & 1;
            if ((which == 0 && PEER_F6U) || (which == 1 && PEER_F6V)) task_convert6((which ? p.in[I_PV] : p.in[I_PU]) + (size_t)layer * PEER_TBL + (size_t)ch * 65536, ws + OFF_PEER + (size_t)ti * PEER_TBL + (size_t)ch * 32 * 1536, which ? PEER_VSCALE6 : PEER_USCALE);
            else task_convert((which ? p.in[I_PV] : p.in[I_PU]) + (size_t)layer * PEER_TBL + (size_t)ch * 65536, ws + OFF_PEER + (size_t)ti * PEER_TBL + (size_t)ch * 65536, which ? PEER_VSCALE : PEER_USCALE);
        } else if (task < P0_T6) {
            const int t = task - P0_T5, layer = t >> 9, hh = (t >> 5) & 15, jt = t & 31;
            task_wqk(ldsf, p.in[I_PWQ] + (size_t)layer * 2048 * 2048, ((hh & 1) ? p.in[I_PK2] : p.in[I_PK1]) + (size_t)layer * 16384, (bf16_t*)(ws + OFF_WQK) + (size_t)layer * 2048 * 2048, hh, jt);
        } else if (task < P0_T7) {
            const int t = task - P0_T6, layer = t / 192, ch = t % 192;
            float* mod = (float*)(ws + OFF_MOD) + (size_t)layer * 2 * 12288;
            task_ada(ldsf, p.in[I_C], p.in[I_CCTX], p.in[I_ADAW] + (size_t)layer * 2048 * 12288, p.in[I_ADAB] + (size_t)layer * 12288, mod, mod + 12288, ch * 64);
        } else if (task < P0_T8) {
            task_a3(p, ldsf, (bf16_t*)(ws + OFF_A3), task - P0_T7);
        } else {
            f32x2* rt = (f32x2*)(ws + OFF_ROPE);
            for (int i = otid(); i < 256 * 32; i += 512) { const int pos = i >> 5, q = i & 31;
                const float inv = expf(-(float)q * (9.210340371976184f / 32.0f)); float sn, cs; sincosf((float)pos * inv, &sn, &cs); rt[i] = (f32x2){cs, sn}; }
        }
    }
}

__device__ __forceinline__ void modulate_rows(const float* __restrict__ xlat, const float* __restrict__ xctx, const float* __restrict__ mod  , bf16_t* __restrict__ U, unsigned char* __restrict__ U8 = nullptr) {
    const int tid = otid(), w = tid >> 6, lane = tid & 63;
    const int stride = gridDim.x * 8;
    for (int r0 = blockIdx.x * 8 + w; r0 < MT; r0 += 2 * stride) {
        f32x4 xa[2][4], xb[2][4];
#pragma unroll
        for (int k = 0; k < 2; ++k) { const int r = r0 + k * stride; if (r < MT) { const float* src = r < TL ? xlat + (size_t)r * DM : xctx + (size_t)(r - TL) * DM;
#pragma unroll
            for (int pc = 0; pc < 4; ++pc) { const int e = pc * 512 + lane * 8; xa[k][pc] = *(const f32x4*)(src + e); xb[k][pc] = *(const f32x4*)(src + e + 4); } } }
#pragma unroll
        for (int k = 0; k < 2; ++k) { const int r = r0 + k * stride; if (r < MT) { const float* md = mod + (r < TL ? 0 : 12288);
#pragma unroll
            for (int pc = 0; pc < 4; ++pc) { const int e = pc * 512 + lane * 8;
                const f32x4 s0 = *(const f32x4*)(md + 2048 + e), s1 = *(const f32x4*)(md + 2048 + e + 4), h0 = *(const f32x4*)(md + e), h1 = *(const f32x4*)(md + e + 4);
                const f32x4 x = xa[k][pc] * (s0 + 1.f) + h0, y = xb[k][pc] * (s1 + 1.f) + h1;
#if F8_L0
                u32x2 o; o.x = fp8x4(clamp8(x[0] * G8_XS), clamp8(x[1] * G8_XS), clamp8(x[2] * G8_XS), clamp8(x[3] * G8_XS)); o.y = fp8x4(clamp8(y[0] * G8_XS), clamp8(y[1] * G8_XS), clamp8(y[2] * G8_XS), clamp8(y[3] * G8_XS));
                *(u32x2*)((unsigned char*)U + (size_t)r * DM + e) = o; } } }
#else
                u32x4 o; o.x = pk_bf16(x[0], x[1]); o.y = pk_bf16(x[2], x[3]); o.z = pk_bf16(y[0], y[1]); o.w = pk_bf16(y[2], y[3]);
                *(u32x4*)(U + (size_t)r * DM + e) = o;
#if F8_L0NA
                { u32x2 o8; o8.x = fp8x4(clamp8(x[0] * G8_XS), clamp8(x[1] * G8_XS), clamp8(x[2] * G8_XS), clamp8(x[3] * G8_XS)); o8.y = fp8x4(clamp8(y[0] * G8_XS), clamp8(y[1] * G8_XS), clamp8(y[2] * G8_XS), clamp8(y[3] * G8_XS));
                  *(u32x2*)(U8 + (size_t)r * DM + e) = o8; }
#endif
                } } }
#endif
    }
}
__device__ __forceinline__ void hyena_taps(const Params& p) {
    const int tid = otid(), w = tid >> 6, lane = tid & 63, fr = lane & 15, fq = lane >> 4;
    const bf16_t* a3 = (const bf16_t*)(p.ws + OFF_A3);
    const float* w4 = p.in[I_FW4];
    bf16_t* HmT = (bf16_t*)(p.ws + OFF_BIG1);
    bf16_t* HmC = HmT + (size_t)4096 * TL;
    const int NWT = 256 * 16 + 256;
    for (int wt = blockIdx.x * 8 + w; wt < NWT; wt += gridDim.x * 8) {
        const bool isctx = wt >= 4096;
        const int ct = isctx ? wt - 4096 : (wt >> 4), tch = isctx ? 0 : (wt & 15);
        const int col = ct * 16 + fr;
        bf16x8 bw[2];
#pragma unroll
        for (int ks = 0; ks < 2; ++ks)
#pragma unroll
            for (int j = 0; j < 8; ++j) bw[ks][j] = (short)f2bf(w4[(size_t)(ks * 32 + fq * 8 + j) * 4096 + col]);
        const int ch = col & 1023;
        const float mind = -3.0701134573253945f, maxd = -15.350567286626973f;
        const float delta = fabsf(mind + (maxd - mind) * ((float)ch / 1023.0f));
        const int nblk = isctx ? 4 : 16;
        const int t00 = isctx ? 0 : tch * 1024;
        const float invL1 = isctx ? (1.0f / 255.0f) : (1.0f / 16383.0f);
        for (int blk = 0; blk < nblk; ++blk) {
            const int t0 = t00 + blk * 64;
            f32x4 acc[4];
#pragma unroll
            for (int tau = 0; tau < 4; ++tau) {
                acc[tau] = (f32x4){0.f, 0.f, 0.f, 0.f};
                const int trow = t0 + 16 * (fr >> 2) + 4 * tau + (fr & 3);
                const bf16_t* ap = a3 + (size_t)((isctx ? TL : 0) + trow) * 64 + fq * 8;
                const bf16x8 a0 = *(const bf16x8*)(ap), a1 = *(const bf16x8*)(ap + 32);
                acc[tau] = __builtin_amdgcn_mfma_f32_16x16x32_bf16(a0, bw[0], acc[tau], 0, 0, 0);
                acc[tau] = __builtin_amdgcn_mfma_f32_16x16x32_bf16(a1, bw[1], acc[tau], 0, 0, 0);
            }
            unsigned o[8];
#pragma unroll
            for (int tau = 0; tau < 4; ++tau) {
                float v[4];
#pragma unroll
                for (int rg = 0; rg < 4; ++rg) { const int t = t0 + 16 * fq + 4 * tau + rg; v[rg] = acc[tau][rg] * __expf(-(float)t * invL1 * delta); }
                o[tau * 2] = pk_bf16(v[0], v[1]); o[tau * 2 + 1] = pk_bf16(v[2], v[3]);
            }
            bf16_t* dst = isctx ? HmC + (size_t)col * TCX + t0 + 16 * fq : HmT + (size_t)col * TL + t0 + 16 * fq;
            *(u32x4*)(dst) = (u32x4){o[0], o[1], o[2], o[3]};
            *(u32x4*)(dst + 8) = (u32x4){o[4], o[5], o[6], o[7]};
        }
    }
}
constexpr int HY_TW = 143360;
__device__ __forceinline__ f32x2 cmul(f32x2 a, f32x2 b) { return (f32x2){a.x * b.x - a.y * b.y, a.x * b.y + a.y * b.x}; }
__device__ __forceinline__ int fpad(int p) { return p + (p >> 4) + ((p >> 9) << 4); }
__device__ __forceinline__ int kpos(int k) { return fpad((k & 31) * 512 + ((k >> 5) & 31) * 16 + (k >> 10)); }
__host__ __device__ constexpr int brev_c(int q, int bits) { int r = 0; for (int i = 0; i < bits; ++i) r |= ((q >> i) & 1) << (bits - 1 - i); return r; }

template <int R, int LOGR, bool INV>
__device__ __forceinline__ void fft_regs(f32x2 (&v)[R]) {
    constexpr float C32[16] = {1.0f, 0.98078528040323043f, 0.92387953251128674f, 0.83146961230254524f, 0.70710678118654757f, 0.55557023301960229f, 0.38268343236508984f, 0.19509032201612833f,
                               0.0f, -0.19509032201612819f, -0.38268343236508973f, -0.55557023301960196f, -0.70710678118654746f, -0.83146961230254535f, -0.92387953251128674f, -0.98078528040323043f};
    constexpr float S32[16] = {0.0f, 0.19509032201612825f, 0.38268343236508978f, 0.55557023301960218f, 0.70710678118654746f, 0.83146961230254524f, 0.92387953251128674f, 0.98078528040323043f,
                               1.0f, 0.98078528040323043f, 0.92387953251128674f, 0.83146961230254546f, 0.70710678118654757f, 0.55557023301960218f, 0.38268343236508989f, 0.19509032201612861f};
#pragma unroll
    for (int s = 0; s < LOGR; ++s) {
        const int half = (R / 2) >> s;
#pragma unroll
        for (int start = 0; start < R; start += 2 * half) {
#pragma unroll
            for (int i = 0; i < half; ++i) {
                const f32x2 a = v[start + i], b = v[start + i + half];
                v[start + i] = a + b;
                const f32x2 d = a - b;
                const int e = i * (16 / half);
                if (e == 0) v[start + i + half] = d;
                else if (e == 8) v[start + i + half] = INV ? (f32x2){-d.y, d.x} : (f32x2){d.y, -d.x};
                else { const float c = C32[e], sn = INV ? S32[e] : -S32[e]; v[start + i + half] = (f32x2){d.x * c - d.y * sn, d.x * sn + d.y * c}; }
            }
        }
    }
}
template <int R, int LOGR, bool INV, bool TW>
__device__ __forceinline__ void fft_bfly(LAS f32x2* Z, int a0, int astride, f32x2 bw) {
    f32x2 v[R];
#pragma unroll
    for (int r = 0; r < R; ++r) v[r] = Z[a0 + r * astride];
    if (TW) {
        const f32x2 base = (f32x2){bw.x, INV ? -bw.y : bw.y};
        f32x2 tw = base;
        if (INV) {
#pragma unroll
            for (int q = 1; q < R; ++q) { v[q] = cmul(v[q], tw); tw = cmul(tw, base); }
            fft_regs<R, LOGR, INV>(v);
        } else {
            fft_regs<R, LOGR, INV>(v);
#pragma unroll
            for (int q = 1; q < R; ++q) { v[brev_c(q, LOGR)] = cmul(v[brev_c(q, LOGR)], tw); tw = cmul(tw, base); }
        }
    } else fft_regs<R, LOGR, INV>(v);
#pragma unroll
    for (int q = 0; q < R; ++q) Z[a0 + q * astride] = v[brev_c(q, LOGR)];
}
__device__ __forceinline__ void fft16k_fwd(LAS f32x2* Z) {
    const int tid = otid();
    const LAS f32x2* T1 = (const LAS f32x2*)((LAS unsigned char*)Z + HY_TW);
    fft_bfly<32, 5, false, true>(Z, tid + (tid >> 4), 560, T1[tid]);
    __syncthreads();
    { const int b = tid >> 4, j = tid & 15; fft_bfly<32, 5, false, true>(Z, 560 * b + j, 17, T1[32 * j]); }
    __syncthreads();
#pragma unroll
    for (int h = 0; h < 2; ++h) { const int bb = tid + 512 * h; fft_bfly<16, 4, false, false>(Z, 17 * bb + 16 * (bb >> 5), 1, (f32x2){1.f, 0.f}); }
    __syncthreads();
}
__device__ __forceinline__ void fft16k_inv(LAS f32x2* Z) {
    const int tid = otid();
#pragma unroll
    for (int h = 0; h < 2; ++h) { const int bb = tid + 512 * h; fft_bfly<16, 4, true, false>(Z, 17 * bb + 16 * (bb >> 5), 1, (f32x2){1.f, 0.f}); }
    __syncthreads();
    const LAS f32x2* T1 = (const LAS f32x2*)((LAS unsigned char*)Z + HY_TW);
    { const int b = tid >> 4, j = tid & 15; fft_bfly<32, 5, true, true>(Z, 560 * b + j, 17, T1[32 * j]); }
    __syncthreads();
    fft_bfly<32, 5, true, true>(Z, tid + (tid >> 4), 560, T1[tid]);
    __syncthreads();
}
__device__ __forceinline__ int pair_k(int tid, int jj) { return ((tid >> 8) * 16 + jj) + 32 * ((tid >> 3) & 31) + 1024 * (tid & 7); }

__device__ __forceinline__ void hy_stash(LAS f32x2* Z, f32x4 (&st)[16], f32x4& stx) {
    const int tid = otid();
#pragma unroll
    for (int jj = 0; jj < 16; ++jj) { const int k = pair_k(tid, jj), kp = (16384 - k) & 16383;
        const f32x2 A = Z[kpos(k)], Bc = Z[kpos(kp)]; const f32x2 B = (f32x2){Bc.x, -Bc.y};
        const f32x2 S = A + B, Dd = A - B;
        st[jj] = (f32x4){0.5f * S.x, 0.5f * S.y, 0.5f * Dd.y, -0.5f * Dd.x}; }
    { const f32x2 A = Z[kpos(8192)]; stx = (f32x4){A.x, 0.f, A.y, 0.f}; }
}
__device__ __forceinline__ void hy_pointwise_one(LAS f32x2* Z, int k, const f32x4 hh, bool do_write) {
    const int kp = (16384 - k) & 16383; const int pa = kpos(k), pb = kpos(kp);
    const f32x2 A = Z[pa], Bc = Z[pb]; const f32x2 B = (f32x2){Bc.x, -Bc.y};
    const f32x2 S = A + B, Dd = A - B;
    const f32x2 Xe = (f32x2){0.5f * S.x, 0.5f * S.y}, Xo = (f32x2){0.5f * Dd.y, -0.5f * Dd.x};
    const f32x2 He = (f32x2){hh.x, hh.y}, Ho = (f32x2){hh.z, hh.w};
    const LAS f32x2* T1 = (const LAS f32x2*)((LAS unsigned char*)Z + HY_TW);
    const f32x2 w2 = cmul(T1[k & 511], T1[512 + (k >> 9)]);
    const f32x2 P = cmul(Xe, He) + cmul(w2, cmul(Xo, Ho));
    const f32x2 Q = cmul(Xe, Ho) + cmul(Xo, He);
    if (do_write) { Z[pa] = (f32x2){P.x - Q.y, P.y + Q.x}; Z[pb] = (f32x2){P.x + Q.y, Q.x - P.y}; }
}
__device__ __forceinline__ void hy_pointwise(LAS f32x2* Z, const f32x4 (&st)[16], const f32x4& stx) {
    const int tid = otid();
#pragma unroll
    for (int jj = 0; jj < 16; ++jj) hy_pointwise_one(Z, pair_k(tid, jj), st[jj], true);
    hy_pointwise_one(Z, 8192, stx, tid == 0);
    __syncthreads();
}
__device__ __forceinline__ void ld32bf(const bf16_t* __restrict__ p, float (&o)[32]) {
#pragma unroll
    for (int q = 0; q < 4; ++q) { const u32x4 w = *(const u32x4*)(p + q * 8);
        o[q * 8 + 0] = bflo(w.x); o[q * 8 + 1] = bfhi(w.x); o[q * 8 + 2] = bflo(w.y); o[q * 8 + 3] = bfhi(w.y);
        o[q * 8 + 4] = bflo(w.z); o[q * 8 + 5] = bfhi(w.z); o[q * 8 + 6] = bflo(w.w); o[q * 8 + 7] = bfhi(w.w); }
}
__device__ __forceinline__ void conv32(const bf16_t* __restrict__ row, int t0, int len, float w0, float w1, float w2, float cb, float (&o)[32]) {
    float x[32]; ld32bf(row + t0, x);
    const float xm = t0 > 0 ? bf2f(row[t0 - 1]) : 0.f, xp = (t0 + 32 < len) ? bf2f(row[t0 + 32]) : 0.f;
#pragma unroll
    for (int i = 0; i < 32; ++i) { const float a = i > 0 ? x[i - 1] : xm, c = i < 31 ? x[i + 1] : xp; o[i] = cb + w0 * a + w1 * x[i] + w2 * c; }
}
__device__ __forceinline__ void hy_load_taps(LAS f32x2* Z, const bf16_t* __restrict__ hf, const bf16_t* __restrict__ hb) {
    const int tid = otid();
    { float x[32]; ld32bf(hf + 32 * tid, x);
#pragma unroll
      for (int i = 0; i < 16; ++i) Z[fpad(16 * tid + i)] = (f32x2){x[2 * i], x[2 * i + 1]}; }
    { const int e0 = 16384 - 32 * tid; float x[32]; ld32bf(hb + e0 - 32, x);
      const float ex = (e0 < 16384) ? bf2f(hb[e0]) : 0.f;
#pragma unroll
      for (int i = 0; i < 16; ++i) Z[fpad(8192 + 16 * tid + i)] = (f32x2){i == 0 ? ex : x[32 - 2 * i], x[31 - 2 * i]}; }
    __syncthreads();
}
__device__ __forceinline__ void hy_load_data(LAS f32x2* Z, const float (&zc)[32]) {
    const int tid = otid();
#pragma unroll
    for (int i = 0; i < 16; ++i) { Z[fpad(16 * tid + i)] = (f32x2){zc[2 * i], zc[2 * i + 1]}; Z[fpad(8192 + 16 * tid + i)] = (f32x2){0.f, 0.f}; }
    __syncthreads();
}
__device__ __forceinline__ void hy_get_z(const Params& p, int o, int c, int t0, float (&zc)[32]) {
    if (o == 0) { const bf16_t* PRE = (const bf16_t*)(p.ws + OFF_BIG2); const float* cw = p.in[I_HYCW];
        conv32(PRE + (size_t)c * MT, t0, TL, cw[c], cw[3072 + c], cw[6144 + c], p.in[I_HYCB][c], zc);
    } else { const float* ZS = (const float*)(p.ws + OFF_X) + (size_t)c * TL + t0;
#pragma unroll
        for (int q = 0; q < 8; ++q) { const f32x4 v = *(const f32x4*)(ZS + 4 * q); zc[4 * q] = v[0]; zc[4 * q + 1] = v[1]; zc[4 * q + 2] = v[2]; zc[4 * q + 3] = v[3]; } }
}
__device__ __forceinline__ void hyena_channel(const Params& p, LAS f32x2* Z, int c) {
    const int tid = otid();
    const bf16_t* PRE = (const bf16_t*)(p.ws + OFF_BIG2);
    const bf16_t* HmT = (const bf16_t*)(p.ws + OFF_BIG1);
    bf16_t* hyT = (bf16_t*)(p.ws + OFF_HYT);
    float* ZS = (float*)(p.ws + OFF_X);
    const float* cw = p.in[I_HYCW]; const float* cbias = p.in[I_HYCB]; const float* skip = p.in[I_HYSKIP];
    const int t0 = 32 * tid;
#pragma unroll 1
    for (int o = 0; o < 2; ++o) {
        f32x4 st[16], stx;
        hy_load_taps(Z, HmT + (size_t)(o * 1024 + c) * TL, HmT + (size_t)(2048 + o * 1024 + c) * TL);
        fft16k_fwd(Z);
        hy_stash(Z, st, stx);
        __syncthreads();
        { float zc[32]; hy_get_z(p, o, c, t0, zc); hy_load_data(Z, zc); }
        fft16k_fwd(Z);
        hy_pointwise(Z, st, stx);
        fft16k_inv(Z);
        {
            const int gr = (o + 1) * 1024 + c;
            float zc[32]; hy_get_z(p, o, c, t0, zc);
            float g[32]; conv32(PRE + (size_t)gr * MT, t0, TL, cw[gr], cw[3072 + gr], cw[6144 + gr], cbias[gr], g);
            const float sk = skip[o * 1024 + c];
#pragma unroll
            for (int i = 0; i < 16; ++i) { const f32x2 y = Z[fpad(16 * tid + i)];
                zc[2 * i] = g[2 * i] * (y.x * (1.0f / 16384.0f) + sk * zc[2 * i]); zc[2 * i + 1] = g[2 * i + 1] * (y.y * (1.0f / 16384.0f) + sk * zc[2 * i + 1]); }
            if (o == 0) {
#pragma unroll
                for (int q = 0; q < 8; ++q) *(f32x4*)(ZS + (size_t)c * TL + t0 + 4 * q) = (f32x4){zc[4 * q], zc[4 * q + 1], zc[4 * q + 2], zc[4 * q + 3]};
            } else {
                bf16_t* dst = hyT + (size_t)c * MT + t0;
#pragma unroll
                for (int q = 0; q < 4; ++q) { u32x4 w; w.x = pk_bf16(zc[q * 8], zc[q * 8 + 1]); w.y = pk_bf16(zc[q * 8 + 2], zc[q * 8 + 3]); w.z = pk_bf16(zc[q * 8 + 4], zc[q * 8 + 5]); w.w = pk_bf16(zc[q * 8 + 6], zc[q * 8 + 7]);
                    *(u32x4*)(dst + q * 8) = w; }
            }
        }
        __syncthreads();
    }
}
__device__ __forceinline__ void hyena_ctx_channel(const Params& p, LAS float* wl, int c) {
    const int lane = otid() & 63;
    const bf16_t* PRE = (const bf16_t*)(p.ws + OFF_BIG2);
    const bf16_t* HmC = (const bf16_t*)(p.ws + OFF_BIG1) + (size_t)4096 * TL;
    bf16_t* hyT = (bf16_t*)(p.ws + OFF_HYT);
    const float* cw = p.in[I_HYCW]; const float* cbias = p.in[I_HYCB]; const float* skip = p.in[I_HYSKIP];
    LAS float* zs = wl; LAS float* tp = wl + 256;
    float z[4];
    {
        const bf16_t* row = PRE + (size_t)c * MT + TL;
        float x[6];
#pragma unroll
        for (int i = 0; i < 6; ++i) { const int t = 4 * lane - 1 + i; x[i] = (t >= 0 && t < TCX) ? bf2f(row[t]) : 0.f; }
#pragma unroll
        for (int i = 0; i < 4; ++i) z[i] = cbias[c] + cw[c] * x[i] + cw[3072 + c] * x[i + 1] + cw[6144 + c] * x[i + 2];
    }
#pragma unroll 1
    for (int o = 0; o < 2; ++o) {
        const bf16_t* hf = HmC + (size_t)(o * 1024 + c) * TCX; const bf16_t* hb = HmC + (size_t)(2048 + o * 1024 + c) * TCX;
#pragma unroll
        for (int i = 0; i < 4; ++i) { const int d = 4 * lane + i; zs[d] = z[i]; tp[255 + d] = bf2f(hf[d]); if (d > 0) tp[255 - d] = bf2f(hb[d]); }
        __builtin_amdgcn_s_waitcnt(0);
        __builtin_amdgcn_wave_barrier();
        float y[4] = {0.f, 0.f, 0.f, 0.f};
        for (int s = 0; s < 256; ++s) { const float zv = zs[s];
#pragma unroll
            for (int i = 0; i < 4; ++i) y[i] = fmaf(tp[255 + 4 * lane + i - s], zv, y[i]); }
        const int gr = (o + 1) * 1024 + c;
        const bf16_t* row = PRE + (size_t)gr * MT + TL;
        float x[6];
#pragma unroll
        for (int i = 0; i < 6; ++i) { const int t = 4 * lane - 1 + i; x[i] = (t >= 0 && t < TCX) ? bf2f(row[t]) : 0.f; }
        const float sk = skip[o * 1024 + c];
#pragma unroll
        for (int i = 0; i < 4; ++i) { const float g = cbias[gr] + cw[gr] * x[i] + cw[3072 + gr] * x[i + 1] + cw[6144 + gr] * x[i + 2]; z[i] = g * (y[i] + sk * z[i]); }
        __builtin_amdgcn_wave_barrier();
    }
    *(u32x2*)(hyT + (size_t)c * MT + TL + 4 * lane) = (u32x2){pk_bf16(z[0], z[1]), pk_bf16(z[2], z[3])};
}

constexpr int NA_KS = 0;
constexpr int NA_VS = 34816;
__device__ __forceinline__ void na_block_task(const Params& p, LAS unsigned char* lds, int task) {
    const int tid = otid(), wv = __builtin_amdgcn_readfirstlane(tid >> 6), lane = tid & 63, fr = lane & 15, fq = lane >> 4;
    const bf16_t* QK = (const bf16_t*)(p.ws + OFF_QK);
    const bf16_t* VT = (const bf16_t*)(p.ws + OFF_BIG2) + (size_t)3072 * MT;
    bf16_t* A2 = (bf16_t*)(p.ws + OFF_A);
    const float* rpb = p.in[I_RPB];
    const float scale = 0.08838834764831845f;
    const int hl = wv >> 2;
    int hp, qrow, nlat, r = 0, g = 0, r0 = 0, cb = 0;
    if (task < 1024) { hp = task & 3; r = task >> 2; g = wv & 3; qrow = r * 64 + 16 * g + fr; nlat = 8;
        r0 = r - 4; r0 = r0 < 0 ? 0 : (r0 > 248 ? 248 : r0); cb = 16 * g - 8; cb = cb < 0 ? 0 : (cb > 32 ? 32 : cb);
    } else { const int t = task - 1024; hp = t & 3; qrow = TL + 16 * (4 * (t >> 2) + (wv & 3)) + fr; nlat = 0; }
    const int h = 2 * hp + hl;
    const unsigned so_k = (unsigned)((tid >> 3) * 2048 + (tid & 7) * 8);
    const unsigned so_v = (unsigned)((tid >> 1) * MT + (tid & 1) * 32);
    u32x4 sk[4], sv[4];
#define NA_LOAD(tk0_) do { const bf16_t* kb_ = QK + (size_t)(tk0_) * 2048 + 1024 + hp * 256; const bf16_t* vb_ = VT + (size_t)(hp * 256) * MT + (tk0_); \
        _Pragma("unroll") for (int j = 0; j < 4; ++j) { sk[j] = *(const u32x4*)(kb_ + so_k + 64u * j); sv[j] = *(const u32x4*)(vb_ + so_v + 8u * j); } } while (0)
#define NA_STORE() do { _Pragma("unroll") for (int j = 0; j < 4; ++j) { \
        *(LAS u32x4*)(lds + NA_KS + (j >> 1) * 17408 + (tid >> 3) * 272 + ((tid & 7) * 8 + 64 * (j & 1)) * 2) = sk[j]; \
        *(LAS u32x4*)(lds + NA_VS + (tid >> 1) * 144 + ((tid & 1) * 32 + 8 * j) * 2) = sv[j]; } } while (0)
    bf16x8 qf[4];
#pragma unroll
    for (int ks = 0; ks < 4; ++ks) qf[ks] = *(const bf16x8*)(QK + (size_t)qrow * 2048 + h * 128 + ks * 32 + fq * 8);
    f32x4 oacc[8];
#pragma unroll
    for (int dt = 0; dt < 8; ++dt) oacc[dt] = (f32x4){0.f, 0.f, 0.f, 0.f};
    float mrun = -1e30f, lrun = 0.f;
    const int c = 16 * g + fr;
    int cs = c - 8; cs = cs < 0 ? 0 : (cs > 48 ? 48 : cs);
    const int nsteps = nlat + 4;
    __syncthreads();
    { const int tk0 = nlat ? r0 * 64 : TL; NA_LOAD(tk0); NA_STORE(); }
    __syncthreads();
    LAS unsigned char* Kh = lds + NA_KS + hl * 17408;
    LAS unsigned char* Vh = lds + NA_VS + hl * 128 * 144;
#pragma unroll 1
    for (int step = 0; step < nsteps; ++step) {
        const bool lat = step < nlat;
        if (step + 1 < nsteps) { const int tk1 = (step + 1 < nlat) ? (r0 + step + 1) * 64 : TL + 64 * (step + 1 - nlat); NA_LOAD(tk1); }
        const int kr = r0 + step;
        const int nsub = lat ? 1 : 2;
#pragma unroll 1
        for (int sub = 0; sub < nsub; ++sub) {
            const int kb = lat ? cb : 32 * sub;
            f32x4 s[2];
#pragma unroll
            for (int tl = 0; tl < 2; ++tl) {
                s[tl] = (f32x4){0.f, 0.f, 0.f, 0.f};
#pragma unroll
                for (int ks = 0; ks < 4; ++ks) { const bf16x8 kf = *(const LAS bf16x8*)(Kh + (kb + 16 * tl + fr) * 272 + 64 * ks + 16 * fq);
                    s[tl] = __builtin_amdgcn_mfma_f32_16x16x32_bf16(kf, qf[ks], s[tl], 0, 0, 0); }
            }
            float svv[8]; float mx = -1e30f;
#pragma unroll
            for (int tl = 0; tl < 2; ++tl)
#pragma unroll
                for (int rg = 0; rg < 4; ++rg) {
                    float v = s[tl][rg] * scale;
                    if (lat) { const int kc = kb + 16 * tl + 4 * fq + rg; const bool ok = (kc >= cs) && (kc < cs + 16);
                        const int ro = kr - r + 7, co = kc - c + 15;
                        const float bias = ok ? rpb[(h * 15 + ro) * 31 + co] : 0.f;
                        v = ok ? v + bias : -1e30f; }
                    svv[tl * 4 + rg] = v; mx = fmaxf(mx, v);
                }
            mx = fmaxf(mx, __shfl_xor(mx, 16)); mx = fmaxf(mx, __shfl_xor(mx, 32));
            const float mnew = fmaxf(mrun, mx);
            const float alpha = __expf(mrun - mnew);
            float ps = 0.f; float pv[8];
#pragma unroll
            for (int i = 0; i < 8; ++i) { pv[i] = (svv[i] > -1e29f) ? __expf(svv[i] - mnew) : 0.f; ps += pv[i]; }
            ps += __shfl_xor(ps, 16); ps += __shfl_xor(ps, 32);
            lrun = lrun * alpha + ps; mrun = mnew;
            bf16x8 pf;
            { const u32x4 w = (u32x4){pk_bf16(pv[0], pv[1]), pk_bf16(pv[2], pv[3]), pk_bf16(pv[4], pv[5]), pk_bf16(pv[6], pv[7])}; pf = __builtin_bit_cast(bf16x8, w); }
#pragma unroll
            for (int dt = 0; dt < 8; ++dt) {
                oacc[dt] *= alpha;
                LAS unsigned char* vp = Vh + (dt * 16 + fr) * 144 + (kb + 4 * fq) * 2;
                const u32x2 va = *(const LAS u32x2*)(vp), vb = *(const LAS u32x2*)(vp + 32);
                const u32x4 vw = (u32x4){va.x, va.y, vb.x, vb.y};
                oacc[dt] = __builtin_amdgcn_mfma_f32_16x16x32_bf16(__builtin_bit_cast(bf16x8, vw), pf, oacc[dt], 0, 0, 0);
            }
        }
        __syncthreads();
        if (step + 1 < nsteps) NA_STORE();
        __syncthreads();
    }
#undef NA_LOAD
#undef NA_STORE
    const float inv = 1.0f / lrun;
#pragma unroll
    for (int dt = 0; dt < 8; ++dt) {
        const f32x4 o = oacc[dt] * inv;
        *(u32x2*)(A2 + (size_t)qrow * 2048 + 1024 + h * 128 + dt * 16 + 4 * fq) = (u32x2){pk_bf16(o[0], o[1]), pk_bf16(o[2], o[3])};
    }
}

__device__ __forceinline__ void phase3(const Params& p, LAS unsigned char* lds, int which = 7) {
    const int tid = otid(), w = tid >> 6;
    {
        LAS f32x2* T1 = (LAS f32x2*)(lds + HY_TW); float sn, cs;
        sincospif((float)tid * (1.0f / 8192.0f), &sn, &cs); T1[tid] = (f32x2){cs, -sn};
        if (tid < 17) { sincospif((float)tid * (1.0f / 16.0f), &sn, &cs); T1[512 + tid] = (f32x2){cs, -sn}; }
        __syncthreads();
    }
    if (which & 1) for (int c = blockIdx.x; c < 1024; c += gridDim.x) hyena_channel(p, (LAS f32x2*)lds, c);
    __syncthreads();
    if (which & 2) for (int c = blockIdx.x * 8 + w; c < 1024; c += gridDim.x * 8) hyena_ctx_channel(p, (LAS float*)lds + w * 768, c);
    __syncthreads();
    if (which & 4) for (int t = blockIdx.x; t < 1024 + 16; t += gridDim.x) na_block_task(p, lds, t);
}

__device__ __forceinline__ void phase4(const Params& p, LAS unsigned char* lds) {
    LAS unsigned short* tile = (LAS unsigned short*)lds;
    const bf16_t* hyT = (const bf16_t*)(p.ws + OFF_HYT);
    bf16_t* A2 = (bf16_t*)(p.ws + OFF_A);
    const int tid = otid();
    for (int task = blockIdx.x; task < 16 * 260; task += gridDim.x) {
        const int ct = task & 15, rt = task >> 4;
#pragma unroll
        for (int it = 0; it < 4; ++it) { const int i = tid + it * 512, cc = i >> 5, rp = i & 31;
            const unsigned v = *(const unsigned*)(hyT + (size_t)(ct * 64 + cc) * MT + rt * 64 + 2 * rp);
            tile[cc * 66 + 2 * rp] = (unsigned short)(v & 0xFFFFu); tile[cc * 66 + 2 * rp + 1] = (unsigned short)(v >> 16); }
        __syncthreads();
#pragma unroll
        for (int it = 0; it < 4; ++it) { const int i = tid + it * 512, rr = i >> 5, cp = i & 31;
            const unsigned lo = tile[(2 * cp) * 66 + rr], hi = tile[(2 * cp + 1) * 66 + rr];
            *(unsigned*)(A2 + (size_t)(rt * 64 + rr) * 2048 + ct * 64 + 2 * cp) = (lo | (hi << 16)); }
        __syncthreads();
    }
}
__device__ __forceinline__ void ld8(const float* __restrict__ p, float (&o)[8]) { const f32x4 a = *(const f32x4*)p, b = *(const f32x4*)(p + 4);
    o[0] = a[0]; o[1] = a[1]; o[2] = a[2]; o[3] = a[3]; o[4] = b[0]; o[5] = b[1]; o[6] = b[2]; o[7] = b[3]; }
__device__ __forceinline__ void st8(float* __restrict__ p, const float (&o)[8]) { *(f32x4*)p = (f32x4){o[0], o[1], o[2], o[3]}; *(f32x4*)(p + 4) = (f32x4){o[4], o[5], o[6], o[7]}; }
__device__ __forceinline__ void st8bf(bf16_t* __restrict__ p, const float (&o)[8]) { *(u32x4*)p = (u32x4){pk_bf16(o[0], o[1]), pk_bf16(o[2], o[3]), pk_bf16(o[4], o[5]), pk_bf16(o[6], o[7])}; }

__device__ __forceinline__ void ld8bf(const bf16_t* __restrict__ p, float (&o)[8]) { const u32x4 w = *(const u32x4*)p; o[0] = bflo(w.x); o[1] = bfhi(w.x); o[2] = bflo(w.y); o[3] = bfhi(w.y); o[4] = bflo(w.z); o[5] = bfhi(w.z); o[6] = bflo(w.w); o[7] = bfhi(w.w); }
__device__ __forceinline__ void ln_row(float (&v)[4][8], const float* __restrict__ lw, const float* __restrict__ lb, int lane) {
    float s = 0.f;
#pragma unroll
    for (int pc = 0; pc < 4; ++pc)
#pragma unroll
        for (int j = 0; j < 8; ++j) s += v[pc][j];
    const float mu = wave_sum(s) * (1.0f / 2048.0f);
    float q = 0.f;
#pragma unroll
    for (int pc = 0; pc < 4; ++pc)
#pragma unroll
        for (int j = 0; j < 8; ++j) { const float d = v[pc][j] - mu; q += d * d; }
    const float rs = rsqrtf(wave_sum(q) * (1.0f / 2048.0f) + LN_EPS);
#pragma unroll
    for (int pc = 0; pc < 4; ++pc) { float w[8], b[8]; ld8(lw + pc * 512 + lane * 8, w); ld8(lb + pc * 512 + lane * 8, b);
#pragma unroll
        for (int j = 0; j < 8; ++j) v[pc][j] = (v[pc][j] - mu) * rs * w[j] + b[j]; }
}

template <bool SLAB>
__device__ __forceinline__ void ln1_load(const Params& p, int layer, int r, int lane, const float* __restrict__ slab, float (&v)[4][8]) {
    const bf16_t* y = (const bf16_t*)(p.ws + OFF_BIG2); const bf16_t* H = (const bf16_t*)(p.ws + OFF_H);
    const float* hp = r < TL ? p.in[I_X] + (size_t)r * DM : p.in[I_CTX] + (size_t)(r - TL) * DM;
    const float* md = (const float*)(p.ws + OFF_MOD) + (size_t)layer * 2 * 12288 + (r < TL ? 0 : 12288);
#pragma unroll
    for (int pc = 0; pc < 4; ++pc) { const int e = pc * 512 + lane * 8; float hv[8], yv[8], gv[8];
        if (layer == 0) ld8(hp + e, hv); else ld8bf(H + (size_t)r * DM + e, hv);
        if (SLAB) {
#pragma unroll
            for (int j = 0; j < 8; ++j) yv[j] = 0.f;
#pragma unroll 1
            for (int sl = 0; sl < 8; ++sl) { float t8[8]; ld8(slab + ((size_t)(sl * 8 + (e >> 8)) << 16) + (size_t)(r - TL) * 256 + (e & 255), t8);
#pragma unroll
                for (int j = 0; j < 8; ++j) yv[j] += t8[j]; }
        } else ld8bf(y + (size_t)r * DM + e, yv);
        ld8(md + 2 * 2048 + e, gv);
#pragma unroll
        for (int j = 0; j < 8; ++j) v[pc][j] = DN_ALPHA * hv[j] + gv[j] * yv[j]; }
}
__device__ __forceinline__ void ln1_finish(const Params& p, int layer, int r, int lane, float (&v)[4][8]) {
    bf16_t* H = (bf16_t*)(p.ws + OFF_H); bf16_t* A = (bf16_t*)(p.ws + OFF_A);
    const float* lw = p.in[I_LNW] + (size_t)(layer * 2 + 0) * DM; const float* lb = p.in[I_LNB] + (size_t)(layer * 2 + 0) * DM;
    const float* md = (const float*)(p.ws + OFF_MOD) + (size_t)layer * 2 * 12288 + (r < TL ? 0 : 12288);
    ln_row(v, lw, lb, lane);
#pragma unroll
    for (int pc = 0; pc < 4; ++pc) { const int e = pc * 512 + lane * 8; st8bf(H + (size_t)r * DM + e, v[pc]);
        float sc[8], sh[8], o[8]; ld8(md + 4 * 2048 + e, sc); ld8(md + 3 * 2048 + e, sh);
#pragma unroll
        for (int j = 0; j < 8; ++j) o[j] = v[pc][j] * (1.f + sc[j]) + sh[j];
        st8bf(A + (size_t)r * DM + e, o); }
}
__device__ __forceinline__ void phase_ln1(const Params& p, int layer, int nrows, const float* __restrict__ slab) {
    const int tid = otid(), w = tid >> 6, lane = tid & 63;
    const int stride = gridDim.x * 8;
    const int nmain = slab != nullptr ? TL : nrows;
    for (int r = blockIdx.x * 8 + w; r < nmain; r += 2 * stride) {
        const int r2 = r + stride; const bool has2 = r2 < nmain;
        float v[4][8], v2[4][8];
        ln1_load<false>(p, layer, r, lane, slab, v);
        if (has2) ln1_load<false>(p, layer, r2, lane, slab, v2);
        ln1_finish(p, layer, r, lane, v);
        if (has2) ln1_finish(p, layer, r2, lane, v2);
    }
    if (slab != nullptr) {
#pragma unroll 1
        for (int r = TL + blockIdx.x * 8 + w; r < nrows; r += stride) { float v[4][8]; ln1_load<true>(p, layer, r, lane, slab, v); ln1_finish(p, layer, r, lane, v); }
    }
}

__device__ __forceinline__ unsigned fkey(float f) { const unsigned u = __float_as_uint(f); return (u & 0x80000000u) ? ~u : (u | 0x80000000u); }
__device__ __forceinline__ float kval(unsigned k) { const unsigned u = (k & 0x80000000u) ? (k & 0x7FFFFFFFu) : ~k; return __uint_as_float(u); }
__device__ __forceinline__ void kins(unsigned (&L)[16], unsigned x) {
#pragma unroll
    for (int i = 0; i < 16; ++i) { const unsigned hi = L[i] > x ? L[i] : x; x = L[i] > x ? x : L[i]; L[i] = hi; }
}
__device__ __forceinline__ unsigned wave_umax(unsigned v) {
#pragma unroll
    for (int o = 32; o > 0; o >>= 1) { const unsigned t = (unsigned)__shfl_xor((int)v, o); v = v > t ? v : t; }
    return v;
}
__device__ __forceinline__ void topk_ctx_wave(const Params& p, const float* __restrict__ slab) {
    const int tid = otid(), wv = tid >> 6, lane = tid & 63;
    int* EI = (int*)(p.ws + OFF_EXP); float* EG = (float*)(p.ws + OFF_EXP + (size_t)MT * 128 * 4);
    for (int item = blockIdx.x * 8 + wv; item < TCX * 8; item += gridDim.x * 8) {
        const int h = item & 7, rl = item >> 3, r = TL + rl;
        float s1a = 0.f, s1b = 0.f, s2a = 0.f, s2b = 0.f;
#pragma unroll
        for (int sl = 0; sl < 8; ++sl) { const float* sb = slab + ((size_t)(sl * 8 + h) << 16) + rl;
            s1a += sb[(size_t)lane * 256]; s1b += sb[(size_t)(lane + 64) * 256]; s2a += sb[(size_t)(128 + lane) * 256]; s2b += sb[(size_t)(192 + lane) * 256]; }
        unsigned k1a = (fkey(s1a) & ~0x7Fu) | (unsigned)(127 - lane), k1b = (fkey(s1b) & ~0x7Fu) | (unsigned)(63 - lane);
        unsigned k2a = (fkey(s2a) & ~0x7Fu) | (unsigned)(127 - lane), k2b = (fkey(s2b) & ~0x7Fu) | (unsigned)(63 - lane);
        unsigned vec1 = 0u, vec2 = 0u;
#pragma unroll
        for (int i = 0; i < 16; ++i) {
            const unsigned w1 = wave_umax(k1a > k1b ? k1a : k1b); if (k1a == w1) k1a = 0u; if (k1b == w1) k1b = 0u; vec1 = lane == i ? w1 : vec1;
            const unsigned w2 = wave_umax(k2a > k2b ? k2a : k2b); if (k2a == w2) k2a = 0u; if (k2b == w2) k2b = 0u; vec2 = lane == i ? w2 : vec2;
        }
        const float v1 = kval((unsigned)__shfl((int)vec1, lane >> 2) & ~0x7Fu);
        unsigned ck[4];
#pragma unroll
        for (int t = 0; t < 4; ++t) { const int i = lane >> 2, j = 4 * (lane & 3) + t; const float v2 = kval((unsigned)__shfl((int)vec2, j) & ~0x7Fu);
            ck[t] = ((i + 1) * (j + 1) <= 16) ? ((fkey(v1 + v2) & ~0xFFu) | (unsigned)(255 - (i * 16 + j))) : 0u; }
        unsigned vec3 = 0u;
#pragma unroll
        for (int s3 = 0; s3 < 16; ++s3) { unsigned m = ck[0] > ck[1] ? ck[0] : ck[1]; const unsigned m2 = ck[2] > ck[3] ? ck[2] : ck[3]; m = m > m2 ? m : m2;
            const unsigned w3 = wave_umax(m);
#pragma unroll
            for (int t = 0; t < 4; ++t) if (ck[t] == w3) ck[t] = 0u;
            vec3 = lane == s3 ? w3 : vec3; }
        const float top = kval((unsigned)__shfl((int)vec3, 0) & ~0xFFu);
        const float ev = lane < 16 ? __expf(kval(vec3 & ~0xFFu) - top) : 0.f;
        const float sum = wave_sum(ev);
        const unsigned id = 255u - (vec3 & 0xFFu); const int ii = (int)(id >> 4), jj = (int)(id & 15u);
        const unsigned kk1 = (unsigned)__shfl((int)vec1, ii), kk2 = (unsigned)__shfl((int)vec2, jj);
        if (lane < 16) { const int n1 = 127 - (int)(kk1 & 0x7Fu), n2 = 127 - (int)(kk2 & 0x7Fu);
            EI[(size_t)r * 128 + h * 16 + lane] = n1 * 128 + n2; EG[(size_t)r * 128 + h * 16 + lane] = ev / sum; }
    }
}

__device__ __forceinline__ void phase_topk(const Params& p, LAS unsigned char* lds, int nrows, const float* __restrict__ slab) {
    LAS unsigned short* nsel = (LAS unsigned short*)lds;
    const float* ST = (const float*)(p.ws + OFF_BIG1);
    int* EI = (int*)(p.ws + OFF_EXP); float* EG = (float*)(p.ws + OFF_EXP + (size_t)MT * 128 * 4);
    const int tid = otid();
    const int nch = slab != nullptr ? TL / 512 : (nrows + 511) / 512;
    for (int task = blockIdx.x; task < nch * 8; task += gridDim.x) {
        const int h = task & 7, r = (task >> 3) * 512 + tid;
        const bool act = r < nrows; const int rr = act ? r : nrows - 1;
        unsigned L1[16], L2[16], L3[16];
#pragma unroll
        for (int i = 0; i < 16; ++i) { L1[i] = 0u; L2[i] = 0u; L3[i] = 0u; }
        const float* s1 = ST + (size_t)(h * 256) * MT + rr; const float* s2 = s1 + (size_t)128 * MT;
#pragma unroll 1
        for (int n0 = 0; n0 < 128; n0 += 16) {
            float a[16], b[16];
#pragma unroll
            for (int j = 0; j < 16; ++j) { a[j] = s1[(size_t)(n0 + j) * MT]; b[j] = s2[(size_t)(n0 + j) * MT]; }
#pragma unroll
            for (int j = 0; j < 16; ++j) { kins(L1, (fkey(a[j]) & ~0x7Fu) | (unsigned)(127 - n0 - j)); kins(L2, (fkey(b[j]) & ~0x7Fu) | (unsigned)(127 - n0 - j)); }
        }
        float v1[16], v2[16];
#pragma unroll
        for (int i = 0; i < 16; ++i) { v1[i] = kval(L1[i] & ~0x7Fu); v2[i] = kval(L2[i] & ~0x7Fu);
            nsel[i * 512 + tid] = (unsigned short)(127u - (L1[i] & 0x7Fu)); nsel[(16 + i) * 512 + tid] = (unsigned short)(127u - (L2[i] & 0x7Fu)); }
#pragma unroll
        for (int i = 0; i < 16; ++i)
#pragma unroll
            for (int j = 0; j < 16; ++j)
                if ((i + 1) * (j + 1) <= 16) { const unsigned kc = (fkey(v1[i] + v2[j]) & ~0xFFu) | (unsigned)(255 - (i * 16 + j)); kins(L3, kc); }
        const float m = kval(L3[0] & ~0xFFu);
        float e[16], sum = 0.f;
#pragma unroll
        for (int s = 0; s < 16; ++s) { e[s] = __expf(kval(L3[s] & ~0xFFu) - m); sum += e[s]; }
        const float inv = 1.0f / sum;
        if (act) {
#pragma unroll
            for (int s = 0; s < 16; ++s) { const unsigned id = 255u - (L3[s] & 0xFFu); const unsigned i = id >> 4, j = id & 15u;
                const int n1 = nsel[i * 512 + tid], n2 = nsel[(16 + j) * 512 + tid];
                EI[(size_t)r * 128 + h * 16 + s] = n1 * 128 + n2; EG[(size_t)r * 128 + h * 16 + s] = e[s] * inv; }
        }
    }
    if (slab != nullptr) topk_ctx_wave(p, slab);
}

__device__ __forceinline__ float dpp_sum63(float v) {
    v += __builtin_bit_cast(float, __builtin_amdgcn_update_dpp(0, __builtin_bit_cast(int, v), 0x111, 0xf, 0xf, false));
    v += __builtin_bit_cast(float, __builtin_amdgcn_update_dpp(0, __builtin_bit_cast(int, v), 0x112, 0xf, 0xf, false));
    v += __builtin_bit_cast(float, __builtin_amdgcn_update_dpp(0, __builtin_bit_cast(int, v), 0x114, 0xf, 0xf, false));
    v += __builtin_bit_cast(float, __builtin_amdgcn_update_dpp(0, __builtin_bit_cast(int, v), 0x118, 0xf, 0xf, false));
    v += __builtin_bit_cast(float, __builtin_amdgcn_update_dpp(0, __builtin_bit_cast(int, v), 0x142, 0xa, 0xf, false));
    v += __builtin_bit_cast(float, __builtin_amdgcn_update_dpp(0, __builtin_bit_cast(int, v), 0x143, 0xc, 0xf, false));
    return v;
}
__device__ __forceinline__ float readlane_f(float v, int l) { return __builtin_bit_cast(float, __builtin_amdgcn_readlane(__builtin_bit_cast(int, v), l)); }
__device__ __forceinline__ float dot8(const u32x4 a, const u32x4 b, float acc) {
    const unsigned a0 = a.x, a1 = a.y, a2 = a.z, a3 = a.w, b0 = b.x, b1 = b.y, b2 = b.z, b3 = b.w;
    acc = __builtin_amdgcn_fdot2_f32_bf16(__builtin_bit_cast(bf2_t, a0), __builtin_bit_cast(bf2_t, b0), acc, false);
    acc = __builtin_amdgcn_fdot2_f32_bf16(__builtin_bit_cast(bf2_t, a1), __builtin_bit_cast(bf2_t, b1), acc, false);
    acc = __builtin_amdgcn_fdot2_f32_bf16(__builtin_bit_cast(bf2_t, a2), __builtin_bit_cast(bf2_t, b2), acc, false);
    acc = __builtin_amdgcn_fdot2_f32_bf16(__builtin_bit_cast(bf2_t, a3), __builtin_bit_cast(bf2_t, b3), acc, false);
    return acc;
}
__device__ __forceinline__ void axpy8(float (&o)[8], const u32x4 v, float c) {
    o[0] = fmaf(c, bflo(v.x), o[0]); o[1] = fmaf(c, bfhi(v.x), o[1]); o[2] = fmaf(c, bflo(v.y), o[2]); o[3] = fmaf(c, bfhi(v.y), o[3]);
    o[4] = fmaf(c, bflo(v.z), o[4]); o[5] = fmaf(c, bfhi(v.z), o[5]); o[6] = fmaf(c, bflo(v.w), o[6]); o[7] = fmaf(c, bfhi(v.w), o[7]);
}
__device__ __forceinline__ void cvt16(const u32x4 w, float (&o)[16]) {
    const int w0 = (int)w.x, w1 = (int)w.y, w2 = (int)w.z, w3 = (int)w.w;
    f32x2 t;
    t = __builtin_amdgcn_cvt_pk_f32_fp8(w0, false); o[0] = t.x; o[1] = t.y;   t = __builtin_amdgcn_cvt_pk_f32_fp8(w0, true); o[2] = t.x; o[3] = t.y;
    t = __builtin_amdgcn_cvt_pk_f32_fp8(w1, false); o[4] = t.x; o[5] = t.y;   t = __builtin_amdgcn_cvt_pk_f32_fp8(w1, true); o[6] = t.x; o[7] = t.y;
    t = __builtin_amdgcn_cvt_pk_f32_fp8(w2, false); o[8] = t.x; o[9] = t.y;   t = __builtin_amdgcn_cvt_pk_f32_fp8(w2, true); o[10] = t.x; o[11] = t.y;
    t = __builtin_amdgcn_cvt_pk_f32_fp8(w3, false); o[12] = t.x; o[13] = t.y; t = __builtin_amdgcn_cvt_pk_f32_fp8(w3, true); o[14] = t.x; o[15] = t.y;
}
__device__ __forceinline__ void ld16(const float* __restrict__ p, float (&o)[16]) {
#pragma unroll
    for (int q = 0; q < 4; ++q) { const f32x4 a = *(const f32x4*)(p + 4 * q); o[4 * q] = a[0]; o[4 * q + 1] = a[1]; o[4 * q + 2] = a[2]; o[4 * q + 3] = a[3]; }
}
__device__ __forceinline__ void peer_finish(const Params& p, int layer, int r, int lane, float (&f)[2][16]) {
    bf16_t* H = (bf16_t*)(p.ws + OFF_H); bf16_t* A = (bf16_t*)(p.ws + OFF_A);
    const float* lw = p.in[I_LNW] + (size_t)(layer * 2 + 1) * DM; const float* lb = p.in[I_LNB] + (size_t)(layer * 2 + 1) * DM;
    const float* md = (const float*)(p.ws + OFF_MOD) + (size_t)layer * 2 * 12288 + (r < TL ? 0 : 12288);
    float s = 0.f;
#pragma unroll
    for (int pc = 0; pc < 2; ++pc) { const int e = PEER_F6V ? lane * 32 + pc * 16 : pc * 1024 + lane * 16; float hv[16], gv[16]; { float t0[8], t1[8]; ld8bf(H + (size_t)r * DM + e, t0); ld8bf(H + (size_t)r * DM + e + 8, t1);
#pragma unroll
            for (int j = 0; j < 8; ++j) { hv[j] = t0[j]; hv[8 + j] = t1[j]; } } ld16(md + 5 * 2048 + e, gv);
#pragma unroll
        for (int j = 0; j < 16; ++j) { f[pc][j] = DN_ALPHA * hv[j] + gv[j] * f[pc][j]; s += f[pc][j]; } }
    const float mu = wave_sum(s) * (1.0f / 2048.0f);
    float qv = 0.f;
#pragma unroll
    for (int pc = 0; pc < 2; ++pc)
#pragma unroll
        for (int j = 0; j < 16; ++j) { const float d = f[pc][j] - mu; qv += d * d; }
    const float rs = rsqrtf(wave_sum(qv) * (1.0f / 2048.0f) + LN_EPS);
    const float* md1 = (const float*)(p.ws + OFF_MOD) + (size_t)2 * 12288 + (r < TL ? 0 : 12288);
#pragma unroll
    for (int pc = 0; pc < 2; ++pc) { const int e = PEER_F6V ? lane * 32 + pc * 16 : pc * 1024 + lane * 16; float wv[16], bv[16]; ld16(lw + e, wv); ld16(lb + e, bv);
        float o[16];
#pragma unroll
        for (int j = 0; j < 16; ++j) o[j] = (f[pc][j] - mu) * rs * wv[j] + bv[j];
        if (layer == 0) {
            *(u32x4*)(H + (size_t)r * DM + e) = (u32x4){pk_bf16(o[0], o[1]), pk_bf16(o[2], o[3]), pk_bf16(o[4], o[5]), pk_bf16(o[6], o[7])};
            *(u32x4*)(H + (size_t)r * DM + e + 8) = (u32x4){pk_bf16(o[8], o[9]), pk_bf16(o[10], o[11]), pk_bf16(o[12], o[13]), pk_bf16(o[14], o[15])};
            float sc[16], sh[16]; ld16(md1 + 2048 + e, sc); ld16(md1 + e, sh);
#pragma unroll
            for (int j = 0; j < 16; ++j) o[j] = o[j] * (1.f + sc[j]) + sh[j];
#if F8_L1
            unsigned char* ap = p.ws + OFF_X + (size_t)r * DM + e;
            *(u32x4*)ap = (u32x4){fp8x4(clamp8(o[0] * G8_XS), clamp8(o[1] * G8_XS), clamp8(o[2] * G8_XS), clamp8(o[3] * G8_XS)), fp8x4(clamp8(o[4] * G8_XS), clamp8(o[5] * G8_XS), clamp8(o[6] * G8_XS), clamp8(o[7] * G8_XS)),
                                  fp8x4(clamp8(o[8] * G8_XS), clamp8(o[9] * G8_XS), clamp8(o[10] * G8_XS), clamp8(o[11] * G8_XS)), fp8x4(clamp8(o[12] * G8_XS), clamp8(o[13] * G8_XS), clamp8(o[14] * G8_XS), clamp8(o[15] * G8_XS))};
#else
            bf16_t* ap = A + (size_t)r * DM + e;
            *(u32x4*)ap = (u32x4){pk_bf16(o[0], o[1]), pk_bf16(o[2], o[3]), pk_bf16(o[4], o[5]), pk_bf16(o[6], o[7])};
            *(u32x4*)(ap + 8) = (u32x4){pk_bf16(o[8], o[9]), pk_bf16(o[10], o[11]), pk_bf16(o[12], o[13]), pk_bf16(o[14], o[15])};
#endif
        } else {
#pragma unroll
            for (int q = 0; q < 4; ++q) *(f32x4*)(p.out + (size_t)r * DM + e + 4 * q) = (f32x4){o[4 * q], o[4 * q + 1], o[4 * q + 2], o[4 * q + 3]};
        }
    }
}
typedef long i64_t;
constexpr float PEER_XS = 16.0f;
__device__ __forceinline__ i64_t mk64(unsigned lo, unsigned hi) { return (i64_t)(((unsigned long long)hi << 32) | (unsigned long long)lo); }
#if PEER_F6U
constexpr float PEER_XSE = 1.0f;
__device__ __forceinline__ void peer_load_x8(const bf16_t* __restrict__ A, int r, int lane, u32x4 (&xh)[2], u32x4 (&xl)[2]) {
    const bf16_t* ap = A + (size_t)r * DM + lane * 32;
    float v[32];
#pragma unroll
    for (int q = 0; q < 4; ++q) { const u32x4 a = *(const u32x4*)(ap + 8 * q); const unsigned w[4] = {a.x, a.y, a.z, a.w};
#pragma unroll
        for (int k = 0; k < 4; ++k) { v[8 * q + 2 * k] = bflo(w[k]); v[8 * q + 2 * k + 1] = bfhi(w[k]); } }
    unsigned wh[6], wl[6]; fp6enc32(v, wh);
    { const u32x6 ph = {wh[0], wh[1], wh[2], wh[3], wh[4], wh[5]}; const f32x32 hv = __builtin_amdgcn_cvt_scalef32_pk32_f32_fp6(ph, 1.0f);
#pragma unroll
      for (int j = 0; j < 32; ++j) v[j] = (v[j] - hv[j]) * 8.f; }
    fp6enc32(v, wl);
    xh[0] = (u32x4){wh[0], wh[1], wh[2], wh[3]}; xh[1] = (u32x4){wh[4], wh[5], 0u, 0u};
    xl[0] = (u32x4){wl[0], wl[1], wl[2], wl[3]}; xl[1] = (u32x4){wl[4], wl[5], 0u, 0u};
}
#else
constexpr float PEER_XSE = PEER_XS;
__device__ __forceinline__ void peer_load_x8(const bf16_t* __restrict__ A, int r, int lane, u32x4 (&xh)[2], u32x4 (&xl)[2]) {
#pragma unroll
    for (int pc = 0; pc < 2; ++pc) { const bf16_t* ap = A + (size_t)r * DM + lane * 32 + pc * 16;
        const u32x4 a = *(const u32x4*)ap, b = *(const u32x4*)(ap + 8);
        const unsigned w[8] = {a.x, a.y, a.z, a.w, b.x, b.y, b.z, b.w};
        unsigned h[4], l[4];
#pragma unroll
        for (int q = 0; q < 4; ++q) { const float v0 = bflo(w[2 * q]) * PEER_XS, v1 = bfhi(w[2 * q]) * PEER_XS, v2 = bflo(w[2 * q + 1]) * PEER_XS, v3 = bfhi(w[2 * q + 1]) * PEER_XS;
            h[q] = fp8x4(__builtin_amdgcn_fmed3f(v0, -448.f, 448.f), __builtin_amdgcn_fmed3f(v1, -448.f, 448.f), __builtin_amdgcn_fmed3f(v2, -448.f, 448.f), __builtin_amdgcn_fmed3f(v3, -448.f, 448.f));
            const f32x2 d0 = __builtin_amdgcn_cvt_pk_f32_fp8((int)h[q], false), d1 = __builtin_amdgcn_cvt_pk_f32_fp8((int)h[q], true);
            l[q] = fp8x4(__builtin_amdgcn_fmed3f(v0 - d0.x, -448.f, 448.f), __builtin_amdgcn_fmed3f(v1 - d0.y, -448.f, 448.f), __builtin_amdgcn_fmed3f(v2 - d1.x, -448.f, 448.f), __builtin_amdgcn_fmed3f(v3 - d1.y, -448.f, 448.f)); }
        xh[pc] = (u32x4){h[0], h[1], h[2], h[3]}; xl[pc] = (u32x4){l[0], l[1], l[2], l[3]}; }
}
#endif
template <int nb4, int NLO>
__device__ __forceinline__ void peer_acc3(const unsigned char* __restrict__ U, const unsigned char* __restrict__ V, int lane, int myid, float myg, const u32x4 (&xh)[2], const u32x4 (&xl)[2], float (&f)[2][16]) {
    float actv = 0.f;
    const bool dg = (((lane & 15) >> 2) == (lane >> 4));
    const float w0 = (dg && (lane & 3) == 0) ? 1.f : 0.f, w1 = (dg && (lane & 3) == 1) ? 1.f : 0.f, w2 = (dg && (lane & 3) == 2) ? 1.f : 0.f, w3 = (dg && (lane & 3) == 3) ? 1.f : 0.f;
    const i32x8 bh = {(int)xh[0].x, (int)xh[0].y, (int)xh[0].z, (int)xh[0].w, (int)xh[1].x, (int)xh[1].y, (int)xh[1].z, (int)xh[1].w};
    const i32x8 bl = {(int)xl[0].x, (int)xl[0].y, (int)xl[0].z, (int)xl[0].w, (int)xl[1].x, (int)xl[1].y, (int)xl[1].z, (int)xl[1].w};
    int sc = 0x7F7F7F7F; asm volatile("" : "+v"(sc));
#if PEER_F6U
    int sclo = 0x7C7C7C7C; asm volatile("" : "+v"(sclo));
#endif
#pragma unroll 1
    for (int e4 = 0; e4 < nb4; ++e4) {
#if PEER_F6U
        u32x4 rawa[4]; u32x2 rawb[4];
#pragma unroll
        for (int q = 0; q < 4; ++q) { const int eid = __builtin_amdgcn_readlane(myid, e4 * 4 + q);
            const unsigned char* row = U + (size_t)eid * 1536;
            rawa[q] = *(const u32x4*)(row + lane * 16); rawb[q] = *(const u32x2*)(row + 1024 + lane * 8); }
#pragma unroll
        for (int q = 0; q < 4; ++q) { f32x4 acc = (f32x4){0.f, 0.f, 0.f, 0.f};
            const i32x8 a = {(int)rawa[q].x, (int)rawa[q].y, (int)rawa[q].z, (int)rawa[q].w, (int)rawb[q].x, (int)rawb[q].y, 0, 0};
            acc = __builtin_amdgcn_mfma_scale_f32_16x16x128_f8f6f4(a, bh, acc, 2, 2, 0, sc, 0, sc);
            if (NLO) acc = __builtin_amdgcn_mfma_scale_f32_16x16x128_f8f6f4(a, bl, acc, 2, 2, 0, sc, 0, sclo);
#else
        u32x4 raw[4][2];
#pragma unroll
        for (int q = 0; q < 4; ++q) { const int eid = __builtin_amdgcn_readlane(myid, e4 * 4 + q);
            const unsigned char* row = U + (size_t)eid * DM + lane * 32;
            raw[q][0] = *(const u32x4*)row; raw[q][1] = *(const u32x4*)(row + 16); }
#pragma unroll
        for (int q = 0; q < 4; ++q) { f32x4 acc = (f32x4){0.f, 0.f, 0.f, 0.f};
            const i32x8 a = {(int)raw[q][0].x, (int)raw[q][0].y, (int)raw[q][0].z, (int)raw[q][0].w, (int)raw[q][1].x, (int)raw[q][1].y, (int)raw[q][1].z, (int)raw[q][1].w};
            acc = __builtin_amdgcn_mfma_scale_f32_16x16x128_f8f6f4(a, bh, acc, 0, 0, 0, sc, 0, sc);
            if (NLO) acc = __builtin_amdgcn_mfma_scale_f32_16x16x128_f8f6f4(a, bl, acc, 0, 0, 0, sc, 0, sc);
#endif
            const float dv = fmaf(acc[0], w0, fmaf(acc[1], w1, fmaf(acc[2], w2, acc[3] * w3)));
            const float tot = readlane_f(dpp_sum63(dv), 63); actv = (lane == e4 * 4 + q) ? tot : actv; }
    }
    actv *= (1.0f / (PEER_XSE * PEER_USCALE));
#if PEER_F6V
    const float coef = myg * (0.5f / PEER_VSCALE6) * actv * (1.0f + erff(actv * 0.70710678118654752f));
#pragma unroll 1
    for (int e4 = 0; e4 < nb4; ++e4) {
        u32x4 rawa[4]; u32x2 rawb[4]; float cf[4];
#pragma unroll
        for (int q = 0; q < 4; ++q) { const int eid = __builtin_amdgcn_readlane(myid, e4 * 4 + q); cf[q] = readlane_f(coef, e4 * 4 + q);
            const unsigned char* row = V + (size_t)eid * 1536;
            rawa[q] = *(const u32x4*)(row + lane * 16); rawb[q] = *(const u32x2*)(row + 1024 + lane * 8); }
#pragma unroll
        for (int q = 0; q < 4; ++q) { const u32x6 pk = {rawa[q].x, rawa[q].y, rawa[q].z, rawa[q].w, rawb[q].x, rawb[q].y};
            const f32x32 vv = __builtin_amdgcn_cvt_scalef32_pk32_f32_fp6(pk, 1.0f);
#pragma unroll
            for (int pc = 0; pc < 2; ++pc)
#pragma unroll
                for (int j = 0; j < 16; ++j) f[pc][j] = fmaf(cf[q], vv[pc * 16 + j], f[pc][j]); }
    }
}
#else
    const float coef = myg * (0.5f / PEER_VSCALE) * actv * (1.0f + erff(actv * 0.70710678118654752f));
#pragma unroll 1
    for (int e4 = 0; e4 < nb4; ++e4) {
        u32x4 raw[4][2]; float cf[4];
#pragma unroll
        for (int q = 0; q < 4; ++q) { const int eid = __builtin_amdgcn_readlane(myid, e4 * 4 + q); cf[q] = readlane_f(coef, e4 * 4 + q);
            const unsigned char* row = V + (size_t)eid * DM + lane * 16;
            raw[q][0] = *(const u32x4*)row; raw[q][1] = *(const u32x4*)(row + 1024); }
#pragma unroll
        for (int q = 0; q < 4; ++q)
#pragma unroll
            for (int pc = 0; pc < 2; ++pc) { float vv[16]; cvt16(raw[q][pc], vv);
#pragma unroll
                for (int j = 0; j < 16; ++j) f[pc][j] = fmaf(cf[q], vv[j], f[pc][j]); }
    }
}
#endif
__device__ __forceinline__ void phase_peer(const Params& p, LAS unsigned char* lds, int layer, int nrows) {
    const int tid = otid(), w = tid >> 6, lane = tid & 63;
    const unsigned char* U = p.ws + OFF_PEER + (size_t)(layer * 2) * PEER_TBL; const unsigned char* V = U + PEER_TBL;
    const int* EI = (const int*)(p.ws + OFF_EXP); const float* EG = (const float*)(p.ws + OFF_EXP + (size_t)MT * 128 * 4);
    const bf16_t* A = (const bf16_t*)(p.ws + OFF_A);
    const int xg = blockIdx.x & 7, cnt8 = (((int)gridDim.x - xg + 7) >> 3) * 8;
    for (int rl = (blockIdx.x >> 3) * 8 + w; rl < TL / 8; rl += cnt8) {
        const int r = xg * (TL / 8) + rl;
        u32x4 xh[2], xl[2]; peer_load_x8(A, r, lane, xh, xl);
        float f[2][16];
#pragma unroll
        for (int pc = 0; pc < 2; ++pc)
#pragma unroll
            for (int j = 0; j < 16; ++j) f[pc][j] = 0.f;
#pragma unroll
        for (int hf = 0; hf < 2; ++hf) peer_acc3<16, 1>(U, V, lane, EI[(size_t)r * 128 + hf * 64 + lane], EG[(size_t)r * 128 + hf * 64 + lane], xh, xl, f);
        peer_finish(p, layer, r, lane, f);
    }
    if (nrows > TL) {
        LAS float* fb = (LAS float*)lds;
        for (int rc = blockIdx.x; rc < nrows - TL; rc += gridDim.x) {
            const int r = TL + rc;
            u32x4 xh[2], xl[2]; peer_load_x8(A, r, lane, xh, xl);
            float f[2][16];
#pragma unroll
            for (int pc = 0; pc < 2; ++pc)
#pragma unroll
                for (int j = 0; j < 16; ++j) f[pc][j] = 0.f;
            const int li = lane & 15;
            peer_acc3<4, 1>(U, V, lane, EI[(size_t)r * 128 + w * 16 + li], EG[(size_t)r * 128 + w * 16 + li], xh, xl, f);
            __syncthreads();
#pragma unroll
            for (int pc = 0; pc < 2; ++pc)
#pragma unroll
                for (int q = 0; q < 4; ++q) *(LAS f32x4*)(fb + w * 2048 + pc * 1024 + lane * 16 + 4 * q) = (f32x4){f[pc][4 * q], f[pc][4 * q + 1], f[pc][4 * q + 2], f[pc][4 * q + 3]};
            __syncthreads();
            if (w == 0) {
#pragma unroll
                for (int pc = 0; pc < 2; ++pc)
#pragma unroll
                    for (int j = 0; j < 16; ++j) f[pc][j] = 0.f;
#pragma unroll 1
                for (int ww = 0; ww < 8; ++ww)
#pragma unroll
                    for (int pc = 0; pc < 2; ++pc)
#pragma unroll
                        for (int q = 0; q < 4; ++q) { const f32x4 t = *(const LAS f32x4*)(fb + ww * 2048 + pc * 1024 + lane * 16 + 4 * q);
                            f[pc][4 * q] += t[0]; f[pc][4 * q + 1] += t[1]; f[pc][4 * q + 2] += t[2]; f[pc][4 * q + 3] += t[3]; }
                peer_finish(p, layer, r, lane, f);
            }
        }
        __syncthreads();
    }
}

constexpr size_t L1_OFF_OB = OFF_BIG2 + (size_t)2048 * MT * 2;
constexpr size_t L1_OFF_QS = OFF_BIG1;
constexpr size_t L1_OFF_KS = L1_OFF_QS + (size_t)TL * 1024 * 2;
constexpr size_t L1_OFF_KT = L1_OFF_KS + (size_t)MT * 1024 * 2;
static_assert(L1_OFF_KT + (size_t)MT * 1024 * 2 <= OFF_BIG1 + BIG_BYTES, "BIG1 overflow");
static_assert(L1_OFF_OB + (size_t)MT * 2048 * 2 <= OFF_BIG2 + BIG_BYTES, "BIG2 overflow");

__device__ __forceinline__ float logsig_f(float x) { return fminf(x, 0.f) - log1pf(expf(-fabsf(x))); }
__device__ __forceinline__ int chunk_row0(int cidx) { return cidx < 256 ? cidx * 64 : TL + (cidx - 256) * 64; }
__device__ __forceinline__ int chunk_of(int sc, int dir, int i) { return sc == 0 ? (dir ? 259 - i : 256 + i) : (dir ? 255 - (sc - 1) * 16 - i : (sc - 1) * 16 + i); }

__device__ __forceinline__ void unpack8(const u32x4 w, float (&o)[8]) { o[0] = bflo(w.x); o[1] = bfhi(w.x); o[2] = bflo(w.y); o[3] = bfhi(w.y); o[4] = bflo(w.z); o[5] = bfhi(w.z); o[6] = bflo(w.w); o[7] = bfhi(w.w); }
__device__ __forceinline__ void l1_qk_task(const Params& p, LAS unsigned char* lds, int task) {
    const int tid = otid();
    int tile, isk, hq, nh, h0;
    if (task < 32) { tile = 256 + (task >> 3); isk = 1; h0 = task & 7; nh = 1; hq = h0 >> 2; } else { const int t = task - 32; tile = t >> 2; isk = (t >> 1) & 1; hq = t & 1; h0 = hq * 4; nh = 4; }
    const bool lat = tile < 256;
    const int r0 = lat ? tile * 64 : TL + (tile - 256) * 64;
    const int sq0 = lat ? 0 : TL, sq1 = lat ? TL : MT;
    const bf16_t* QKp = (const bf16_t*)(p.ws + OFF_QK);
    bf16_t* QS = (bf16_t*)(p.ws + L1_OFF_QS); bf16_t* KS = (bf16_t*)(p.ws + L1_OFF_KS); bf16_t* KT = (bf16_t*)(p.ws + L1_OFF_KT);
    const float* cw = p.in[I_MLCW]; const float* cb = p.in[I_MLCB];
    const f32x2* rope = (const f32x2*)(p.ws + OFF_ROPE);
    LAS unsigned short* tl_ = (LAS unsigned short*)lds;
    LAS float* wl = (LAS float*)(lds + 4 * 128 * 66 * 2);
    { const int c = tid, col = isk * 1024 + hq * 512 + c;
#pragma unroll
      for (int j = 0; j < 4; ++j) wl[j * 512 + c] = j < 3 ? cw[j * 2048 + col] : cb[col]; }
    __syncthreads();
    const int tl = tid >> 3, pc = tid & 7, half = pc >> 2, cc = pc & 3;
    const int d1 = half * 64 + cc * 8, d2 = d1 + 32;
    const int r = r0 + tl;
    const int pos = half == 0 ? (r >> 6) : (r & 63);
    f32x2 csn[8];
#pragma unroll
    for (int j = 0; j < 8; ++j) csn[j] = lat ? rope[pos * 32 + cc * 8 + j] : (f32x2){1.f, 0.f};
    const u32x4 z4 = (u32x4){0u, 0u, 0u, 0u};
#pragma unroll 1
    for (int hh = h0 - hq * 4; hh < h0 - hq * 4 + nh; ++hh) {
        const int h = hq * 4 + hh;
        const bf16_t* x0 = QKp + (size_t)r * 2048 + isk * 1024 + h * 128;
        const u32x4 a0 = *(const u32x4*)(x0 + d1), b0 = *(const u32x4*)(x0 + d2);
        const u32x4 am = r > sq0 ? *(const u32x4*)(x0 + d1 - 2048) : z4, bm = r > sq0 ? *(const u32x4*)(x0 + d2 - 2048) : z4;
        const u32x4 ap = r + 1 < sq1 ? *(const u32x4*)(x0 + d1 + 2048) : z4, bp = r + 1 < sq1 ? *(const u32x4*)(x0 + d2 + 2048) : z4;
        float A0[8], B0[8], AM[8], BM[8], AP[8], BP[8];
        unpack8(a0, A0); unpack8(b0, B0); unpack8(am, AM); unpack8(bm, BM); unpack8(ap, AP); unpack8(bp, BP);
        float o1[8], o2[8];
        const int w1 = hh * 128 + d1, w2 = hh * 128 + d2;
#pragma unroll
        for (int j = 0; j < 8; ++j) {
            const float y1 = silu_f(wl[1536 + w1 + j] + wl[w1 + j] * AM[j] + wl[512 + w1 + j] * A0[j] + wl[1024 + w1 + j] * AP[j]);
            const float y2 = silu_f(wl[1536 + w2 + j] + wl[w2 + j] * BM[j] + wl[512 + w2 + j] * B0[j] + wl[1024 + w2 + j] * BP[j]);
            float q1 = y1 * csn[j].x - y2 * csn[j].y, q2 = y1 * csn[j].y + y2 * csn[j].x;
            if (isk) { q1 *= 0.08838834764831845f; q2 *= 0.08838834764831845f; }
            o1[j] = q1; o2[j] = q2;
        }
        const u32x4 v1 = (u32x4){pk_bf16(o1[0], o1[1]), pk_bf16(o1[2], o1[3]), pk_bf16(o1[4], o1[5]), pk_bf16(o1[6], o1[7])};
        const u32x4 v2 = (u32x4){pk_bf16(o2[0], o2[1]), pk_bf16(o2[2], o2[3]), pk_bf16(o2[4], o2[5]), pk_bf16(o2[6], o2[7])};
        if (isk) {
            bf16_t* dst = KS + (size_t)r * 1024 + h * 128;
            *(u32x4*)(dst + d1) = v1; *(u32x4*)(dst + d2) = v2;
            LAS unsigned short* th = tl_ + hh * 128 * 66;
            const unsigned u1[4] = {v1.x, v1.y, v1.z, v1.w}, u2[4] = {v2.x, v2.y, v2.z, v2.w};
#pragma unroll
            for (int j = 0; j < 4; ++j) { th[(d1 + 2 * j) * 66 + tl] = (unsigned short)(u1[j] & 0xFFFFu); th[(d1 + 2 * j + 1) * 66 + tl] = (unsigned short)(u1[j] >> 16);
                                          th[(d2 + 2 * j) * 66 + tl] = (unsigned short)(u2[j] & 0xFFFFu); th[(d2 + 2 * j + 1) * 66 + tl] = (unsigned short)(u2[j] >> 16); }
        } else {
            bf16_t* dst = QS + (size_t)r * 1024 + h * 128;
            *(u32x4*)(dst + d1) = v1; *(u32x4*)(dst + d2) = v2;
        }
    }
    if (isk) {
        __syncthreads();
#pragma unroll 4
        for (int it = (h0 - hq * 4) * 8; it < (h0 - hq * 4 + nh) * 8; ++it) { const int i = tid + 512 * it, d = i >> 5, tp = i & 31;
            const unsigned lo = tl_[d * 66 + 2 * tp], hi = tl_[d * 66 + 2 * tp + 1];
            *(unsigned*)(KT + (size_t)(hq * 512 + d) * MT + r0 + 2 * tp) = lo | (hi << 16); }
    }
    __syncthreads();
}
__device__ __forceinline__ void l1_gate_items(const Params& p) {
    const int tid = otid(), wv = tid >> 6, lane = tid & 63;
    const float* G = (const float*)(p.ws + OFF_GATE); const float* bg = p.in[I_MLBG];
    float* GA = (float*)(p.ws + OFF_GX); float* GC = GA + GX_STRIDE; float* GW = GC + GX_STRIDE; float* DEC = GW + GX_STRIDE;
    for (int item = blockIdx.x * 8 + wv; item < 260 * 16; item += gridDim.x * 8) {
        const int cidx = item >> 4, hd = item & 15, h = hd >> 1, dir = hd & 1;
        const int r = chunk_row0(cidx) + lane;
        const int ci = (dir ? 2 : 0) * 8 + h, cf = (dir ? 3 : 1) * 8 + h;
        const float lf = logsig_f(G[(size_t)r * 32 + cf] + bg[cf]), li = G[(size_t)r * 32 + ci] + bg[ci];
        float b = lf;
        if (dir == 0) {
#pragma unroll
            for (int o = 1; o < 64; o <<= 1) { const float t = __shfl_up(b, o); if (lane >= o) b += t; }
        } else {
#pragma unroll
            for (int o = 1; o < 64; o <<= 1) { const float t = __shfl_down(b, o); if (lane + o < 64) b += t; }
        }
        const float bend = __shfl(b, dir ? 0 : 63);
        const size_t gb = (size_t)(dir * 8 + h) * MT;
        GA[gb + r] = expf(b); GC[gb + r] = expf(li - b); GW[gb + r] = expf(bend - b + li);
        if (lane == 0) DEC[(dir * 8 + h) * 260 + cidx] = expf(bend);
    }
}
__device__ __forceinline__ void phase_l1_prep(const Params& p, LAS unsigned char* lds) {
    l1_gate_items(p);
    for (int task = blockIdx.x; task < 32 + 1024; task += gridDim.x) l1_qk_task(p, lds, task);
}

__device__ __forceinline__ void phase_l1_passB(const Params& p) {
    const float* DEC = (const float*)(p.ws + OFF_GX) + 3 * GX_STRIDE;
    float* CST = (float*)(p.ws + OFF_HYT); float* NST = (float*)(p.ws + OFF_NST);
    const int NE = 16 * 32768 + 16 * 128;
    for (int g = blockIdx.x * 512 + otid(); g < NE; g += gridDim.x * 512) {
        const bool isn = g >= 16 * 32768;
        const int hd = isn ? (g - 16 * 32768) >> 7 : g >> 15, idx = isn ? (g - 16 * 32768) & 127 : g & 32767;
        const int h = hd >> 1, dir = hd & 1;
        float cin = 0.f;
        for (int sc = 0; sc < 17; ++sc) {
            float dsc = 1.f; const int nc = sc == 0 ? 4 : 16;
            for (int c = 0; c < nc; ++c) dsc *= DEC[(dir * 8 + h) * 260 + chunk_of(sc, dir, c)];
            float* ptr = isn ? NST + (size_t)(sc * 16 + hd) * 128 + idx : CST + (size_t)(sc * 16 + hd) * 32768 + idx;
            const float loc = sc < 16 ? *ptr : 0.f; *ptr = cin; cin = dsc * cin + loc;
        }
    }
}
constexpr int PC_QS = 0;
constexpr int PC_KS = 16896;
constexpr int PC_KT = 33792;
constexpr int PC_VS = 52224;
constexpr int PC_OS = 89088;
constexpr int PC_WT = 130048;
constexpr int PC_NL = 130816;
__device__ __forceinline__ bf16x8 pack8(const f32x16& v, int o) {
    u32x4 w; w.x = pk_bf16(v[o], v[o + 1]); w.y = pk_bf16(v[o + 2], v[o + 3]); w.z = pk_bf16(v[o + 4], v[o + 5]); w.w = pk_bf16(v[o + 6], v[o + 7]);
    return __builtin_bit_cast(bf16x8, w);
}
struct PcStage { u32x4 q0, q1, k0, k1, t0, t1, v0, v1, v2, v3; float wt; };
__device__ __forceinline__ bf16x8 lds_frag2(LAS unsigned char* base, int byteoff) {
    const u32x2 a = *(const LAS u32x2*)(base + byteoff), b = *(const LAS u32x2*)(base + byteoff + 16);
    const u32x4 w = (u32x4){a.x, a.y, b.x, b.y}; return __builtin_bit_cast(bf16x8, w);
}
__device__ __forceinline__ void phase_l1_passC(const Params& p, LAS unsigned char* lds) {
    const int tid = otid(), wv = __builtin_amdgcn_readfirstlane(tid >> 6), lane = tid & 63, l31 = lane & 31, hh = lane >> 5;
    const bf16_t* QS = (const bf16_t*)(p.ws + L1_OFF_QS); const bf16_t* KS = (const bf16_t*)(p.ws + L1_OFF_KS); const bf16_t* KT = (const bf16_t*)(p.ws + L1_OFF_KT);
    const bf16_t* VT = (const bf16_t*)(p.ws + OFF_BIG2);
    const unsigned so_q = (unsigned)((tid >> 3) * 1024 + (tid & 7) * 8), so_t = (unsigned)((tid >> 2) * MT + (tid & 3) * 8), so_v = (unsigned)((lane >> 1) * MT + (lane & 1) * 32), so_w = (unsigned)((tid >> 6) * (int)GX_STRIDE + (tid & 63));
    const float* GX = (const float*)(p.ws + OFF_GX); const float* DEC = GX + 3 * GX_STRIDE;
    const float* CST = (const float*)(p.ws + OFF_HYT); const float* NST = (const float*)(p.ws + OFF_NST);
    bf16_t* HF = (bf16_t*)(p.ws + OFF_A); bf16_t* HB = (bf16_t*)(p.ws + OFF_X);
    const u32x4 ones_u = (u32x4){0x3F803F80u, 0x3F803F80u, 0x3F803F80u, 0x3F803F80u};
    const bf16x8 ones = __builtin_bit_cast(bf16x8, ones_u);
    LAS float* WT = (LAS float*)(lds + PC_WT);
    LAS unsigned char* VSw = lds + PC_VS + wv * 4608;
    LAS unsigned char* OSw = lds + PC_OS + wv * 5120;
    for (int task = blockIdx.x; task < 16 * 16; task += gridDim.x) {
        const int hd = task & 15, sc = 1 + (task >> 4), h = hd >> 1, dir = hd & 1, w = wv;
        const size_t gb = (size_t)(dir * 8 + h) * MT;
        bf16_t* HO = dir ? HB : HF;
        f32x16 X[4];
        { const float* src = CST + (size_t)((sc * 16 + hd) * 8 + w) * 4096;
#pragma unroll
          for (int i = 0; i < 4; ++i)
#pragma unroll
              for (int q = 0; q < 16; ++q) X[i][q] = src[(i * 16 + q) * 64 + lane]; }
        LAS float* nlc = (LAS float*)(lds + PC_NL); LAS float* nln = nlc + 128;
        if (tid < 128) nlc[tid] = NST[(size_t)(sc * 16 + hd) * 128 + tid];
        PcStage sg;
#define PC_LOAD(cidx_) do { const int rw_ = (cidx_) * 64; \
            const bf16_t* qb_ = QS + (size_t)rw_ * 1024 + h * 128; sg.q0 = *(const u32x4*)(qb_ + so_q); sg.q1 = *(const u32x4*)(qb_ + so_q + 64u); \
            const bf16_t* kb_ = KS + (size_t)rw_ * 1024 + h * 128; sg.k0 = *(const u32x4*)(kb_ + so_q); sg.k1 = *(const u32x4*)(kb_ + so_q + 64u); \
            const bf16_t* tb_ = KT + (size_t)(h * 128) * MT + rw_; sg.t0 = *(const u32x4*)(tb_ + so_t); sg.t1 = *(const u32x4*)(tb_ + so_t + 32u); \
            const bf16_t* vb2_ = VT + (size_t)(h * 256 + 32 * w) * MT + rw_; sg.v0 = *(const u32x4*)(vb2_ + so_v); sg.v1 = *(const u32x4*)(vb2_ + so_v + 8u); sg.v2 = *(const u32x4*)(vb2_ + so_v + 16u); sg.v3 = *(const u32x4*)(vb2_ + so_v + 24u); \
            sg.wt = tid < 192 ? (GX + gb + rw_)[so_w] : 0.f; } while (0)
#define PC_ST64(base_, off_, v_) do { *(LAS u32x2*)((base_) + (off_)) = (u32x2){(v_).x, (v_).y}; *(LAS u32x2*)((base_) + (off_) + 8) = (u32x2){(v_).z, (v_).w}; } while (0)
#define PC_STORE() do { \
            PC_ST64(lds + PC_QS, (tid >> 3) * 264 + (tid & 7) * 16, sg.q0); PC_ST64(lds + PC_QS, (tid >> 3) * 264 + (tid & 7) * 16 + 128, sg.q1); \
            PC_ST64(lds + PC_KS, (tid >> 3) * 264 + (tid & 7) * 16, sg.k0); PC_ST64(lds + PC_KS, (tid >> 3) * 264 + (tid & 7) * 16 + 128, sg.k1); \
            *(LAS u32x4*)(lds + PC_KT + (tid >> 2) * 144 + (tid & 3) * 16) = sg.t0; *(LAS u32x4*)(lds + PC_KT + (tid >> 2) * 144 + (tid & 3) * 16 + 64) = sg.t1; \
            { LAS unsigned char* vb_ = VSw + (lane >> 1) * 144 + (lane & 1) * 64; *(LAS u32x4*)vb_ = sg.v0; *(LAS u32x4*)(vb_ + 16) = sg.v1; *(LAS u32x4*)(vb_ + 32) = sg.v2; *(LAS u32x4*)(vb_ + 48) = sg.v3; } \
            if (tid < 192) WT[tid] = sg.wt; } while (0)
        __syncthreads();
        PC_LOAD(chunk_of(sc, dir, 0)); PC_STORE();
        __syncthreads();
#pragma unroll 1
        for (int c = 0; c < 16; ++c) {
            const int cidx = chunk_of(sc, dir, c), rw0 = cidx * 64;
#pragma unroll 1
            for (int tt = 0; tt < 2; ++tt) {
                const int qoff = PC_QS + (32 * tt + l31) * 264 + 8 * hh;
                f32x16 num, den;
#pragma unroll
                for (int q = 0; q < 16; ++q) { num[q] = 0.f; den[q] = 0.f; }
#pragma unroll
                for (int st = 0; st < 2; ++st) {
                    f32x16 S;
#pragma unroll
                    for (int q = 0; q < 16; ++q) S[q] = 0.f;
#pragma unroll
                    for (int ks = 0; ks < 8; ++ks) { const bf16x8 qf = lds_frag2(lds, qoff + 32 * ks); const bf16x8 kf = lds_frag2(lds, PC_KS + (32 * st + l31) * 264 + 8 * hh + 32 * ks);
                        S = __builtin_amdgcn_mfma_f32_32x32x16_bf16(kf, qf, S, 0, 0, 0); }
                    const int t = 32 * tt + l31;
#pragma unroll
                    for (int g = 0; g < 4; ++g) { const f32x4 c4 = *(const LAS f32x4*)(WT + 64 + 32 * st + 8 * g + 4 * hh);
#pragma unroll
                        for (int q = 0; q < 4; ++q) { const int s_ = 32 * st + 8 * g + 4 * hh + q; const bool ok = dir ? (s_ >= t) : (s_ <= t);
                            S[4 * g + q] = ok ? S[4 * g + q] * c4[q] : 0.f; } }
#pragma unroll
                    for (int kk = 0; kk < 2; ++kk) {
                        const bf16x8 xf = pack8(S, 8 * kk);
                        const bf16x8 vf = lds_frag2(VSw, l31 * 144 + (32 * st + 16 * kk + 4 * hh) * 2);
                        num = __builtin_amdgcn_mfma_f32_32x32x16_bf16(xf, vf, num, 0, 0, 0);
                        den = __builtin_amdgcn_mfma_f32_32x32x16_bf16(xf, ones, den, 0, 0, 0);
                    }
                }
#pragma unroll
                for (int i = 0; i < 4; ++i)
#pragma unroll
                    for (int s2 = 0; s2 < 2; ++s2) {
                        const bf16x8 bx = pack8(X[i], 8 * s2);
                        const bf16x8 qf = lds_frag2(lds, qoff + 32 * (2 * i + s2));
                        num = __builtin_amdgcn_mfma_f32_32x32x16_bf16(qf, bx, num, 0, 0, 0);
                        const f32x4 na = *(const LAS f32x4*)(nlc + 32 * i + 16 * s2 + 4 * hh), nb = *(const LAS f32x4*)(nlc + 32 * i + 16 * s2 + 8 + 4 * hh);
                        u32x4 nw; nw.x = pk_bf16(na[0], na[1]); nw.y = pk_bf16(na[2], na[3]); nw.z = pk_bf16(nb[0], nb[1]); nw.w = pk_bf16(nb[2], nb[3]);
                        den = __builtin_amdgcn_mfma_f32_32x32x16_bf16(qf, __builtin_bit_cast(bf16x8, nw), den, 0, 0, 0);
                    }
#pragma unroll
                for (int g = 0; g < 4; ++g) { const f32x4 a4 = *(const LAS f32x4*)(WT + 32 * tt + 8 * g + 4 * hh);
#pragma unroll
                    for (int q = 0; q < 4; ++q) { const float a = a4[q]; const float hv = a * num[4 * g + q] / fmaxf(fabsf(a * den[4 * g + q]), 1.0f);
                        *(LAS unsigned short*)(OSw + (32 * tt + 8 * g + 4 * hh + q) * 80 + l31 * 2) = f2bf(hv); } }
            }
#pragma unroll
            for (int it = 0; it < 4; ++it) { const int tok = it * 16 + (lane >> 2), sgm = lane & 3;
                const u32x4 ov = *(const LAS u32x4*)(OSw + tok * 80 + sgm * 16);
                *(u32x4*)((HO + (size_t)rw0 * 2048 + h * 256 + 32 * w) + (unsigned)(tok * 2048 + sgm * 8)) = ov; }
            const float dec = DEC[(dir * 8 + h) * 260 + cidx];
#pragma unroll
            for (int i = 0; i < 4; ++i) X[i] *= dec;
#pragma unroll
            for (int ks = 0; ks < 4; ++ks) {
                const u32x4 vr = *(const LAS u32x4*)(VSw + l31 * 144 + 32 * ks + 16 * hh);
                const f32x4 wa = *(const LAS f32x4*)(WT + 128 + 16 * ks + 8 * hh), wb = *(const LAS f32x4*)(WT + 128 + 16 * ks + 8 * hh + 4);
                u32x4 vs; vs.x = pk_bf16(bflo(vr.x) * wa[0], bfhi(vr.x) * wa[1]); vs.y = pk_bf16(bflo(vr.y) * wa[2], bfhi(vr.y) * wa[3]);
                vs.z = pk_bf16(bflo(vr.z) * wb[0], bfhi(vr.z) * wb[1]); vs.w = pk_bf16(bflo(vr.w) * wb[2], bfhi(vr.w) * wb[3]);
                const bf16x8 bfr = __builtin_bit_cast(bf16x8, vs);
#pragma unroll
                for (int i = 0; i < 4; ++i) { const u32x4 ar = *(const LAS u32x4*)(lds + PC_KT + (32 * i + l31) * 144 + 32 * ks + 16 * hh);
                    X[i] = __builtin_amdgcn_mfma_f32_32x32x16_bf16(__builtin_bit_cast(bf16x8, ar), bfr, X[i], 0, 0, 0); }
            }
            if (tid < 128) { float a = 0.f;
#pragma unroll
                for (int q = 0; q < 8; ++q) { const u32x4 kr = *(const LAS u32x4*)(lds + PC_KT + tid * 144 + 16 * q);
                    const f32x4 wa = *(const LAS f32x4*)(WT + 128 + 8 * q), wb = *(const LAS f32x4*)(WT + 128 + 8 * q + 4);
                    a = fmaf(wa[0], bflo(kr.x), a); a = fmaf(wa[1], bfhi(kr.x), a); a = fmaf(wa[2], bflo(kr.y), a); a = fmaf(wa[3], bfhi(kr.y), a);
                    a = fmaf(wb[0], bflo(kr.z), a); a = fmaf(wb[1], bfhi(kr.z), a); a = fmaf(wb[2], bflo(kr.w), a); a = fmaf(wb[3], bfhi(kr.w), a); }
                nln[tid] = dec * nlc[tid] + a; }
            __syncthreads();
            if (c + 1 < 16) { PC_LOAD(chunk_of(sc, dir, c + 1)); PC_STORE(); }
            { LAS float* t_ = nlc; nlc = nln; nln = t_; }
            __syncthreads();
        }
#undef PC_LOAD
#undef PC_ST64
#undef PC_STORE
    }
}
__device__ __forceinline__ void phase_l1_passA2(const Params& p, LAS unsigned char* lds) {
    const int tid = otid(), wv = __builtin_amdgcn_readfirstlane(tid >> 6), lane = tid & 63, l31 = lane & 31, hh = lane >> 5;
    const bf16_t* KT = (const bf16_t*)(p.ws + L1_OFF_KT); const bf16_t* VT = (const bf16_t*)(p.ws + OFF_BIG2);
    const float* GX = (const float*)(p.ws + OFF_GX); const float* DEC = GX + 3 * GX_STRIDE;
    float* CST = (float*)(p.ws + OFF_HYT); float* NST = (float*)(p.ws + OFF_NST);
    const unsigned so_t = (unsigned)((tid >> 2) * MT + (tid & 3) * 8), so_v = (unsigned)((lane >> 1) * MT + (lane & 1) * 32);
    LAS float* WT = (LAS float*)(lds + PC_WT);
    LAS unsigned char* VSw = lds + PC_VS + wv * 4608;
    for (int task = blockIdx.x; task < 16 * 16; task += gridDim.x) {
        const int hd = task & 15, sc = task >> 4, h = hd >> 1, dir = hd & 1, w = wv;
        const size_t gb = (size_t)(dir * 8 + h) * MT;
        f32x16 X[4];
#pragma unroll
        for (int i = 0; i < 4; ++i)
#pragma unroll
            for (int q = 0; q < 16; ++q) X[i][q] = 0.f;
        float nacc = 0.f;
        const int nc = sc == 0 ? 4 : 16;
#pragma unroll 1
        for (int c = 0; c < nc; ++c) {
            const int cidx = chunk_of(sc, dir, c), rw0 = chunk_row0(cidx);
            __syncthreads();
            { const bf16_t* tb_ = KT + (size_t)(h * 128) * MT + rw0; const u32x4 t0 = *(const u32x4*)(tb_ + so_t), t1 = *(const u32x4*)(tb_ + so_t + 32u);
              const bf16_t* vb_ = VT + (size_t)(h * 256 + 32 * w) * MT + rw0; const u32x4 v0 = *(const u32x4*)(vb_ + so_v), v1 = *(const u32x4*)(vb_ + so_v + 8u), v2 = *(const u32x4*)(vb_ + so_v + 16u), v3 = *(const u32x4*)(vb_ + so_v + 24u);
              const float wt = tid < 64 ? (GX + 2 * GX_STRIDE + gb + rw0)[tid] : 0.f;
              *(LAS u32x4*)(lds + PC_KT + (tid >> 2) * 144 + (tid & 3) * 16) = t0; *(LAS u32x4*)(lds + PC_KT + (tid >> 2) * 144 + (tid & 3) * 16 + 64) = t1;
              LAS unsigned char* vb2 = VSw + (lane >> 1) * 144 + (lane & 1) * 64; *(LAS u32x4*)vb2 = v0; *(LAS u32x4*)(vb2 + 16) = v1; *(LAS u32x4*)(vb2 + 32) = v2; *(LAS u32x4*)(vb2 + 48) = v3;
              if (tid < 64) WT[128 + tid] = wt; }
            __syncthreads();
            const float dec = DEC[(dir * 8 + h) * 260 + cidx];
#pragma unroll
            for (int i = 0; i < 4; ++i) X[i] *= dec;
#pragma unroll
            for (int ks = 0; ks < 4; ++ks) {
                const u32x4 vr = *(const LAS u32x4*)(VSw + l31 * 144 + 32 * ks + 16 * hh);
                const f32x4 wa = *(const LAS f32x4*)(WT + 128 + 16 * ks + 8 * hh), wb = *(const LAS f32x4*)(WT + 128 + 16 * ks + 8 * hh + 4);
                u32x4 vs; vs.x = pk_bf16(bflo(vr.x) * wa[0], bfhi(vr.x) * wa[1]); vs.y = pk_bf16(bflo(vr.y) * wa[2], bfhi(vr.y) * wa[3]);
                vs.z = pk_bf16(bflo(vr.z) * wb[0], bfhi(vr.z) * wb[1]); vs.w = pk_bf16(bflo(vr.w) * wb[2], bfhi(vr.w) * wb[3]);
                const bf16x8 bfr = __builtin_bit_cast(bf16x8, vs);
#pragma unroll
                for (int i = 0; i < 4; ++i) { const u32x4 ar = *(const LAS u32x4*)(lds + PC_KT + (32 * i + l31) * 144 + 32 * ks + 16 * hh);
                    X[i] = __builtin_amdgcn_mfma_f32_32x32x16_bf16(__builtin_bit_cast(bf16x8, ar), bfr, X[i], 0, 0, 0); }
            }
            if (tid < 128) { float a = 0.f;
#pragma unroll
                for (int q = 0; q < 8; ++q) { const u32x4 kr = *(const LAS u32x4*)(lds + PC_KT + tid * 144 + 16 * q);
                    const f32x4 wa = *(const LAS f32x4*)(WT + 128 + 8 * q), wb = *(const LAS f32x4*)(WT + 128 + 8 * q + 4);
                    a = fmaf(wa[0], bflo(kr.x), a); a = fmaf(wa[1], bfhi(kr.x), a); a = fmaf(wa[2], bflo(kr.y), a); a = fmaf(wa[3], bfhi(kr.y), a);
                    a = fmaf(wb[0], bflo(kr.z), a); a = fmaf(wb[1], bfhi(kr.z), a); a = fmaf(wb[2], bflo(kr.w), a); a = fmaf(wb[3], bfhi(kr.w), a); }
                nacc = dec * nacc + a; }
        }
        float* dst = CST + (size_t)((sc * 16 + hd) * 8 + w) * 4096;
#pragma unroll
        for (int i = 0; i < 4; ++i)
#pragma unroll
            for (int q = 0; q < 16; ++q) dst[(i * 16 + q) * 64 + lane] = X[i][q];
        if (tid < 128) NST[(size_t)(sc * 16 + hd) * 128 + tid] = nacc;
    }
    __syncthreads();
}
__device__ __forceinline__ void phase_l1_merge(const Params& p) {
    const int tid = otid(), wv = tid >> 6, lane = tid & 63;
    const bf16_t* HF = (const bf16_t*)(p.ws + OFF_A); const bf16_t* HB = (const bf16_t*)(p.ws + OFF_X); const bf16_t* Ob = (const bf16_t*)(p.ws + L1_OFF_OB);
    bf16_t* OUT = (bf16_t*)(p.ws + OFF_QK);
    const float* nw = p.in[I_MLNW];
    for (int t = blockIdx.x * 8 + wv; t < TL; t += gridDim.x * 8) {
#pragma unroll
        for (int pc = 0; pc < 4; ++pc) { const int e = pc * 512 + lane * 8;
            const u32x4 a = *(const u32x4*)(HF + (size_t)t * 2048 + e), b = *(const u32x4*)(HB + (size_t)t * 2048 + e), o = *(const u32x4*)(Ob + (size_t)t * 2048 + e);
            float hv[8] = {bflo(a.x) + bflo(b.x), bfhi(a.x) + bfhi(b.x), bflo(a.y) + bflo(b.y), bfhi(a.y) + bfhi(b.y), bflo(a.z) + bflo(b.z), bfhi(a.z) + bfhi(b.z), bflo(a.w) + bflo(b.w), bfhi(a.w) + bfhi(b.w)};
            const float ov[8] = {bflo(o.x), bfhi(o.x), bflo(o.y), bfhi(o.y), bflo(o.z), bfhi(o.z), bflo(o.w), bfhi(o.w)};
            float s = 0.f;
#pragma unroll
            for (int j = 0; j < 8; ++j) s += hv[j];
#pragma unroll
            for (int of = 16; of > 0; of >>= 1) s += __shfl_xor(s, of);
            const float mu = s * (1.0f / 256.0f);
            float q = 0.f;
#pragma unroll
            for (int j = 0; j < 8; ++j) { const float d = hv[j] - mu; q += d * d; }
#pragma unroll
            for (int of = 16; of > 0; of >>= 1) q += __shfl_xor(q, of);
            const float rs = rsqrtf(q * (1.0f / 256.0f) + LN_EPS);
            float wn[8], r8[8]; ld8(nw + e, wn);
#pragma unroll
            for (int j = 0; j < 8; ++j) { const float hn = bf2f(f2bf((hv[j] - mu) * rs * wn[j])); r8[j] = hn * sigmoid_f(ov[j]); }
#if F8_L1O
            *(u32x2*)((unsigned char*)OUT + (size_t)t * 2048 + e) = (u32x2){fp8x4(clamp8(r8[0] * G8_XS), clamp8(r8[1] * G8_XS), clamp8(r8[2] * G8_XS), clamp8(r8[3] * G8_XS)), fp8x4(clamp8(r8[4] * G8_XS), clamp8(r8[5] * G8_XS), clamp8(r8[6] * G8_XS), clamp8(r8[7] * G8_XS))}; }
#else
            st8bf(OUT + (size_t)t * 2048 + e, r8); }
#endif
    }
}
__global__ void __launch_bounds__(NTHREADS, 2) hybrid_fwd_megakernel(Params p) {
    extern __shared__ __attribute__((aligned(16))) unsigned char smem_raw[];
    LAS unsigned char* lds = (LAS unsigned char*)smem_raw;
    volatile LAS unsigned* bst = (volatile LAS unsigned*)(lds + LDS_BYTES - 16);
    if (threadIdx.x < 4) bst[threadIdx.x] = 0u;
    __syncthreads();
    XcdBarrier bar = xcd_barrier_post((unsigned*)(p.ws + OFF_BAR), bst);
#define ws (get_ws())
#define Abuf ((bf16_t*)(ws + OFF_A))
    phase0(fresh(p), lds, P0_T0, P0_T2);
    phase0(fresh(p), lds, P0_T4, P0_T5);
    phase0(fresh(p), lds, P0_T5, P0_T6);
    phase0(fresh(p), lds, P0_T6, P0_T7);
    phase0(fresh(p), lds, P0_T7, P0_NT);
    xcd_barrier(bar);
    modulate_rows(p.in[I_X], p.in[I_CTX], (const float*)(ws + OFF_MOD), Abuf, ws + OFF_X);
    hyena_taps(fresh(p));
    xcd_barrier(bar);
    {
        unsigned char* w_ = ws;
#if F8_L0NA
        {
            pg8::Sched2<pg8::EpiBf16, 2> S{(const char*)(w_ + OFF_W0T), (const char*)(w_ + OFF_A), 12, 65, nullptr, nullptr, 0, 0, (int)gridDim.x, (int)blockIdx.x};
            pg8::EpiS2<pg8::EpiBf16> E{pg8::EpiBf16{(bf16_t*)(w_ + OFF_BIG2), MT}, pg8::EpiBf16{(bf16_t*)(w_ + OFF_QK), 2048}};
            pg8::gemm_stream<pg8::EpiS2<pg8::EpiBf16>, pg8::Sched2<pg8::EpiBf16, 2>, false>(lds, 2048, S, E); __syncthreads(); }
        {
            const char* w8 = (const char*)(w_ + OFF_W0T + (size_t)3072 * 4096); const char* u8 = (const char*)(w_ + OFF_X);
            pg8::Sched2<pg8::EpiBf16, 1> S{w8, u8, 4, 65, u8, w8 + (size_t)1024 * 2048, 65, 8, (int)gridDim.x, (int)gridDim.x - 1 - (int)blockIdx.x};
            pg8::EpiS2<pg8::EpiBf16> E{pg8::EpiBf16{(bf16_t*)(w_ + OFF_BIG2) + (size_t)3072 * MT, MT}, pg8::EpiBf16{(bf16_t*)(w_ + OFF_QK), 2048}};
            pg8::gemm_stream<pg8::EpiS2<pg8::EpiBf16>, pg8::Sched2<pg8::EpiBf16, 1>, true>(lds, 2048, S, E); __syncthreads(); }
#else
        constexpr int ES = F8_L0 ? 1 : 2;
        pg8::Sched2<pg8::EpiBf16, ES> S{(const char*)(w_ + OFF_W0T), (const char*)(w_ + OFF_A), 16, 65, (const char*)(w_ + OFF_A), (const char*)(w_ + OFF_W0T) + (size_t)4096 * 2048 * ES, 65, 8, (int)gridDim.x, (int)blockIdx.x};
        pg8::EpiS2<pg8::EpiBf16> E{pg8::EpiBf16{(bf16_t*)(w_ + OFF_BIG2), MT}, pg8::EpiBf16{(bf16_t*)(w_ + OFF_QK), 2048}};
        pg8::gemm_stream<pg8::EpiS2<pg8::EpiBf16>, pg8::Sched2<pg8::EpiBf16, ES>, ES == 1>(lds, 2048, S, E); __syncthreads();
#endif
    }
    xcd_barrier(bar);
    phase3(fresh(p), lds);
    xcd_barrier(bar);
    phase4(fresh(p), lds);
    xcd_barrier(bar);
    {
        unsigned char* w_ = ws;
        pg8::SchedTail S{(const char*)(w_ + OFF_A), (const char*)(w_ + OFF_WO0T), 64, 8, true, (int)gridDim.x, (int)blockIdx.x};
        pg8::EpiTail<true, pg8::EpiBf16> E{pg8::EpiBf16{(bf16_t*)(w_ + OFF_BIG2), 2048}, (float*)(w_ + OFF_X)};
        pg8::gemm_stream(lds, 2048, S, E); __syncthreads();
    }
    phase0(fresh(p), lds, P0_T2, P0_T4, 8);
    xcd_barrier(bar);
    phase_ln1(fresh(p), 0, MT, (const float*)(ws + OFF_X));
    xcd_barrier(bar);
    {
        unsigned char* w_ = ws;
        pg8::SchedTail S{(const char*)(w_ + OFF_WQK), (const char*)(w_ + OFF_A), 8, 64, false, (int)gridDim.x, (int)blockIdx.x};
        pg8::EpiTail<false, pg8::EpiF32> E{pg8::EpiF32{(float*)(w_ + OFF_BIG1), MT}, (float*)(w_ + OFF_X)};
        pg8::gemm_stream(lds, 2048, S, E); __syncthreads();
    }
    xcd_barrier(bar);
    phase_topk(fresh(p), lds, MT, (const float*)(ws + OFF_X));
    xcd_barrier(bar);
    phase_peer(fresh(p), lds, 0, MT);
    xcd_barrier(bar);
    {
        unsigned char* w_ = ws;
        constexpr int ES = F8_L1 ? 1 : 2;
        const char* u1 = (const char*)(w_ + (F8_L1 ? OFF_X : OFF_A));
        pg8::Sched2<pg8::EpiL1, ES> S{(const char*)(w_ + OFF_W1T), u1, 8, 65, u1, (const char*)(w_ + OFF_W1T) + (size_t)2048 * 2048 * ES, 65, 17, (int)gridDim.x, (int)blockIdx.x};
        pg8::EpiS2<pg8::EpiL1> E{pg8::EpiBf16{(bf16_t*)(w_ + OFF_BIG2), MT}, pg8::EpiL1{(bf16_t*)(w_ + OFF_QK), (bf16_t*)(w_ + L1_OFF_OB), (float*)(w_ + OFF_GATE)}};
        pg8::gemm_stream<pg8::EpiS2<pg8::EpiL1>, pg8::Sched2<pg8::EpiL1, ES>, ES == 1>(lds, 2048, S, E); __syncthreads();
    }
    xcd_barrier(bar);
    phase_l1_prep(fresh(p), lds);
    xcd_barrier(bar);
    phase_l1_passA2(fresh(p), lds);
    xcd_barrier(bar);
    phase_l1_passB(fresh(p));
    xcd_barrier(bar);
    phase_l1_passC(fresh(p), lds);
    xcd_barrier(bar);
    phase_l1_merge(fresh(p));
    xcd_barrier(bar);
#if F8_L1O
    {   unsigned char* w_ = ws;
        pg8::Sched1<1> S{(const char*)(w_ + OFF_QK), (const char*)(w_ + OFF_WO1T), TL / 256, 8, (int)gridDim.x, (int)blockIdx.x};
        pg8::EpiG<pg8::EpiBf16> E{pg8::EpiBf16{(bf16_t*)(w_ + OFF_BIG2), 2048}};
        pg8::gemm_stream<pg8::EpiG<pg8::EpiBf16>, pg8::Sched1<1>, true>(lds, 2048, S, E); __syncthreads();
    }
#else
    run_gemm(lds, (const bf16_t*)(ws + OFF_QK), (const bf16_t*)(ws + OFF_WO1T), TL, 2048, 2048, pg8::EpiBf16{(bf16_t*)(ws + OFF_BIG2), 2048});
#endif
    xcd_barrier(bar);
    phase_ln1(fresh(p), 1, TL, nullptr);
    xcd_barrier(bar);
    run_gemm(lds, (const bf16_t*)(ws + OFF_WQK) + (size_t)2048 * 2048, Abuf, 2048, TL, 2048, pg8::EpiF32{(float*)(ws + OFF_BIG1), MT});
    xcd_barrier(bar);
    phase_topk(fresh(p), lds, TL, nullptr);
    xcd_barrier(bar);
    phase_peer(fresh(p), lds, 1, TL);
#undef ws
#undef Abuf
}

extern "C" void kernel_launch(void* const* d_in, const int* in_sizes, int n_in, void* d_out, int out_size, void* d_ws, size_t ws_size, hipStream_t stream) {
    static int grid = 0;
    if (grid == 0) {
        int dev = 0, cus = 0;
        if (hipGetDevice(&dev) != hipSuccess || hipDeviceGetAttribute(&cus, hipDeviceAttributeMultiprocessorCount, dev) != hipSuccess) { fprintf(stderr, "kernel_launch: device query failed\n"); grid = -1; return; }
        if (hipFuncSetAttribute((const void*)hybrid_fwd_megakernel, hipFuncAttributeMaxDynamicSharedMemorySize, LDS_BYTES) != hipSuccess) { fprintf(stderr, "kernel_launch: hipFuncSetAttribute failed\n"); grid = -1; return; }
        int per_cu = 0;
        if (hipOccupancyMaxActiveBlocksPerMultiprocessor(&per_cu, (const void*)hybrid_fwd_megakernel, NTHREADS, LDS_BYTES) != hipSuccess || per_cu < 1) { fprintf(stderr, "kernel_launch: occupancy query says %d blocks/CU\n", per_cu); (void)hipGetLastError(); }
        if (n_in != 32 || ws_size < WS_END) { fprintf(stderr, "kernel_launch: unexpected n_in %d / ws_size %zu (need %zu)\n", n_in, ws_size, (size_t)WS_END); grid = -1; return; }
        grid = cus;
    }
    if (grid < 0) return;
    (void)hipMemsetAsync((char*)d_ws + OFF_BAR, 0, 16384, stream);
    Params prm{};
    for (int i = 0; i < 32; ++i) prm.in[i] = (const float*)d_in[i];
    prm.out = (float*)d_out; prm.ws = (unsigned char*)d_ws;
    void* args[] = {&prm};
    hipError_t e = hipLaunchCooperativeKernel((const void*)hybrid_fwd_megakernel, dim3(grid), dim3(NTHREADS), args, LDS_BYTES, stream);
    if (e != hipSuccess) fprintf(stderr, "kernel_launch: cooperative launch failed: %s (grid %d)\n", hipGetErrorString(e), grid);
}
```

```cpp
#include <hip/hip_runtime.h>
#include <cstdio>
#include <cstdint>

#define LAS __attribute__((address_space(3)))
typedef unsigned short bf16_t;
typedef short bf16x8 __attribute__((ext_vector_type(8)));
typedef short bf16x4 __attribute__((ext_vector_type(4)));
typedef float f32x2 __attribute__((ext_vector_type(2)));
typedef float f32x4 __attribute__((ext_vector_type(4)));
typedef float f32x16 __attribute__((ext_vector_type(16)));
typedef unsigned u32x2 __attribute__((ext_vector_type(2)));
typedef unsigned u32x4 __attribute__((ext_vector_type(4)));
typedef __bf16 bf2_t __attribute__((ext_vector_type(2)));

constexpr int DM = 2048;
constexpr int TL = 16384;
constexpr int TCX = 256;
constexpr int MT = TL + TCX;
constexpr int NTHREADS = 512;
constexpr int LDS_BYTES = 151552;
constexpr float LN_EPS = 1e-6f;
constexpr float DN_ALPHA = 1.41421356237309515f;

constexpr size_t al256(size_t x) { return (x + 255) & ~(size_t)255; }
constexpr size_t OFF_BAR   = 0;
constexpr size_t OFF_MOD   = 16384;
constexpr size_t OFF_ROPE  = OFF_MOD + al256((size_t)2 * 2 * 12288 * 4);
constexpr size_t OFF_A3    = OFF_ROPE + al256((size_t)256 * 32 * 8);
constexpr size_t OFF_GATE  = OFF_A3 + al256((size_t)MT * 64 * 2);
constexpr size_t OFF_GX    = OFF_GATE + al256((size_t)MT * 32 * 4);
constexpr size_t GX_STRIDE = (size_t)2 * 8 * MT;
constexpr size_t OFF_NST   = OFF_GX + al256((3 * GX_STRIDE + 2 * 8 * 260 + 64) * 4);
constexpr size_t OFF_W0T   = OFF_NST + al256((size_t)17 * 16 * 128 * 4);
constexpr size_t OFF_WO0T  = OFF_W0T + (size_t)6144 * 2048 * 2;
constexpr size_t OFF_W1T   = OFF_WO0T + (size_t)2048 * 2048 * 2;
constexpr size_t OFF_WO1T  = OFF_W1T + (size_t)6400 * 2048 * 2;
constexpr size_t OFF_WQK   = OFF_WO1T + (size_t)2048 * 2048 * 2;
constexpr size_t OFF_PEER  = OFF_WQK + (size_t)2 * 2048 * 2048 * 2;
constexpr size_t PEER_TBL  = (size_t)16384 * 2048;
constexpr float PEER_USCALE = 64.0f, PEER_VSCALE = 4.0f, PEER_VSCALE6 = 3.0f;
constexpr size_t OFF_BIG1  = OFF_PEER + 4 * PEER_TBL * 2;
constexpr size_t BIG_BYTES = al256((size_t)140000000);
constexpr size_t OFF_BIG2  = OFF_BIG1 + BIG_BYTES;
constexpr size_t OFF_H     = OFF_BIG2 + BIG_BYTES;
constexpr size_t OFF_A     = OFF_H + (size_t)MT * DM * 4;
constexpr size_t OFF_QK    = OFF_A + (size_t)MT * DM * 2;
constexpr size_t OFF_HYT   = OFF_QK + (size_t)MT * DM * 2;
constexpr size_t OFF_EXP   = OFF_HYT + al256((size_t)40000000);
constexpr size_t OFF_X     = OFF_EXP + (size_t)MT * 128 * 8;
constexpr size_t WS_END    = OFF_X + (size_t)MT * DM * 2;
static_assert(WS_END <= (size_t)1073741824, "workspace map exceeds 1 GiB");

__device__ __forceinline__ int opq(int v) { asm volatile("" : "+s"(v)); return v; }
__device__ __forceinline__ int otid() { int t = threadIdx.x; asm volatile("" : "+v"(t)); return t; }
__device__ __forceinline__ bf16_t f2bf(float f) { unsigned u = __float_as_uint(f); u += 0x7FFFu + ((u >> 16) & 1u); return (bf16_t)(u >> 16); }
__device__ __forceinline__ float bf2f(bf16_t b) { return __uint_as_float(((unsigned)b) << 16); }
__device__ __forceinline__ unsigned pk_bf16(float lo, float hi) { unsigned r; asm volatile("v_cvt_pk_bf16_f32 %0, %1, %2" : "=v"(r) : "v"(lo), "v"(hi)); return r; }
typedef int i32x4 __attribute__((ext_vector_type(4)));
typedef int i32x8 __attribute__((ext_vector_type(8)));
typedef unsigned u32x6 __attribute__((ext_vector_type(6)));
typedef float f32x32 __attribute__((ext_vector_type(32)));
__device__ __forceinline__ unsigned fp8x4(float a, float b, float c, float d) { int v = 0; v = __builtin_amdgcn_cvt_pk_fp8_f32(a, b, v, false); v = __builtin_amdgcn_cvt_pk_fp8_f32(c, d, v, true); return (unsigned)v; }
__device__ __forceinline__ float clamp8(float v) { return __builtin_amdgcn_fmed3f(v, -448.f, 448.f); }
constexpr float G8_XS = 16.0f, G8_WS = 64.0f, G8_OS = 1.0f / (16.0f * 64.0f);
#define PEER_F6U 1
#define PEER_PBU 8
#define PEER_PBV 8
#define PEER_F6V 1
typedef float f32x16_t __attribute__((ext_vector_type(16)));
__device__ __forceinline__ void fp6enc32(const float (&v)[32], unsigned (&w)[6]) {
    f32x16_t a, b;
#pragma unroll
    for (int i = 0; i < 16; ++i) { a[i] = __builtin_amdgcn_fmed3f(v[2 * i], -7.5f, 7.5f); b[i] = __builtin_amdgcn_fmed3f(v[2 * i + 1], -7.5f, 7.5f); }
    const u32x6 p = __builtin_amdgcn_cvt_scalef32_2xpk16_fp6_f32(a, b, 1.0f);
#pragma unroll
    for (int k = 0; k < 6; ++k) w[k] = p[k];
}
#define F8_L0 0
#define F8_L0NA 1
#define F8_L1 1
#define F8_L1O 1
__device__ __forceinline__ float bflo(unsigned u) { return __uint_as_float(u << 16); }
__device__ __forceinline__ float bfhi(unsigned u) { return __uint_as_float(u & 0xFFFF0000u); }
__device__ __forceinline__ float wave_sum(float v) {
#pragma unroll
    for (int o = 32; o > 0; o >>= 1) v += __shfl_xor(v, o);
    return v;
}
__device__ __forceinline__ float wave_max(float v) {
#pragma unroll
    for (int o = 32; o > 0; o >>= 1) v = fmaxf(v, __shfl_xor(v, o));
    return v;
}
__device__ __forceinline__ float silu_f(float x) { return x / (1.f + __expf(-x)); }
__device__ __forceinline__ float sigmoid_f(float x) { return 1.f / (1.f + __expf(-x)); }

#define XB_TMO      128
#define XB_XCNT(j)  (256  + 64 * (j))
#define XB_XSUB(j)  (1280 + 64 * (j))
#define XB_XGEN(j)  (2304 + 64 * (j))
#define XB_TOP      3328
#define XB_TOPGEN   3392
#define XCD_BAR_WORDS 3456
#define XB_SPIN_CAP (1u << 30)
__device__ __forceinline__ unsigned xb_ld(unsigned* p)              { return __hip_atomic_load(p, __ATOMIC_RELAXED, __HIP_MEMORY_SCOPE_AGENT); }
__device__ __forceinline__ unsigned xb_add(unsigned* p, unsigned v) { return __hip_atomic_fetch_add(p, v, __ATOMIC_RELAXED, __HIP_MEMORY_SCOPE_AGENT); }
__device__ __forceinline__ unsigned xb_xcc_id() { return (unsigned)__builtin_amdgcn_s_getreg((3 << 11) | 20) & 0xFu; }
#define XB_SPIN(cond, bar) do { unsigned _sp = 0; while (cond) { __builtin_amdgcn_s_sleep(1); \
    if ((++_sp & 255u) == 0u) { if (xb_ld(&(bar)[XB_TMO])) break; if (_sp > XB_SPIN_CAP) { atomicAdd(&(bar)[XB_TMO], 1u); break; } } } } while (0)
struct XcdBarrier { unsigned* bar; unsigned x; volatile LAS unsigned* st; };
__device__ __forceinline__ XcdBarrier xcd_barrier_post(unsigned* bar, volatile LAS unsigned* st) {
    XcdBarrier b; b.bar = bar; b.x = xb_xcc_id(); b.st = st;
    if (threadIdx.x == 0) (void)xb_add(&bar[XB_XCNT(b.x)], 1u);
    return b;
}
__device__ __forceinline__ void xcd_barrier_complete(unsigned* bar, unsigned x, unsigned& nloc, unsigned& nx) {
    const unsigned G = gridDim.x * gridDim.y * gridDim.z;
    unsigned sum, cnt, mine, sp = 0u;
    for (;;) {
        sum = 0u; cnt = 0u; mine = 0u;
#pragma unroll
        for (unsigned j = 0; j < 16; ++j) { const unsigned c = xb_ld(&bar[XB_XCNT(j)]); sum += c; cnt += (c > 0u) ? 1u : 0u; mine = (j == x) ? c : mine; }
        if (sum == G) break;
        __builtin_amdgcn_s_sleep(1);
        if ((++sp & 255u) == 0u) { if (xb_ld(&bar[XB_TMO])) break; if (sp > XB_SPIN_CAP) { atomicAdd(&bar[XB_TMO], 1u); break; } }
    }
    nloc = mine > 0u ? mine : 1u; nx = cnt > 0u ? cnt : 1u;
}
__device__ __forceinline__ void xcd_barrier(const XcdBarrier& b) {
    asm volatile("s_waitcnt vmcnt(0)" ::: "memory");
    __syncthreads();
    if (threadIdx.x == 0) {
        unsigned* bar = b.bar;
        __builtin_amdgcn_s_waitcnt(0);
        unsigned nloc = b.st[0], nx = b.st[1];
        if (nloc == 0u) { xcd_barrier_complete(bar, b.x, nloc, nx); b.st[0] = nloc; b.st[1] = nx; }
        const unsigned old = xb_add(&bar[XB_XSUB(b.x)], 1u);
        const unsigned gen = old / nloc;
        if (old + 1u == (gen + 1u) * nloc) {
            __builtin_amdgcn_fence(__ATOMIC_RELEASE, "agent");
            asm volatile("s_waitcnt vmcnt(0)" ::: "memory");
            const unsigned og = xb_add(&bar[XB_TOP], 1u);
            const unsigned tg = og / nx;
            if (og + 1u == (tg + 1u) * nx) xb_add(&bar[XB_TOPGEN], 1u);
            else XB_SPIN(xb_ld(&bar[XB_TOPGEN]) == tg, bar);
            __builtin_amdgcn_fence(__ATOMIC_ACQUIRE, "agent");
            xb_add(&bar[XB_XGEN(b.x)], 1u);
            asm volatile("s_waitcnt vmcnt(0)" ::: "memory");
        } else {
            XB_SPIN(xb_ld(&bar[XB_XGEN(b.x)]) == gen, bar);
            __builtin_amdgcn_fence(__ATOMIC_ACQUIRE, "agent");
            asm volatile("s_waitcnt vmcnt(0)" ::: "memory");
        }
    }
    __syncthreads();
}

namespace pg8 {
constexpr int BM = 256, BK = 64, HALF = 128, HTB = HALF * BK * 2, STAGE_BYTES = 8 * HTB, NXCD = 8, WGM = 8;
__host__ __device__ __forceinline__ int lds_byte(int r, int c) { const int st = (r >> 4) * 2 + (c >> 5), rr = r & 15, cc = c & 31, ob = rr * 64 + cc * 2; return st * 1024 + (ob ^ (((ob >> 9) & 1) << 5)); }
__host__ __device__ __forceinline__ void stage_rc(int b, int& R, int& C) { const int st = b / 1024, sb = b % 1024, swz = sb ^ (((sb >> 9) & 1) << 5); R = (st >> 1) * 16 + swz / 64; C = (st & 1) * 32 + (swz % 64) / 2; }
__host__ __device__ __forceinline__ int perm32(int rho) { const int n = rho >> 4, i = rho & 15; return 8 * (i >> 2) + 4 * n + (i & 3); }
struct Unit { int pm, pn; };
struct Gemm { const bf16_t* A; const bf16_t* Bt; int M, N, K; };
struct StaticOrder {
    int nM, nN, nwg, G, c;
    __host__ __device__ void init(int M, int N, int G_, int c_) { nM = M / BM; nN = N / BM; nwg = nM * nN; G = G_; c = c_; }
    __host__ __device__ bool next(int i, Unit& u) const {
        const long L = (long)i * G + c; if (L >= nwg) return false;
        int wgid = (int)L; { const int q = nwg / NXCD, r = nwg % NXCD, xcd = wgid % NXCD, off = wgid / NXCD; wgid = (xcd < r ? xcd * (q + 1) : r * (q + 1) + (xcd - r) * q) + off; }
        const int nig = WGM * nN, gid = wgid / nig, fm = gid * WGM, gsz = (nM - fm) < WGM ? (nM - fm) : WGM;
        u.pm = fm + ((wgid % nig) % gsz); u.pn = (wgid % nig) / gsz; return true;
    }
    __device__ __forceinline__ void a_ready(const Unit&) const {}
    __device__ __forceinline__ void done(const Unit&) const {}
};
struct EpiF32 {
    static constexpr bool PERM = false;
    float* C; int ldc;
    __device__ __forceinline__ void operator()(const f32x4 (&acc)[2][2][4][2], const Unit& u, int wr, int wc, int fr, int fq) const {
        const int row0 = u.pm * BM + wr * 64 + fr, col0 = u.pn * BM + wc * 32 + 4 * fq;
#pragma unroll
        for (int ai = 0; ai < 2; ++ai)
#pragma unroll
            for (int m = 0; m < 4; ++m) { float* rowp = C + (size_t)(row0 + ai * HALF + m * 16) * ldc + col0;
#pragma unroll
                for (int bj = 0; bj < 2; ++bj)
#pragma unroll
                    for (int n = 0; n < 2; ++n) *(f32x4*)(rowp + bj * HALF + n * 16) = acc[ai][bj][m][n]; }
    }
};
struct EpiBf16 {
    static constexpr bool PERM = true;
    bf16_t* O; int ldc;
    __device__ __forceinline__ void operator()(const f32x4 (&acc)[2][2][4][2], const Unit& u, int wr, int wc, int fr, int fq) const {
        const int row0 = u.pm * BM + wr * 64 + fr, col0 = u.pn * BM + wc * 32 + 8 * fq;
#pragma unroll
        for (int ai = 0; ai < 2; ++ai)
#pragma unroll
            for (int m = 0; m < 4; ++m) { bf16_t* rowp = O + (size_t)(row0 + ai * HALF + m * 16) * ldc + col0;
#pragma unroll
                for (int bj = 0; bj < 2; ++bj) { const f32x4 v0 = acc[ai][bj][m][0], v1 = acc[ai][bj][m][1];
                    u32x4 w; w.x = pk_bf16(v0[0], v0[1]); w.y = pk_bf16(v0[2], v0[3]); w.z = pk_bf16(v1[0], v1[1]); w.w = pk_bf16(v1[2], v1[3]);
                    *(u32x4*)(rowp + bj * HALF) = w; } }
    }
};
struct EpiL1 {
    static constexpr bool PERM = true;
    bf16_t* QKp; bf16_t* Ob; float* G;
    __device__ __forceinline__ void operator()(const f32x4 (&acc)[2][2][4][2], const Unit& u, int wr, int wc, int fr, int fq) const {
        const int row0 = u.pm * BM + wr * 64 + fr;
        if (u.pn < 16) {
            bf16_t* base = (u.pn < 8) ? QKp : Ob; const int col0 = (u.pn & 7) * BM + wc * 32 + 8 * fq;
#pragma unroll
            for (int ai = 0; ai < 2; ++ai)
#pragma unroll
                for (int m = 0; m < 4; ++m) { bf16_t* rowp = base + (size_t)(row0 + ai * HALF + m * 16) * 2048 + col0;
#pragma unroll
                    for (int bj = 0; bj < 2; ++bj) { const f32x4 v0 = acc[ai][bj][m][0], v1 = acc[ai][bj][m][1];
                        u32x4 w; w.x = pk_bf16(v0[0], v0[1]); w.y = pk_bf16(v0[2], v0[3]); w.z = pk_bf16(v1[0], v1[1]); w.w = pk_bf16(v1[2], v1[3]);
                        *(u32x4*)(rowp + bj * HALF) = w; } }
        } else if (wc == 0) {
#pragma unroll
            for (int ai = 0; ai < 2; ++ai)
#pragma unroll
                for (int m = 0; m < 4; ++m) { float* rowp = G + (size_t)(row0 + ai * HALF + m * 16) * 32 + 8 * fq;
                    *(f32x4*)(rowp) = acc[ai][0][m][0]; *(f32x4*)(rowp + 4) = acc[ai][0][m][1]; }
        }
    }
};

template <class Epi, class Sched>
__device__ __forceinline__ void gemm_phase(LAS unsigned char* lds, const Gemm g, const Sched& S, const Epi& E) {
    const int tid = otid(), wid = __builtin_amdgcn_readfirstlane(tid >> 6), lane = tid & 63, wr = wid >> 2, wc = wid & 3, fr = lane & 15, fq = lane >> 4;
    const int K = g.K, nt = K / BK;
    unsigned voffA[2], voffB[2];
#pragma unroll
    for (int i = 0; i < 2; ++i) { int R, C; stage_rc(tid * 16 + i * 8192, R, C); const int Rb = Epi::PERM ? ((R & ~31) + perm32(R & 31)) : R;
        voffA[i] = (unsigned)(R * K + C) * 2u; voffB[i] = (unsigned)(Rb * K + C) * 2u; }
    const size_t kstep = (size_t)(BK * 2);
    const size_t hstep = (size_t)HALF * K * 2;
    const size_t tstep = 2 * hstep;
    const unsigned ldsw = (unsigned)wid * 1024u;
    const int aoff = lds_byte(wr * 64 + fr, fq * 8), boff = lds_byte(wc * 32 + fr, fq * 8);
#define PG8_SA(b, h) (((b) * 2 + (h)) * HTB)
#define PG8_SB(b, h) ((4 + (b) * 2 + (h)) * HTB)
#define PG8_STAGE(bufoff, gbase, voff) do { _Pragma("unroll") for (int _i = 0; _i < 2; ++_i) \
        __builtin_amdgcn_global_load_lds((const unsigned*)((const char*)(gbase) + (voff)[_i]), (LAS unsigned*)(lds + (bufoff) + ldsw + _i * 8192), 16, 0, 0); } while (0)
#define PG8_LDA(dst, b, h) do { _Pragma("unroll") for (int m = 0; m < 4; ++m) _Pragma("unroll") for (int k = 0; k < 2; ++k) dst[m][k] = *(const LAS bf16x8*)(lds + PG8_SA(b, h) + aoff + m * 2048 + k * 1024); } while (0)
#define PG8_LDB(dst, b, h) do { _Pragma("unroll") for (int n = 0; n < 2; ++n) _Pragma("unroll") for (int k = 0; k < 2; ++k) dst[n][k] = *(const LAS bf16x8*)(lds + PG8_SB(b, h) + boff + n * 2048 + k * 1024); } while (0)
#define PG8_MMA(ai, bj, At, Bt) do { __builtin_amdgcn_s_setprio(1); _Pragma("unroll") for (int m = 0; m < 4; ++m) _Pragma("unroll") for (int n = 0; n < 2; ++n) _Pragma("unroll") for (int k = 0; k < 2; ++k) \
        acc[ai][bj][m][n] = __builtin_amdgcn_mfma_f32_16x16x32_bf16(Bt[n][k], At[m][k], acc[ai][bj][m][n], 0, 0, 0); __builtin_amdgcn_s_setprio(0); } while (0)
#define PG8_WAIT_V(n) asm volatile("s_waitcnt vmcnt(" #n ")" ::: "memory")
#define PG8_WAIT_L(n) asm volatile("s_waitcnt lgkmcnt(" #n ")" ::: "memory")
#define PG8_BAR __builtin_amdgcn_s_barrier()
#define PG8_SCHED __builtin_amdgcn_sched_barrier(0)
    Unit cur, nxt; int ui = 0;
    if (!S.next(0, cur)) return;
    f32x4 acc[2][2][4][2];
#pragma unroll
    for (int a = 0; a < 2; ++a)
#pragma unroll
        for (int b = 0; b < 2; ++b)
#pragma unroll
            for (int m = 0; m < 4; ++m)
#pragma unroll
                for (int n = 0; n < 2; ++n) acc[a][b][m][n] = (f32x4){0.f, 0.f, 0.f, 0.f};
    bf16x8 At[4][2], B0[2][2], B1[2][2];
    const char* cA = (const char*)g.A + (size_t)cur.pm * tstep; const char* cB = (const char*)g.Bt + (size_t)cur.pn * tstep;
    S.a_ready(cur);
    PG8_STAGE(PG8_SB(0, 0), cB, voffB); PG8_STAGE(PG8_SA(0, 0), cA, voffA); PG8_STAGE(PG8_SB(0, 1), cB + hstep, voffB); PG8_STAGE(PG8_SA(0, 1), cA + hstep, voffA);
    if (wr == 1) PG8_BAR;
    PG8_WAIT_V(4); PG8_BAR;
    PG8_STAGE(PG8_SB(1, 0), cB + kstep, voffB); PG8_STAGE(PG8_SA(1, 0), cA + kstep, voffA); PG8_STAGE(PG8_SB(1, 1), cB + hstep + kstep, voffB);
    PG8_WAIT_V(6); PG8_BAR;
    for (;;) {
        const bool has_next = S.next(ui + 1, nxt);
        const char* nA = has_next ? (const char*)g.A + (size_t)nxt.pm * tstep : cA; const char* nB = has_next ? (const char*)g.Bt + (size_t)nxt.pn * tstep : cB;
        for (int t = 0; t < nt; t += 2) {
            const bool last = (t == nt - 2);
            const char* a1 = cA + (size_t)(t + 1) * kstep;
            const char* a2 = last ? nA : cA + (size_t)(t + 2) * kstep; const char* b2 = last ? nB : cB + (size_t)(t + 2) * kstep;
            const char* a3 = a2 + kstep; const char* b3 = b2 + kstep;
            if (last && has_next) S.a_ready(nxt);
            PG8_LDB(B0, 0, 0); PG8_SCHED; PG8_LDA(At, 0, 0); PG8_STAGE(PG8_SA(1, 1), a1 + hstep, voffA);
            PG8_WAIT_L(8); PG8_BAR; PG8_WAIT_L(0); PG8_MMA(0, 0, At, B0); PG8_BAR; PG8_SCHED;
            PG8_LDB(B1, 0, 1); PG8_STAGE(PG8_SB(0, 0), b2, voffB);
            PG8_BAR; PG8_WAIT_L(0); PG8_MMA(0, 1, At, B1); PG8_BAR;
            PG8_LDA(At, 0, 1); PG8_STAGE(PG8_SA(0, 0), a2, voffA);
            PG8_BAR; PG8_WAIT_L(0); PG8_MMA(1, 0, At, B0); PG8_BAR; PG8_SCHED;
            PG8_STAGE(PG8_SB(0, 1), b2 + hstep, voffB);
            PG8_WAIT_V(6); PG8_BAR; PG8_MMA(1, 1, At, B1); PG8_BAR;
            PG8_LDB(B0, 1, 0); PG8_SCHED; PG8_LDA(At, 1, 0); PG8_STAGE(PG8_SA(0, 1), a2 + hstep, voffA);
            PG8_WAIT_L(8); PG8_BAR; PG8_WAIT_L(0); PG8_MMA(0, 0, At, B0); PG8_BAR; PG8_SCHED;
            PG8_LDB(B1, 1, 1); PG8_STAGE(PG8_SB(1, 0), b3, voffB);
            PG8_BAR; PG8_WAIT_L(0); PG8_MMA(0, 1, At, B1); PG8_BAR;
            PG8_LDA(At, 1, 1); PG8_STAGE(PG8_SA(1, 0), a3, voffA);
            PG8_BAR; PG8_WAIT_L(0); PG8_MMA(1, 0, At, B0); PG8_BAR; PG8_SCHED;
            PG8_STAGE(PG8_SB(1, 1), b3 + hstep, voffB);
            PG8_WAIT_V(6); PG8_BAR; PG8_MMA(1, 1, At, B1); PG8_BAR;
        }
        E(acc, cur, wr, wc, fr, fq); S.done(cur);
        if (!has_next) break;
#pragma unroll
        for (int a = 0; a < 2; ++a)
#pragma unroll
            for (int b = 0; b < 2; ++b)
#pragma unroll
                for (int m = 0; m < 4; ++m)
#pragma unroll
                    for (int n = 0; n < 2; ++n) acc[a][b][m][n] = (f32x4){0.f, 0.f, 0.f, 0.f};
        cur = nxt; cA = nA; cB = nB; ++ui;
    }
    PG8_WAIT_V(0);
    if (wr == 0) PG8_BAR;
    PG8_BAR;
#undef PG8_SA
#undef PG8_SB
#undef PG8_STAGE
#undef PG8_LDA
#undef PG8_LDB
#undef PG8_MMA
#undef PG8_WAIT_V
#undef PG8_WAIT_L
#undef PG8_BAR
#undef PG8_SCHED
}
__device__ __forceinline__ void mfma8(f32x4& acc, const i32x8 b, const i32x8 a, int sc) {
    asm volatile("v_mfma_scale_f32_16x16x128_f8f6f4 %0, %1, %2, %0, %3, %3 op_sel_hi:[0,0,0]" : "+v"(acc) : "v"(b), "v"(a), "v"(sc)); }
__device__ __forceinline__ i32x8 cat8(const bf16x8 a, const bf16x8 b) { const i32x4 x = __builtin_bit_cast(i32x4, a), y = __builtin_bit_cast(i32x4, b); return __builtin_shufflevector(x, y, 0, 1, 2, 3, 4, 5, 6, 7); }
struct GUnit { const char* A; const char* B; int pm, pn, nkt, tag; };
template <class Epi, class Sched, bool F8 = false>
__device__ __forceinline__ void gemm_stream(LAS unsigned char* lds, const int K, const Sched& S, const Epi& E) {
    const int tid = otid(), wid = __builtin_amdgcn_readfirstlane(tid >> 6), lane = tid & 63, wr = wid >> 2, wc = wid & 3, fr = lane & 15, fq = lane >> 4;
    unsigned voffA[2], voffB[2];
    const int Kb = F8 ? K : 2 * K;
#pragma unroll
    for (int i = 0; i < 2; ++i) { int R, C; stage_rc(tid * 16 + i * 8192, R, C); const int Rb = Epi::PERM ? ((R & ~31) + perm32(R & 31)) : R;
        voffA[i] = (unsigned)(R * Kb + C * 2); voffB[i] = (unsigned)(Rb * Kb + C * 2); }
    int sc8 = 0x7F7F7F7F; asm volatile("" : "+v"(sc8));
    const size_t kstep = (size_t)(BK * 2);
    const size_t hstep = (size_t)HALF * Kb;
    const unsigned ldsw = (unsigned)wid * 1024u;
    const int aoff = lds_byte(wr * 64 + fr, fq * 8), boff = lds_byte(wc * 32 + fr, fq * 8);
#define PG8_SA(b, h) (((b) * 2 + (h)) * HTB)
#define PG8_SB(b, h) ((4 + (b) * 2 + (h)) * HTB)
#define PG8_STAGE(bufoff, gbase, voff) do { _Pragma("unroll") for (int _i = 0; _i < 2; ++_i) \
        __builtin_amdgcn_global_load_lds((const unsigned*)((const char*)(gbase) + (voff)[_i]), (LAS unsigned*)(lds + (bufoff) + ldsw + _i * 8192), 16, 0, 0); } while (0)
#define PG8_LDA(dst, b, h) do { _Pragma("unroll") for (int m = 0; m < 4; ++m) _Pragma("unroll") for (int k = 0; k < 2; ++k) dst[m][k] = *(const LAS bf16x8*)(lds + PG8_SA(b, h) + aoff + m * 2048 + k * 1024); } while (0)
#define PG8_LDB(dst, b, h) do { _Pragma("unroll") for (int n = 0; n < 2; ++n) _Pragma("unroll") for (int k = 0; k < 2; ++k) dst[n][k] = *(const LAS bf16x8*)(lds + PG8_SB(b, h) + boff + n * 2048 + k * 1024); } while (0)
#define PG8_MMA(ai, bj, At, Bt) do { __builtin_amdgcn_s_setprio(1); \
        if constexpr (F8) { _Pragma("unroll") for (int m = 0; m < 4; ++m) _Pragma("unroll") for (int n = 0; n < 2; ++n) \
            mfma8(acc[ai][bj][m][n], cat8(Bt[n][0], Bt[n][1]), cat8(At[m][0], At[m][1]), sc8); } \
        else { _Pragma("unroll") for (int m = 0; m < 4; ++m) _Pragma("unroll") for (int n = 0; n < 2; ++n) _Pragma("unroll") for (int k = 0; k < 2; ++k) \
            acc[ai][bj][m][n] = __builtin_amdgcn_mfma_f32_16x16x32_bf16(Bt[n][k], At[m][k], acc[ai][bj][m][n], 0, 0, 0); } \
        __builtin_amdgcn_s_setprio(0); } while (0)
#define PG8_WAIT_V(n) asm volatile("s_waitcnt vmcnt(" #n ")" ::: "memory")
#define PG8_WAIT_L(n) asm volatile("s_waitcnt lgkmcnt(" #n ")" ::: "memory")
#define PG8_BAR __builtin_amdgcn_s_barrier()
#define PG8_SCHED __builtin_amdgcn_sched_barrier(0)
    GUnit cur, nxt; int ui = 0;
    if (!S.next(0, cur)) return;
    f32x4 acc[2][2][4][2];
#pragma unroll
    for (int a = 0; a < 2; ++a)
#pragma unroll
        for (int b = 0; b < 2; ++b)
#pragma unroll
            for (int m = 0; m < 4; ++m)
#pragma unroll
                for (int n = 0; n < 2; ++n) acc[a][b][m][n] = (f32x4){0.f, 0.f, 0.f, 0.f};
    bf16x8 At[4][2], B0[2][2], B1[2][2];
    const char* cA = cur.A; const char* cB = cur.B;
    PG8_STAGE(PG8_SB(0, 0), cB, voffB); PG8_STAGE(PG8_SA(0, 0), cA, voffA); PG8_STAGE(PG8_SB(0, 1), cB + hstep, voffB); PG8_STAGE(PG8_SA(0, 1), cA + hstep, voffA);
    if (wr == 1) PG8_BAR;
    PG8_WAIT_V(4); PG8_BAR;
    PG8_STAGE(PG8_SB(1, 0), cB + kstep, voffB); PG8_STAGE(PG8_SA(1, 0), cA + kstep, voffA); PG8_STAGE(PG8_SB(1, 1), cB + hstep + kstep, voffB);
    PG8_WAIT_V(6); PG8_BAR;
    for (;;) {
        const bool has_next = S.next(ui + 1, nxt);
        const char* nA = has_next ? nxt.A : cA; const char* nB = has_next ? nxt.B : cB;
        const int nt = cur.nkt;
        for (int t = 0; t < nt; t += 2) {
            const bool last = (t == nt - 2);
            const char* a1 = cA + (size_t)(t + 1) * kstep;
            const char* a2 = last ? nA : cA + (size_t)(t + 2) * kstep; const char* b2 = last ? nB : cB + (size_t)(t + 2) * kstep;
            const char* a3 = a2 + kstep; const char* b3 = b2 + kstep;
            PG8_LDB(B0, 0, 0); PG8_SCHED; PG8_LDA(At, 0, 0); PG8_STAGE(PG8_SA(1, 1), a1 + hstep, voffA);
            PG8_WAIT_L(8); PG8_BAR; PG8_WAIT_L(0); PG8_MMA(0, 0, At, B0); PG8_BAR; PG8_SCHED;
            PG8_LDB(B1, 0, 1); PG8_STAGE(PG8_SB(0, 0), b2, voffB);
            PG8_BAR; PG8_WAIT_L(0); PG8_MMA(0, 1, At, B1); PG8_BAR;
            PG8_LDA(At, 0, 1); PG8_STAGE(PG8_SA(0, 0), a2, voffA);
            PG8_BAR; PG8_WAIT_L(0); PG8_MMA(1, 0, At, B0); PG8_BAR; PG8_SCHED;
            PG8_STAGE(PG8_SB(0, 1), b2 + hstep, voffB);
            PG8_WAIT_V(6); PG8_BAR; PG8_MMA(1, 1, At, B1); PG8_BAR;
            PG8_LDB(B0, 1, 0); PG8_SCHED; PG8_LDA(At, 1, 0); PG8_STAGE(PG8_SA(0, 1), a2 + hstep, voffA);
            PG8_WAIT_L(8); PG8_BAR; PG8_WAIT_L(0); PG8_MMA(0, 0, At, B0); PG8_BAR; PG8_SCHED;
            PG8_LDB(B1, 1, 1); PG8_STAGE(PG8_SB(1, 0), b3, voffB);
            PG8_BAR; PG8_WAIT_L(0); PG8_MMA(0, 1, At, B1); PG8_BAR;
            PG8_LDA(At, 1, 1); PG8_STAGE(PG8_SA(1, 0), a3, voffA);
            PG8_BAR; PG8_WAIT_L(0); PG8_MMA(1, 0, At, B0); PG8_BAR; PG8_SCHED;
            PG8_STAGE(PG8_SB(1, 1), b3 + hstep, voffB);
            PG8_WAIT_V(6); PG8_BAR; PG8_MMA(1, 1, At, B1); PG8_BAR;
        }
        if constexpr (F8) {
            asm volatile("s_nop 15\n\ts_nop 15" ::: "memory");
#pragma unroll
            for (int a = 0; a < 2; ++a)
#pragma unroll
                for (int b = 0; b < 2; ++b)
#pragma unroll
                    for (int m = 0; m < 4; ++m)
#pragma unroll
                        for (int n = 0; n < 2; ++n) acc[a][b][m][n] *= G8_OS; }
        E(acc, cur, wr, wc, fr, fq);
        if (!has_next) break;
#pragma unroll
        for (int a = 0; a < 2; ++a)
#pragma unroll
            for (int b = 0; b < 2; ++b)
#pragma unroll
                for (int m = 0; m < 4; ++m)
#pragma unroll
                    for (int n = 0; n < 2; ++n) acc[a][b][m][n] = (f32x4){0.f, 0.f, 0.f, 0.f};
        cur = nxt; cA = nA; cB = nB; ++ui;
    }
    PG8_WAIT_V(0);
    if (wr == 0) PG8_BAR;
    PG8_BAR;
#undef PG8_SA
#undef PG8_SB
#undef PG8_STAGE
#undef PG8_LDA
#undef PG8_LDB
#undef PG8_MMA
#undef PG8_WAIT_V
#undef PG8_WAIT_L
#undef PG8_BAR
#undef PG8_SCHED
}
}

namespace pg8 {
__device__ __forceinline__ void tile_map(int L, int nM, int nN, int& pm, int& pn) {
    const int nwg = nM * nN; int wgid = L; { const int q = nwg / NXCD, r = nwg % NXCD, xcd = wgid % NXCD, off = wgid / NXCD; wgid = (xcd < r ? xcd * (q + 1) : r * (q + 1) + (xcd - r) * q) + off; }
    const int nig = WGM * nN, gid = wgid / nig, fm = gid * WGM, gsz = (nM - fm) < WGM ? (nM - fm) : WGM;
    pm = fm + ((wgid % nig) % gsz); pn = (wgid % nig) / gsz;
}
constexpr size_t TROW = (size_t)256 * 2048 * 2;
template <bool PERM_>
__device__ __forceinline__ void store_f32_tile(const f32x4 (&acc)[2][2][4][2], float* C, int ldc, int wr, int wc, int fr, int fq) {
    const int row0 = wr * 64 + fr, col0 = wc * 32 + (PERM_ ? 8 : 4) * fq;
#pragma unroll
    for (int ai = 0; ai < 2; ++ai)
#pragma unroll
        for (int m = 0; m < 4; ++m) { float* rowp = C + (size_t)(row0 + ai * HALF + m * 16) * ldc + col0;
#pragma unroll
            for (int bj = 0; bj < 2; ++bj)
#pragma unroll
                for (int n = 0; n < 2; ++n) *(f32x4*)(rowp + bj * HALF + n * (PERM_ ? 4 : 16)) = acc[ai][bj][m][n]; }
}
template <class Epi1, int ESZ = 2> struct Sched2 {
    const char* A0; const char* B0; int nM0, nN0; const char* A1; const char* B1; int nM1, nN1; int G, c;
    static constexpr size_t TR = TROW * ESZ / 2; static constexpr int NKT = 16 * ESZ;
    __device__ __forceinline__ bool next(int i, GUnit& u) const {
        int L = i * G + c; const int n0 = nM0 * nN0;
        if (L < n0) { tile_map(L, nM0, nN0, u.pm, u.pn); u.A = A0 + (size_t)u.pm * TR; u.B = B0 + (size_t)u.pn * TR; u.nkt = NKT; u.tag = 0; return true; }
        L -= n0; if (L >= nM1 * nN1) return false;
        tile_map(L, nM1, nN1, u.pm, u.pn); u.A = A1 + (size_t)u.pm * TR; u.B = B1 + (size_t)u.pn * TR; u.nkt = NKT; u.tag = 1; return true;
    }
};
template <class Epi1> struct EpiS2 {
    static constexpr bool PERM = true;
    EpiBf16 e0; Epi1 e1;
    __device__ __forceinline__ void operator()(const f32x4 (&acc)[2][2][4][2], const GUnit& g, int wr, int wc, int fr, int fq) const {
        const Unit u{g.pm, g.pn}; if (g.tag == 0) e0(acc, u, wr, wc, fr, fq); else e1(acc, u, wr, wc, fr, fq); }
};
template <int ESZ> struct Sched1 {
    const char* A; const char* B; int nM, nN, G, c;
    static constexpr size_t TR = TROW * ESZ / 2; static constexpr int NKT = 16 * ESZ;
    __device__ __forceinline__ bool next(int i, GUnit& u) const {
        const int L = i * G + c; if (L >= nM * nN) return false;
        tile_map(L, nM, nN, u.pm, u.pn); u.A = A + (size_t)u.pm * TR; u.B = B + (size_t)u.pn * TR; u.nkt = NKT; u.tag = 0; return true;
    }
};
template <class Epi0> struct EpiG {
    static constexpr bool PERM = Epi0::PERM;
    Epi0 e0;
    __device__ __forceinline__ void operator()(const f32x4 (&acc)[2][2][4][2], const GUnit& g, int wr, int wc, int fr, int fq) const { const Unit u{g.pm, g.pn}; e0(acc, u, wr, wc, fr, fq); }
};
struct SchedTail {
    const char* A; const char* B; int nM, nN; bool ctx_is_row;
    int G, c;
    __device__ __forceinline__ bool next(int i, GUnit& u) const {
        int L = i * G + c; const int n0 = nM * nN;
        if (L < n0) { tile_map(L, nM, nN, u.pm, u.pn); u.A = A + (size_t)u.pm * TROW; u.B = B + (size_t)u.pn * TROW; u.nkt = 32; u.tag = 0; return true; }
        L -= n0; const int nt_ = ctx_is_row ? nN : nM; if (L >= nt_ * 8) return false;
        const int t = L >> 3, sl = L & 7;
        u.pm = ctx_is_row ? nM : t; u.pn = ctx_is_row ? t : nN;
        u.A = A + (size_t)u.pm * TROW + (size_t)sl * 512; u.B = B + (size_t)u.pn * TROW + (size_t)sl * 512; u.nkt = 4; u.tag = 1 + sl + 8 * t; return true;
    }
};
template <bool PERM_, class Epi0> struct EpiTail {
    static constexpr bool PERM = PERM_;
    Epi0 e0; float* slab;
    __device__ __forceinline__ void operator()(const f32x4 (&acc)[2][2][4][2], const GUnit& g, int wr, int wc, int fr, int fq) const {
        if (g.tag == 0) { const Unit u{g.pm, g.pn}; e0(acc, u, wr, wc, fr, fq); }
        else { const int sl = (g.tag - 1) & 7, t = (g.tag - 1) >> 3; store_f32_tile<PERM_>(acc, slab + ((size_t)(sl * 8 + t) << 16), 256, wr, wc, fr, fq); }
    }
};
}
template <class Epi>
__device__ __forceinline__ void run_gemm(LAS unsigned char* lds, const bf16_t* A, const bf16_t* Bt, int M, int N, int K, const Epi& E) {
    pg8::Gemm g{A, Bt, M, N, K};
    pg8::StaticOrder S; S.init(M, N, (int)gridDim.x, (int)blockIdx.x);
    pg8::gemm_phase(lds, g, S, E);
    __syncthreads();
}
struct Params {
    const float* in[32];
    float* out;
    unsigned char* ws;
};
__device__ __forceinline__ unsigned char* get_ws() { const __attribute__((address_space(4))) char* ka = (const __attribute__((address_space(4))) char*)__builtin_amdgcn_kernarg_segment_ptr();
    unsigned long long w = *(const __attribute__((address_space(4))) unsigned long long*)(ka + __builtin_offsetof(Params, ws)); asm volatile("" : "+s"(w));
    return (unsigned char*)(__attribute__((address_space(1))) unsigned char*)w; }
__device__ __forceinline__ Params fresh(const Params& p) { Params q = p; q.ws = get_ws(); return q; }
enum { I_X = 0, I_C, I_CTX, I_CCTX, I_ADAW, I_ADAB, I_LNW, I_LNB, I_ABWIN, I_HYCW, I_HYCB, I_FW1, I_FB1, I_FW2, I_FB2, I_FW3, I_FB3, I_FW4, I_HYSKIP, I_RPB, I_ABWOUT,
       I_MLWIN, I_MLBG, I_MLCW, I_MLCB, I_MLNW, I_MLWOUT, I_PWQ, I_PK1, I_PK2, I_PU, I_PV };

template <bool F8>
__device__ __forceinline__ void task_transpose(LAS float* tile, const float* __restrict__ src, int ld, int ncols, bf16_t* __restrict__ dst, int K, int k0, int n_src0, int n_dst0) {
    const int tid = otid();
    const int nn = tid & 63, kb = tid >> 6;
    const bool ok = n_src0 + nn < ncols;
    const float* sp = src + (size_t)(k0 + kb) * ld + n_src0 + nn;
#pragma unroll
    for (int h = 0; h < 2; ++h) { float v[16];
#pragma unroll
        for (int it = 0; it < 16; ++it) v[it] = ok ? sp[(size_t)((h * 16 + it) * 8) * ld] : 0.f;
#pragma unroll
        for (int it = 0; it < 16; ++it) tile[nn * 257 + (h * 16 + it) * 8 + kb] = v[it]; }
    __syncthreads();
    if (F8) {
        unsigned char* d8 = (unsigned char*)dst;
#pragma unroll
        for (int it = 0; it < 8; ++it) { const int i = tid + it * 512, n2 = i >> 6, kq = i & 63; const LAS float* tp = tile + n2 * 257 + 4 * kq;
            *(unsigned*)(d8 + (size_t)(n_dst0 + n2) * K + k0 + 4 * kq) = fp8x4(clamp8(tp[0] * G8_WS), clamp8(tp[1] * G8_WS), clamp8(tp[2] * G8_WS), clamp8(tp[3] * G8_WS)); }
    } else {
#pragma unroll
        for (int it = 0; it < 16; ++it) { const int i = tid + it * 512, n2 = i >> 7, kp = i & 127;
            const float a = tile[n2 * 257 + 2 * kp], b = tile[n2 * 257 + 2 * kp + 1];
            *(unsigned*)(dst + (size_t)(n_dst0 + n2) * K + k0 + 2 * kp) = pk_bf16(a, b); }
    }
    __syncthreads();
}
__device__ __forceinline__ void task_convert(const float* __restrict__ src, unsigned char* __restrict__ dst, float scale) {
    const int tid = otid();
#pragma unroll 2
    for (int it = 0; it < 8; ++it) { const size_t i = ((size_t)it * 512 + tid) * 16;
        u32x4 w;
#pragma unroll
        for (int q = 0; q < 4; ++q) { const f32x4 a = *(const f32x4*)(src + i + 4 * q) * scale;
            int v = 0; v = __builtin_amdgcn_cvt_pk_fp8_f32(a[0], a[1], v, false); v = __builtin_amdgcn_cvt_pk_fp8_f32(a[2], a[3], v, true);
            if (q == 0) w.x = (unsigned)v; else if (q == 1) w.y = (unsigned)v; else if (q == 2) w.z = (unsigned)v; else w.w = (unsigned)v; }
        *(u32x4*)(dst + i) = w; }
}
__device__ __forceinline__ void task_convert6(const float* __restrict__ src, unsigned char* __restrict__ dst, float scale) {
    const int tid = otid(), w = tid >> 6, lane = tid & 63;
#pragma unroll 1
    for (int rr = w; rr < 32; rr += 8) { const float* sp = src + (size_t)rr * 2048 + lane * 32;
        float c[32];
#pragma unroll
        for (int q = 0; q < 8; ++q) { const f32x4 a = *(const f32x4*)(sp + 4 * q) * scale; c[4 * q] = a[0]; c[4 * q + 1] = a[1]; c[4 * q + 2] = a[2]; c[4 * q + 3] = a[3]; }
        unsigned wd[6]; fp6enc32(c, wd);
        unsigned char* dp = dst + (size_t)rr * 1536;
        *(u32x4*)(dp + lane * 16) = (u32x4){wd[0], wd[1], wd[2], wd[3]}; *(u32x2*)(dp + 1024 + lane * 8) = (u32x2){wd[4], wd[5]}; }
}
__device__ __forceinline__ void task_wqk(LAS float* lds, const float* __restrict__ wq, const float* __restrict__ keys, bf16_t* __restrict__ dstT, int hh, int jt) {
    LAS float* km = lds;
    LAS float* wt = lds + 128 * 129;
    const int tid = otid();
    for (int i = tid; i < 128 * 128; i += 512) { const int n = i >> 7, d = i & 127; km[n * 129 + d] = keys[i]; }
    for (int i = tid; i < 64 * 128; i += 512) { const int j = i >> 7, d = i & 127; wt[j * 129 + d] = wq[(size_t)(jt * 64 + j) * 2048 + hh * 128 + d]; }
    __syncthreads();
    const int ns = tid & 31, js = tid >> 5;
    float acc[4][4];
#pragma unroll
    for (int a = 0; a < 4; ++a)
#pragma unroll
        for (int b = 0; b < 4; ++b) acc[a][b] = 0.f;
    for (int d = 0; d < 128; ++d) {
        float kv[4], wv[4];
#pragma unroll
        for (int a = 0; a < 4; ++a) kv[a] = km[(ns + 32 * a) * 129 + d];
#pragma unroll
        for (int b = 0; b < 4; ++b) wv[b] = wt[(js + 16 * b) * 129 + d];
#pragma unroll
        for (int a = 0; a < 4; ++a)
#pragma unroll
            for (int b = 0; b < 4; ++b) acc[a][b] = fmaf(kv[a], wv[b], acc[a][b]);
    }
    __syncthreads();
    LAS float* ot = wt;
#pragma unroll
    for (int a = 0; a < 4; ++a)
#pragma unroll
        for (int b = 0; b < 4; ++b) ot[(ns + 32 * a) * 65 + js + 16 * b] = acc[a][b];
    __syncthreads();
#pragma unroll
    for (int it = 0; it < 8; ++it) { const int i = tid + it * 512, n = i >> 5, jp = i & 31;
        *(unsigned*)(dstT + (size_t)(hh * 128 + n) * 2048 + jt * 64 + 2 * jp) = pk_bf16(ot[n * 65 + 2 * jp], ot[n * 65 + 2 * jp + 1]); }
    __syncthreads();
}
__device__ __forceinline__ void task_ada(LAS float* lds, const float* __restrict__ c, const float* __restrict__ cc, const float* __restrict__ W, const float* __restrict__ bias,
                                         float* __restrict__ out_lat, float* __restrict__ out_ctx, int n0) {
    LAS float* sl = lds; LAS float* sc = lds + 2048; LAS float* red = lds + 4096;
    const int tid = otid(), w = tid >> 6, lane = tid & 63;
    for (int i = tid; i < 2048; i += 512) { sl[i] = silu_f(c[i]); sc[i] = silu_f(cc[i]); }
    __syncthreads();
    float al = 0.f, ac = 0.f;
    const float* wp = W + (size_t)(w * 256) * 12288 + n0 + lane;
#pragma unroll 8
    for (int k = 0; k < 256; ++k) { const float wv = wp[(size_t)k * 12288]; al = fmaf(sl[w * 256 + k], wv, al); ac = fmaf(sc[w * 256 + k], wv, ac); }
    red[(w * 64 + lane) * 2] = al; red[(w * 64 + lane) * 2 + 1] = ac;
    __syncthreads();
    if (tid < 64) { float a = 0.f, b = 0.f;
#pragma unroll
        for (int ww = 0; ww < 8; ++ww) { a += red[(ww * 64 + tid) * 2]; b += red[(ww * 64 + tid) * 2 + 1]; }
        out_lat[n0 + tid] = a + bias[n0 + tid]; out_ctx[n0 + tid] = b + bias[n0 + tid]; }
    __syncthreads();
}
__device__ __forceinline__ void task_a3(const Params& p, LAS float* lds, bf16_t* __restrict__ a3, int task) {
    const int tid = otid(), w = tid >> 6, lane = tid & 63;
    LAS float* W2s = lds; LAS float* W3s = lds + 4096; LAS float* hb = lds + 8192 + w * 128;
    for (int i = tid; i < 4096; i += 512) { W2s[i] = p.in[I_FW2][i]; W3s[i] = p.in[I_FW3][i]; }
    __syncthreads();
    const float* W1 = p.in[I_FW1];
    float w1[33];
#pragma unroll
    for (int f = 0; f < 33; ++f) w1[f] = W1[f * 64 + lane];
    const float b1 = p.in[I_FB1][lane], b2 = p.in[I_FB2][lane], b3 = p.in[I_FB3][lane];
    const float freq = 1e-4f + (float)(lane & 15) * ((15.0f - 1e-4f) / 15.0f);
#pragma unroll 1
    for (int i = 0; i < (w == 0 ? 9 : 8); ++i) {
        const int pos = task * 65 + (i < 8 ? w * 8 + i : 64);
        const int n = pos < TL ? pos : pos - TL; const int L = pos < TL ? TL : TCX;
        const float tl = (float)n / (float)(L - 1);
        const float omega = 6.283185307179586f * (float)n / (float)L;
        float sn, cs; sincosf(omega * freq, &sn, &cs);
        float h = fmaf(tl, w1[0], b1);
#pragma unroll
        for (int b = 0; b < 16; ++b) { h = fmaf(__shfl(cs, b), w1[1 + b], h); h = fmaf(-__shfl(sn, b), w1[17 + b], h); }
        hb[lane] = sinf(h);
        __builtin_amdgcn_wave_barrier();
        float g = b2;
#pragma unroll 8
        for (int j = 0; j < 64; ++j) g = fmaf(hb[j], W2s[j * 64 + lane], g);
        hb[64 + lane] = sinf(g);
        __builtin_amdgcn_wave_barrier();
        float q = b3;
#pragma unroll 8
        for (int j = 0; j < 64; ++j) q = fmaf(hb[64 + j], W3s[j * 64 + lane], q);
        a3[(size_t)pos * 64 + lane] = f2bf(sinf(q));
        __builtin_amdgcn_wave_barrier();
    }
    __syncthreads();
}

constexpr int P0_NT_TR0 = 8 * 96, P0_NT_TRO = 8 * 32, P0_NT_TR1 = 8 * 100;
constexpr int P0_T0 = 0;
constexpr int P0_T1 = P0_T0 + P0_NT_TR0;
constexpr int P0_T2 = P0_T1 + P0_NT_TRO;
constexpr int P0_T3 = P0_T2 + P0_NT_TR1;
constexpr int P0_T4 = P0_T3 + P0_NT_TRO;
constexpr int P0_T5 = P0_T4 + 4 * 512;
constexpr int P0_T6 = P0_T5 + 1024;
constexpr int P0_T7 = P0_T6 + 384;
constexpr int P0_T8 = P0_T7 + 256;
constexpr int P0_NT = P0_T8 + 1;
constexpr int P0_T5B = P0_T5 + 512;
constexpr int P0_T6B = P0_T6 + 192;

__device__ __forceinline__ void phase0(const Params& p, LAS unsigned char* lds, int t_begin = 0, int t_end = P0_NT, int skip_blocks = 0) {
    LAS float* ldsf = (LAS float*)lds;
    unsigned char* ws = p.ws;
    if ((int)blockIdx.x < skip_blocks) return;
    for (int task = t_begin + (int)blockIdx.x - skip_blocks; task < t_end; task += (int)gridDim.x - skip_blocks) {
        if (task < P0_T1) {
            const int t = task - P0_T0, kt = t & 7, nt = t >> 3; const int nd = nt * 64;
            const int nsrc = nd < 3072 ? nd : (nd < 4096 ? 5120 + (nd - 3072) : 3072 + (nd - 4096));
#if F8_L0NA
            if (nd >= 3072) task_transpose<true>(ldsf, p.in[I_ABWIN], 6144, 6144, (bf16_t*)(ws + OFF_W0T + (size_t)3072 * 4096), 2048, kt * 256, nsrc, nd - 3072);
            else task_transpose<false>(ldsf, p.in[I_ABWIN], 6144, 6144, (bf16_t*)(ws + OFF_W0T), 2048, kt * 256, nsrc, nd);
#else
            task_transpose<F8_L0 != 0>(ldsf, p.in[I_ABWIN], 6144, 6144, (bf16_t*)(ws + OFF_W0T), 2048, kt * 256, nsrc, nd);
#endif
        } else if (task < P0_T2) {
            const int t = task - P0_T1, kt = t & 7, nt = t >> 3;
            task_transpose<false>(ldsf, p.in[I_ABWOUT], 2048, 2048, (bf16_t*)(ws + OFF_WO0T), 2048, kt * 256, nt * 64, nt * 64);
        } else if (task < P0_T3) {
            const int t = task - P0_T2, kt = t & 7, nt = t >> 3; const int nd = nt * 64;
            const int nsrc = nd < 2048 ? 2048 + nd : (nd < 4096 ? nd - 2048 : nd);
            task_transpose<F8_L1 != 0>(ldsf, p.in[I_MLWIN], 6176, 6176, (bf16_t*)(ws + OFF_W1T), 2048, kt * 256, nsrc, nd);
        } else if (task < P0_T4) {
            const int t = task - P0_T3, kt = t & 7, nt = t >> 3;
            task_transpose<F8_L1O != 0>(ldsf, p.in[I_MLWOUT], 2048, 2048, (bf16_t*)(ws + OFF_WO1T), 2048, kt * 256, nt * 64, nt * 64);
        } else if (task < P0_T5) {
            const int t = task - P0_T4, ti = t >> 9, ch = t & 511; const int layer = ti >> 1, which = ti & 1;
            if ((which == 0 && PEER_F6U) || (which == 1 && PEER_F6V)) task_convert6((which ? p.in[I_PV] : p.in[I_PU]) + (size_t)layer * PEER_TBL + (size_t)ch * 65536, ws + OFF_PEER + (size_t)ti * PEER_TBL + (size_t)ch * 32 * 1536, which ? PEER_VSCALE6 : PEER_USCALE);
            else task_convert((which ? p.in[I_PV] : p.in[I_PU]) + (size_t)layer * PEER_TBL + (size_t)ch * 65536, ws + OFF_PEER + (size_t)ti * PEER_TBL + (size_t)ch * 65536, which ? PEER_VSCALE : PEER_USCALE);
        } else if (task < P0_T6) {
            const int t = task - P0_T5, layer = t >> 9, hh = (t >> 5) & 15, jt = t & 31;
            task_wqk(ldsf, p.in[I_PWQ] + (size_t)layer * 2048 * 2048, ((hh & 1) ? p.in[I_PK2] : p.in[I_PK1]) + (size_t)layer * 16384, (bf16_t*)(ws + OFF_WQK) + (size_t)layer * 2048 * 2048, hh, jt);
        } else if (task < P0_T7) {
            const int t = task - P0_T6, layer = t / 192, ch = t % 192;
            float* mod = (float*)(ws + OFF_MOD) + (size_t)layer * 2 * 12288;
            task_ada(ldsf, p.in[I_C], p.in[I_CCTX], p.in[I_ADAW] + (size_t)layer * 2048 * 12288, p.in[I_ADAB] + (size_t)layer * 12288, mod, mod + 12288, ch * 64);
        } else if (task < P0_T8) {
            task_a3(p, ldsf, (bf16_t*)(ws + OFF_A3), task - P0_T7);
        } else {
            f32x2* rt = (f32x2*)(ws + OFF_ROPE);
            for (int i = otid(); i < 256 * 32; i += 512) { const int pos = i >> 5, q = i & 31;
                const float inv = expf(-(float)q * (9.210340371976184f / 32.0f)); float sn, cs; sincosf((float)pos * inv, &sn, &cs); rt[i] = (f32x2){cs, sn}; }
        }
    }
}

__device__ __forceinline__ void modulate_rows(const float* __restrict__ xlat, const float* __restrict__ xctx, const float* __restrict__ mod  , bf16_t* __restrict__ U, unsigned char* __restrict__ U8 = nullptr) {
    const int tid = otid(), w = tid >> 6, lane = tid & 63;
    const int stride = gridDim.x * 8;
    for (int r0 = blockIdx.x * 8 + w; r0 < MT; r0 += 2 * stride) {
        f32x4 xa[2][4], xb[2][4];
#pragma unroll
        for (int k = 0; k < 2; ++k) { const int r = r0 + k * stride; if (r < MT) { const float* src = r < TL ? xlat + (size_t)r * DM : xctx + (size_t)(r - TL) * DM;
#pragma unroll
            for (int pc = 0; pc < 4; ++pc) { const int e = pc * 512 + lane * 8; xa[k][pc] = *(const f32x4*)(src + e); xb[k][pc] = *(const f32x4*)(src + e + 4); } } }
#pragma unroll
        for (int k = 0; k < 2; ++k) { const int r = r0 + k * stride; if (r < MT) { const float* md = mod + (r < TL ? 0 : 12288);
#pragma unroll
            for (int pc = 0; pc < 4; ++pc) { const int e = pc * 512 + lane * 8;
                const f32x4 s0 = *(const f32x4*)(md + 2048 + e), s1 = *(const f32x4*)(md + 2048 + e + 4), h0 = *(const f32x4*)(md + e), h1 = *(const f32x4*)(md + e + 4);
                const f32x4 x = xa[k][pc] * (s0 + 1.f) + h0, y = xb[k][pc] * (s1 + 1.f) + h1;
#if F8_L0
                u32x2 o; o.x = fp8x4(clamp8(x[0] * G8_XS), clamp8(x[1] * G8_XS), clamp8(x[2] * G8_XS), clamp8(x[3] * G8_XS)); o.y = fp8x4(clamp8(y[0] * G8_XS), clamp8(y[1] * G8_XS), clamp8(y[2] * G8_XS), clamp8(y[3] * G8_XS));
                *(u32x2*)((unsigned char*)U + (size_t)r * DM + e) = o; } } }
#else
                u32x4 o; o.x = pk_bf16(x[0], x[1]); o.y = pk_bf16(x[2], x[3]); o.z = pk_bf16(y[0], y[1]); o.w = pk_bf16(y[2], y[3]);
                *(u32x4*)(U + (size_t)r * DM + e) = o;
#if F8_L0NA
                { u32x2 o8; o8.x = fp8x4(clamp8(x[0] * G8_XS), clamp8(x[1] * G8_XS), clamp8(x[2] * G8_XS), clamp8(x[3] * G8_XS)); o8.y = fp8x4(clamp8(y[0] * G8_XS), clamp8(y[1] * G8_XS), clamp8(y[2] * G8_XS), clamp8(y[3] * G8_XS));
                  *(u32x2*)(U8 + (size_t)r * DM + e) = o8; }
#endif
                } } }
#endif
    }
}
__device__ __forceinline__ void hyena_taps(const Params& p) {
    const int tid = otid(), w = tid >> 6, lane = tid & 63, fr = lane & 15, fq = lane >> 4;
    const bf16_t* a3 = (const bf16_t*)(p.ws + OFF_A3);
    const float* w4 = p.in[I_FW4];
    bf16_t* HmT = (bf16_t*)(p.ws + OFF_BIG1);
    bf16_t* HmC = HmT + (size_t)4096 * TL;
    const int NWT = 256 * 16 + 256;
    for (int wt = blockIdx.x * 8 + w; wt < NWT; wt += gridDim.x * 8) {
        const bool isctx = wt >= 4096;
        const int ct = isctx ? wt - 4096 : (wt >> 4), tch = isctx ? 0 : (wt & 15);
        const int col = ct * 16 + fr;
        bf16x8 bw[2];
#pragma unroll
        for (int ks = 0; ks < 2; ++ks)
#pragma unroll
            for (int j = 0; j < 8; ++j) bw[ks][j] = (short)f2bf(w4[(size_t)(ks * 32 + fq * 8 + j) * 4096 + col]);
        const int ch = col & 1023;
        const float mind = -3.0701134573253945f, maxd = -15.350567286626973f;
        const float delta = fabsf(mind + (maxd - mind) * ((float)ch / 1023.0f));
        const int nblk = isctx ? 4 : 16;
        const int t00 = isctx ? 0 : tch * 1024;
        const float invL1 = isctx ? (1.0f / 255.0f) : (1.0f / 16383.0f);
        for (int blk = 0; blk < nblk; ++blk) {
            const int t0 = t00 + blk * 64;
            f32x4 acc[4];
#pragma unroll
            for (int tau = 0; tau < 4; ++tau) {
                acc[tau] = (f32x4){0.f, 0.f, 0.f, 0.f};
                const int trow = t0 + 16 * (fr >> 2) + 4 * tau + (fr & 3);
                const bf16_t* ap = a3 + (size_t)((isctx ? TL : 0) + trow) * 64 + fq * 8;
                const bf16x8 a0 = *(const bf16x8*)(ap), a1 = *(const bf16x8*)(ap + 32);
                acc[tau] = __builtin_amdgcn_mfma_f32_16x16x32_bf16(a0, bw[0], acc[tau], 0, 0, 0);
                acc[tau] = __builtin_amdgcn_mfma_f32_16x16x32_bf16(a1, bw[1], acc[tau], 0, 0, 0);
            }
            unsigned o[8];
#pragma unroll
            for (int tau = 0; tau < 4; ++tau) {
                float v[4];
#pragma unroll
                for (int rg = 0; rg < 4; ++rg) { const int t = t0 + 16 * fq + 4 * tau + rg; v[rg] = acc[tau][rg] * __expf(-(float)t * invL1 * delta); }
                o[tau * 2] = pk_bf16(v[0], v[1]); o[tau * 2 + 1] = pk_bf16(v[2], v[3]);
            }
            bf16_t* dst = isctx ? HmC + (size_t)col * TCX + t0 + 16 * fq : HmT + (size_t)col * TL + t0 + 16 * fq;
            *(u32x4*)(dst) = (u32x4){o[0], o[1], o[2], o[3]};
            *(u32x4*)(dst + 8) = (u32x4){o[4], o[5], o[6], o[7]};
        }
    }
}
constexpr int HY_TW = 143360;
__device__ __forceinline__ f32x2 cmul(f32x2 a, f32x2 b) { return (f32x2){a.x * b.x - a.y * b.y, a.x * b.y + a.y * b.x}; }
__device__ __forceinline__ int fpad(int p) { return p + (p >> 4) + ((p >> 9) << 4); }
__device__ __forceinline__ int kpos(int k) { return fpad((k & 31) * 512 + ((k >> 5) & 31) * 16 + (k >> 10)); }
__host__ __device__ constexpr int brev_c(int q, int bits) { int r = 0; for (int i = 0; i < bits; ++i) r |= ((q >> i) & 1) << (bits - 1 - i); return r; }

template <int R, int LOGR, bool INV>
__device__ __forceinline__ void fft_regs(f32x2 (&v)[R]) {
    constexpr float C32[16] = {1.0f, 0.98078528040323043f, 0.92387953251128674f, 0.83146961230254524f, 0.70710678118654757f, 0.55557023301960229f, 0.38268343236508984f, 0.19509032201612833f,
                               0.0f, -0.19509032201612819f, -0.38268343236508973f, -0.55557023301960196f, -0.70710678118654746f, -0.83146961230254535f, -0.92387953251128674f, -0.98078528040323043f};
    constexpr float S32[16] = {0.0f, 0.19509032201612825f, 0.38268343236508978f, 0.55557023301960218f, 0.70710678118654746f, 0.83146961230254524f, 0.92387953251128674f, 0.98078528040323043f,
                               1.0f, 0.98078528040323043f, 0.92387953251128674f, 0.83146961230254546f, 0.70710678118654757f, 0.55557023301960218f, 0.38268343236508989f, 0.19509032201612861f};
#pragma unroll
    for (int s = 0; s < LOGR; ++s) {
        const int half = (R / 2) >> s;
#pragma unroll
        for (int start = 0; start < R; start += 2 * half) {
#pragma unroll
            for (int i = 0; i < half; ++i) {
                const f32x2 a = v[start + i], b = v[start + i + half];
                v[start + i] = a + b;
                const f32x2 d = a - b;
                const int e = i * (16 / half);
                if (e == 0) v[start + i + half] = d;
                else if (e == 8) v[start + i + half] = INV ? (f32x2){-d.y, d.x} : (f32x2){d.y, -d.x};
                else { const float c = C32[e], sn = INV ? S32[e] : -S32[e]; v[start + i + half] = (f32x2){d.x * c - d.y * sn, d.x * sn + d.y * c}; }
            }
        }
    }
}
template <int R, int LOGR, bool INV, bool TW>
__device__ __forceinline__ void fft_bfly(LAS f32x2* Z, int a0, int astride, f32x2 bw) {
    f32x2 v[R];
#pragma unroll
    for (int r = 0; r < R; ++r) v[r] = Z[a0 + r * astride];
    if (TW) {
        const f32x2 base = (f32x2){bw.x, INV ? -bw.y : bw.y};
        f32x2 tw = base;
        if (INV) {
#pragma unroll
            for (int q = 1; q < R; ++q) { v[q] = cmul(v[q], tw); tw = cmul(tw, base); }
            fft_regs<R, LOGR, INV>(v);
        } else {
            fft_regs<R, LOGR, INV>(v);
#pragma unroll
            for (int q = 1; q < R; ++q) { v[brev_c(q, LOGR)] = cmul(v[brev_c(q, LOGR)], tw); tw = cmul(tw, base); }
        }
    } else fft_regs<R, LOGR, INV>(v);
#pragma unroll
    for (int q = 0; q < R; ++q) Z[a0 + q * astride] = v[brev_c(q, LOGR)];
}
__device__ __forceinline__ void fft16k_fwd(LAS f32x2* Z) {
    const int tid = otid();
    const LAS f32x2* T1 = (const LAS f32x2*)((LAS unsigned char*)Z + HY_TW);
    fft_bfly<32, 5, false, true>(Z, tid + (tid >> 4), 560, T1[tid]);
    __syncthreads();
    { const int b = tid >> 4, j = tid & 15; fft_bfly<32, 5, false, true>(Z, 560 * b + j, 17, T1[32 * j]); }
    __syncthreads();
#pragma unroll
    for (int h = 0; h < 2; ++h) { const int bb = tid + 512 * h; fft_bfly<16, 4, false, false>(Z, 17 * bb + 16 * (bb >> 5), 1, (f32x2){1.f, 0.f}); }
    __syncthreads();
}
__device__ __forceinline__ void fft16k_inv(LAS f32x2* Z) {
    const int tid = otid();
#pragma unroll
    for (int h = 0; h < 2; ++h) { const int bb = tid + 512 * h; fft_bfly<16, 4, true, false>(Z, 17 * bb + 16 * (bb >> 5), 1, (f32x2){1.f, 0.f}); }
    __syncthreads();
    const LAS f32x2* T1 = (const LAS f32x2*)((LAS unsigned char*)Z + HY_TW);
    { const int b = tid >> 4, j = tid & 15; fft_bfly<32, 5, true, true>(Z, 560 * b + j, 17, T1[32 * j]); }
    __syncthreads();
    fft_bfly<32, 5, true, true>(Z, tid + (tid >> 4), 560, T1[tid]);
    __syncthreads();
}
__device__ __forceinline__ int pair_k(int tid, int jj) { return ((tid >> 8) * 16 + jj) + 32 * ((tid >> 3) & 31) + 1024 * (tid & 7); }

__device__ __forceinline__ void hy_stash(LAS f32x2* Z, f32x4 (&st)[16], f32x4& stx) {
    const int tid = otid();
#pragma unroll
    for (int jj = 0; jj < 16; ++jj) { const int k = pair_k(tid, jj), kp = (16384 - k) & 16383;
        const f32x2 A = Z[kpos(k)], Bc = Z[kpos(kp)]; const f32x2 B = (f32x2){Bc.x, -Bc.y};
        const f32x2 S = A + B, Dd = A - B;
        st[jj] = (f32x4){0.5f * S.x, 0.5f * S.y, 0.5f * Dd.y, -0.5f * Dd.x}; }
    { const f32x2 A = Z[kpos(8192)]; stx = (f32x4){A.x, 0.f, A.y, 0.f}; }
}
__device__ __forceinline__ void hy_pointwise_one(LAS f32x2* Z, int k, const f32x4 hh, bool do_write) {
    const int kp = (16384 - k) & 16383; const int pa = kpos(k), pb = kpos(kp);
    const f32x2 A = Z[pa], Bc = Z[pb]; const f32x2 B = (f32x2){Bc.x, -Bc.y};
    const f32x2 S = A + B, Dd = A - B;
    const f32x2 Xe = (f32x2){0.5f * S.x, 0.5f * S.y}, Xo = (f32x2){0.5f * Dd.y, -0.5f * Dd.x};
    const f32x2 He = (f32x2){hh.x, hh.y}, Ho = (f32x2){hh.z, hh.w};
    const LAS f32x2* T1 = (const LAS f32x2*)((LAS unsigned char*)Z + HY_TW);
    const f32x2 w2 = cmul(T1[k & 511], T1[512 + (k >> 9)]);
    const f32x2 P = cmul(Xe, He) + cmul(w2, cmul(Xo, Ho));
    const f32x2 Q = cmul(Xe, Ho) + cmul(Xo, He);
    if (do_write) { Z[pa] = (f32x2){P.x - Q.y, P.y + Q.x}; Z[pb] = (f32x2){P.x + Q.y, Q.x - P.y}; }
}
__device__ __forceinline__ void hy_pointwise(LAS f32x2* Z, const f32x4 (&st)[16], const f32x4& stx) {
    const int tid = otid();
#pragma unroll
    for (int jj = 0; jj < 16; ++jj) hy_pointwise_one(Z, pair_k(tid, jj), st[jj], true);
    hy_pointwise_one(Z, 8192, stx, tid == 0);
    __syncthreads();
}
__device__ __forceinline__ void ld32bf(const bf16_t* __restrict__ p, float (&o)[32]) {
#pragma unroll
    for (int q = 0; q < 4; ++q) { const u32x4 w = *(const u32x4*)(p + q * 8);
        o[q * 8 + 0] = bflo(w.x); o[q * 8 + 1] = bfhi(w.x); o[q * 8 + 2] = bflo(w.y); o[q * 8 + 3] = bfhi(w.y);
        o[q * 8 + 4] = bflo(w.z); o[q * 8 + 5] = bfhi(w.z); o[q * 8 + 6] = bflo(w.w); o[q * 8 + 7] = bfhi(w.w); }
}
__device__ __forceinline__ void conv32(const bf16_t* __restrict__ row, int t0, int len, float w0, float w1, float w2, float cb, float (&o)[32]) {
    float x[32]; ld32bf(row + t0, x);
    const float xm = t0 > 0 ? bf2f(row[t0 - 1]) : 0.f, xp = (t0 + 32 < len) ? bf2f(row[t0 + 32]) : 0.f;
#pragma unroll
    for (int i = 0; i < 32; ++i) { const float a = i > 0 ? x[i - 1] : xm, c = i < 31 ? x[i + 1] : xp; o[i] = cb + w0 * a + w1 * x[i] + w2 * c; }
}
__device__ __forceinline__ void hy_load_taps(LAS f32x2* Z, const bf16_t* __restrict__ hf, const bf16_t* __restrict__ hb) {
    const int tid = otid();
    { float x[32]; ld32bf(hf + 32 * tid, x);
#pragma unroll
      for (int i = 0; i < 16; ++i) Z[fpad(16 * tid + i)] = (f32x2){x[2 * i], x[2 * i + 1]}; }
    { const int e0 = 16384 - 32 * tid; float x[32]; ld32bf(hb + e0 - 32, x);
      const float ex = (e0 < 16384) ? bf2f(hb[e0]) : 0.f;
#pragma unroll
      for (int i = 0; i < 16; ++i) Z[fpad(8192 + 16 * tid + i)] = (f32x2){i == 0 ? ex : x[32 - 2 * i], x[31 - 2 * i]}; }
    __syncthreads();
}
__device__ __forceinline__ void hy_load_data(LAS f32x2* Z, const float (&zc)[32]) {
    const int tid = otid();
#pragma unroll
    for (int i = 0; i < 16; ++i) { Z[fpad(16 * tid + i)] = (f32x2){zc[2 * i], zc[2 * i + 1]}; Z[fpad(8192 + 16 * tid + i)] = (f32x2){0.f, 0.f}; }
    __syncthreads();
}
__device__ __forceinline__ void hy_get_z(const Params& p, int o, int c, int t0, float (&zc)[32]) {
    if (o == 0) { const bf16_t* PRE = (const bf16_t*)(p.ws + OFF_BIG2); const float* cw = p.in[I_HYCW];
        conv32(PRE + (size_t)c * MT, t0, TL, cw[c], cw[3072 + c], cw[6144 + c], p.in[I_HYCB][c], zc);
    } else { const float* ZS = (const float*)(p.ws + OFF_X) + (size_t)c * TL + t0;
#pragma unroll
        for (int q = 0; q < 8; ++q) { const f32x4 v = *(const f32x4*)(ZS + 4 * q); zc[4 * q] = v[0]; zc[4 * q + 1] = v[1]; zc[4 * q + 2] = v[2]; zc[4 * q + 3] = v[3]; } }
}
__device__ __forceinline__ void hyena_channel(const Params& p, LAS f32x2* Z, int c) {
    const int tid = otid();
    const bf16_t* PRE = (const bf16_t*)(p.ws + OFF_BIG2);
    const bf16_t* HmT = (const bf16_t*)(p.ws + OFF_BIG1);
    bf16_t* hyT = (bf16_t*)(p.ws + OFF_HYT);
    float* ZS = (float*)(p.ws + OFF_X);
    const float* cw = p.in[I_HYCW]; const float* cbias = p.in[I_HYCB]; const float* skip = p.in[I_HYSKIP];
    const int t0 = 32 * tid;
#pragma unroll 1
    for (int o = 0; o < 2; ++o) {
        f32x4 st[16], stx;
        hy_load_taps(Z, HmT + (size_t)(o * 1024 + c) * TL, HmT + (size_t)(2048 + o * 1024 + c) * TL);
        fft16k_fwd(Z);
        hy_stash(Z, st, stx);
        __syncthreads();
        { float zc[32]; hy_get_z(p, o, c, t0, zc); hy_load_data(Z, zc); }
        fft16k_fwd(Z);
        hy_pointwise(Z, st, stx);
        fft16k_inv(Z);
        {
            const int gr = (o + 1) * 1024 + c;
            float zc[32]; hy_get_z(p, o, c, t0, zc);
            float g[32]; conv32(PRE + (size_t)gr * MT, t0, TL, cw[gr], cw[3072 + gr], cw[6144 + gr], cbias[gr], g);
            const float sk = skip[o * 1024 + c];
#pragma unroll
            for (int i = 0; i < 16; ++i) { const f32x2 y = Z[fpad(16 * tid + i)];
                zc[2 * i] = g[2 * i] * (y.x * (1.0f / 16384.0f) + sk * zc[2 * i]); zc[2 * i + 1] = g[2 * i + 1] * (y.y * (1.0f / 16384.0f) + sk * zc[2 * i + 1]); }
            if (o == 0) {
#pragma unroll
                for (int q = 0; q < 8; ++q) *(f32x4*)(ZS + (size_t)c * TL + t0 + 4 * q) = (f32x4){zc[4 * q], zc[4 * q + 1], zc[4 * q + 2], zc[4 * q + 3]};
            } else {
                bf16_t* dst = hyT + (size_t)c * MT + t0;
#pragma unroll
                for (int q = 0; q < 4; ++q) { u32x4 w; w.x = pk_bf16(zc[q * 8], zc[q * 8 + 1]); w.y = pk_bf16(zc[q * 8 + 2], zc[q * 8 + 3]); w.z = pk_bf16(zc[q * 8 + 4], zc[q * 8 + 5]); w.w = pk_bf16(zc[q * 8 + 6], zc[q * 8 + 7]);
                    *(u32x4*)(dst + q * 8) = w; }
            }
        }
        __syncthreads();
    }
}
__device__ __forceinline__ void hyena_ctx_channel(const Params& p, LAS float* wl, int c) {
    const int lane = otid() & 63;
    const bf16_t* PRE = (const bf16_t*)(p.ws + OFF_BIG2);
    const bf16_t* HmC = (const bf16_t*)(p.ws + OFF_BIG1) + (size_t)4096 * TL;
    bf16_t* hyT = (bf16_t*)(p.ws + OFF_HYT);
    const float* cw = p.in[I_HYCW]; const float* cbias = p.in[I_HYCB]; const float* skip = p.in[I_HYSKIP];
    LAS float* zs = wl; LAS float* tp = wl + 256;
    float z[4];
    {
        const bf16_t* row = PRE + (size_t)c * MT + TL;
        float x[6];
#pragma unroll
        for (int i = 0; i < 6; ++i) { const int t = 4 * lane - 1 + i; x[i] = (t >= 0 && t < TCX) ? bf2f(row[t]) : 0.f; }
#pragma unroll
        for (int i = 0; i < 4; ++i) z[i] = cbias[c] + cw[c] * x[i] + cw[3072 + c] * x[i + 1] + cw[6144 + c] * x[i + 2];
    }
#pragma unroll 1
    for (int o = 0; o < 2; ++o) {
        const bf16_t* hf = HmC + (size_t)(o * 1024 + c) * TCX; const bf16_t* hb = HmC + (size_t)(2048 + o * 1024 + c) * TCX;
#pragma unroll
        for (int i = 0; i < 4; ++i) { const int d = 4 * lane + i; zs[d] = z[i]; tp[255 + d] = bf2f(hf[d]); if (d > 0) tp[255 - d] = bf2f(hb[d]); }
        __builtin_amdgcn_s_waitcnt(0);
        __builtin_amdgcn_wave_barrier();
        float y[4] = {0.f, 0.f, 0.f, 0.f};
        for (int s = 0; s < 256; ++s) { const float zv = zs[s];
#pragma unroll
            for (int i = 0; i < 4; ++i) y[i] = fmaf(tp[255 + 4 * lane + i - s], zv, y[i]); }
        const int gr = (o + 1) * 1024 + c;
        const bf16_t* row = PRE + (size_t)gr * MT + TL;
        float x[6];
#pragma unroll
        for (int i = 0; i < 6; ++i) { const int t = 4 * lane - 1 + i; x[i] = (t >= 0 && t < TCX) ? bf2f(row[t]) : 0.f; }
        const float sk = skip[o * 1024 + c];
#pragma unroll
        for (int i = 0; i < 4; ++i) { const float g = cbias[gr] + cw[gr] * x[i] + cw[3072 + gr] * x[i + 1] + cw[6144 + gr] * x[i + 2]; z[i] = g * (y[i] + sk * z[i]); }
        __builtin_amdgcn_wave_barrier();
    }
    *(u32x2*)(hyT + (size_t)c * MT + TL + 4 * lane) = (u32x2){pk_bf16(z[0], z[1]), pk_bf16(z[2], z[3])};
}

constexpr int NA_KS = 0;
constexpr int NA_VS = 34816;
__device__ __forceinline__ void na_block_task(const Params& p, LAS unsigned char* lds, int task) {
    const int tid = otid(), wv = __builtin_amdgcn_readfirstlane(tid >> 6), lane = tid & 63, fr = lane & 15, fq = lane >> 4;
    const bf16_t* QK = (const bf16_t*)(p.ws + OFF_QK);
    const bf16_t* VT = (const bf16_t*)(p.ws + OFF_BIG2) + (size_t)3072 * MT;
    bf16_t* A2 = (bf16_t*)(p.ws + OFF_A);
    const float* rpb = p.in[I_RPB];
    const float scale = 0.08838834764831845f;
    const int hl = wv >> 2;
    int hp, qrow, nlat, r = 0, g = 0, r0 = 0, cb = 0;
    if (task < 1024) { hp = task & 3; r = task >> 2; g = wv & 3; qrow = r * 64 + 16 * g + fr; nlat = 8;
        r0 = r - 4; r0 = r0 < 0 ? 0 : (r0 > 248 ? 248 : r0); cb = 16 * g - 8; cb = cb < 0 ? 0 : (cb > 32 ? 32 : cb);
    } else { const int t = task - 1024; hp = t & 3; qrow = TL + 16 * (4 * (t >> 2) + (wv & 3)) + fr; nlat = 0; }
    const int h = 2 * hp + hl;
    const unsigned so_k = (unsigned)((tid >> 3) * 2048 + (tid & 7) * 8);
    const unsigned so_v = (unsigned)((tid >> 1) * MT + (tid & 1) * 32);
    u32x4 sk[4], sv[4];
#define NA_LOAD(tk0_) do { const bf16_t* kb_ = QK + (size_t)(tk0_) * 2048 + 1024 + hp * 256; const bf16_t* vb_ = VT + (size_t)(hp * 256) * MT + (tk0_); \
        _Pragma("unroll") for (int j = 0; j < 4; ++j) { sk[j] = *(const u32x4*)(kb_ + so_k + 64u * j); sv[j] = *(const u32x4*)(vb_ + so_v + 8u * j); } } while (0)
#define NA_STORE() do { _Pragma("unroll") for (int j = 0; j < 4; ++j) { \
        *(LAS u32x4*)(lds + NA_KS + (j >> 1) * 17408 + (tid >> 3) * 272 + ((tid & 7) * 8 + 64 * (j & 1)) * 2) = sk[j]; \
        *(LAS u32x4*)(lds + NA_VS + (tid >> 1) * 144 + ((tid & 1) * 32 + 8 * j) * 2) = sv[j]; } } while (0)
    bf16x8 qf[4];
#pragma unroll
    for (int ks = 0; ks < 4; ++ks) qf[ks] = *(const bf16x8*)(QK + (size_t)qrow * 2048 + h * 128 + ks * 32 + fq * 8);
    f32x4 oacc[8];
#pragma unroll
    for (int dt = 0; dt < 8; ++dt) oacc[dt] = (f32x4){0.f, 0.f, 0.f, 0.f};
    float mrun = -1e30f, lrun = 0.f;
    const int c = 16 * g + fr;
    int cs = c - 8; cs = cs < 0 ? 0 : (cs > 48 ? 48 : cs);
    const int nsteps = nlat + 4;
    __syncthreads();
    { const int tk0 = nlat ? r0 * 64 : TL; NA_LOAD(tk0); NA_STORE(); }
    __syncthreads();
    LAS unsigned char* Kh = lds + NA_KS + hl * 17408;
    LAS unsigned char* Vh = lds + NA_VS + hl * 128 * 144;
#pragma unroll 1
    for (int step = 0; step < nsteps; ++step) {
        const bool lat = step < nlat;
        if (step + 1 < nsteps) { const int tk1 = (step + 1 < nlat) ? (r0 + step + 1) * 64 : TL + 64 * (step + 1 - nlat); NA_LOAD(tk1); }
        const int kr = r0 + step;
        const int nsub = lat ? 1 : 2;
#pragma unroll 1
        for (int sub = 0; sub < nsub; ++sub) {
            const int kb = lat ? cb : 32 * sub;
            f32x4 s[2];
#pragma unroll
            for (int tl = 0; tl < 2; ++tl) {
                s[tl] = (f32x4){0.f, 0.f, 0.f, 0.f};
#pragma unroll
                for (int ks = 0; ks < 4; ++ks) { const bf16x8 kf = *(const LAS bf16x8*)(Kh + (kb + 16 * tl + fr) * 272 + 64 * ks + 16 * fq);
                    s[tl] = __builtin_amdgcn_mfma_f32_16x16x32_bf16(kf, qf[ks], s[tl], 0, 0, 0); }
            }
            float svv[8]; float mx = -1e30f;
#pragma unroll
            for (int tl = 0; tl < 2; ++tl)
#pragma unroll
                for (int rg = 0; rg < 4; ++rg) {
                    float v = s[tl][rg] * scale;
                    if (lat) { const int kc = kb + 16 * tl + 4 * fq + rg; const bool ok = (kc >= cs) && (kc < cs + 16);
                        const int ro = kr - r + 7, co = kc - c + 15;
                        const float bias = ok ? rpb[(h * 15 + ro) * 31 + co] : 0.f;
                        v = ok ? v + bias : -1e30f; }
                    svv[tl * 4 + rg] = v; mx = fmaxf(mx, v);
                }
            mx = fmaxf(mx, __shfl_xor(mx, 16)); mx = fmaxf(mx, __shfl_xor(mx, 32));
            const float mnew = fmaxf(mrun, mx);
            const float alpha = __expf(mrun - mnew);
            float ps = 0.f; float pv[8];
#pragma unroll
            for (int i = 0; i < 8; ++i) { pv[i] = (svv[i] > -1e29f) ? __expf(svv[i] - mnew) : 0.f; ps += pv[i]; }
            ps += __shfl_xor(ps, 16); ps += __shfl_xor(ps, 32);
            lrun = lrun * alpha + ps; mrun = mnew;
            bf16x8 pf;
            { const u32x4 w = (u32x4){pk_bf16(pv[0], pv[1]), pk_bf16(pv[2], pv[3]), pk_bf16(pv[4], pv[5]), pk_bf16(pv[6], pv[7])}; pf = __builtin_bit_cast(bf16x8, w); }
#pragma unroll
            for (int dt = 0; dt < 8; ++dt) {
                oacc[dt] *= alpha;
                LAS unsigned char* vp = Vh + (dt * 16 + fr) * 144 + (kb + 4 * fq) * 2;
                const u32x2 va = *(const LAS u32x2*)(vp), vb = *(const LAS u32x2*)(vp + 32);
                const u32x4 vw = (u32x4){va.x, va.y, vb.x, vb.y};
                oacc[dt] = __builtin_amdgcn_mfma_f32_16x16x32_bf16(__builtin_bit_cast(bf16x8, vw), pf, oacc[dt], 0, 0, 0);
            }
        }
        __syncthreads();
        if (step + 1 < nsteps) NA_STORE();
        __syncthreads();
    }
#undef NA_LOAD
#undef NA_STORE
    const float inv = 1.0f / lrun;
#pragma unroll
    for (int dt = 0; dt < 8; ++dt) {
        const f32x4 o = oacc[dt] * inv;
        *(u32x2*)(A2 + (size_t)qrow * 2048 + 1024 + h * 128 + dt * 16 + 4 * fq) = (u32x2){pk_bf16(o[0], o[1]), pk_bf16(o[2], o[3])};
    }
}

__device__ __forceinline__ void phase3(const Params& p, LAS unsigned char* lds, int which = 7) {
    const int tid = otid(), w = tid >> 6;
    {
        LAS f32x2* T1 = (LAS f32x2*)(lds + HY_TW); float sn, cs;
        sincospif((float)tid * (1.0f / 8192.0f), &sn, &cs); T1[tid] = (f32x2){cs, -sn};
        if (tid < 17) { sincospif((float)tid * (1.0f / 16.0f), &sn, &cs); T1[512 + tid] = (f32x2){cs, -sn}; }
        __syncthreads();
    }
    if (which & 1) for (int c = blockIdx.x; c < 1024; c += gridDim.x) hyena_channel(p, (LAS f32x2*)lds, c);
    __syncthreads();
    if (which & 2) for (int c = blockIdx.x * 8 + w; c < 1024; c += gridDim.x * 8) hyena_ctx_channel(p, (LAS float*)lds + w * 768, c);
    __syncthreads();
    if (which & 4) for (int t = blockIdx.x; t < 1024 + 16; t += gridDim.x) na_block_task(p, lds, t);
}

__device__ __forceinline__ void phase4(const Params& p, LAS unsigned char* lds) {
    LAS unsigned short* tile = (LAS unsigned short*)lds;
    const bf16_t* hyT = (const bf16_t*)(p.ws + OFF_HYT);
    bf16_t* A2 = (bf16_t*)(p.ws + OFF_A);
    const int tid = otid();
    for (int task = blockIdx.x; task < 16 * 260; task += gridDim.x) {
        const int ct = task & 15, rt = task >> 4;
#pragma unroll
        for (int it = 0; it < 4; ++it) { const int i = tid + it * 512, cc = i >> 5, rp = i & 31;
            const unsigned v = *(const unsigned*)(hyT + (size_t)(ct * 64 + cc) * MT + rt * 64 + 2 * rp);
            tile[cc * 66 + 2 * rp] = (unsigned short)(v & 0xFFFFu); tile[cc * 66 + 2 * rp + 1] = (unsigned short)(v >> 16); }
        __syncthreads();
#pragma unroll
        for (int it = 0; it < 4; ++it) { const int i = tid + it * 512, rr = i >> 5, cp = i & 31;
            const unsigned lo = tile[(2 * cp) * 66 + rr], hi = tile[(2 * cp + 1) * 66 + rr];
            *(unsigned*)(A2 + (size_t)(rt * 64 + rr) * 2048 + ct * 64 + 2 * cp) = (lo | (hi << 16)); }
        __syncthreads();
    }
}
__device__ __forceinline__ void ld8(const float* __restrict__ p, float (&o)[8]) { const f32x4 a = *(const f32x4*)p, b = *(const f32x4*)(p + 4);
    o[0] = a[0]; o[1] = a[1]; o[2] = a[2]; o[3] = a[3]; o[4] = b[0]; o[5] = b[1]; o[6] = b[2]; o[7] = b[3]; }
__device__ __forceinline__ void st8(float* __restrict__ p, const float (&o)[8]) { *(f32x4*)p = (f32x4){o[0], o[1], o[2], o[3]}; *(f32x4*)(p + 4) = (f32x4){o[4], o[5], o[6], o[7]}; }
__device__ __forceinline__ void st8bf(bf16_t* __restrict__ p, const float (&o)[8]) { *(u32x4*)p = (u32x4){pk_bf16(o[0], o[1]), pk_bf16(o[2], o[3]), pk_bf16(o[4], o[5]), pk_bf16(o[6], o[7])}; }

__device__ __forceinline__ void ld8bf(const bf16_t* __restrict__ p, float (&o)[8]) { const u32x4 w = *(const u32x4*)p; o[0] = bflo(w.x); o[1] = bfhi(w.x); o[2] = bflo(w.y); o[3] = bfhi(w.y); o[4] = bflo(w.z); o[5] = bfhi(w.z); o[6] = bflo(w.w); o[7] = bfhi(w.w); }
__device__ __forceinline__ void ln_row(float (&v)[4][8], const float* __restrict__ lw, const float* __restrict__ lb, int lane) {
    float s = 0.f;
#pragma unroll
    for (int pc = 0; pc < 4; ++pc)
#pragma unroll
        for (int j = 0; j < 8; ++j) s += v[pc][j];
    const float mu = wave_sum(s) * (1.0f / 2048.0f);
    float q = 0.f;
#pragma unroll
    for (int pc = 0; pc < 4; ++pc)
#pragma unroll
        for (int j = 0; j < 8; ++j) { const float d = v[pc][j] - mu; q += d * d; }
    const float rs = rsqrtf(wave_sum(q) * (1.0f / 2048.0f) + LN_EPS);
#pragma unroll
    for (int pc = 0; pc < 4; ++pc) { float w[8], b[8]; ld8(lw + pc * 512 + lane * 8, w); ld8(lb + pc * 512 + lane * 8, b);
#pragma unroll
        for (int j = 0; j < 8; ++j) v[pc][j] = (v[pc][j] - mu) * rs * w[j] + b[j]; }
}

template <bool SLAB>
__device__ __forceinline__ void ln1_load(const Params& p, int layer, int r, int lane, const float* __restrict__ slab, float (&v)[4][8]) {
    const bf16_t* y = (const bf16_t*)(p.ws + OFF_BIG2); const bf16_t* H = (const bf16_t*)(p.ws + OFF_H);
    const float* hp = r < TL ? p.in[I_X] + (size_t)r * DM : p.in[I_CTX] + (size_t)(r - TL) * DM;
    const float* md = (const float*)(p.ws + OFF_MOD) + (size_t)layer * 2 * 12288 + (r < TL ? 0 : 12288);
#pragma unroll
    for (int pc = 0; pc < 4; ++pc) { const int e = pc * 512 + lane * 8; float hv[8], yv[8], gv[8];
        if (layer == 0) ld8(hp + e, hv); else ld8bf(H + (size_t)r * DM + e, hv);
        if (SLAB) {
#pragma unroll
            for (int j = 0; j < 8; ++j) yv[j] = 0.f;
#pragma unroll 1
            for (int sl = 0; sl < 8; ++sl) { float t8[8]; ld8(slab + ((size_t)(sl * 8 + (e >> 8)) << 16) + (size_t)(r - TL) * 256 + (e & 255), t8);
#pragma unroll
                for (int j = 0; j < 8; ++j) yv[j] += t8[j]; }
        } else ld8bf(y + (size_t)r * DM + e, yv);
        ld8(md + 2 * 2048 + e, gv);
#pragma unroll
        for (int j = 0; j < 8; ++j) v[pc][j] = DN_ALPHA * hv[j] + gv[j] * yv[j]; }
}
__device__ __forceinline__ void ln1_finish(const Params& p, int layer, int r, int lane, float (&v)[4][8]) {
    bf16_t* H = (bf16_t*)(p.ws + OFF_H); bf16_t* A = (bf16_t*)(p.ws + OFF_A);
    const float* lw = p.in[I_LNW] + (size_t)(layer * 2 + 0) * DM; const float* lb = p.in[I_LNB] + (size_t)(layer * 2 + 0) * DM;
    const float* md = (const float*)(p.ws + OFF_MOD) + (size_t)layer * 2 * 12288 + (r < TL ? 0 : 12288);
    ln_row(v, lw, lb, lane);
#pragma unroll
    for (int pc = 0; pc < 4; ++pc) { const int e = pc * 512 + lane * 8; st8bf(H + (size_t)r * DM + e, v[pc]);
        float sc[8], sh[8], o[8]; ld8(md + 4 * 2048 + e, sc); ld8(md + 3 * 2048 + e, sh);
#pragma unroll
        for (int j = 0; j < 8; ++j) o[j] = v[pc][j] * (1.f + sc[j]) + sh[j];
        st8bf(A + (size_t)r * DM + e, o); }
}
__device__ __forceinline__ void phase_ln1(const Params& p, int layer, int nrows, const float* __restrict__ slab) {
    const int tid = otid(), w = tid >> 6, lane = tid & 63;
    const int stride = gridDim.x * 8;
    const int nmain = slab != nullptr ? TL : nrows;
    for (int r = blockIdx.x * 8 + w; r < nmain; r += 2 * stride) {
        const int r2 = r + stride; const bool has2 = r2 < nmain;
        float v[4][8], v2[4][8];
        ln1_load<false>(p, layer, r, lane, slab, v);
        if (has2) ln1_load<false>(p, layer, r2, lane, slab, v2);
        ln1_finish(p, layer, r, lane, v);
        if (has2) ln1_finish(p, layer, r2, lane, v2);
    }
    if (slab != nullptr) {
#pragma unroll 1
        for (int r = TL + blockIdx.x * 8 + w; r < nrows; r += stride) { float v[4][8]; ln1_load<true>(p, layer, r, lane, slab, v); ln1_finish(p, layer, r, lane, v); }
    }
}

__device__ __forceinline__ unsigned fkey(float f) { const unsigned u = __float_as_uint(f); return (u & 0x80000000u) ? ~u : (u | 0x80000000u); }
__device__ __forceinline__ float kval(unsigned k) { const unsigned u = (k & 0x80000000u) ? (k & 0x7FFFFFFFu) : ~k; return __uint_as_float(u); }
__device__ __forceinline__ void kins(unsigned (&L)[16], unsigned x) {
#pragma unroll
    for (int i = 0; i < 16; ++i) { const unsigned hi = L[i] > x ? L[i] : x; x = L[i] > x ? x : L[i]; L[i] = hi; }
}
__device__ __forceinline__ unsigned wave_umax(unsigned v) {
#pragma unroll
    for (int o = 32; o > 0; o >>= 1) { const unsigned t = (unsigned)__shfl_xor((int)v, o); v = v > t ? v : t; }
    return v;
}
__device__ __forceinline__ void topk_ctx_wave(const Params& p, const float* __restrict__ slab) {
    const int tid = otid(), wv = tid >> 6, lane = tid & 63;
    int* EI = (int*)(p.ws + OFF_EXP); float* EG = (float*)(p.ws + OFF_EXP + (size_t)MT * 128 * 4);
    for (int item = blockIdx.x * 8 + wv; item < TCX * 8; item += gridDim.x * 8) {
        const int h = item & 7, rl = item >> 3, r = TL + rl;
        float s1a = 0.f, s1b = 0.f, s2a = 0.f, s2b = 0.f;
#pragma unroll
        for (int sl = 0; sl < 8; ++sl) { const float* sb = slab + ((size_t)(sl * 8 + h) << 16) + rl;
            s1a += sb[(size_t)lane * 256]; s1b += sb[(size_t)(lane + 64) * 256]; s2a += sb[(size_t)(128 + lane) * 256]; s2b += sb[(size_t)(192 + lane) * 256]; }
        unsigned k1a = (fkey(s1a) & ~0x7Fu) | (unsigned)(127 - lane), k1b = (fkey(s1b) & ~0x7Fu) | (unsigned)(63 - lane);
        unsigned k2a = (fkey(s2a) & ~0x7Fu) | (unsigned)(127 - lane), k2b = (fkey(s2b) & ~0x7Fu) | (unsigned)(63 - lane);
        unsigned vec1 = 0u, vec2 = 0u;
#pragma unroll
        for (int i = 0; i < 16; ++i) {
            const unsigned w1 = wave_umax(k1a > k1b ? k1a : k1b); if (k1a == w1) k1a = 0u; if (k1b == w1) k1b = 0u; vec1 = lane == i ? w1 : vec1;
            const unsigned w2 = wave_umax(k2a > k2b ? k2a : k2b); if (k2a == w2) k2a = 0u; if (k2b == w2) k2b = 0u; vec2 = lane == i ? w2 : vec2;
        }
        const float v1 = kval((unsigned)__shfl((int)vec1, lane >> 2) & ~0x7Fu);
        unsigned ck[4];
#pragma unroll
        for (int t = 0; t < 4; ++t) { const int i = lane >> 2, j = 4 * (lane & 3) + t; const float v2 = kval((unsigned)__shfl((int)vec2, j) & ~0x7Fu);
            ck[t] = ((i + 1) * (j + 1) <= 16) ? ((fkey(v1 + v2) & ~0xFFu) | (unsigned)(255 - (i * 16 + j))) : 0u; }
        unsigned vec3 = 0u;
#pragma unroll
        for (int s3 = 0; s3 < 16; ++s3) { unsigned m = ck[0] > ck[1] ? ck[0] : ck[1]; const unsigned m2 = ck[2] > ck[3] ? ck[2] : ck[3]; m = m > m2 ? m : m2;
            const unsigned w3 = wave_umax(m);
#pragma unroll
            for (int t = 0; t < 4; ++t) if (ck[t] == w3) ck[t] = 0u;
            vec3 = lane == s3 ? w3 : vec3; }
        const float top = kval((unsigned)__shfl((int)vec3, 0) & ~0xFFu);
        const float ev = lane < 16 ? __expf(kval(vec3 & ~0xFFu) - top) : 0.f;
        const float sum = wave_sum(ev);
        const unsigned id = 255u - (vec3 & 0xFFu); const int ii = (int)(id >> 4), jj = (int)(id & 15u);
        const unsigned kk1 = (unsigned)__shfl((int)vec1, ii), kk2 = (unsigned)__shfl((int)vec2, jj);
        if (lane < 16) { const int n1 = 127 - (int)(kk1 & 0x7Fu), n2 = 127 - (int)(kk2 & 0x7Fu);
            EI[(size_t)r * 128 + h * 16 + lane] = n1 * 128 + n2; EG[(size_t)r * 128 + h * 16 + lane] = ev / sum; }
    }
}

__device__ __forceinline__ void phase_topk(const Params& p, LAS unsigned char* lds, int nrows, const float* __restrict__ slab) {
    LAS unsigned short* nsel = (LAS unsigned short*)lds;
    const float* ST = (const float*)(p.ws + OFF_BIG1);
    int* EI = (int*)(p.ws + OFF_EXP); float* EG = (float*)(p.ws + OFF_EXP + (size_t)MT * 128 * 4);
    const int tid = otid();
    const int nch = slab != nullptr ? TL / 512 : (nrows + 511) / 512;
    for (int task = blockIdx.x; task < nch * 8; task += gridDim.x) {
        const int h = task & 7, r = (task >> 3) * 512 + tid;
        const bool act = r < nrows; const int rr = act ? r : nrows - 1;
        unsigned L1[16], L2[16], L3[16];
#pragma unroll
        for (int i = 0; i < 16; ++i) { L1[i] = 0u; L2[i] = 0u; L3[i] = 0u; }
        const float* s1 = ST + (size_t)(h * 256) * MT + rr; const float* s2 = s1 + (size_t)128 * MT;
#pragma unroll 1
        for (int n0 = 0; n0 < 128; n0 += 16) {
            float a[16], b[16];
#pragma unroll
            for (int j = 0; j < 16; ++j) { a[j] = s1[(size_t)(n0 + j) * MT]; b[j] = s2[(size_t)(n0 + j) * MT]; }
#pragma unroll
            for (int j = 0; j < 16; ++j) { kins(L1, (fkey(a[j]) & ~0x7Fu) | (unsigned)(127 - n0 - j)); kins(L2, (fkey(b[j]) & ~0x7Fu) | (unsigned)(127 - n0 - j)); }
        }
        float v1[16], v2[16];
#pragma unroll
        for (int i = 0; i < 16; ++i) { v1[i] = kval(L1[i] & ~0x7Fu); v2[i] = kval(L2[i] & ~0x7Fu);
            nsel[i * 512 + tid] = (unsigned short)(127u - (L1[i] & 0x7Fu)); nsel[(16 + i) * 512 + tid] = (unsigned short)(127u - (L2[i] & 0x7Fu)); }
#pragma unroll
        for (int i = 0; i < 16; ++i)
#pragma unroll
            for (int j = 0; j < 16; ++j)
                if ((i + 1) * (j + 1) <= 16) { const unsigned kc = (fkey(v1[i] + v2[j]) & ~0xFFu) | (unsigned)(255 - (i * 16 + j)); kins(L3, kc); }
        const float m = kval(L3[0] & ~0xFFu);
        float e[16], sum = 0.f;
#pragma unroll
        for (int s = 0; s < 16; ++s) { e[s] = __expf(kval(L3[s] & ~0xFFu) - m); sum += e[s]; }
        const float inv = 1.0f / sum;
        if (act) {
#pragma unroll
            for (int s = 0; s < 16; ++s) { const unsigned id = 255u - (L3[s] & 0xFFu); const unsigned i = id >> 4, j = id & 15u;
                const int n1 = nsel[i * 512 + tid], n2 = nsel[(16 + j) * 512 + tid];
                EI[(size_t)r * 128 + h * 16 + s] = n1 * 128 + n2; EG[(size_t)r * 128 + h * 16 + s] = e[s] * inv; }
        }
    }
    if (slab != nullptr) topk_ctx_wave(p, slab);
}

__device__ __forceinline__ float dpp_sum63(float v) {
    v += __builtin_bit_cast(float, __builtin_amdgcn_update_dpp(0, __builtin_bit_cast(int, v), 0x111, 0xf, 0xf, false));
    v += __builtin_bit_cast(float, __builtin_amdgcn_update_dpp(0, __builtin_bit_cast(int, v), 0x112, 0xf, 0xf, false));
    v += __builtin_bit_cast(float, __builtin_amdgcn_update_dpp(0, __builtin_bit_cast(int, v), 0x114, 0xf, 0xf, false));
    v += __builtin_bit_cast(float, __builtin_amdgcn_update_dpp(0, __builtin_bit_cast(int, v), 0x118, 0xf, 0xf, false));
    v += __builtin_bit_cast(float, __builtin_amdgcn_update_dpp(0, __builtin_bit_cast(int, v), 0x142, 0xa, 0xf, false));
    v += __builtin_bit_cast(float, __builtin_amdgcn_update_dpp(0, __builtin_bit_cast(int, v), 0x143, 0xc, 0xf, false));
    return v;
}
__device__ __forceinline__ float readlane_f(float v, int l) { return __builtin_bit_cast(float, __builtin_amdgcn_readlane(__builtin_bit_cast(int, v), l)); }
__device__ __forceinline__ float dot8(const u32x4 a, const u32x4 b, float acc) {
    const unsigned a0 = a.x, a1 = a.y, a2 = a.z, a3 = a.w, b0 = b.x, b1 = b.y, b2 = b.z, b3 = b.w;
    acc = __builtin_amdgcn_fdot2_f32_bf16(__builtin_bit_cast(bf2_t, a0), __builtin_bit_cast(bf2_t, b0), acc, false);
    acc = __builtin_amdgcn_fdot2_f32_bf16(__builtin_bit_cast(bf2_t, a1), __builtin_bit_cast(bf2_t, b1), acc, false);
    acc = __builtin_amdgcn_fdot2_f32_bf16(__builtin_bit_cast(bf2_t, a2), __builtin_bit_cast(bf2_t, b2), acc, false);
    acc = __builtin_amdgcn_fdot2_f32_bf16(__builtin_bit_cast(bf2_t, a3), __builtin_bit_cast(bf2_t, b3), acc, false);
    return acc;
}
__device__ __forceinline__ void axpy8(float (&o)[8], const u32x4 v, float c) {
    o[0] = fmaf(c, bflo(v.x), o[0]); o[1] = fmaf(c, bfhi(v.x), o[1]); o[2] = fmaf(c, bflo(v.y), o[2]); o[3] = fmaf(c, bfhi(v.y), o[3]);
    o[4] = fmaf(c, bflo(v.z), o[4]); o[5] = fmaf(c, bfhi(v.z), o[5]); o[6] = fmaf(c, bflo(v.w), o[6]); o[7] = fmaf(c, bfhi(v.w), o[7]);
}
__device__ __forceinline__ void cvt16(const u32x4 w, float (&o)[16]) {
    const int w0 = (int)w.x, w1 = (int)w.y, w2 = (int)w.z, w3 = (int)w.w;
    f32x2 t;
    t = __builtin_amdgcn_cvt_pk_f32_fp8(w0, false); o[0] = t.x; o[1] = t.y;   t = __builtin_amdgcn_cvt_pk_f32_fp8(w0, true); o[2] = t.x; o[3] = t.y;
    t = __builtin_amdgcn_cvt_pk_f32_fp8(w1, false); o[4] = t.x; o[5] = t.y;   t = __builtin_amdgcn_cvt_pk_f32_fp8(w1, true); o[6] = t.x; o[7] = t.y;
    t = __builtin_amdgcn_cvt_pk_f32_fp8(w2, false); o[8] = t.x; o[9] = t.y;   t = __builtin_amdgcn_cvt_pk_f32_fp8(w2, true); o[10] = t.x; o[11] = t.y;
    t = __builtin_amdgcn_cvt_pk_f32_fp8(w3, false); o[12] = t.x; o[13] = t.y; t = __builtin_amdgcn_cvt_pk_f32_fp8(w3, true); o[14] = t.x; o[15] = t.y;
}
__device__ __forceinline__ void ld16(const float* __restrict__ p, float (&o)[16]) {
#pragma unroll
    for (int q = 0; q < 4; ++q) { const f32x4 a = *(const f32x4*)(p + 4 * q); o[4 * q] = a[0]; o[4 * q + 1] = a[1]; o[4 * q + 2] = a[2]; o[4 * q + 3] = a[3]; }
}
__device__ __forceinline__ void peer_finish(const Params& p, int layer, int r, int lane, float (&f)[2][16]) {
    bf16_t* H = (bf16_t*)(p.ws + OFF_H); bf16_t* A = (bf16_t*)(p.ws + OFF_A);
    const float* lw = p.in[I_LNW] + (size_t)(layer * 2 + 1) * DM; const float* lb = p.in[I_LNB] + (size_t)(layer * 2 + 1) * DM;
    const float* md = (const float*)(p.ws + OFF_MOD) + (size_t)layer * 2 * 12288 + (r < TL ? 0 : 12288);
    float s = 0.f;
#pragma unroll
    for (int pc = 0; pc < 2; ++pc) { const int e = PEER_F6V ? lane * 32 + pc * 16 : pc * 1024 + lane * 16; float hv[16], gv[16]; { float t0[8], t1[8]; ld8bf(H + (size_t)r * DM + e, t0); ld8bf(H + (size_t)r * DM + e + 8, t1);
#pragma unroll
            for (int j = 0; j < 8; ++j) { hv[j] = t0[j]; hv[8 + j] = t1[j]; } } ld16(md + 5 * 2048 + e, gv);
#pragma unroll
        for (int j = 0; j < 16; ++j) { f[pc][j] = DN_ALPHA * hv[j] + gv[j] * f[pc][j]; s += f[pc][j]; } }
    const float mu = wave_sum(s) * (1.0f / 2048.0f);
    float qv = 0.f;
#pragma unroll
    for (int pc = 0; pc < 2; ++pc)
#pragma unroll
        for (int j = 0; j < 16; ++j) { const float d = f[pc][j] - mu; qv += d * d; }
    const float rs = rsqrtf(wave_sum(qv) * (1.0f / 2048.0f) + LN_EPS);
    const float* md1 = (const float*)(p.ws + OFF_MOD) + (size_t)2 * 12288 + (r < TL ? 0 : 12288);
#pragma unroll
    for (int pc = 0; pc < 2; ++pc) { const int e = PEER_F6V ? lane * 32 + pc * 16 : pc * 1024 + lane * 16; float wv[16], bv[16]; ld16(lw + e, wv); ld16(lb + e, bv);
        float o[16];
#pragma unroll
        for (int j = 0; j < 16; ++j) o[j] = (f[pc][j] - mu) * rs * wv[j] + bv[j];
        if (layer == 0) {
            *(u32x4*)(H + (size_t)r * DM + e) = (u32x4){pk_bf16(o[0], o[1]), pk_bf16(o[2], o[3]), pk_bf16(o[4], o[5]), pk_bf16(o[6], o[7])};
            *(u32x4*)(H + (size_t)r * DM + e + 8) = (u32x4){pk_bf16(o[8], o[9]), pk_bf16(o[10], o[11]), pk_bf16(o[12], o[13]), pk_bf16(o[14], o[15])};
            float sc[16], sh[16]; ld16(md1 + 2048 + e, sc); ld16(md1 + e, sh);
#pragma unroll
            for (int j = 0; j < 16; ++j) o[j] = o[j] * (1.f + sc[j]) + sh[j];
#if F8_L1
            unsigned char* ap = p.ws + OFF_X + (size_t)r * DM + e;
            *(u32x4*)ap = (u32x4){fp8x4(clamp8(o[0] * G8_XS), clamp8(o[1] * G8_XS), clamp8(o[2] * G8_XS), clamp8(o[3] * G8_XS)), fp8x4(clamp8(o[4] * G8_XS), clamp8(o[5] * G8_XS), clamp8(o[6] * G8_XS), clamp8(o[7] * G8_XS)),
                                  fp8x4(clamp8(o[8] * G8_XS), clamp8(o[9] * G8_XS), clamp8(o[10] * G8_XS), clamp8(o[11] * G8_XS)), fp8x4(clamp8(o[12] * G8_XS), clamp8(o[13] * G8_XS), clamp8(o[14] * G8_XS), clamp8(o[15] * G8_XS))};
#else
            bf16_t* ap = A + (size_t)r * DM + e;
            *(u32x4*)ap = (u32x4){pk_bf16(o[0], o[1]), pk_bf16(o[2], o[3]), pk_bf16(o[4], o[5]), pk_bf16(o[6], o[7])};
            *(u32x4*)(ap + 8) = (u32x4){pk_bf16(o[8], o[9]), pk_bf16(o[10], o[11]), pk_bf16(o[12], o[13]), pk_bf16(o[14], o[15])};
#endif
        } else {
#pragma unroll
            for (int q = 0; q < 4; ++q) *(f32x4*)(p.out + (size_t)r * DM + e + 4 * q) = (f32x4){o[4 * q], o[4 * q + 1], o[4 * q + 2], o[4 * q + 3]};
        }
    }
}
typedef long i64_t;
constexpr float PEER_XS = 16.0f;
__device__ __forceinline__ i64_t mk64(unsigned lo, unsigned hi) { return (i64_t)(((unsigned long long)hi << 32) | (unsigned long long)lo); }
#if PEER_F6U
constexpr float PEER_XSE = 1.0f;
__device__ __forceinline__ void peer_load_x8(const bf16_t* __restrict__ A, int r, int lane, u32x4 (&xh)[2], u32x4 (&xl)[2]) {
    const bf16_t* ap = A + (size_t)r * DM + lane * 32;
    float v[32];
#pragma unroll
    for (int q = 0; q < 4; ++q) { const u32x4 a = *(const u32x4*)(ap + 8 * q); const unsigned w[4] = {a.x, a.y, a.z, a.w};
#pragma unroll
        for (int k = 0; k < 4; ++k) { v[8 * q + 2 * k] = bflo(w[k]); v[8 * q + 2 * k + 1] = bfhi(w[k]); } }
    unsigned wh[6], wl[6]; fp6enc32(v, wh);
    { const u32x6 ph = {wh[0], wh[1], wh[2], wh[3], wh[4], wh[5]}; const f32x32 hv = __builtin_amdgcn_cvt_scalef32_pk32_f32_fp6(ph, 1.0f);
#pragma unroll
      for (int j = 0; j < 32; ++j) v[j] = (v[j] - hv[j]) * 8.f; }
    fp6enc32(v, wl);
    xh[0] = (u32x4){wh[0], wh[1], wh[2], wh[3]}; xh[1] = (u32x4){wh[4], wh[5], 0u, 0u};
    xl[0] = (u32x4){wl[0], wl[1], wl[2], wl[3]}; xl[1] = (u32x4){wl[4], wl[5], 0u, 0u};
}
#else
constexpr float PEER_XSE = PEER_XS;
__device__ __forceinline__ void peer_load_x8(const bf16_t* __restrict__ A, int r, int lane, u32x4 (&xh)[2], u32x4 (&xl)[2]) {
#pragma unroll
    for (int pc = 0; pc < 2; ++pc) { const bf16_t* ap = A + (size_t)r * DM + lane * 32 + pc * 16;
        const u32x4 a = *(const u32x4*)ap, b = *(const u32x4*)(ap + 8);
        const unsigned w[8] = {a.x, a.y, a.z, a.w, b.x, b.y, b.z, b.w};
        unsigned h[4], l[4];
#pragma unroll
        for (int q = 0; q < 4; ++q) { const float v0 = bflo(w[2 * q]) * PEER_XS, v1 = bfhi(w[2 * q]) * PEER_XS, v2 = bflo(w[2 * q + 1]) * PEER_XS, v3 = bfhi(w[2 * q + 1]) * PEER_XS;
            h[q] = fp8x4(__builtin_amdgcn_fmed3f(v0, -448.f, 448.f), __builtin_amdgcn_fmed3f(v1, -448.f, 448.f), __builtin_amdgcn_fmed3f(v2, -448.f, 448.f), __builtin_amdgcn_fmed3f(v3, -448.f, 448.f));
            const f32x2 d0 = __builtin_amdgcn_cvt_pk_f32_fp8((int)h[q], false), d1 = __builtin_amdgcn_cvt_pk_f32_fp8((int)h[q], true);
            l[q] = fp8x4(__builtin_amdgcn_fmed3f(v0 - d0.x, -448.f, 448.f), __builtin_amdgcn_fmed3f(v1 - d0.y, -448.f, 448.f), __builtin_amdgcn_fmed3f(v2 - d1.x, -448.f, 448.f), __builtin_amdgcn_fmed3f(v3 - d1.y, -448.f, 448.f)); }
        xh[pc] = (u32x4){h[0], h[1], h[2], h[3]}; xl[pc] = (u32x4){l[0], l[1], l[2], l[3]}; }
}
#endif
template <int nb4, int NLO>
__device__ __forceinline__ void peer_acc3(const unsigned char* __restrict__ U, const unsigned char* __restrict__ V, int lane, int myid, float myg, const u32x4 (&xh)[2], const u32x4 (&xl)[2], float (&f)[2][16]) {
    float actv = 0.f;
    const bool dg = (((lane & 15) >> 2) == (lane >> 4));
    const float w0 = (dg && (lane & 3) == 0) ? 1.f : 0.f, w1 = (dg && (lane & 3) == 1) ? 1.f : 0.f, w2 = (dg && (lane & 3) == 2) ? 1.f : 0.f, w3 = (dg && (lane & 3) == 3) ? 1.f : 0.f;
    const i32x8 bh = {(int)xh[0].x, (int)xh[0].y, (int)xh[0].z, (int)xh[0].w, (int)xh[1].x, (int)xh[1].y, (int)xh[1].z, (int)xh[1].w};
    const i32x8 bl = {(int)xl[0].x, (int)xl[0].y, (int)xl[0].z, (int)xl[0].w, (int)xl[1].x, (int)xl[1].y, (int)xl[1].z, (int)xl[1].w};
    int sc = 0x7F7F7F7F; asm volatile("" : "+v"(sc));
    int sclo = 0x7C7C7C7C; asm volatile("" : "+v"(sclo));
    constexpr int PB = PEER_PBU, NBAT = nb4 * 4 / PB;
#pragma unroll 1
    for (int eb = 0; eb < NBAT; ++eb) {
        u32x4 rawa[PB]; u32x2 rawb[PB];
#pragma unroll
        for (int q = 0; q < PB; ++q) { const int eid = __builtin_amdgcn_readlane(myid, eb * PB + q);
            const unsigned char* row = U + (size_t)eid * 1536;
            rawa[q] = *(const u32x4*)(row + lane * 16); rawb[q] = *(const u32x2*)(row + 1024 + lane * 8); }
#pragma unroll
        for (int q = 0; q < PB; ++q) { f32x4 acc = (f32x4){0.f, 0.f, 0.f, 0.f};
            const i32x8 a = {(int)rawa[q].x, (int)rawa[q].y, (int)rawa[q].z, (int)rawa[q].w, (int)rawb[q].x, (int)rawb[q].y, 0, 0};
            acc = __builtin_amdgcn_mfma_scale_f32_16x16x128_f8f6f4(a, bh, acc, 2, 2, 0, sc, 0, sc);
            if (NLO) acc = __builtin_amdgcn_mfma_scale_f32_16x16x128_f8f6f4(a, bl, acc, 2, 2, 0, sc, 0, sclo);
            const float dv = fmaf(acc[0], w0, fmaf(acc[1], w1, fmaf(acc[2], w2, acc[3] * w3)));
            const float tot = readlane_f(dpp_sum63(dv), 63); actv = (lane == eb * PB + q) ? tot : actv; }
    }
    actv *= (1.0f / (PEER_XSE * PEER_USCALE));
    const float coef = myg * (0.5f / PEER_VSCALE6) * actv * (1.0f + erff(actv * 0.70710678118654752f));
    constexpr int PV = PEER_PBV, NBV = nb4 * 4 / PV;
#pragma unroll 1
    for (int eb = 0; eb < NBV; ++eb) {
        u32x4 rawa[PV]; u32x2 rawb[PV]; float cf[PV];
#pragma unroll
        for (int q = 0; q < PV; ++q) { const int eid = __builtin_amdgcn_readlane(myid, eb * PV + q); cf[q] = readlane_f(coef, eb * PV + q);
            const unsigned char* row = V + (size_t)eid * 1536;
            rawa[q] = *(const u32x4*)(row + lane * 16); rawb[q] = *(const u32x2*)(row + 1024 + lane * 8); }
#pragma unroll
        for (int q = 0; q < PV; ++q) { const u32x6 pk = {rawa[q].x, rawa[q].y, rawa[q].z, rawa[q].w, rawb[q].x, rawb[q].y};
            const f32x32 vv = __builtin_amdgcn_cvt_scalef32_pk32_f32_fp6(pk, 1.0f);
#pragma unroll
            for (int pc = 0; pc < 2; ++pc)
#pragma unroll
                for (int j = 0; j < 16; ++j) f[pc][j] = fmaf(cf[q], vv[pc * 16 + j], f[pc][j]); }
    }
}
__device__ __forceinline__ void phase_peer(const Params& p, LAS unsigned char* lds, int layer, int nrows) {
    const int tid = otid(), w = tid >> 6, lane = tid & 63;
    const unsigned char* U = p.ws + OFF_PEER + (size_t)(layer * 2) * PEER_TBL; const unsigned char* V = U + PEER_TBL;
    const int* EI = (const int*)(p.ws + OFF_EXP); const float* EG = (const float*)(p.ws + OFF_EXP + (size_t)MT * 128 * 4);
    const bf16_t* A = (const bf16_t*)(p.ws + OFF_A);
    const int xg = blockIdx.x & 7, cnt8 = (((int)gridDim.x - xg + 7) >> 3) * 8;
    for (int rl = (blockIdx.x >> 3) * 8 + w; rl < TL / 8; rl += cnt8) {
        const int r = xg * (TL / 8) + rl;
        u32x4 xh[2], xl[2]; peer_load_x8(A, r, lane, xh, xl);
        float f[2][16];
#pragma unroll
        for (int pc = 0; pc < 2; ++pc)
#pragma unroll
            for (int j = 0; j < 16; ++j) f[pc][j] = 0.f;
#pragma unroll
        for (int hf = 0; hf < 2; ++hf) peer_acc3<16, 1>(U, V, lane, EI[(size_t)r * 128 + hf * 64 + lane], EG[(size_t)r * 128 + hf * 64 + lane], xh, xl, f);
        peer_finish(p, layer, r, lane, f);
    }
    if (nrows > TL) {
        LAS float* fb = (LAS float*)lds;
        for (int rc = blockIdx.x; rc < nrows - TL; rc += gridDim.x) {
            const int r = TL + rc;
            u32x4 xh[2], xl[2]; peer_load_x8(A, r, lane, xh, xl);
            float f[2][16];
#pragma unroll
            for (int pc = 0; pc < 2; ++pc)
#pragma unroll
                for (int j = 0; j < 16; ++j) f[pc][j] = 0.f;
            const int li = lane & 15;
            peer_acc3<4, 1>(U, V, lane, EI[(size_t)r * 128 + w * 16 + li], EG[(size_t)r * 128 + w * 16 + li], xh, xl, f);
            __syncthreads();
#pragma unroll
            for (int pc = 0; pc < 2; ++pc)
#pragma unroll
                for (int q = 0; q < 4; ++q) *(LAS f32x4*)(fb + w * 2048 + pc * 1024 + lane * 16 + 4 * q) = (f32x4){f[pc][4 * q], f[pc][4 * q + 1], f[pc][4 * q + 2], f[pc][4 * q + 3]};
            __syncthreads();
            if (w == 0) {
#pragma unroll
                for (int pc = 0; pc < 2; ++pc)
#pragma unroll
                    for (int j = 0; j < 16; ++j) f[pc][j] = 0.f;
#pragma unroll 1
                for (int ww = 0; ww < 8; ++ww)
#pragma unroll
                    for (int pc = 0; pc < 2; ++pc)
#pragma unroll
                        for (int q = 0; q < 4; ++q) { const f32x4 t = *(const LAS f32x4*)(fb + ww * 2048 + pc * 1024 + lane * 16 + 4 * q);
                            f[pc][4 * q] += t[0]; f[pc][4 * q + 1] += t[1]; f[pc][4 * q + 2] += t[2]; f[pc][4 * q + 3] += t[3]; }
                peer_finish(p, layer, r, lane, f);
            }
        }
        __syncthreads();
    }
}

constexpr size_t L1_OFF_OB = OFF_BIG2 + (size_t)2048 * MT * 2;
constexpr size_t L1_OFF_QS = OFF_BIG1;
constexpr size_t L1_OFF_KS = L1_OFF_QS + (size_t)TL * 1024 * 2;
constexpr size_t L1_OFF_KT = L1_OFF_KS + (size_t)MT * 1024 * 2;
static_assert(L1_OFF_KT + (size_t)MT * 1024 * 2 <= OFF_BIG1 + BIG_BYTES, "BIG1 overflow");
static_assert(L1_OFF_OB + (size_t)MT * 2048 * 2 <= OFF_BIG2 + BIG_BYTES, "BIG2 overflow");

__device__ __forceinline__ float logsig_f(float x) { return fminf(x, 0.f) - log1pf(expf(-fabsf(x))); }
__device__ __forceinline__ int chunk_row0(int cidx) { return cidx < 256 ? cidx * 64 : TL + (cidx - 256) * 64; }
__device__ __forceinline__ int chunk_of(int sc, int dir, int i) { return sc == 0 ? (dir ? 259 - i : 256 + i) : (dir ? 255 - (sc - 1) * 16 - i : (sc - 1) * 16 + i); }

__device__ __forceinline__ void unpack8(const u32x4 w, float (&o)[8]) { o[0] = bflo(w.x); o[1] = bfhi(w.x); o[2] = bflo(w.y); o[3] = bfhi(w.y); o[4] = bflo(w.z); o[5] = bfhi(w.z); o[6] = bflo(w.w); o[7] = bfhi(w.w); }
__device__ __forceinline__ void l1_qk_task(const Params& p, LAS unsigned char* lds, int task) {
    const int tid = otid();
    int tile, isk, hq, nh, h0;
    if (task < 32) { tile = 256 + (task >> 3); isk = 1; h0 = task & 7; nh = 1; hq = h0 >> 2; } else { const int t = task - 32; tile = t >> 2; isk = (t >> 1) & 1; hq = t & 1; h0 = hq * 4; nh = 4; }
    const bool lat = tile < 256;
    const int r0 = lat ? tile * 64 : TL + (tile - 256) * 64;
    const int sq0 = lat ? 0 : TL, sq1 = lat ? TL : MT;
    const bf16_t* QKp = (const bf16_t*)(p.ws + OFF_QK);
    bf16_t* QS = (bf16_t*)(p.ws + L1_OFF_QS); bf16_t* KS = (bf16_t*)(p.ws + L1_OFF_KS); bf16_t* KT = (bf16_t*)(p.ws + L1_OFF_KT);
    const float* cw = p.in[I_MLCW]; const float* cb = p.in[I_MLCB];
    const f32x2* rope = (const f32x2*)(p.ws + OFF_ROPE);
    LAS unsigned short* tl_ = (LAS unsigned short*)lds;
    LAS float* wl = (LAS float*)(lds + 4 * 128 * 66 * 2);
    { const int c = tid, col = isk * 1024 + hq * 512 + c;
#pragma unroll
      for (int j = 0; j < 4; ++j) wl[j * 512 + c] = j < 3 ? cw[j * 2048 + col] : cb[col]; }
    __syncthreads();
    const int tl = tid >> 3, pc = tid & 7, half = pc >> 2, cc = pc & 3;
    const int d1 = half * 64 + cc * 8, d2 = d1 + 32;
    const int r = r0 + tl;
    const int pos = half == 0 ? (r >> 6) : (r & 63);
    f32x2 csn[8];
#pragma unroll
    for (int j = 0; j < 8; ++j) csn[j] = lat ? rope[pos * 32 + cc * 8 + j] : (f32x2){1.f, 0.f};
    const u32x4 z4 = (u32x4){0u, 0u, 0u, 0u};
#pragma unroll 1
    for (int hh = h0 - hq * 4; hh < h0 - hq * 4 + nh; ++hh) {
        const int h = hq * 4 + hh;
        const bf16_t* x0 = QKp + (size_t)r * 2048 + isk * 1024 + h * 128;
        const u32x4 a0 = *(const u32x4*)(x0 + d1), b0 = *(const u32x4*)(x0 + d2);
        const u32x4 am = r > sq0 ? *(const u32x4*)(x0 + d1 - 2048) : z4, bm = r > sq0 ? *(const u32x4*)(x0 + d2 - 2048) : z4;
        const u32x4 ap = r + 1 < sq1 ? *(const u32x4*)(x0 + d1 + 2048) : z4, bp = r + 1 < sq1 ? *(const u32x4*)(x0 + d2 + 2048) : z4;
        float A0[8], B0[8], AM[8], BM[8], AP[8], BP[8];
        unpack8(a0, A0); unpack8(b0, B0); unpack8(am, AM); unpack8(bm, BM); unpack8(ap, AP); unpack8(bp, BP);
        float o1[8], o2[8];
        const int w1 = hh * 128 + d1, w2 = hh * 128 + d2;
#pragma unroll
        for (int j = 0; j < 8; ++j) {
            const float y1 = silu_f(wl[1536 + w1 + j] + wl[w1 + j] * AM[j] + wl[512 + w1 + j] * A0[j] + wl[1024 + w1 + j] * AP[j]);
            const float y2 = silu_f(wl[1536 + w2 + j] + wl[w2 + j] * BM[j] + wl[512 + w2 + j] * B0[j] + wl[1024 + w2 + j] * BP[j]);
            float q1 = y1 * csn[j].x - y2 * csn[j].y, q2 = y1 * csn[j].y + y2 * csn[j].x;
            if (isk) { q1 *= 0.08838834764831845f; q2 *= 0.08838834764831845f; }
            o1[j] = q1; o2[j] = q2;
        }
        const u32x4 v1 = (u32x4){pk_bf16(o1[0], o1[1]), pk_bf16(o1[2], o1[3]), pk_bf16(o1[4], o1[5]), pk_bf16(o1[6], o1[7])};
        const u32x4 v2 = (u32x4){pk_bf16(o2[0], o2[1]), pk_bf16(o2[2], o2[3]), pk_bf16(o2[4], o2[5]), pk_bf16(o2[6], o2[7])};
        if (isk) {
            bf16_t* dst = KS + (size_t)r * 1024 + h * 128;
            *(u32x4*)(dst + d1) = v1; *(u32x4*)(dst + d2) = v2;
            LAS unsigned short* th = tl_ + hh * 128 * 66;
            const unsigned u1[4] = {v1.x, v1.y, v1.z, v1.w}, u2[4] = {v2.x, v2.y, v2.z, v2.w};
#pragma unroll
            for (int j = 0; j < 4; ++j) { th[(d1 + 2 * j) * 66 + tl] = (unsigned short)(u1[j] & 0xFFFFu); th[(d1 + 2 * j + 1) * 66 + tl] = (unsigned short)(u1[j] >> 16);
                                          th[(d2 + 2 * j) * 66 + tl] = (unsigned short)(u2[j] & 0xFFFFu); th[(d2 + 2 * j + 1) * 66 + tl] = (unsigned short)(u2[j] >> 16); }
        } else {
            bf16_t* dst = QS + (size_t)r * 1024 + h * 128;
            *(u32x4*)(dst + d1) = v1; *(u32x4*)(dst + d2) = v2;
        }
    }
    if (isk) {
        __syncthreads();
#pragma unroll 4
        for (int it = (h0 - hq * 4) * 8; it < (h0 - hq * 4 + nh) * 8; ++it) { const int i = tid + 512 * it, d = i >> 5, tp = i & 31;
            const unsigned lo = tl_[d * 66 + 2 * tp], hi = tl_[d * 66 + 2 * tp + 1];
            *(unsigned*)(KT + (size_t)(hq * 512 + d) * MT + r0 + 2 * tp) = lo | (hi << 16); }
    }
    __syncthreads();
}
__device__ __forceinline__ void l1_gate_items(const Params& p) {
    const int tid = otid(), wv = tid >> 6, lane = tid & 63;
    const float* G = (const float*)(p.ws + OFF_GATE); const float* bg = p.in[I_MLBG];
    float* GA = (float*)(p.ws + OFF_GX); float* GC = GA + GX_STRIDE; float* GW = GC + GX_STRIDE; float* DEC = GW + GX_STRIDE;
    for (int item = blockIdx.x * 8 + wv; item < 260 * 16; item += gridDim.x * 8) {
        const int cidx = item >> 4, hd = item & 15, h = hd >> 1, dir = hd & 1;
        const int r = chunk_row0(cidx) + lane;
        const int ci = (dir ? 2 : 0) * 8 + h, cf = (dir ? 3 : 1) * 8 + h;
        const float lf = logsig_f(G[(size_t)r * 32 + cf] + bg[cf]), li = G[(size_t)r * 32 + ci] + bg[ci];
        float b = lf;
        if (dir == 0) {
#pragma unroll
            for (int o = 1; o < 64; o <<= 1) { const float t = __shfl_up(b, o); if (lane >= o) b += t; }
        } else {
#pragma unroll
            for (int o = 1; o < 64; o <<= 1) { const float t = __shfl_down(b, o); if (lane + o < 64) b += t; }
        }
        const float bend = __shfl(b, dir ? 0 : 63);
        const size_t gb = (size_t)(dir * 8 + h) * MT;
        GA[gb + r] = expf(b); GC[gb + r] = expf(li - b); GW[gb + r] = expf(bend - b + li);
        if (lane == 0) DEC[(dir * 8 + h) * 260 + cidx] = expf(bend);
    }
}
__device__ __forceinline__ void phase_l1_prep(const Params& p, LAS unsigned char* lds) {
    l1_gate_items(p);
    for (int task = blockIdx.x; task < 32 + 1024; task += gridDim.x) l1_qk_task(p, lds, task);
}

__device__ __forceinline__ void phase_l1_passB(const Params& p) {
    const float* DEC = (const float*)(p.ws + OFF_GX) + 3 * GX_STRIDE;
    float* CST = (float*)(p.ws + OFF_HYT); float* NST = (float*)(p.ws + OFF_NST);
    const int NE = 16 * 32768 + 16 * 128;
    for (int g = blockIdx.x * 512 + otid(); g < NE; g += gridDim.x * 512) {
        const bool isn = g >= 16 * 32768;
        const int hd = isn ? (g - 16 * 32768) >> 7 : g >> 15, idx = isn ? (g - 16 * 32768) & 127 : g & 32767;
        const int h = hd >> 1, dir = hd & 1;
        float cin = 0.f;
        for (int sc = 0; sc < 17; ++sc) {
            float dsc = 1.f; const int nc = sc == 0 ? 4 : 16;
            for (int c = 0; c < nc; ++c) dsc *= DEC[(dir * 8 + h) * 260 + chunk_of(sc, dir, c)];
            float* ptr = isn ? NST + (size_t)(sc * 16 + hd) * 128 + idx : CST + (size_t)(sc * 16 + hd) * 32768 + idx;
            const float loc = sc < 16 ? *ptr : 0.f; *ptr = cin; cin = dsc * cin + loc;
        }
    }
}
constexpr int PC_QS = 0;
constexpr int PC_KS = 16896;
constexpr int PC_KT = 33792;
constexpr int PC_VS = 52224;
constexpr int PC_OS = 89088;
constexpr int PC_WT = 130048;
constexpr int PC_NL = 130816;
__device__ __forceinline__ bf16x8 pack8(const f32x16& v, int o) {
    u32x4 w; w.x = pk_bf16(v[o], v[o + 1]); w.y = pk_bf16(v[o + 2], v[o + 3]); w.z = pk_bf16(v[o + 4], v[o + 5]); w.w = pk_bf16(v[o + 6], v[o + 7]);
    return __builtin_bit_cast(bf16x8, w);
}
struct PcStage { u32x4 q0, q1, k0, k1, t0, t1, v0, v1, v2, v3; float wt; };
__device__ __forceinline__ bf16x8 lds_frag2(LAS unsigned char* base, int byteoff) {
    const u32x2 a = *(const LAS u32x2*)(base + byteoff), b = *(const LAS u32x2*)(base + byteoff + 16);
    const u32x4 w = (u32x4){a.x, a.y, b.x, b.y}; return __builtin_bit_cast(bf16x8, w);
}
__device__ __forceinline__ void phase_l1_passC(const Params& p, LAS unsigned char* lds) {
    const int tid = otid(), wv = __builtin_amdgcn_readfirstlane(tid >> 6), lane = tid & 63, l31 = lane & 31, hh = lane >> 5;
    const bf16_t* QS = (const bf16_t*)(p.ws + L1_OFF_QS); const bf16_t* KS = (const bf16_t*)(p.ws + L1_OFF_KS); const bf16_t* KT = (const bf16_t*)(p.ws + L1_OFF_KT);
    const bf16_t* VT = (const bf16_t*)(p.ws + OFF_BIG2);
    const unsigned so_q = (unsigned)((tid >> 3) * 1024 + (tid & 7) * 8), so_t = (unsigned)((tid >> 2) * MT + (tid & 3) * 8), so_v = (unsigned)((lane >> 1) * MT + (lane & 1) * 32), so_w = (unsigned)((tid >> 6) * (int)GX_STRIDE + (tid & 63));
    const float* GX = (const float*)(p.ws + OFF_GX); const float* DEC = GX + 3 * GX_STRIDE;
    const float* CST = (const float*)(p.ws + OFF_HYT); const float* NST = (const float*)(p.ws + OFF_NST);
    bf16_t* HF = (bf16_t*)(p.ws + OFF_A); bf16_t* HB = (bf16_t*)(p.ws + OFF_X);
    const u32x4 ones_u = (u32x4){0x3F803F80u, 0x3F803F80u, 0x3F803F80u, 0x3F803F80u};
    const bf16x8 ones = __builtin_bit_cast(bf16x8, ones_u);
    LAS float* WT = (LAS float*)(lds + PC_WT);
    LAS unsigned char* VSw = lds + PC_VS + wv * 4608;
    LAS unsigned char* OSw = lds + PC_OS + wv * 5120;
    for (int task = blockIdx.x; task < 16 * 16; task += gridDim.x) {
        const int hd = task & 15, sc = 1 + (task >> 4), h = hd >> 1, dir = hd & 1, w = wv;
        const size_t gb = (size_t)(dir * 8 + h) * MT;
        bf16_t* HO = dir ? HB : HF;
        f32x16 X[4];
        { const float* src = CST + (size_t)((sc * 16 + hd) * 8 + w) * 4096;
#pragma unroll
          for (int i = 0; i < 4; ++i)
#pragma unroll
              for (int q = 0; q < 16; ++q) X[i][q] = src[(i * 16 + q) * 64 + lane]; }
        LAS float* nlc = (LAS float*)(lds + PC_NL); LAS float* nln = nlc + 128;
        if (tid < 128) nlc[tid] = NST[(size_t)(sc * 16 + hd) * 128 + tid];
        PcStage sg;
#define PC_LOAD(cidx_) do { const int rw_ = (cidx_) * 64; \
            const bf16_t* qb_ = QS + (size_t)rw_ * 1024 + h * 128; sg.q0 = *(const u32x4*)(qb_ + so_q); sg.q1 = *(const u32x4*)(qb_ + so_q + 64u); \
            const bf16_t* kb_ = KS + (size_t)rw_ * 1024 + h * 128; sg.k0 = *(const u32x4*)(kb_ + so_q); sg.k1 = *(const u32x4*)(kb_ + so_q + 64u); \
            const bf16_t* tb_ = KT + (size_t)(h * 128) * MT + rw_; sg.t0 = *(const u32x4*)(tb_ + so_t); sg.t1 = *(const u32x4*)(tb_ + so_t + 32u); \
            const bf16_t* vb2_ = VT + (size_t)(h * 256 + 32 * w) * MT + rw_; sg.v0 = *(const u32x4*)(vb2_ + so_v); sg.v1 = *(const u32x4*)(vb2_ + so_v + 8u); sg.v2 = *(const u32x4*)(vb2_ + so_v + 16u); sg.v3 = *(const u32x4*)(vb2_ + so_v + 24u); \
            sg.wt = tid < 192 ? (GX + gb + rw_)[so_w] : 0.f; } while (0)
#define PC_ST64(base_, off_, v_) do { *(LAS u32x2*)((base_) + (off_)) = (u32x2){(v_).x, (v_).y}; *(LAS u32x2*)((base_) + (off_) + 8) = (u32x2){(v_).z, (v_).w}; } while (0)
#define PC_STORE() do { \
            PC_ST64(lds + PC_QS, (tid >> 3) * 264 + (tid & 7) * 16, sg.q0); PC_ST64(lds + PC_QS, (tid >> 3) * 264 + (tid & 7) * 16 + 128, sg.q1); \
            PC_ST64(lds + PC_KS, (tid >> 3) * 264 + (tid & 7) * 16, sg.k0); PC_ST64(lds + PC_KS, (tid >> 3) * 264 + (tid & 7) * 16 + 128, sg.k1); \
            *(LAS u32x4*)(lds + PC_KT + (tid >> 2) * 144 + (tid & 3) * 16) = sg.t0; *(LAS u32x4*)(lds + PC_KT + (tid >> 2) * 144 + (tid & 3) * 16 + 64) = sg.t1; \
            { LAS unsigned char* vb_ = VSw + (lane >> 1) * 144 + (lane & 1) * 64; *(LAS u32x4*)vb_ = sg.v0; *(LAS u32x4*)(vb_ + 16) = sg.v1; *(LAS u32x4*)(vb_ + 32) = sg.v2; *(LAS u32x4*)(vb_ + 48) = sg.v3; } \
            if (tid < 192) WT[tid] = sg.wt; } while (0)
        __syncthreads();
        PC_LOAD(chunk_of(sc, dir, 0)); PC_STORE();
        __syncthreads();
#pragma unroll 1
        for (int c = 0; c < 16; ++c) {
            const int cidx = chunk_of(sc, dir, c), rw0 = cidx * 64;
#pragma unroll 1
            for (int tt = 0; tt < 2; ++tt) {
                const int qoff = PC_QS + (32 * tt + l31) * 264 + 8 * hh;
                f32x16 num, den;
#pragma unroll
                for (int q = 0; q < 16; ++q) { num[q] = 0.f; den[q] = 0.f; }
#pragma unroll
                for (int st = 0; st < 2; ++st) {
                    f32x16 S;
#pragma unroll
                    for (int q = 0; q < 16; ++q) S[q] = 0.f;
#pragma unroll
                    for (int ks = 0; ks < 8; ++ks) { const bf16x8 qf = lds_frag2(lds, qoff + 32 * ks); const bf16x8 kf = lds_frag2(lds, PC_KS + (32 * st + l31) * 264 + 8 * hh + 32 * ks);
                        S = __builtin_amdgcn_mfma_f32_32x32x16_bf16(kf, qf, S, 0, 0, 0); }
                    const int t = 32 * tt + l31;
#pragma unroll
                    for (int g = 0; g < 4; ++g) { const f32x4 c4 = *(const LAS f32x4*)(WT + 64 + 32 * st + 8 * g + 4 * hh);
#pragma unroll
                        for (int q = 0; q < 4; ++q) { const int s_ = 32 * st + 8 * g + 4 * hh + q; const bool ok = dir ? (s_ >= t) : (s_ <= t);
                            S[4 * g + q] = ok ? S[4 * g + q] * c4[q] : 0.f; } }
#pragma unroll
                    for (int kk = 0; kk < 2; ++kk) {
                        const bf16x8 xf = pack8(S, 8 * kk);
                        const bf16x8 vf = lds_frag2(VSw, l31 * 144 + (32 * st + 16 * kk + 4 * hh) * 2);
                        num = __builtin_amdgcn_mfma_f32_32x32x16_bf16(xf, vf, num, 0, 0, 0);
                        den = __builtin_amdgcn_mfma_f32_32x32x16_bf16(xf, ones, den, 0, 0, 0);
                    }
                }
#pragma unroll
                for (int i = 0; i < 4; ++i)
#pragma unroll
                    for (int s2 = 0; s2 < 2; ++s2) {
                        const bf16x8 bx = pack8(X[i], 8 * s2);
                        const bf16x8 qf = lds_frag2(lds, qoff + 32 * (2 * i + s2));
                        num = __builtin_amdgcn_mfma_f32_32x32x16_bf16(qf, bx, num, 0, 0, 0);
                        const f32x4 na = *(const LAS f32x4*)(nlc + 32 * i + 16 * s2 + 4 * hh), nb = *(const LAS f32x4*)(nlc + 32 * i + 16 * s2 + 8 + 4 * hh);
                        u32x4 nw; nw.x = pk_bf16(na[0], na[1]); nw.y = pk_bf16(na[2], na[3]); nw.z = pk_bf16(nb[0], nb[1]); nw.w = pk_bf16(nb[2], nb[3]);
                        den = __builtin_amdgcn_mfma_f32_32x32x16_bf16(qf, __builtin_bit_cast(bf16x8, nw), den, 0, 0, 0);
                    }
#pragma unroll
                for (int g = 0; g < 4; ++g) { const f32x4 a4 = *(const LAS f32x4*)(WT + 32 * tt + 8 * g + 4 * hh);
#pragma unroll
                    for (int q = 0; q < 4; ++q) { const float a = a4[q]; const float hv = a * num[4 * g + q] / fmaxf(fabsf(a * den[4 * g + q]), 1.0f);
                        *(LAS unsigned short*)(OSw + (32 * tt + 8 * g + 4 * hh + q) * 80 + l31 * 2) = f2bf(hv); } }
            }
#pragma unroll
            for (int it = 0; it < 4; ++it) { const int tok = it * 16 + (lane >> 2), sgm = lane & 3;
                const u32x4 ov = *(const LAS u32x4*)(OSw + tok * 80 + sgm * 16);
                *(u32x4*)((HO + (size_t)rw0 * 2048 + h * 256 + 32 * w) + (unsigned)(tok * 2048 + sgm * 8)) = ov; }
            const float dec = DEC[(dir * 8 + h) * 260 + cidx];
#pragma unroll
            for (int i = 0; i < 4; ++i) X[i] *= dec;
#pragma unroll
            for (int ks = 0; ks < 4; ++ks) {
                const u32x4 vr = *(const LAS u32x4*)(VSw + l31 * 144 + 32 * ks + 16 * hh);
                const f32x4 wa = *(const LAS f32x4*)(WT + 128 + 16 * ks + 8 * hh), wb = *(const LAS f32x4*)(WT + 128 + 16 * ks + 8 * hh + 4);
                u32x4 vs; vs.x = pk_bf16(bflo(vr.x) * wa[0], bfhi(vr.x) * wa[1]); vs.y = pk_bf16(bflo(vr.y) * wa[2], bfhi(vr.y) * wa[3]);
                vs.z = pk_bf16(bflo(vr.z) * wb[0], bfhi(vr.z) * wb[1]); vs.w = pk_bf16(bflo(vr.w) * wb[2], bfhi(vr.w) * wb[3]);
                const bf16x8 bfr = __builtin_bit_cast(bf16x8, vs);
#pragma unroll
                for (int i = 0; i < 4; ++i) { const u32x4 ar = *(const LAS u32x4*)(lds + PC_KT + (32 * i + l31) * 144 + 32 * ks + 16 * hh);
                    X[i] = __builtin_amdgcn_mfma_f32_32x32x16_bf16(__builtin_bit_cast(bf16x8, ar), bfr, X[i], 0, 0, 0); }
            }
            if (tid < 128) { float a = 0.f;
#pragma unroll
                for (int q = 0; q < 8; ++q) { const u32x4 kr = *(const LAS u32x4*)(lds + PC_KT + tid * 144 + 16 * q);
                    const f32x4 wa = *(const LAS f32x4*)(WT + 128 + 8 * q), wb = *(const LAS f32x4*)(WT + 128 + 8 * q + 4);
                    a = fmaf(wa[0], bflo(kr.x), a); a = fmaf(wa[1], bfhi(kr.x), a); a = fmaf(wa[2], bflo(kr.y), a); a = fmaf(wa[3], bfhi(kr.y), a);
                    a = fmaf(wb[0], bflo(kr.z), a); a = fmaf(wb[1], bfhi(kr.z), a); a = fmaf(wb[2], bflo(kr.w), a); a = fmaf(wb[3], bfhi(kr.w), a); }
                nln[tid] = dec * nlc[tid] + a; }
            __syncthreads();
            if (c + 1 < 16) { PC_LOAD(chunk_of(sc, dir, c + 1)); PC_STORE(); }
            { LAS float* t_ = nlc; nlc = nln; nln = t_; }
            __syncthreads();
        }
#undef PC_LOAD
#undef PC_ST64
#undef PC_STORE
    }
}
__device__ __forceinline__ void phase_l1_passA2(const Params& p, LAS unsigned char* lds) {
    const int tid = otid(), wv = __builtin_amdgcn_readfirstlane(tid >> 6), lane = tid & 63, l31 = lane & 31, hh = lane >> 5;
    const bf16_t* KT = (const bf16_t*)(p.ws + L1_OFF_KT); const bf16_t* VT = (const bf16_t*)(p.ws + OFF_BIG2);
    const float* GX = (const float*)(p.ws + OFF_GX); const float* DEC = GX + 3 * GX_STRIDE;
    float* CST = (float*)(p.ws + OFF_HYT); float* NST = (float*)(p.ws + OFF_NST);
    const unsigned so_t = (unsigned)((tid >> 2) * MT + (tid & 3) * 8), so_v = (unsigned)((lane >> 1) * MT + (lane & 1) * 32);
    LAS float* WT = (LAS float*)(lds + PC_WT);
    LAS unsigned char* VSw = lds + PC_VS + wv * 4608;
    for (int task = blockIdx.x; task < 16 * 16; task += gridDim.x) {
        const int hd = task & 15, sc = task >> 4, h = hd >> 1, dir = hd & 1, w = wv;
        const size_t gb = (size_t)(dir * 8 + h) * MT;
        f32x16 X[4];
#pragma unroll
        for (int i = 0; i < 4; ++i)
#pragma unroll
            for (int q = 0; q < 16; ++q) X[i][q] = 0.f;
        float nacc = 0.f;
        const int nc = sc == 0 ? 4 : 16;
#pragma unroll 1
        for (int c = 0; c < nc; ++c) {
            const int cidx = chunk_of(sc, dir, c), rw0 = chunk_row0(cidx);
            __syncthreads();
            { const bf16_t* tb_ = KT + (size_t)(h * 128) * MT + rw0; const u32x4 t0 = *(const u32x4*)(tb_ + so_t), t1 = *(const u32x4*)(tb_ + so_t + 32u);
              const bf16_t* vb_ = VT + (size_t)(h * 256 + 32 * w) * MT + rw0; const u32x4 v0 = *(const u32x4*)(vb_ + so_v), v1 = *(const u32x4*)(vb_ + so_v + 8u), v2 = *(const u32x4*)(vb_ + so_v + 16u), v3 = *(const u32x4*)(vb_ + so_v + 24u);
              const float wt = tid < 64 ? (GX + 2 * GX_STRIDE + gb + rw0)[tid] : 0.f;
              *(LAS u32x4*)(lds + PC_KT + (tid >> 2) * 144 + (tid & 3) * 16) = t0; *(LAS u32x4*)(lds + PC_KT + (tid >> 2) * 144 + (tid & 3) * 16 + 64) = t1;
              LAS unsigned char* vb2 = VSw + (lane >> 1) * 144 + (lane & 1) * 64; *(LAS u32x4*)vb2 = v0; *(LAS u32x4*)(vb2 + 16) = v1; *(LAS u32x4*)(vb2 + 32) = v2; *(LAS u32x4*)(vb2 + 48) = v3;
              if (tid < 64) WT[128 + tid] = wt; }
            __syncthreads();
            const float dec = DEC[(dir * 8 + h) * 260 + cidx];
#pragma unroll
            for (int i = 0; i < 4; ++i) X[i] *= dec;
#pragma unroll
            for (int ks = 0; ks < 4; ++ks) {
                const u32x4 vr = *(const LAS u32x4*)(VSw + l31 * 144 + 32 * ks + 16 * hh);
                const f32x4 wa = *(const LAS f32x4*)(WT + 128 + 16 * ks + 8 * hh), wb = *(const LAS f32x4*)(WT + 128 + 16 * ks + 8 * hh + 4);
                u32x4 vs; vs.x = pk_bf16(bflo(vr.x) * wa[0], bfhi(vr.x) * wa[1]); vs.y = pk_bf16(bflo(vr.y) * wa[2], bfhi(vr.y) * wa[3]);
                vs.z = pk_bf16(bflo(vr.z) * wb[0], bfhi(vr.z) * wb[1]); vs.w = pk_bf16(bflo(vr.w) * wb[2], bfhi(vr.w) * wb[3]);
                const bf16x8 bfr = __builtin_bit_cast(bf16x8, vs);
#pragma unroll
                for (int i = 0; i < 4; ++i) { const u32x4 ar = *(const LAS u32x4*)(lds + PC_KT + (32 * i + l31) * 144 + 32 * ks + 16 * hh);
                    X[i] = __builtin_amdgcn_mfma_f32_32x32x16_bf16(__builtin_bit_cast(bf16x8, ar), bfr, X[i], 0, 0, 0); }
            }
            if (tid < 128) { float a = 0.f;
#pragma unroll
                for (int q = 0; q < 8; ++q) { const u32x4 kr = *(const LAS u32x4*)(lds + PC_KT + tid * 144 + 16 * q);
                    const f32x4 wa = *(const LAS f32x4*)(WT + 128 + 8 * q), wb = *(const LAS f32x4*)(WT + 128 + 8 * q + 4);
                    a = fmaf(wa[0], bflo(kr.x), a); a = fmaf(wa[1], bfhi(kr.x), a); a = fmaf(wa[2], bflo(kr.y), a); a = fmaf(wa[3], bfhi(kr.y), a);
                    a = fmaf(wb[0], bflo(kr.z), a); a = fmaf(wb[1], bfhi(kr.z), a); a = fmaf(wb[2], bflo(kr.w), a); a = fmaf(wb[3], bfhi(kr.w), a); }
                nacc = dec * nacc + a; }
        }
        float* dst = CST + (size_t)((sc * 16 + hd) * 8 + w) * 4096;
#pragma unroll
        for (int i = 0; i < 4; ++i)
#pragma unroll
            for (int q = 0; q < 16; ++q) dst[(i * 16 + q) * 64 + lane] = X[i][q];
        if (tid < 128) NST[(size_t)(sc * 16 + hd) * 128 + tid] = nacc;
    }
    __syncthreads();
}
__device__ __forceinline__ void phase_l1_merge(const Params& p) {
    const int tid = otid(), wv = tid >> 6, lane = tid & 63;
    const bf16_t* HF = (const bf16_t*)(p.ws + OFF_A); const bf16_t* HB = (const bf16_t*)(p.ws + OFF_X); const bf16_t* Ob = (const bf16_t*)(p.ws + L1_OFF_OB);
    bf16_t* OUT = (bf16_t*)(p.ws + OFF_QK);
    const float* nw = p.in[I_MLNW];
    for (int t = blockIdx.x * 8 + wv; t < TL; t += gridDim.x * 8) {
#pragma unroll
        for (int pc = 0; pc < 4; ++pc) { const int e = pc * 512 + lane * 8;
            const u32x4 a = *(const u32x4*)(HF + (size_t)t * 2048 + e), b = *(const u32x4*)(HB + (size_t)t * 2048 + e), o = *(const u32x4*)(Ob + (size_t)t * 2048 + e);
            float hv[8] = {bflo(a.x) + bflo(b.x), bfhi(a.x) + bfhi(b.x), bflo(a.y) + bflo(b.y), bfhi(a.y) + bfhi(b.y), bflo(a.z) + bflo(b.z), bfhi(a.z) + bfhi(b.z), bflo(a.w) + bflo(b.w), bfhi(a.w) + bfhi(b.w)};
            const float ov[8] = {bflo(o.x), bfhi(o.x), bflo(o.y), bfhi(o.y), bflo(o.z), bfhi(o.z), bflo(o.w), bfhi(o.w)};
            float s = 0.f;
#pragma unroll
            for (int j = 0; j < 8; ++j) s += hv[j];
#pragma unroll
            for (int of = 16; of > 0; of >>= 1) s += __shfl_xor(s, of);
            const float mu = s * (1.0f / 256.0f);
            float q = 0.f;
#pragma unroll
            for (int j = 0; j < 8; ++j) { const float d = hv[j] - mu; q += d * d; }
#pragma unroll
            for (int of = 16; of > 0; of >>= 1) q += __shfl_xor(q, of);
            const float rs = rsqrtf(q * (1.0f / 256.0f) + LN_EPS);
            float wn[8], r8[8]; ld8(nw + e, wn);
#pragma unroll
            for (int j = 0; j < 8; ++j) { const float hn = bf2f(f2bf((hv[j] - mu) * rs * wn[j])); r8[j] = hn * sigmoid_f(ov[j]); }
#if F8_L1O
            *(u32x2*)((unsigned char*)OUT + (size_t)t * 2048 + e) = (u32x2){fp8x4(clamp8(r8[0] * G8_XS), clamp8(r8[1] * G8_XS), clamp8(r8[2] * G8_XS), clamp8(r8[3] * G8_XS)), fp8x4(clamp8(r8[4] * G8_XS), clamp8(r8[5] * G8_XS), clamp8(r8[6] * G8_XS), clamp8(r8[7] * G8_XS))}; }
#else
            st8bf(OUT + (size_t)t * 2048 + e, r8); }
#endif
    }
}
__global__ void __launch_bounds__(NTHREADS, 2) hybrid_fwd_megakernel(Params p) {
    extern __shared__ __attribute__((aligned(16))) unsigned char smem_raw[];
    LAS unsigned char* lds = (LAS unsigned char*)smem_raw;
    volatile LAS unsigned* bst = (volatile LAS unsigned*)(lds + LDS_BYTES - 16);
    if (threadIdx.x < 4) bst[threadIdx.x] = 0u;
    __syncthreads();
    XcdBarrier bar = xcd_barrier_post((unsigned*)(p.ws + OFF_BAR), bst);
#define ws (get_ws())
#define Abuf ((bf16_t*)(ws + OFF_A))
    phase0(fresh(p), lds, P0_T0, P0_T2);
    phase0(fresh(p), lds, P0_T4, P0_T5);
    phase0(fresh(p), lds, P0_T5, P0_T6);
    phase0(fresh(p), lds, P0_T6, P0_T7);
    phase0(fresh(p), lds, P0_T7, P0_NT);
    xcd_barrier(bar);
    modulate_rows(p.in[I_X], p.in[I_CTX], (const float*)(ws + OFF_MOD), Abuf, ws + OFF_X);
    hyena_taps(fresh(p));
    xcd_barrier(bar);
    {
        unsigned char* w_ = ws;
#if F8_L0NA
        {
            pg8::Sched2<pg8::EpiBf16, 2> S{(const char*)(w_ + OFF_W0T), (const char*)(w_ + OFF_A), 12, 65, nullptr, nullptr, 0, 0, (int)gridDim.x, (int)blockIdx.x};
            pg8::EpiS2<pg8::EpiBf16> E{pg8::EpiBf16{(bf16_t*)(w_ + OFF_BIG2), MT}, pg8::EpiBf16{(bf16_t*)(w_ + OFF_QK), 2048}};
            pg8::gemm_stream<pg8::EpiS2<pg8::EpiBf16>, pg8::Sched2<pg8::EpiBf16, 2>, false>(lds, 2048, S, E); __syncthreads(); }
        {
            const char* w8 = (const char*)(w_ + OFF_W0T + (size_t)3072 * 4096); const char* u8 = (const char*)(w_ + OFF_X);
            pg8::Sched2<pg8::EpiBf16, 1> S{w8, u8, 4, 65, u8, w8 + (size_t)1024 * 2048, 65, 8, (int)gridDim.x, (int)gridDim.x - 1 - (int)blockIdx.x};
            pg8::EpiS2<pg8::EpiBf16> E{pg8::EpiBf16{(bf16_t*)(w_ + OFF_BIG2) + (size_t)3072 * MT, MT}, pg8::EpiBf16{(bf16_t*)(w_ + OFF_QK), 2048}};
            pg8::gemm_stream<pg8::EpiS2<pg8::EpiBf16>, pg8::Sched2<pg8::EpiBf16, 1>, true>(lds, 2048, S, E); __syncthreads(); }
#else
        constexpr int ES = F8_L0 ? 1 : 2;
        pg8::Sched2<pg8::EpiBf16, ES> S{(const char*)(w_ + OFF_W0T), (const char*)(w_ + OFF_A), 16, 65, (const char*)(w_ + OFF_A), (const char*)(w_ + OFF_W0T) + (size_t)4096 * 2048 * ES, 65, 8, (int)gridDim.x, (int)blockIdx.x};
        pg8::EpiS2<pg8::EpiBf16> E{pg8::EpiBf16{(bf16_t*)(w_ + OFF_BIG2), MT}, pg8::EpiBf16{(bf16_t*)(w_ + OFF_QK), 2048}};
        pg8::gemm_stream<pg8::EpiS2<pg8::EpiBf16>, pg8::Sched2<pg8::EpiBf16, ES>, ES == 1>(lds, 2048, S, E); __syncthreads();
#endif
    }
    xcd_barrier(bar);
    phase3(fresh(p), lds);
    xcd_barrier(bar);
    phase4(fresh(p), lds);
    xcd_barrier(bar);
    {
        unsigned char* w_ = ws;
        pg8::SchedTail S{(const char*)(w_ + OFF_A), (const char*)(w_ + OFF_WO0T), 64, 8, true, (int)gridDim.x, (int)blockIdx.x};
        pg8::EpiTail<true, pg8::EpiBf16> E{pg8::EpiBf16{(bf16_t*)(w_ + OFF_BIG2), 2048}, (float*)(w_ + OFF_X)};
        pg8::gemm_stream(lds, 2048, S, E); __syncthreads();
    }
    phase0(fresh(p), lds, P0_T2, P0_T4, 8);
    xcd_barrier(bar);
    phase_ln1(fresh(p), 0, MT, (const float*)(ws + OFF_X));
    xcd_barrier(bar);
    {
        unsigned char* w_ = ws;
        pg8::SchedTail S{(const char*)(w_ + OFF_WQK), (const char*)(w_ + OFF_A), 8, 64, false, (int)gridDim.x, (int)blockIdx.x};
        pg8::EpiTail<false, pg8::EpiF32> E{pg8::EpiF32{(float*)(w_ + OFF_BIG1), MT}, (float*)(w_ + OFF_X)};
        pg8::gemm_stream(lds, 2048, S, E); __syncthreads();
    }
    xcd_barrier(bar);
    phase_topk(fresh(p), lds, MT, (const float*)(ws + OFF_X));
    xcd_barrier(bar);
    phase_peer(fresh(p), lds, 0, MT);
    xcd_barrier(bar);
    {
        unsigned char* w_ = ws;
        constexpr int ES = F8_L1 ? 1 : 2;
        const char* u1 = (const char*)(w_ + (F8_L1 ? OFF_X : OFF_A));
        pg8::Sched2<pg8::EpiL1, ES> S{(const char*)(w_ + OFF_W1T), u1, 8, 65, u1, (const char*)(w_ + OFF_W1T) + (size_t)2048 * 2048 * ES, 65, 17, (int)gridDim.x, (int)blockIdx.x};
        pg8::EpiS2<pg8::EpiL1> E{pg8::EpiBf16{(bf16_t*)(w_ + OFF_BIG2), MT}, pg8::EpiL1{(bf16_t*)(w_ + OFF_QK), (bf16_t*)(w_ + L1_OFF_OB), (float*)(w_ + OFF_GATE)}};
        pg8::gemm_stream<pg8::EpiS2<pg8::EpiL1>, pg8::Sched2<pg8::EpiL1, ES>, ES == 1>(lds, 2048, S, E); __syncthreads();
    }
    xcd_barrier(bar);
    phase_l1_prep(fresh(p), lds);
    xcd_barrier(bar);
    phase_l1_passA2(fresh(p), lds);
    xcd_barrier(bar);
    phase_l1_passB(fresh(p));
    xcd_barrier(bar);
    phase_l1_passC(fresh(p), lds);
    xcd_barrier(bar);
    phase_l1_merge(fresh(p));
    xcd_barrier(bar);
#if F8_L1O
    {   unsigned char* w_ = ws;
        pg8::Sched1<1> S{(const char*)(w_ + OFF_QK), (const char*)(w_ + OFF_WO1T), TL / 256, 8, (int)gridDim.x, (int)blockIdx.x};
        pg8::EpiG<pg8::EpiBf16> E{pg8::EpiBf16{(bf16_t*)(w_ + OFF_BIG2), 2048}};
        pg8::gemm_stream<pg8::EpiG<pg8::EpiBf16>, pg8::Sched1<1>, true>(lds, 2048, S, E); __syncthreads();
    }
#else
    run_gemm(lds, (const bf16_t*)(ws + OFF_QK), (const bf16_t*)(ws + OFF_WO1T), TL, 2048, 2048, pg8::EpiBf16{(bf16_t*)(ws + OFF_BIG2), 2048});
#endif
    xcd_barrier(bar);
    phase_ln1(fresh(p), 1, TL, nullptr);
    xcd_barrier(bar);
    run_gemm(lds, (const bf16_t*)(ws + OFF_WQK) + (size_t)2048 * 2048, Abuf, 2048, TL, 2048, pg8::EpiF32{(float*)(ws + OFF_BIG1), MT});
    xcd_barrier(bar);
    phase_topk(fresh(p), lds, TL, nullptr);
    xcd_barrier(bar);
    phase_peer(fresh(p), lds, 1, TL);
#undef ws
#undef Abuf
}

extern "C" void kernel_launch(void* const* d_in, const int* in_sizes, int n_in, void* d_out, int out_size, void* d_ws, size_t ws_size, hipStream_t stream) {
    static int grid = 0;
    if (grid == 0) {
        int dev = 0, cus = 0;
        if (hipGetDevice(&dev) != hipSuccess || hipDeviceGetAttribute(&cus, hipDeviceAttributeMultiprocessorCount, dev) != hipSuccess) { fprintf(stderr, "kernel_launch: device query failed\n"); grid = -1; return; }
        if (hipFuncSetAttribute((const void*)hybrid_fwd_megakernel, hipFuncAttributeMaxDynamicSharedMemorySize, LDS_BYTES) != hipSuccess) { fprintf(stderr, "kernel_launch: hipFuncSetAttribute failed\n"); grid = -1; return; }
        int per_cu = 0;
        if (hipOccupancyMaxActiveBlocksPerMultiprocessor(&per_cu, (const void*)hybrid_fwd_megakernel, NTHREADS, LDS_BYTES) != hipSuccess || per_cu < 1) { fprintf(stderr, "kernel_launch: occupancy query says %d blocks/CU\n", per_cu); (void)hipGetLastError(); }
        if (n_in != 32 || ws_size < WS_END) { fprintf(stderr, "kernel_launch: unexpected n_in %d / ws_size %zu (need %zu)\n", n_in, ws_size, (size_t)WS_END); grid = -1; return; }
        grid = cus;
    }
    if (grid < 0) return;
    (void)hipMemsetAsync((char*)d_ws + OFF_BAR, 0, 16384, stream);
    Params prm{};
    for (int i = 0; i < 32; ++i) prm.in[i] = (const float*)d_in[i];
    prm.out = (float*)d_out; prm.ws = (unsigned char*)d_ws;
    void* args[] = {&prm};
    hipError_t e = hipLaunchCooperativeKernel((const void*)hybrid_fwd_megakernel, dim3(grid), dim3(NTHREADS), args, LDS_BYTES, stream);
    if (e != hipSuccess) fprintf(stderr, "kernel_launch: cooperative launch failed: %s (grid %d)\n", hipGetErrorString(e), grid);
}
```
